# Optimizing an MI355X kernel written in HIP

```python
import math
import jax, jax.numpy as jnp
from jax import lax
import numpy as np

D_MODEL = 2048
BATCH = 8
SEQ = 2048
DEPTH = 2

MEM_LEN = 256
EPS = 1e-6
NEG_INF = -1e30
Q_BLOCK = 128

FOX_HEADS = 8
FOX_HEAD_DIM = 128
FORGET_BIAS_OFFSET = 2.0

MLA_HEADS = 8
MLA_NOPE_DIM = 128
MLA_ROPE_DIM = 64
MLA_V_DIM = 128
MLA_Q_RANK = 768
MLA_KV_RANK = 512
ROPE_THETA = 10000.0

NSA_HEADS = 8
NSA_GROUPS = 2
NSA_HPG = NSA_HEADS // NSA_GROUPS
NSA_DK = 192
NSA_DV = 128
CMP_BLOCK = 32
CMP_STRIDE = 16
SEL_BLOCK = 64
N_SEL = 8
WINDOW = 512
SEL_FORCE = 1e6

REL_BUCKETS = 32
REL_MAX_DIST = 128

N_BRANCH = 3
BRANCH_W = FOX_HEADS * FOX_HEAD_DIM

MEM_HEADS = 4
MEM_HEAD_DIM = 128

N_GROUPS = 4
EXPERTS_PER_GROUP = 8
N_EXPERTS = N_GROUPS * EXPERTS_PER_GROUP
TOP_K_IN_GROUP = 2
D_EXPERT = 1024
MOE_ROW_BLOCK = 128

IN_SPLITS = (
    FOX_HEADS * FOX_HEAD_DIM,
    FOX_HEADS * FOX_HEAD_DIM,
    FOX_HEADS * FOX_HEAD_DIM,
    FOX_HEADS,
    MLA_Q_RANK,
    MLA_KV_RANK,
    MLA_ROPE_DIM,
    NSA_HEADS * NSA_DK,
    NSA_GROUPS * NSA_DK,
    NSA_GROUPS * NSA_DV,
    NSA_GROUPS * NSA_DK,
    NSA_GROUPS * NSA_DV,
    NSA_GROUPS * NSA_DK,
    NSA_GROUPS * NSA_DV,
    NSA_HEADS * 3,
    N_BRANCH * D_MODEL,
)
D_IN = sum(IN_SPLITS)

kernel_name = "hybrid_fox_mla_nsa_hmoe_block"


def rmsnorm(x, g):
    xf = x.astype(jnp.float32)
    y = xf * lax.rsqrt(jnp.mean(xf * xf, axis=-1, keepdims=True) + EPS)
    return (y * g.astype(jnp.float32)).astype(x.dtype)


def t5_bucket(dist):
    dist = jnp.maximum(dist, 0)
    exact = REL_BUCKETS // 2
    df = jnp.maximum(dist, 1).astype(jnp.float32)
    large = exact + (jnp.log(df / exact) / math.log(REL_MAX_DIST / exact) * (REL_BUCKETS - exact)).astype(jnp.int32)
    large = jnp.minimum(large, REL_BUCKETS - 1)
    return jnp.where(dist < exact, dist, large)


def rope(x, pos):
    half = x.shape[-1] // 2
    inv = ROPE_THETA ** (-jnp.arange(half, dtype=jnp.float32) / half)
    ang = (pos.astype(jnp.float32)[:, None] * inv).reshape((pos.shape[0],) + (1,) * (x.ndim - 3) + (half,))
    c, s = jnp.cos(ang), jnp.sin(ang)
    xf = x.astype(jnp.float32)
    x1, x2 = xf[..., :half], xf[..., half:]
    return jnp.concatenate([x1 * c - x2 * s, x2 * c + x1 * s], axis=-1).astype(x.dtype)


def causal_block_attention(q, k, v, scale, log_decay=None):
    S = q.shape[1]
    outs = []
    for i in range(S // Q_BLOCK):
        q0, q1 = i * Q_BLOCK, (i + 1) * Q_BLOCK
        s = jnp.einsum("bqhd,bkhd->bhqk", q[:, q0:q1], k[:, :q1], preferred_element_type=jnp.float32) * scale
        if log_decay is not None:
            fq = jnp.transpose(log_decay[:, q0:q1], (0, 2, 1))[:, :, :, None]
            fk = jnp.transpose(log_decay[:, :q1], (0, 2, 1))[:, :, None, :]
            s = s + (fq - fk)
        mask = jnp.arange(q0, q1)[:, None] >= jnp.arange(q1)[None, :]
        s = jnp.where(mask, s, NEG_INF)
        p = jax.nn.softmax(s, axis=-1).astype(v.dtype)
        outs.append(jnp.einsum("bhqk,bkhd->bqhd", p, v[:, :q1]))
    return jnp.concatenate(outs, axis=1)


def fox_mixer(zq, zk, zv, zf, b_f):
    B, S, _ = zq.shape
    q = zq.reshape(B, S, FOX_HEADS, FOX_HEAD_DIM)
    k = zk.reshape(B, S, FOX_HEADS, FOX_HEAD_DIM)
    v = zv.reshape(B, S, FOX_HEADS, FOX_HEAD_DIM)
    log_f = jax.nn.log_sigmoid(zf.astype(jnp.float32) + b_f.astype(jnp.float32))
    cum = jnp.cumsum(log_f, axis=1)
    o = causal_block_attention(q, k, v, FOX_HEAD_DIM ** -0.5, cum)
    return o.reshape(B, S, FOX_HEADS * FOX_HEAD_DIM)


def mla_mixer(zcq, zckv, zkr, g_cq, g_ckv, w_uq, w_ukv, pos):
    B, S, _ = zcq.shape
    q = (rmsnorm(zcq, g_cq) @ w_uq).reshape(B, S, MLA_HEADS, MLA_NOPE_DIM + MLA_ROPE_DIM)
    kv = (rmsnorm(zckv, g_ckv) @ w_ukv).reshape(B, S, MLA_HEADS, MLA_NOPE_DIM + MLA_V_DIM)
    q_nope, q_rope = q[..., :MLA_NOPE_DIM], q[..., MLA_NOPE_DIM:]
    k_nope, v = kv[..., :MLA_NOPE_DIM], kv[..., MLA_NOPE_DIM:]
    k_rope = rope(zkr, pos)
    q = jnp.concatenate([q_nope, rope(q_rope, pos)], axis=-1)
    k = jnp.concatenate([k_nope, jnp.broadcast_to(k_rope[:, :, None, :], (B, S, MLA_HEADS, MLA_ROPE_DIM))], axis=-1)
    o = causal_block_attention(q, k, v, (MLA_NOPE_DIM + MLA_ROPE_DIM) ** -0.5)
    return o.reshape(B, S, MLA_HEADS * MLA_V_DIM)


def nsa_mixer(zq, zkc, zvc, zks, zvs, zkw, zvw, zg, pe_k, pe_v, w_ck1, w_ck2, w_cv1, w_cv2, rel_bias):
    B, S, _ = zq.shape
    G, Hg = NSA_GROUPS, NSA_HPG
    dt = zq.dtype
    scale = NSA_DK ** -0.5
    q = zq.reshape(B, S, G, Hg, NSA_DK)
    kc_raw = zkc.reshape(B, S, G, NSA_DK)
    vc_raw = zvc.reshape(B, S, G, NSA_DV)
    ks = zks.reshape(B, S, G, NSA_DK)
    vs = zvs.reshape(B, S, G, NSA_DV)
    kw = zkw.reshape(B, S, G, NSA_DK)
    vw = zvw.reshape(B, S, G, NSA_DV)
    t = jnp.arange(S)
    tab = jnp.transpose(rel_bias.reshape(REL_BUCKETS, G, Hg), (1, 0, 2))

    n_cmp = (S - CMP_BLOCK) // CMP_STRIDE + 1
    cidx = CMP_STRIDE * jnp.arange(n_cmp)[:, None] + jnp.arange(CMP_BLOCK)[None, :]

    def compress(raw, pe, w1, w2):
        d = raw.shape[-1]
        blk = raw[:, cidx] + pe[:, None, :]
        blk = jnp.transpose(blk, (0, 1, 3, 2, 4)).reshape(B, n_cmp, G, CMP_BLOCK * d)
        return jax.nn.gelu(blk @ w1) @ w2

    kc = compress(kc_raw, pe_k, w_ck1, w_ck2)
    vc = compress(vc_raw, pe_v, w_cv1, w_cv2)
    dist_c = t[:, None] - cidx[:, -1][None, :]
    valid_c = dist_c >= 0
    bias_c = jnp.transpose(tab[:, t5_bucket(dist_c)], (0, 3, 1, 2))
    s = jnp.einsum("bsghd,bcgd->bghsc", q, kc, preferred_element_type=jnp.float32) * scale + bias_c[None]
    s = jnp.where(valid_c, s, NEG_INF)
    p_c = jnp.where(valid_c, jax.nn.softmax(s, axis=-1), 0.0)
    o_cmp = jnp.einsum("bghsc,bcgd->bsghd", p_c.astype(dt), vc)

    n_blk = S // SEL_BLOCK
    sstart = SEL_BLOCK * jnp.arange(n_blk)
    overlap = jnp.clip(jnp.minimum(cidx[:, -1][:, None] + 1, sstart[None, :] + SEL_BLOCK)
                       - jnp.maximum(cidx[:, 0][:, None], sstart[None, :]), 0, None).astype(jnp.float32) / CMP_STRIDE
    imp = jnp.einsum("bghsc,cn->bgsn", p_c, overlap)
    cur = t // SEL_BLOCK
    blk_id = jnp.arange(n_blk)
    valid_b = blk_id[None, :] <= cur[:, None]
    forced = (blk_id[None, :] == 0) | (blk_id[None, :] == cur[:, None]) | (blk_id[None, :] == cur[:, None] - 1)
    score = jnp.where(valid_b, imp + jnp.where(forced, SEL_FORCE, 0.0), NEG_INF)
    n_sel = min(N_SEL, n_blk)
    _, sel = lax.top_k(score, n_sel)
    sel = jnp.transpose(sel, (0, 2, 1, 3))

    kw_pad = jnp.pad(kw, ((0, 0), (WINDOW, 0), (0, 0), (0, 0)))
    vw_pad = jnp.pad(vw, ((0, 0), (WINDOW, 0), (0, 0), (0, 0)))
    b_ix = jnp.arange(B)[:, None, None, None]
    g_ix = jnp.arange(G)[None, None, :, None]

    def block(i):
        q0 = i * Q_BLOCK
        qb = lax.dynamic_slice_in_dim(q, q0, Q_BLOCK, axis=1)
        tq = q0 + jnp.arange(Q_BLOCK)
        sb = lax.dynamic_slice_in_dim(sel, q0, Q_BLOCK, axis=1)
        tok = (sb[..., None] * SEL_BLOCK + jnp.arange(SEL_BLOCK)).reshape(B, Q_BLOCK, G, n_sel * SEL_BLOCK)
        k_g = ks[b_ix, tok, g_ix]
        v_g = vs[b_ix, tok, g_ix]
        dist = tq[None, :, None, None] - tok
        bias = jnp.transpose(tab[g_ix, t5_bucket(dist)], (0, 1, 2, 4, 3))
        s1 = jnp.einsum("bqghd,bqgkd->bqghk", qb, k_g, preferred_element_type=jnp.float32) * scale + bias
        s1 = jnp.where((dist >= 0)[:, :, :, None, :], s1, NEG_INF)
        o_s = jnp.einsum("bqghk,bqgkd->bqghd", jax.nn.softmax(s1, axis=-1).astype(dt), v_g)
        kwb = lax.dynamic_slice_in_dim(kw_pad, q0, Q_BLOCK + WINDOW, axis=1)
        vwb = lax.dynamic_slice_in_dim(vw_pad, q0, Q_BLOCK + WINDOW, axis=1)
        sk = q0 - WINDOW + jnp.arange(Q_BLOCK + WINDOW)
        dw = tq[:, None] - sk[None, :]
        wmask = (dw >= 0) & (dw < WINDOW) & (sk[None, :] >= 0)
        bias_w = jnp.transpose(tab[:, t5_bucket(dw)], (1, 0, 3, 2))
        s2 = jnp.einsum("bqghd,bkgd->bqghk", qb, kwb, preferred_element_type=jnp.float32) * scale + bias_w[None]
        s2 = jnp.where(wmask[:, None, None, :], s2, NEG_INF)
        o_w = jnp.einsum("bqghk,bkgd->bqghd", jax.nn.softmax(s2, axis=-1).astype(dt), vwb)
        return o_s, o_w

    o_slc, o_win = lax.map(block, jnp.arange(S // Q_BLOCK))
    o_slc = jnp.transpose(o_slc, (1, 0, 2, 3, 4, 5)).reshape(B, S, G, Hg, NSA_DV)
    o_win = jnp.transpose(o_win, (1, 0, 2, 3, 4, 5)).reshape(B, S, G, Hg, NSA_DV)
    gates = jax.nn.sigmoid(zg.astype(jnp.float32)).reshape(B, S, G, Hg, 3).astype(dt)
    o = gates[..., 0:1] * o_cmp + gates[..., 1:2] * o_slc + gates[..., 2:3] * o_win
    return o.reshape(B, S, NSA_HEADS * NSA_DV)


def memory_attention(u, mem_n, w_q, w_kv, w_o):
    B, S, _ = u.shape
    M = mem_n.shape[1]
    q = (u @ w_q).reshape(B, S, MEM_HEADS, MEM_HEAD_DIM)
    kv = (mem_n @ w_kv).reshape(B, M, 2, MEM_HEADS, MEM_HEAD_DIM)
    s = jnp.einsum("bshd,bmhd->bhsm", q, kv[:, :, 0], preferred_element_type=jnp.float32) * MEM_HEAD_DIM ** -0.5
    p = jax.nn.softmax(s, axis=-1).astype(u.dtype)
    o = jnp.einsum("bhsm,bmhd->bshd", p, kv[:, :, 1]).reshape(B, S, MEM_HEADS * MEM_HEAD_DIM)
    return o @ w_o


def hier_moe(u, w_rg, b_rg, w_re, b_re, w_g, w_u, w_d):
    B, S, D = u.shape
    T = B * S
    xt = u.reshape(T, D)
    glog = (xt @ w_rg).astype(jnp.float32) + b_rg.astype(jnp.float32)
    gprob = jax.nn.softmax(glog, axis=-1)
    gsel = jnp.argmax(glog, axis=-1).astype(jnp.int32)
    pg = jnp.max(gprob, axis=-1, keepdims=True)
    elog = ((xt @ w_re).astype(jnp.float32) + b_re.astype(jnp.float32)).reshape(T, N_GROUPS, EXPERTS_PER_GROUP)
    elog = jnp.take_along_axis(elog, gsel[:, None, None], axis=1)[:, 0]
    top_p, top_j = lax.top_k(jax.nn.softmax(elog, axis=-1), TOP_K_IN_GROUP)
    top_p = top_p / jnp.sum(top_p, axis=-1, keepdims=True)
    weight = (pg * top_p).astype(u.dtype)
    eid = gsel[:, None] * EXPERTS_PER_GROUP + top_j.astype(jnp.int32)
    TK = T * TOP_K_IN_GROUP
    flat_e = eid.reshape(-1)
    flat_tok = jnp.repeat(jnp.arange(T, dtype=jnp.int32), TOP_K_IN_GROUP)
    flat_w = weight.reshape(-1)
    order = jnp.argsort(flat_e)
    sorted_e = flat_e[order]
    counts = jnp.bincount(flat_e, length=N_EXPERTS)
    starts = jnp.cumsum(counts) - counts
    pcounts = ((counts + MOE_ROW_BLOCK - 1) // MOE_ROW_BLOCK) * MOE_ROW_BLOCK
    pends = jnp.cumsum(pcounts)
    pstarts = pends - pcounts
    dest = pstarts[sorted_e] + (jnp.arange(TK) - starts[sorted_e])
    P = TK + N_EXPERTS * MOE_ROW_BLOCK
    n_rb = P // MOE_ROW_BLOCK
    row_tok = jnp.full((P,), T, jnp.int32).at[dest].set(flat_tok[order])
    row_w = jnp.zeros((P,), u.dtype).at[dest].set(flat_w[order])
    blk_e = jnp.clip(jnp.searchsorted(pends, jnp.arange(n_rb) * MOE_ROW_BLOCK, side="right"), 0, N_EXPERTS - 1)
    x_pad = jnp.concatenate([xt, jnp.zeros((1, D), xt.dtype)], axis=0)
    xr = x_pad[row_tok].reshape(n_rb, MOE_ROW_BLOCK, D)

    def expert_block(args):
        xb, e = args
        hdn = jax.nn.silu(xb @ w_g[e]) * (xb @ w_u[e])
        return hdn @ w_d[e]

    y = lax.map(expert_block, (xr, blk_e)).reshape(P, D)
    out = jnp.zeros((T + 1, D), u.dtype).at[row_tok].add(y * row_w[:, None])[:T]
    return out.reshape(B, S, D)


def setup_inputs(seed: int = 0) -> dict:
    key = jax.random.key(seed)
    ks = jax.random.split(key, 32)
    L = DEPTH

    def nrm(k, shape, scale):
        return jax.random.normal(k, shape, jnp.float32) * scale

    def gain(k, shape):
        return 1.0 + nrm(k, shape, 0.01)

    return {
        "x": nrm(ks[0], (BATCH, SEQ, D_MODEL), 1.0),
        "mem": nrm(ks[1], (BATCH, MEM_LEN, D_MODEL), 1.0),
        "g_mix": gain(ks[2], (L, D_MODEL)),
        "w_in": nrm(ks[3], (L, D_MODEL, D_IN), D_MODEL ** -0.5),
        "b_forget": FORGET_BIAS_OFFSET + nrm(ks[4], (L, FOX_HEADS), 0.1),
        "g_cq": gain(ks[5], (L, MLA_Q_RANK)),
        "g_ckv": gain(ks[6], (L, MLA_KV_RANK)),
        "w_uq": nrm(ks[7], (L, MLA_Q_RANK, MLA_HEADS * (MLA_NOPE_DIM + MLA_ROPE_DIM)), MLA_Q_RANK ** -0.5),
        "w_ukv": nrm(ks[8], (L, MLA_KV_RANK, MLA_HEADS * (MLA_NOPE_DIM + MLA_V_DIM)), MLA_KV_RANK ** -0.5),
        "pe_k": nrm(ks[9], (L, CMP_BLOCK, NSA_DK), 0.1),
        "pe_v": nrm(ks[10], (L, CMP_BLOCK, NSA_DV), 0.1),
        "w_cmp_k1": nrm(ks[11], (L, CMP_BLOCK * NSA_DK, NSA_DK), (CMP_BLOCK * NSA_DK) ** -0.5),
        "w_cmp_k2": nrm(ks[12], (L, NSA_DK, NSA_DK), NSA_DK ** -0.5),
        "w_cmp_v1": nrm(ks[13], (L, CMP_BLOCK * NSA_DV, NSA_DV), (CMP_BLOCK * NSA_DV) ** -0.5),
        "w_cmp_v2": nrm(ks[14], (L, NSA_DV, NSA_DV), NSA_DV ** -0.5),
        "rel_bias": nrm(ks[15], (REL_BUCKETS, NSA_HEADS), 0.5),
        "w_branch": nrm(ks[16], (L, N_BRANCH, BRANCH_W, D_MODEL), BRANCH_W ** -0.5),
        "w_out": nrm(ks[17], (L, D_MODEL, D_MODEL), D_MODEL ** -0.5),
        "g_mem_q": gain(ks[18], (L, D_MODEL)),
        "g_mem_kv": gain(ks[19], (L, D_MODEL)),
        "w_mem_q": nrm(ks[20], (L, D_MODEL, MEM_HEADS * MEM_HEAD_DIM), D_MODEL ** -0.5),
        "w_mem_kv": nrm(ks[21], (L, D_MODEL, 2 * MEM_HEADS * MEM_HEAD_DIM), D_MODEL ** -0.5),
        "w_mem_o": nrm(ks[22], (L, MEM_HEADS * MEM_HEAD_DIM, D_MODEL), (MEM_HEADS * MEM_HEAD_DIM) ** -0.5),
        "g_moe": gain(ks[23], (L, D_MODEL)),
        "w_router_group": nrm(ks[24], (L, D_MODEL, N_GROUPS), D_MODEL ** -0.5),
        "b_router_group": nrm(ks[25], (L, N_GROUPS), 0.01),
        "w_router_expert": nrm(ks[26], (L, D_MODEL, N_EXPERTS), D_MODEL ** -0.5),
        "b_router_expert": nrm(ks[27], (L, N_EXPERTS), 0.01),
        "w_exp_gate": nrm(ks[28], (L, N_EXPERTS, D_MODEL, D_EXPERT), D_MODEL ** -0.5),
        "w_exp_up": nrm(ks[29], (L, N_EXPERTS, D_MODEL, D_EXPERT), D_MODEL ** -0.5),
        "w_exp_down": nrm(ks[30], (L, N_EXPERTS, D_EXPERT, D_MODEL), D_EXPERT ** -0.5),
        "g_final": gain(ks[31], (D_MODEL,)),
    }


def reference(x, mem, g_mix, w_in, b_forget, g_cq, g_ckv, w_uq, w_ukv, pe_k, pe_v, w_cmp_k1, w_cmp_k2,
              w_cmp_v1, w_cmp_v2, rel_bias, w_branch, w_out, g_mem_q, g_mem_kv, w_mem_q, w_mem_kv, w_mem_o,
              g_moe, w_router_group, b_router_group, w_router_expert, b_router_expert, w_exp_gate, w_exp_up,
              w_exp_down, g_final):
    B, S, D = x.shape
    pos = jnp.arange(S)
    offs = np.cumsum(IN_SPLITS)[:-1].tolist()
    h = x
    for l in range(DEPTH):
        u = rmsnorm(h, g_mix[l])
        z = u @ w_in[l]
        (fq, fk, fv, ff, mcq, mckv, mkr, nq, nkc, nvc, nks, nvs, nkw, nvw, ngt, mgate) = jnp.split(z, offs, axis=-1)
        o_fox = fox_mixer(fq, fk, fv, ff, b_forget[l])
        o_mla = mla_mixer(mcq, mckv, mkr, g_cq[l], g_ckv[l], w_uq[l], w_ukv[l], pos)
        o_nsa = nsa_mixer(nq, nkc, nvc, nks, nvs, nkw, nvw, ngt, pe_k[l], pe_v[l], w_cmp_k1[l], w_cmp_k2[l],
                          w_cmp_v1[l], w_cmp_v2[l], rel_bias)
        o = jnp.stack([o_fox, o_mla, o_nsa], axis=2)
        y = jnp.einsum("bsnc,ncd->bsnd", o, w_branch[l])
        gts = jax.nn.sigmoid(mgate.reshape(B, S, N_BRANCH, D))
        h = h + jnp.sum(gts * y, axis=2) @ w_out[l]
        h = h + memory_attention(rmsnorm(h, g_mem_q[l]), rmsnorm(mem, g_mem_kv[l]), w_mem_q[l], w_mem_kv[l], w_mem_o[l])
        h = h + hier_moe(rmsnorm(h, g_moe[l]), w_router_group[l], b_router_group[l], w_router_expert[l],
                         b_router_expert[l], w_exp_gate[l], w_exp_up[l], w_exp_down[l])
    return rmsnorm(h, g_final)
```

```cpp
#define COMPRESS_REF 1
#define N_LAUNCH_MODE 1
#include <hip/hip_runtime.h>
#include <cstdio>
#include <cstdint>

#define LAS __attribute__((address_space(3)))
#define GAS __attribute__((address_space(1)))
typedef unsigned short bf16;
typedef short bf16x8 __attribute__((ext_vector_type(8)));
typedef short s16x4 __attribute__((ext_vector_type(4)));
typedef short v4i16_t __attribute__((ext_vector_type(4)));
typedef float f32x2 __attribute__((ext_vector_type(2)));
typedef float f32x4 __attribute__((ext_vector_type(4)));
typedef float f32x16 __attribute__((ext_vector_type(16)));
typedef unsigned u32x2 __attribute__((ext_vector_type(2)));
typedef unsigned u32x4 __attribute__((ext_vector_type(4)));
typedef GAS unsigned gu32;

constexpr int DM = 2048, NB = 8, SEQ = 2048, DEPTH = 2, NT = NB * SEQ;
constexpr int MEML = 256;
constexpr float EPS = 1e-6f;
constexpr int D_IN = 14048, ZLD = 14080;
constexpr int ZC_FQ = 0, ZC_FK = 1024, ZC_FV = 2048, ZC_MCQ = 3072, ZC_MCKV = 3840, ZC_MKR = 4352, ZC_NQ = 4416, ZC_NKC = 5952, ZC_NVC = 6336,
              ZC_NKS = 6592, ZC_NVS = 6976, ZC_NKW = 7232, ZC_NVW = 7616, ZC_MG = 7872, ZC_FF = 14016, ZC_NGT = 14024;
constexpr int NEXP = 32, DEXP = 1024, PMAX = 40960;
constexpr float LOG2E = 1.4426950408889634f;

constexpr size_t MiB = 1u << 20;
constexpr size_t al256(size_t x) { return (x + 255) & ~(size_t)255; }
constexpr size_t WS_CTL = 0, CTL_ZERO_BYTES = 1 * MiB;
constexpr size_t WS_WIN  = 1 * MiB;
constexpr size_t WS_WUQ  = WS_WIN  + al256((size_t)ZLD * DM * 2);
constexpr size_t WS_WUKV = WS_WUQ  + al256((size_t)1536 * 768 * 2);
constexpr size_t WS_WCK1 = WS_WUKV + al256((size_t)2048 * 512 * 2);
constexpr size_t WS_WCK2 = WS_WCK1 + al256((size_t)192 * 6144 * 2);
constexpr size_t WS_WCV1 = WS_WCK2 + al256((size_t)192 * 192 * 2);
constexpr size_t WS_WCV2 = WS_WCV1 + al256((size_t)128 * 4096 * 2);
constexpr size_t WS_WBR  = WS_WCV2 + al256((size_t)128 * 128 * 2);
constexpr size_t WS_WOUT = WS_WBR  + al256((size_t)3 * 2048 * 1024 * 2);
constexpr size_t WS_WMQ  = WS_WOUT + al256((size_t)2048 * 2048 * 2);
constexpr size_t WS_WMKV = WS_WMQ  + al256((size_t)512 * 2048 * 2);
constexpr size_t WS_WMO  = WS_WMKV + al256((size_t)1024 * 2048 * 2);
constexpr size_t WS_WR   = WS_WMO  + al256((size_t)2048 * 512 * 2);
constexpr size_t WS_WGU  = WS_WR   + al256((size_t)256 * 2048 * 2);
constexpr size_t WS_WD   = WS_WGU  + al256((size_t)NEXP * 2048 * 2048 * 2);
constexpr size_t WS_ACT  = WS_WD   + al256((size_t)NEXP * 2048 * 1024 * 2);
constexpr size_t WS_HBF  = WS_ACT;
constexpr size_t WS_HF   = WS_HBF  + al256((size_t)NT * DM * 2);
constexpr size_t WS_Z    = WS_HF   + al256((size_t)NT * DM * 4);
constexpr size_t WS_XG   = WS_Z;
constexpr size_t WS_HDN  = WS_XG   + al256((size_t)PMAX * 2048 * 2);
constexpr size_t WS_Y    = WS_HDN  + al256((size_t)PMAX * 1024 * 2);
constexpr size_t WS_ZEND = WS_Z    + al256((size_t)NT * ZLD * 2);
static_assert(WS_Y + (size_t)PMAX * 2048 * 2 <= WS_ZEND, "MoE overlay fits in z");
constexpr size_t WS_ZS   = WS_ZEND;
constexpr size_t WS_ZSSQ = WS_ZS   + al256((size_t)NT * 32 * 4);
constexpr size_t WS_HSSQ = WS_ZSSQ + al256((size_t)NT * 32 * 4);
constexpr size_t WS_RSTD0= WS_HSSQ + al256((size_t)NT * 32 * 4);
constexpr size_t WS_RSTD2= WS_RSTD0+ al256((size_t)NT * 4);
constexpr size_t WS_QM   = WS_RSTD2+ al256((size_t)NT * 4);
constexpr size_t WS_KM   = WS_QM   + al256((size_t)NT * 1536 * 2);
constexpr size_t WS_VM   = WS_KM   + al256((size_t)NT * 1536 * 2);
constexpr size_t WS_KC   = WS_VM   + al256((size_t)NT * 1024 * 2);
constexpr size_t WS_VC   = WS_KC   + al256((size_t)16 * 128 * 192 * 2);
constexpr size_t WS_KB   = WS_VC   + al256((size_t)16 * 128 * 128 * 2);
constexpr size_t WS_O3   = WS_KB   + al256((size_t)64 * 2048 * 4);
constexpr size_t WS_OW   = WS_O3   + al256((size_t)3 * NT * 1024 * 2);
constexpr size_t WS_MPART= WS_OW   + al256((size_t)NT * 1024 * 2);
constexpr size_t WS_MBF  = WS_MPART+ al256((size_t)NT * DM * 4);
constexpr size_t WS_QMEM = WS_MBF  + al256((size_t)NT * DM * 2);
constexpr size_t WS_KVMEM= WS_QMEM + al256((size_t)NT * 512 * 2);
constexpr size_t WS_OMEM = WS_KVMEM+ al256((size_t)2048 * 1024 * 2);
constexpr size_t WS_LOGIT= WS_OMEM + al256((size_t)NT * 512 * 2);
constexpr size_t WS_MEMBF= WS_LOGIT+ al256((size_t)NT * 64 * 4);
constexpr size_t WS_RSTDM= WS_MEMBF+ al256((size_t)2048 * 2048 * 2);
constexpr size_t WS_ROPE = WS_RSTDM+ al256((size_t)2048 * 4);
constexpr size_t WS_TABD = WS_ROPE + al256((size_t)2048 * 64 * 4);
constexpr size_t WS_C1P  = WS_TABD + al256((size_t)8 * 132 * 4);
constexpr size_t WS_BRT  = WS_C1P  + al256((size_t)(96 * 192 + 64 * 128) * 4);
constexpr size_t WS_ASGE = WS_BRT  + al256(64 * 4);
constexpr size_t WS_ASGI = WS_ASGE + al256((size_t)NT * 2 * 4);
constexpr size_t WS_ASGW = WS_ASGI + al256((size_t)NT * 2 * 4);
constexpr size_t WS_POS  = WS_ASGW + al256((size_t)NT * 2 * 4);
constexpr size_t WS_ROWW = WS_POS  + al256((size_t)NT * 2 * 4);
constexpr size_t WS_ROWR = WS_ROWW + al256((size_t)PMAX * 4);
constexpr size_t WS_TILE = WS_ROWR + al256((size_t)PMAX * 4);
constexpr size_t WS_RMASK= WS_TILE + al256(256 * 4);
constexpr size_t WS_DBG  = WS_RMASK+ al256((size_t)16 * 2048 * 4);
constexpr size_t WS_END  = WS_DBG  + al256(4096);
static_assert(WS_END <= (size_t)2048 * MiB, "workspace budget");

constexpr int CW_BAR = 4096;
constexpr int CW_CNT = 8192;
constexpr int CW_CHK = 12288;

constexpr int RING_BYTES = 131072;
constexpr int LDSCTL_OFF = RING_BYTES, MISC_OFF = LDSCTL_OFF + 320;
constexpr int LDS_BYTES = 147456;
constexpr int NWAVES = 8;

#define RLX_AGENT __ATOMIC_RELAXED, __HIP_MEMORY_SCOPE_AGENT
#define LDS_WAIT() asm volatile("s_waitcnt lgkmcnt(0)" ::: "memory")
#define VM_WAIT() asm volatile("s_waitcnt vmcnt(0)" ::: "memory")

__device__ __forceinline__ unsigned cvt_pk_bf16(float lo, float hi) { unsigned r; asm volatile("v_cvt_pk_bf16_f32 %0, %1, %2" : "=v"(r) : "v"(lo), "v"(hi)); return r; }
__device__ __forceinline__ float bf2f(unsigned short b) { return __uint_as_float(((unsigned)b) << 16); }
__device__ __forceinline__ float bflo(unsigned w) { return __uint_as_float(w << 16); }
__device__ __forceinline__ float bfhi(unsigned w) { return __uint_as_float(w & 0xffff0000u); }
__device__ __forceinline__ unsigned short f2bf(float f) { return (unsigned short)(cvt_pk_bf16(f, 0.f) & 0xffffu); }
__device__ __forceinline__ int llane() { int l; asm volatile("v_mbcnt_lo_u32_b32 %0, -1, 0\n\tv_mbcnt_hi_u32_b32 %0, -1, %0" : "=v"(l)); return l; }
__device__ __forceinline__ float shx(float v, int mask, int lane) { return __int_as_float(__builtin_amdgcn_ds_bpermute((lane ^ mask) << 2, __float_as_int(v))); }
__device__ __forceinline__ float wave_sum(float v, int lane) {
#pragma unroll
    for (int o = 1; o < 64; o <<= 1) v += shx(v, o, lane);
    return v;
}
__device__ __forceinline__ float dot4v(f32x4 a) { return (a[0] * a[0] + a[1] * a[1]) + (a[2] * a[2] + a[3] * a[3]); }
__device__ __forceinline__ float sigmoidf_(float x) { return 1.f / (1.f + __expf(-x)); }

#define XB_TMO      128
#define XB_XCNT(j)  (256  + 64 * (j))
#define XB_XSUB(j)  (1280 + 64 * (j))
#define XB_XGEN(j)  (2304 + 64 * (j))
#define XB_TOP      3328
#define XB_TOPGEN   3392
#define XCD_BAR_WORDS 3456
#define XB_SPIN_CAP (1u << 18)
__device__ __forceinline__ unsigned xb_ld(unsigned* p)              { return __hip_atomic_load(p, __ATOMIC_RELAXED, __HIP_MEMORY_SCOPE_AGENT); }
__device__ __forceinline__ unsigned xb_add(unsigned* p, unsigned v) { return __hip_atomic_fetch_add(p, v, __ATOMIC_RELAXED, __HIP_MEMORY_SCOPE_AGENT); }
__device__ __forceinline__ unsigned xb_xcc_id() { return (unsigned)__builtin_amdgcn_s_getreg((3 << 11) | 20) & 0xFu; }
#define XB_SPIN(cond, bar) do { unsigned _sp = 0; while (cond) { __builtin_amdgcn_s_sleep(1); \
    if ((++_sp & 255u) == 0u) { if (xb_ld(&(bar)[XB_TMO])) break; if (_sp > XB_SPIN_CAP) { atomicAdd(&(bar)[XB_TMO], 1u); break; } } } } while (0)
struct XcdBarrier { unsigned* bar; unsigned x; volatile LAS unsigned* st; };
__device__ __forceinline__ XcdBarrier xcd_barrier_post(unsigned* bar, volatile LAS unsigned* st) {
    XcdBarrier b; b.bar = bar; b.x = xb_xcc_id(); b.st = st;
    if (threadIdx.x == 0) (void)xb_add(&bar[XB_XCNT(b.x)], 1u);
    return b;
}
__device__ __forceinline__ void xcd_barrier_complete(unsigned* bar, unsigned x, unsigned& nloc, unsigned& nx) {
    const unsigned G = gridDim.x * gridDim.y * gridDim.z;
    unsigned sum, cnt, mine, sp = 0u;
    for (;;) {
        sum = 0u; cnt = 0u; mine = 0u;
#pragma unroll
        for (unsigned j = 0; j < 16; ++j) { const unsigned c = xb_ld(&bar[XB_XCNT(j)]); sum += c; cnt += (c > 0u) ? 1u : 0u; mine = (j == x) ? c : mine; }
        if (sum == G) break;
        __builtin_amdgcn_s_sleep(1);
        if ((++sp & 255u) == 0u) { if (xb_ld(&bar[XB_TMO])) break; if (sp > XB_SPIN_CAP) { atomicAdd(&bar[XB_TMO], 1u); break; } }
    }
    nloc = mine > 0u ? mine : 1u; nx = cnt > 0u ? cnt : 1u;
}
__device__ __forceinline__ void xcd_barrier(const XcdBarrier& b) {
    asm volatile("s_waitcnt vmcnt(0)" ::: "memory");
    __syncthreads();
    if (threadIdx.x == 0) {
        unsigned* bar = b.bar;
        __builtin_amdgcn_s_waitcnt(0);
        unsigned nloc = b.st[0], nx = b.st[1];
        if (nloc == 0u) { xcd_barrier_complete(bar, b.x, nloc, nx); b.st[0] = nloc; b.st[1] = nx; }
        const unsigned old = xb_add(&bar[XB_XSUB(b.x)], 1u);
        const unsigned gen = old / nloc;
        if (old + 1u == (gen + 1u) * nloc) {
            __builtin_amdgcn_fence(__ATOMIC_RELEASE, "agent");
            asm volatile("s_waitcnt vmcnt(0)" ::: "memory");
            const unsigned og = xb_add(&bar[XB_TOP], 1u);
            const unsigned tg = og / nx;
            if (og + 1u == (tg + 1u) * nx) xb_add(&bar[XB_TOPGEN], 1u);
            else XB_SPIN(xb_ld(&bar[XB_TOPGEN]) == tg, bar);
            __builtin_amdgcn_fence(__ATOMIC_ACQUIRE, "agent");
            xb_add(&bar[XB_XGEN(b.x)], 1u);
            asm volatile("s_waitcnt vmcnt(0)" ::: "memory");
        } else {
            XB_SPIN(xb_ld(&bar[XB_XGEN(b.x)]) == gen, bar);
            __builtin_amdgcn_fence(__ATOMIC_ACQUIRE, "agent");
            asm volatile("s_waitcnt vmcnt(0)" ::: "memory");
        }
    }
    __syncthreads();
}
namespace pg8 {
constexpr int BM = 256, BK = 64, HALF = 128, HTB = HALF * BK * 2, STAGE_BYTES = 8 * HTB, NXCD = 8, WGM = 8;
__host__ __device__ __forceinline__ int lds_byte(int r, int c) { const int st = (r >> 4) * 2 + (c >> 5), rr = r & 15, cc = c & 31, ob = rr * 64 + cc * 2; return st * 1024 + (ob ^ (((ob >> 9) & 1) << 5)); }
__host__ __device__ __forceinline__ void stage_rc(int b, int& R, int& C) { const int st = b / 1024, sb = b % 1024, swz = sb ^ (((sb >> 9) & 1) << 5); R = (st >> 1) * 16 + swz / 64; C = (st & 1) * 32 + (swz % 64) / 2; }
__host__ __device__ __forceinline__ int perm32(int rho) { const int n = rho >> 4, i = rho & 15; return 8 * (i >> 2) + 4 * n + (i & 3); }

struct Unit { int pm, pn; };
struct Gemm { const bf16* A; const bf16* Bt; int lda; int K; };

struct StaticOrder {
    int nM, nN, nwg, G, c;
    __device__ void init(int M, int N, int G_, int c_) { nM = M / BM; nN = N / BM; nwg = nM * nN; G = G_; c = c_; }
    __device__ __forceinline__ bool next(int i, Unit& u) const {
        const long L = (long)i * G + c; if (L >= nwg) return false;
        int wgid = (int)L; { const int q = nwg / NXCD, r = nwg % NXCD, xcd = wgid % NXCD, off = wgid / NXCD; wgid = (xcd < r ? xcd * (q + 1) : r * (q + 1) + (xcd - r) * q) + off; }
        const int nig = WGM * nN, gid = wgid / nig, fm = gid * WGM, gsz = (nM - fm) < WGM ? (nM - fm) : WGM;
        u.pm = fm + ((wgid % nig) % gsz); u.pn = (wgid % nig) / gsz; return true;
    }
};
struct BranchOrder {
    StaticOrder S;
    __device__ void init(int G_, int c_) { S.init(NT, 2048, G_, c_); }
    __device__ __forceinline__ bool next(int i, Unit& u) const {
        Unit t; if (!S.next(i / 3, t)) return false; const int n = i % 3;
        u.pm = n * 64 + t.pm; u.pn = n * 8 + t.pn; return true;
    }
};
struct MoeOrder {
    const int* tile_e; int nunits, G, c;
    __device__ void init(const int* tab, int G_, int c_) { tile_e = tab; nunits = tab[200] * 8; G = G_; c = c_; }
    __device__ __forceinline__ bool next(int i, Unit& u) const {
        const int L = i * G + c; if (L >= nunits) return false;
        const int rt = L >> 3, j = L & 7; u.pm = rt; u.pn = tile_e[rt] * 8 + j; return true;
    }
};

template <class Epi, class Sched>
__device__ __forceinline__ void gemm_phase(LAS unsigned char* lds, const Gemm g, const Sched& S, const Epi& E, int tid) {
    const int wid = __builtin_amdgcn_readfirstlane(tid >> 6), lane = tid & 63, wr = wid >> 2, wc = wid & 3, fr = lane & 15, fq = lane >> 4;
    const int K = g.K, nt = K / BK, lda = g.lda;
    unsigned voffA[2], voffB[2];
#pragma unroll
    for (int i = 0; i < 2; ++i) { int R, C; stage_rc(tid * 16 + i * 8192, R, C); const int Rb = Epi::PERM ? ((R & ~31) + perm32(R & 31)) : R;
        voffA[i] = (unsigned)(R * lda + C) * 2u; voffB[i] = (unsigned)(Rb * K + C) * 2u; }
    const size_t kstep = (size_t)(BK * 2);
    const size_t hstepA = (size_t)HALF * lda * 2, hstepB = (size_t)HALF * K * 2;
    const size_t tstepA = 2 * hstepA, tstepB = 2 * hstepB;
    const unsigned ldsw = (unsigned)wid * 1024u;
    const int aoff = lds_byte(wr * 64 + fr, fq * 8), boff = lds_byte(wc * 32 + fr, fq * 8);
#define PG8_SA(b, h) (((b) * 2 + (h)) * HTB)
#define PG8_SB(b, h) ((4 + (b) * 2 + (h)) * HTB)
#define PG8_STAGE(bufoff, gbase, voff) do { _Pragma("unroll") for (int _i = 0; _i < 2; ++_i) \
        __builtin_amdgcn_global_load_lds((const unsigned*)((const char*)(gbase) + (voff)[_i]), (LAS unsigned*)(lds + (bufoff) + ldsw + _i * 8192), 16, 0, 0); } while (0)
#define PG8_LDA(dst, b, h) do { _Pragma("unroll") for (int m = 0; m < 4; ++m) _Pragma("unroll") for (int k = 0; k < 2; ++k) dst[m][k] = *(const LAS bf16x8*)(lds + PG8_SA(b, h) + aoff + m * 2048 + k * 1024); } while (0)
#define PG8_LDB(dst, b, h) do { _Pragma("unroll") for (int n = 0; n < 2; ++n) _Pragma("unroll") for (int k = 0; k < 2; ++k) dst[n][k] = *(const LAS bf16x8*)(lds + PG8_SB(b, h) + boff + n * 2048 + k * 1024); } while (0)
#define PG8_MMA(ai, bj, At, Bt) do { __builtin_amdgcn_s_setprio(1); _Pragma("unroll") for (int m = 0; m < 4; ++m) _Pragma("unroll") for (int n = 0; n < 2; ++n) _Pragma("unroll") for (int k = 0; k < 2; ++k) \
        acc[ai][bj][m][n] = __builtin_amdgcn_mfma_f32_16x16x32_bf16(Bt[n][k], At[m][k], acc[ai][bj][m][n], 0, 0, 0); __builtin_amdgcn_s_setprio(0); } while (0)
#define PG8_WAIT_V(n) asm volatile("s_waitcnt vmcnt(" #n ")" ::: "memory")
#define PG8_WAIT_L(n) asm volatile("s_waitcnt lgkmcnt(" #n ")" ::: "memory")
#define PG8_BAR __builtin_amdgcn_s_barrier()
#define PG8_SCHED __builtin_amdgcn_sched_barrier(0)
    Unit cur, nxt; int ui = 0;
    if (!S.next(0, cur)) return;
    f32x4 acc[2][2][4][2];
#pragma unroll
    for (int a = 0; a < 2; ++a)
#pragma unroll
        for (int b = 0; b < 2; ++b)
#pragma unroll
            for (int m = 0; m < 4; ++m)
#pragma unroll
                for (int n = 0; n < 2; ++n) acc[a][b][m][n] = (f32x4){0.f, 0.f, 0.f, 0.f};
    bf16x8 At[4][2], B0[2][2], B1[2][2];
    const char* cA = (const char*)g.A + (size_t)cur.pm * tstepA; const char* cB = (const char*)g.Bt + (size_t)cur.pn * tstepB;
    PG8_STAGE(PG8_SB(0, 0), cB, voffB); PG8_STAGE(PG8_SB(0, 1), cB + hstepB, voffB); PG8_STAGE(PG8_SA(0, 0), cA, voffA); PG8_STAGE(PG8_SA(0, 1), cA + hstepA, voffA);
    if (wr == 1) PG8_BAR;
    PG8_WAIT_V(2); PG8_BAR;
    PG8_STAGE(PG8_SB(1, 0), cB + kstep, voffB); PG8_STAGE(PG8_SA(1, 0), cA + kstep, voffA); PG8_STAGE(PG8_SB(1, 1), cB + hstepB + kstep, voffB);
    PG8_WAIT_V(6); PG8_BAR;
    for (;;) {
        const bool has_next = S.next(ui + 1, nxt);
        const char* nA = has_next ? (const char*)g.A + (size_t)nxt.pm * tstepA : cA; const char* nB = has_next ? (const char*)g.Bt + (size_t)nxt.pn * tstepB : cB;
        for (int t = 0; t < nt; t += 2) {
            const bool last = (t == nt - 2);
            const char* a1 = cA + (size_t)(t + 1) * kstep;
            const char* a2 = last ? nA : cA + (size_t)(t + 2) * kstep; const char* b2 = last ? nB : cB + (size_t)(t + 2) * kstep;
            const char* a3 = a2 + kstep; const char* b3 = b2 + kstep;
            PG8_LDB(B0, 0, 0); PG8_LDB(B1, 0, 1); PG8_SCHED; PG8_LDA(At, 0, 0); PG8_STAGE(PG8_SA(1, 1), a1 + hstepA, voffA);
            PG8_WAIT_V(8); PG8_WAIT_L(0); PG8_BAR; PG8_MMA(0, 0, At, B0); PG8_MMA(0, 1, At, B1); PG8_BAR; PG8_SCHED;
            PG8_LDA(At, 0, 1); PG8_STAGE(PG8_SB(0, 0), b2, voffB); PG8_STAGE(PG8_SB(0, 1), b2 + hstepB, voffB); PG8_STAGE(PG8_SA(0, 0), a2, voffA);
            PG8_WAIT_V(8); PG8_WAIT_L(0); PG8_BAR; PG8_MMA(1, 0, At, B0); PG8_MMA(1, 1, At, B1); PG8_BAR; PG8_SCHED;
            PG8_LDB(B0, 1, 0); PG8_LDB(B1, 1, 1); PG8_SCHED; PG8_LDA(At, 1, 0); PG8_STAGE(PG8_SA(0, 1), a2 + hstepA, voffA);
            PG8_WAIT_V(8); PG8_WAIT_L(0); PG8_BAR; PG8_MMA(0, 0, At, B0); PG8_MMA(0, 1, At, B1); PG8_BAR; PG8_SCHED;
            PG8_LDA(At, 1, 1); PG8_STAGE(PG8_SB(1, 0), b3, voffB); PG8_STAGE(PG8_SB(1, 1), b3 + hstepB, voffB); PG8_STAGE(PG8_SA(1, 0), a3, voffA);
            PG8_WAIT_V(8); PG8_WAIT_L(0); PG8_BAR; PG8_MMA(1, 0, At, B0); PG8_MMA(1, 1, At, B1); PG8_BAR; PG8_SCHED;
        }
        if (wr == 0) PG8_BAR;
        { const int t2 = llane(); E(acc, cur, wr, wc, t2 & 15, t2 >> 4); }
        if (!has_next) break;
#pragma unroll
        for (int a = 0; a < 2; ++a)
#pragma unroll
            for (int b = 0; b < 2; ++b)
#pragma unroll
                for (int m = 0; m < 4; ++m)
#pragma unroll
                    for (int n = 0; n < 2; ++n) acc[a][b][m][n] = (f32x4){0.f, 0.f, 0.f, 0.f};
        cur = nxt; cA = nA; cB = nB; ++ui;
        if (wr == 1) PG8_BAR;
    }
    PG8_WAIT_V(0);
    PG8_BAR;
#undef PG8_SA
#undef PG8_SB
#undef PG8_STAGE
#undef PG8_LDA
#undef PG8_LDB
#undef PG8_MMA
#undef PG8_WAIT_V
#undef PG8_WAIT_L
#undef PG8_BAR
#undef PG8_SCHED
}

typedef const f32x4 (&AccRef)[2][2][4][2];
__device__ __forceinline__ u32x4 pack8(f32x4 a, f32x4 b) { u32x4 w; w.x = cvt_pk_bf16(a[0], a[1]); w.y = cvt_pk_bf16(a[2], a[3]); w.z = cvt_pk_bf16(b[0], b[1]); w.w = cvt_pk_bf16(b[2], b[3]); return w; }
__device__ __forceinline__ float dot4(f32x4 a) { return (a[0] * a[0] + a[1] * a[1]) + (a[2] * a[2] + a[3] * a[3]); }
__device__ __forceinline__ float red_fq_(float s, int lane) { s += shx(s, 16, lane); s += shx(s, 32, lane); return s; }
#define red_fq(s) red_fq_((s), fr + 16 * fq)
__device__ __forceinline__ f32x4 rope4(f32x4 v, f32x4 cs) { return (f32x4){v[0] * cs[0] - v[1] * cs[1], v[1] * cs[0] + v[0] * cs[1], v[2] * cs[2] - v[3] * cs[3], v[3] * cs[2] + v[2] * cs[3]}; }

struct EpiWin {
    static constexpr bool PERM = true;
    bf16* z; float* zs; float* zssq; const float* rstd; bf16* km; const float* rope;
    __device__ __forceinline__ void operator()(AccRef acc, const Unit& u, int wr, int wc, int fr, int fq) const {
        const int row0 = u.pm * BM + wr * 64 + fr, colw = u.pn * BM + wc * 32 + 8 * fq;
        const bool do_ssq = (u.pn >= 12 && u.pn <= 16), do_rope = (u.pn == 17 && wc < 2), do_side = (u.pn == 54 && wc == 2);
#pragma unroll
        for (int ai = 0; ai < 2; ++ai)
#pragma unroll
            for (int m = 0; m < 4; ++m) {
                const int row = row0 + ai * HALF + m * 16; const float rs = rstd[row]; float sq = 0.f;
#pragma unroll
                for (int bj = 0; bj < 2; ++bj) {
                    f32x4 v0 = acc[ai][bj][m][0] * rs, v1 = acc[ai][bj][m][1] * rs;
                    if (bj == 0 && do_rope) {
                        const float* rp = rope + ((size_t)(row & (SEQ - 1)) * 32 + 16 * wc + 4 * fq) * 2;
                        v0 = rope4(v0, *(const f32x4*)rp); v1 = rope4(v1, *(const f32x4*)(rp + 4));
                        const u32x4 w = pack8(v0, v1);
#pragma unroll
                        for (int hh = 0; hh < 8; ++hh) *(u32x4*)(km + (size_t)row * 1536 + hh * 192 + 128 + 32 * wc + 8 * fq) = w;
                    }
                    sq += dot4(v0) + dot4(v1);
                    *(u32x4*)(z + (size_t)row * ZLD + colw + bj * HALF) = pack8(v0, v1);
                    if (bj == 1 && do_side) { float* sp = zs + (size_t)row * 32 + 8 * fq; *(f32x4*)sp = v0; *(f32x4*)(sp + 4) = v1; }
                }
                if (do_ssq) { sq = red_fq(sq); if (fq == 0) zssq[(size_t)row * 32 + (u.pn - 12) * 4 + wc] = sq; }
            }
    }
};
struct EpiMlaQ {
    static constexpr bool PERM = true;
    bf16* qm; const float* zssq; const float* rope;
    __device__ __forceinline__ void operator()(AccRef acc, const Unit& u, int wr, int wc, int fr, int fq) const {
        const int row0 = u.pm * BM + wr * 64 + fr;
#pragma unroll
        for (int ai = 0; ai < 2; ++ai)
#pragma unroll
            for (int m = 0; m < 4; ++m) {
                const int row = row0 + ai * HALF + m * 16;
                float s = 0.f; if (fq < 3) { const f32x4 p = *(const f32x4*)(zssq + (size_t)row * 32 + 4 * fq); s = (p[0] + p[1]) + (p[2] + p[3]); }
                s = red_fq(s); const float rs = rsqrtf(s * (1.f / 768.f) + EPS);
#pragma unroll
                for (int bj = 0; bj < 2; ++bj) {
                    const int cb = u.pn * BM + bj * HALF + wc * 32, within = cb % 192;
                    f32x4 v0 = acc[ai][bj][m][0] * rs, v1 = acc[ai][bj][m][1] * rs;
                    if (within >= 128) {
                        const float* rp = rope + ((size_t)(row & (SEQ - 1)) * 32 + (within - 128) / 2 + 4 * fq) * 2;
                        v0 = rope4(v0, *(const f32x4*)rp); v1 = rope4(v1, *(const f32x4*)(rp + 4));
                    }
                    *(u32x4*)(qm + (size_t)row * 1536 + cb + 8 * fq) = pack8(v0, v1);
                }
            }
    }
};
struct EpiMlaKV {
    static constexpr bool PERM = true;
    bf16* km; bf16* vm; const float* zssq;
    __device__ __forceinline__ void operator()(AccRef acc, const Unit& u, int wr, int wc, int fr, int fq) const {
        const int row0 = u.pm * BM + wr * 64 + fr;
#pragma unroll
        for (int ai = 0; ai < 2; ++ai)
#pragma unroll
            for (int m = 0; m < 4; ++m) {
                const int row = row0 + ai * HALF + m * 16;
                float s = 0.f; if (fq < 2) { const f32x4 p = *(const f32x4*)(zssq + (size_t)row * 32 + 12 + 4 * fq); s = (p[0] + p[1]) + (p[2] + p[3]); }
                s = red_fq(s); const float rs = rsqrtf(s * (1.f / 512.f) + EPS);
                *(u32x4*)(km + (size_t)row * 1536 + u.pn * 192 + wc * 32 + 8 * fq) = pack8(acc[ai][0][m][0] * rs, acc[ai][0][m][1] * rs);
                *(u32x4*)(vm + (size_t)row * 1024 + u.pn * 128 + wc * 32 + 8 * fq) = pack8(acc[ai][1][m][0] * rs, acc[ai][1][m][1] * rs);
            }
    }
};
struct EpiRowScale {
    static constexpr bool PERM = true;
    bf16* O; int ldc; const float* rstd;
    const float* hssq;
    __device__ __forceinline__ void operator()(AccRef acc, const Unit& u, int wr, int wc, int fr, int fq) const {
        const int row0 = u.pm * BM + wr * 64 + fr, colw = u.pn * BM + wc * 32 + 8 * fq;
#pragma unroll
        for (int ai = 0; ai < 2; ++ai)
#pragma unroll
            for (int m = 0; m < 4; ++m) {
                const int row = row0 + ai * HALF + m * 16; float rs;
                if (rstd) rs = rstd[row];
                else { const f32x4 p = *(const f32x4*)(hssq + (size_t)row * 32 + 8 * fq), q = *(const f32x4*)(hssq + (size_t)row * 32 + 8 * fq + 4);
                       float s = ((p[0] + p[1]) + (p[2] + p[3])) + ((q[0] + q[1]) + (q[2] + q[3])); s = red_fq(s); rs = rsqrtf(s * (1.f / 2048.f) + EPS); }
#pragma unroll
                for (int bj = 0; bj < 2; ++bj) *(u32x4*)(O + (size_t)row * ldc + colw + bj * HALF) = pack8(acc[ai][bj][m][0] * rs, acc[ai][bj][m][1] * rs);
            }
    }
};
struct EpiBranch {
    static constexpr bool PERM = true;
    const bf16* z; float* mpart; bf16* mbf;
    __device__ __forceinline__ void operator()(AccRef acc, const Unit& u, int wr, int wc, int fr, int fq) const {
        const int n3 = u.pn >> 3, pnl = u.pn & 7, pml = u.pm & 63;
        const int row0 = pml * BM + wr * 64 + fr, colw = pnl * BM + wc * 32 + 8 * fq;
#pragma unroll
        for (int ai = 0; ai < 2; ++ai)
#pragma unroll
            for (int m = 0; m < 4; ++m) {
                const int row = row0 + ai * HALF + m * 16;
#pragma unroll
                for (int bj = 0; bj < 2; ++bj) {
                    const int col = colw + bj * HALF;
                    const u32x4 gw = *(const u32x4*)(z + (size_t)row * ZLD + ZC_MG + n3 * 2048 + col);
                    f32x4 g0 = (f32x4){sigmoidf_(bflo(gw.x)), sigmoidf_(bfhi(gw.x)), sigmoidf_(bflo(gw.y)), sigmoidf_(bfhi(gw.y))};
                    f32x4 g1 = (f32x4){sigmoidf_(bflo(gw.z)), sigmoidf_(bfhi(gw.z)), sigmoidf_(bflo(gw.w)), sigmoidf_(bfhi(gw.w))};
                    f32x4 v0 = acc[ai][bj][m][0] * g0, v1 = acc[ai][bj][m][1] * g1;
                    float* pp = mpart + (size_t)row * 2048 + col;
                    if (n3 > 0) { v0 += *(const f32x4*)pp; v1 += *(const f32x4*)(pp + 4); }
                    if (n3 < 2) { *(f32x4*)pp = v0; *(f32x4*)(pp + 4) = v1; }
                    else *(u32x4*)(mbf + (size_t)row * 2048 + col) = pack8(v0, v1);
                }
            }
    }
};
struct EpiResid {
    static constexpr bool PERM = true;
    const float* base; float* hf; bf16* hbf; float* hssq;
    __device__ __forceinline__ void operator()(AccRef acc, const Unit& u, int wr, int wc, int fr, int fq) const {
        const int row0 = u.pm * BM + wr * 64 + fr, colw = u.pn * BM + wc * 32 + 8 * fq;
#pragma unroll
        for (int ai = 0; ai < 2; ++ai)
#pragma unroll
            for (int m = 0; m < 4; ++m) {
                const int row = row0 + ai * HALF + m * 16; float sq = 0.f;
#pragma unroll
                for (int bj = 0; bj < 2; ++bj) {
                    const size_t off = (size_t)row * 2048 + colw + bj * HALF;
                    const f32x4 v0 = acc[ai][bj][m][0] + *(const f32x4*)(base + off), v1 = acc[ai][bj][m][1] + *(const f32x4*)(base + off + 4);
                    *(f32x4*)(hf + off) = v0; *(f32x4*)(hf + off + 4) = v1; *(u32x4*)(hbf + off) = pack8(v0, v1);
                    sq += dot4(v0) + dot4(v1);
                }
                sq = red_fq(sq); if (fq == 0) hssq[(size_t)row * 32 + u.pn * 4 + wc] = sq;
            }
    }
};
struct EpiRouter {
    static constexpr bool PERM = false;
    float* logits; const float* hssq; const float* bias; float* rstd2;
    __device__ __forceinline__ void operator()(AccRef acc, const Unit& u, int wr, int wc, int fr, int fq) const {
        const int row0 = u.pm * BM + wr * 64 + fr;
#pragma unroll
        for (int ai = 0; ai < 2; ++ai)
#pragma unroll
            for (int m = 0; m < 4; ++m) {
                const int row = row0 + ai * HALF + m * 16;
                const f32x4 p = *(const f32x4*)(hssq + (size_t)row * 32 + 8 * fq), q = *(const f32x4*)(hssq + (size_t)row * 32 + 8 * fq + 4);
                float s = ((p[0] + p[1]) + (p[2] + p[3])) + ((q[0] + q[1]) + (q[2] + q[3])); s = red_fq(s); const float rs = rsqrtf(s * (1.f / 2048.f) + EPS);
                if (wc == 0 && fq == 0) rstd2[row] = rs;
                if (wc < 2) {
#pragma unroll
                    for (int n = 0; n < 2; ++n) { const int col = wc * 32 + 16 * n + 4 * fq; *(f32x4*)(logits + (size_t)row * 64 + col) = acc[ai][0][m][n] * rs + *(const f32x4*)(bias + col); }
                }
            }
    }
};
struct EpiGateUp {
    static constexpr bool PERM = true;
    bf16* hdn; const float* rowr;
    __device__ __forceinline__ void operator()(AccRef acc, const Unit& u, int wr, int wc, int fr, int fq) const {
        const int row0 = u.pm * BM + wr * 64 + fr, col = (u.pn & 7) * 128 + wc * 32 + 8 * fq;
#pragma unroll
        for (int ai = 0; ai < 2; ++ai)
#pragma unroll
            for (int m = 0; m < 4; ++m) {
                const int row = row0 + ai * HALF + m * 16; const float rs = rowr[row];
                f32x4 o[2];
#pragma unroll
                for (int n = 0; n < 2; ++n) { const f32x4 g = acc[ai][0][m][n] * rs, up = acc[ai][1][m][n] * rs;
#pragma unroll
                    for (int j = 0; j < 4; ++j) o[n][j] = g[j] * sigmoidf_(g[j]) * up[j]; }
                *(u32x4*)(hdn + (size_t)row * 1024 + col) = pack8(o[0], o[1]);
            }
    }
};
struct EpiDown {
    static constexpr bool PERM = true;
    bf16* y; const float* roww;
    __device__ __forceinline__ void operator()(AccRef acc, const Unit& u, int wr, int wc, int fr, int fq) const {
        const int row0 = u.pm * BM + wr * 64 + fr, colw = (u.pn & 7) * BM + wc * 32 + 8 * fq;
#pragma unroll
        for (int ai = 0; ai < 2; ++ai)
#pragma unroll
            for (int m = 0; m < 4; ++m) {
                const int row = row0 + ai * HALF + m * 16; const float w = roww[row];
#pragma unroll
                for (int bj = 0; bj < 2; ++bj) *(u32x4*)(y + (size_t)row * 2048 + colw + bj * HALF) = pack8(acc[ai][bj][m][0] * w, acc[ai][bj][m][1] * w);
            }
    }
};
}
namespace att {
constexpr int VSTR = 320;
template <int DK> struct Geo { static constexpr int KSTR = DK * 2 + 16, KBYTES = 64 * KSTR, VBYTES = 64 * VSTR, BUF = KBYTES + VBYTES, NKL = DK / 64; };
constexpr int ATT_LDS = 2 * Geo<192>::BUF;
constexpr int TAB_OFF = ATT_LDS;
constexpr int RMASK_OFF = TAB_OFF + 4 * 132 * 4;
constexpr int IMPS_OFF = RMASK_OFF + 256;
static_assert(IMPS_OFF + 64 * 33 * 4 <= RING_BYTES, "attention LDS");

__device__ __forceinline__ s16x4 vtr(const LAS unsigned char* p) { return __builtin_bit_cast(s16x4, __builtin_amdgcn_ds_read_tr16_b64_v4i16((LAS v4i16_t*)p)); }
__device__ __forceinline__ float half_max(float v) { auto rr = __builtin_amdgcn_permlane32_swap(__float_as_uint(v), __float_as_uint(v), false, false); return fmaxf(__uint_as_float(rr[0]), __uint_as_float(rr[1])); }
__device__ __forceinline__ float half_sum(float v) { auto rr = __builtin_amdgcn_permlane32_swap(__float_as_uint(v), __float_as_uint(v), false, false); return __uint_as_float(rr[0]) + __uint_as_float(rr[1]); }

template <int DK> struct Stage { u32x4 k[DK / 64]; u32x4 v[2]; };
template <int DK> struct StageOff { unsigned k[DK / 64]; unsigned v[2]; };
template <int DK> __device__ __forceinline__ void stage_offsets(StageOff<DK>& so, int ldk, int ldv, int tid) {
    constexpr int CPR = DK / 8;
#pragma unroll
    for (int i = 0; i < DK / 64; ++i) { const int c = tid + 512 * i, row = c / CPR, cc = c % CPR; so.k[i] = (unsigned)(row * ldk + cc * 8) * 2u; }
#pragma unroll
    for (int i = 0; i < 2; ++i) { const int c = tid + 512 * i, row = c >> 4, cc = c & 15; so.v[i] = (unsigned)(row * ldv + cc * 8) * 2u; }
}
template <int DK> __device__ __forceinline__ void stage_issue(Stage<DK>& s, const StageOff<DK>& so, const bf16* Kg, int ldk, const bf16* Vg, int ldv, int jt) {
    const char* kt = (const char*)(Kg + (size_t)(64 * jt) * ldk); const char* vt = (const char*)(Vg + (size_t)(64 * jt) * ldv);
#pragma unroll
    for (int i = 0; i < DK / 64; ++i) s.k[i] = *(const u32x4*)(kt + so.k[i]);
#pragma unroll
    for (int i = 0; i < 2; ++i) s.v[i] = *(const u32x4*)(vt + so.v[i]);
}
template <int DK> __device__ __forceinline__ void stage_write(const Stage<DK>& s, LAS unsigned char* buf, int tid) {
    constexpr int CPR = DK / 8;
#pragma unroll
    for (int i = 0; i < DK / 64; ++i) { const int c = tid + 512 * i, row = c / CPR, cc = c % CPR; *(LAS u32x4*)(buf + row * Geo<DK>::KSTR + cc * 16) = s.k[i]; }
#pragma unroll
    for (int i = 0; i < 2; ++i) { const int c = tid + 512 * i, row = c >> 4, cc = c & 15; *(LAS u32x4*)(buf + Geo<DK>::KBYTES + row * VSTR + cc * 16) = s.v[i]; }
}

struct State { f32x16 o[4]; float m, l; };
__device__ __forceinline__ void state_init(State& s) {
#pragma unroll
    for (int d = 0; d < 4; ++d)
#pragma unroll
        for (int r = 0; r < 16; ++r) s.o[d][r] = 0.f;
    s.m = -1e30f; s.l = 0.f;
}

template <int DK, bool MASK, bool KBIAS, bool T5, bool SEL, bool CMP, int CT, int HF>
__device__ __forceinline__ void half_compute(const LAS unsigned char* buf, int jt, const bf16x8 (&qf)[DK / 16], int t, int tw0, int W,
                                             const float* kbias, const LAS float* tab, bool rowon, float cs, State& st,
                                             float (&impm)[16], float (&impt)[1], int lane) {
    constexpr int KSTR = Geo<DK>::KSTR, KS = CMP ? 16 : 1;
    const int hi = lane >> 5, l31 = lane & 31;
    const int pk0 = (CMP ? (1024 * jt + 31) : 64 * jt) + 32 * KS * HF, pk1 = pk0 + 31 * KS;
    const int dmin = tw0 - pk1, dmax = tw0 + 31 - pk0;
    if (MASK && (dmax < 0 || dmin >= W)) return;
    f32x4 kbv[4];
    if (KBIAS) {
#pragma unroll
        for (int a = 0; a < 4; ++a) kbv[a] = *(const f32x4*)(kbias + 64 * jt + 32 * HF + 8 * a + 4 * hi);
    }
    f32x16 p;
#pragma unroll
    for (int r = 0; r < 16; ++r) p[r] = 0.f;
    const LAS unsigned char* kp = buf + (32 * HF + l31) * KSTR + hi * 16;
#pragma unroll
    for (int kk = 0; kk < DK / 16; ++kk) {
        const bf16x8 k0 = *(const LAS bf16x8*)(kp + kk * 32);
        p = __builtin_amdgcn_mfma_f32_32x32x16_bf16(k0, qf[kk], p, 0, 0, 0);
        if ((kk & 3) == 3) __builtin_amdgcn_sched_barrier(0);
    }
    const int dq = t - pk0 - 4 * hi * KS;
    const bool need_mask = MASK && (dmin < 0 || dmax >= W);
    const float NEG = -__builtin_inff();
    if (T5 && dmin < 128) {
#pragma unroll
        for (int r = 0; r < 16; ++r) { const int c = (r & 3) + 8 * (r >> 2); const int d0 = dq - KS * c; p[r] = fmaf(p[r], cs, tab[min(max(d0, 0), 128)]); }
    } else {
        const float cfar = T5 ? tab[128] : 0.f;
#pragma unroll
        for (int r = 0; r < 16; ++r) { float b0 = cfar; if (KBIAS) b0 = kbv[r >> 2][r & 3]; p[r] = fmaf(p[r], cs, b0); }
    }
    if (need_mask) {
#pragma unroll
        for (int r = 0; r < 16; ++r) { const int c = (r & 3) + 8 * (r >> 2); if ((unsigned)(dq - KS * c) >= (unsigned)W) p[r] = NEG; }
    }
    if (SEL) { if (!rowon) {
#pragma unroll
        for (int r = 0; r < 16; ++r) p[r] = NEG; } }
    float pm = p[0];
#pragma unroll
    for (int r = 1; r < 16; ++r) pm = fmaxf(pm, p[r]);
    pm = half_max(pm);
    const float mn = fmaxf(st.m, pm), alpha = __builtin_amdgcn_exp2f(st.m - mn);
    st.m = mn;
    float ps = 0.f;
#pragma unroll
    for (int r = 0; r < 16; ++r) { p[r] = __builtin_amdgcn_exp2f(p[r] - mn); ps += p[r]; }
    ps = half_sum(ps);
    st.l = st.l * alpha + ps;
    if (!__all(alpha == 1.f ? 1 : 0)) {
#pragma unroll
        for (int d = 0; d < 4; ++d)
#pragma unroll
            for (int r = 0; r < 16; ++r) st.o[d][r] *= alpha;
        if (CMP) {
#pragma unroll
            for (int i = 0; i < 16; ++i) impm[i] *= alpha;
            impt[0] *= alpha;
        }
    }
    if (CMP) {
        float ot[4];
#pragma unroll
        for (int a = 0; a < 4; ++a) { const float tl = p[4 * a + 3]; auto rr = __builtin_amdgcn_permlane32_swap(__float_as_uint(tl), __float_as_uint(tl), false, false);
            ot[a] = hi ? __uint_as_float(rr[0]) : __uint_as_float(rr[1]); }
#pragma unroll
        for (int a = 0; a < 4; ++a) { const float prev = hi ? ot[a] : (a == 0 ? impt[0] : ot[a > 0 ? a - 1 : 0]);
            impm[CT * 8 + HF * 4 + a] = 2.f * (p[4 * a] + p[4 * a + 1] + p[4 * a + 2]) + p[4 * a + 3] + prev; }
        impt[0] = ot[3];
    }
    bf16x8 pa[2];
    { u32x4 w;
      w.x = cvt_pk_bf16(p[0], p[1]); w.y = cvt_pk_bf16(p[2], p[3]); w.z = cvt_pk_bf16(p[4], p[5]); w.w = cvt_pk_bf16(p[6], p[7]); pa[0] = __builtin_bit_cast(bf16x8, w);
      w.x = cvt_pk_bf16(p[8], p[9]); w.y = cvt_pk_bf16(p[10], p[11]); w.z = cvt_pk_bf16(p[12], p[13]); w.w = cvt_pk_bf16(p[14], p[15]); pa[1] = __builtin_bit_cast(bf16x8, w); }
    const LAS unsigned char* vp = buf + Geo<DK>::KBYTES + (32 * HF + 4 * hi + ((lane & 15) >> 2)) * VSTR + (16 * ((lane >> 4) & 1) + 4 * (lane & 3)) * 2;
#pragma unroll
    for (int s = 0; s < 2; ++s)
#pragma unroll
        for (int db = 0; db < 4; ++db) {
            const s16x4 lo = vtr(vp + 16 * s * VSTR + 64 * db), hi4 = vtr(vp + (16 * s + 8) * VSTR + 64 * db);
            const bf16x8 vf = (bf16x8){lo[0], lo[1], lo[2], lo[3], hi4[0], hi4[1], hi4[2], hi4[3]};
            st.o[db] = __builtin_amdgcn_mfma_f32_32x32x16_bf16(vf, pa[s], st.o[db], 0, 0, 0);
            if (db == 3) __builtin_amdgcn_sched_barrier(0);
        }
}
template <int DK, bool MASK, bool KBIAS, bool T5, bool SEL, bool CMP, int CT>
__device__ __forceinline__ void tile_compute(const LAS unsigned char* buf, int jt, const bf16x8 (&qf)[DK / 16], int t, int tw0, int W,
                                             const float* kbias, const LAS float* tab, unsigned rowmask, float cs, State& st,
                                             float (&impm)[16], float (&impt)[1], int lane) {
    bool rowon = true;
    if (SEL) { rowon = ((rowmask >> jt) & 1u) != 0u; if (!__any(rowon ? 1 : 0)) return; }
    half_compute<DK, MASK, KBIAS, T5, SEL, CMP, CT, 0>(buf, jt, qf, t, tw0, W, kbias, tab, rowon, cs, st, impm, impt, lane);
    half_compute<DK, MASK, KBIAS, T5, SEL, CMP, CT, 1>(buf, jt, qf, t, tw0, W, kbias, tab, rowon, cs, st, impm, impt, lane);
}

template <int DK, bool MASK, bool KBIAS, bool T5, bool SEL>
__device__ __forceinline__ void attn_run(LAS unsigned char* lds, const bf16* Kg, int ldk, const bf16* Vg, int ldv, int jt_lo, int jt_hi,
                                         const bf16x8 (&qf)[DK / 16], int t, int tw0, int W, const float* kbias, const LAS float* tab,
                                         unsigned rowmask, float cs, State& st, int tid) {
    const int lane = tid & 63;
    float dm0[16], dm1[1];
    Stage<DK> sg;
    { StageOff<DK> so; stage_offsets<DK>(so, ldk, ldv, tid); stage_issue<DK>(sg, so, Kg, ldk, Vg, ldv, jt_lo); }
    stage_write<DK>(sg, lds, tid);
    __syncthreads();
    for (int jt = jt_lo; jt < jt_hi; ++jt) {
        const int cur = (jt - jt_lo) & 1;
        const bool more = jt + 1 < jt_hi;
        int tid_ = tid; asm volatile("" : "+v"(tid_));
        if (more) { StageOff<DK> so; stage_offsets<DK>(so, ldk, ldv, tid_); stage_issue<DK>(sg, so, Kg, ldk, Vg, ldv, jt + 1); }
        tile_compute<DK, MASK, KBIAS, T5, SEL, false, 0>(lds + cur * Geo<DK>::BUF, jt, qf, t, tw0, W, kbias, tab, rowmask, cs, st, dm0, dm1, lane);
        if (more) stage_write<DK>(sg, lds + (cur ^ 1) * Geo<DK>::BUF, tid_);
        __syncthreads();
    }
}

template <int DK> __device__ __forceinline__ void load_q(bf16x8 (&qf)[DK / 16], const bf16* qrow, int lane) {
#pragma unroll
    for (int kk = 0; kk < DK / 16; ++kk) qf[kk] = *(const bf16x8*)(qrow + 16 * kk + 8 * (lane >> 5));
}
template <int MODE> __device__ __forceinline__ void store_o(const State& st, float sc, bf16* orow, const bf16* addrow, int lane) {
    const int hi = lane >> 5;
#pragma unroll
    for (int db = 0; db < 4; ++db)
#pragma unroll
        for (int rg = 0; rg < 4; ++rg) {
            const int d = 32 * db + 8 * rg + 4 * hi;
            float v0 = st.o[db][4 * rg] * sc, v1 = st.o[db][4 * rg + 1] * sc, v2 = st.o[db][4 * rg + 2] * sc, v3 = st.o[db][4 * rg + 3] * sc;
            if (MODE != 0) { const u32x2 a = *(const u32x2*)((MODE == 1 ? (const bf16*)orow : addrow) + d); v0 += bflo(a.x); v1 += bfhi(a.x); v2 += bflo(a.y); v3 += bfhi(a.y); }
            u32x2 w; w.x = cvt_pk_bf16(v0, v1); w.y = cvt_pk_bf16(v2, v3);
            *(u32x2*)(orow + d) = w;
        }
}
}
struct Args { const float* in[32]; float* out; unsigned char* ws; int ph_lo, ph_hi, dbg, pad; };

__device__ __forceinline__ float row_to_bf16(const float* xrow, bf16* orow, int lane) {
    const f32x4* xr = (const f32x4*)xrow + lane; f32x4 v[8]; float s = 0.f;
#pragma unroll
    for (int j = 0; j < 8; ++j) { v[j] = xr[64 * j]; s += dot4v(v[j]); }
    s = wave_sum(s, lane);
    u32x2* o8 = (u32x2*)orow + lane;
#pragma unroll
    for (int j = 0; j < 8; ++j) { u32x2 w; w.x = cvt_pk_bf16(v[j][0], v[j][1]); w.y = cvt_pk_bf16(v[j][2], v[j][3]); o8[64 * j] = w; }
    return rsqrtf(s * (1.f / 2048.f) + EPS);
}

__device__ __forceinline__ int t5_bucket(int d) {
    if (d < 16) return d;
    const float df = (float)d;
    int large = 16 + (int)(logf(df / 16.f) / logf(8.f) * 16.f);
    return large < 31 ? large : 31;
}

__device__ __forceinline__ void ph_pre(const Args& a, int tid, int lane, int wave) {
    unsigned char* ws = a.ws;
    const int gw = blockIdx.x * NWAVES + wave, NGW = gridDim.x * NWAVES;
    const int gt = blockIdx.x * 512 + tid, NGT = gridDim.x * 512;
    bf16* hbf = (bf16*)(ws + WS_HBF); float* rstd0 = (float*)(ws + WS_RSTD0);
    for (int row = gw; row < NT; row += NGW) { const float r = row_to_bf16(a.in[0] + (size_t)row * DM, hbf + (size_t)row * DM, lane); if (lane == 0) rstd0[row] = r; }
    bf16* membf = (bf16*)(ws + WS_MEMBF); float* rstdm = (float*)(ws + WS_RSTDM);
    for (int row = gw; row < NB * MEML; row += NGW) { const float r = row_to_bf16(a.in[1] + (size_t)row * DM, membf + (size_t)row * DM, lane); if (lane == 0) rstdm[row] = r; }
    float* rope = (float*)(ws + WS_ROPE);
    for (int i = gt; i < SEQ * 32; i += NGT) { const int pos = i >> 5, k = i & 31; const float inv = powf(10000.f, -(float)k / 32.f); const float ang = (float)pos * inv; rope[2 * i] = cosf(ang); rope[2 * i + 1] = sinf(ang); }
    float* tabd = (float*)(ws + WS_TABD);
    for (int i = gt; i < 8 * 132; i += NGT) { const int h = i / 132, d = i % 132; tabd[i] = (d <= 128) ? a.in[15][t5_bucket(d) * 8 + h] * LOG2E : 0.f; }
}

struct Src { const float* p; int ld; };
__device__ __forceinline__ Src conv_src(const Args& a, int l, int mat, int sub, int d) {
    Src s; s.p = nullptr; s.ld = 0;
    switch (mat) {
    case 0: { int c;
        if (d < 3072) c = d; else if (d < 3840) c = 3080 + (d - 3072); else if (d < 4352) c = 3848 + (d - 3840);
        else if (d < 4416) { const int j = d - 4352, i = j >> 1; c = 4360 + ((j & 1) ? 32 + i : i); }
        else if (d < 7872) c = 4424 + (d - 4416); else if (d < 14016) c = 7904 + (d - 7872);
        else if (d < 14024) c = 3072 + (d - 14016); else if (d < 14048) c = 7880 + (d - 14024); else c = -1;
        if (c >= 0) { s.p = a.in[3] + (size_t)l * DM * D_IN + c; s.ld = D_IN; } break; }
    case 1: { const int hd = d / 192, w = d % 192; int c = d; if (w >= 128) { const int j = w - 128, i = j >> 1; c = hd * 192 + 128 + ((j & 1) ? 32 + i : i); }
        s.p = a.in[7] + (size_t)l * 768 * 1536 + c; s.ld = 1536; break; }
    case 2: s.p = a.in[8] + (size_t)l * 512 * 2048 + d; s.ld = 2048; break;
    case 3: s.p = a.in[11] + (size_t)l * 6144 * 192 + d; s.ld = 192; break;
    case 4: s.p = a.in[12] + (size_t)l * 192 * 192 + d; s.ld = 192; break;
    case 5: s.p = a.in[13] + (size_t)l * 4096 * 128 + d; s.ld = 128; break;
    case 6: s.p = a.in[14] + (size_t)l * 128 * 128 + d; s.ld = 128; break;
    case 7: s.p = a.in[16] + ((size_t)l * 3 + sub) * 1024 * 2048 + d; s.ld = 2048; break;
    case 8: s.p = a.in[17] + (size_t)l * 2048 * 2048 + d; s.ld = 2048; break;
    case 9: s.p = a.in[20] + (size_t)l * 2048 * 512 + d; s.ld = 512; break;
    case 10: s.p = a.in[21] + (size_t)l * 2048 * 1024 + d; s.ld = 1024; break;
    case 11: s.p = a.in[22] + (size_t)l * 512 * 2048 + d; s.ld = 2048; break;
    case 12: if (d < 4) { s.p = a.in[24] + (size_t)l * 2048 * 4 + d; s.ld = 4; } else if (d < 36) { s.p = a.in[26] + (size_t)l * 2048 * 32 + (d - 4); s.ld = 32; } break;
    case 13: { const int j = d >> 8, w = d & 255; const float* base = (w < 128 ? a.in[28] : a.in[29]) + ((size_t)l * NEXP + sub) * 2048 * 1024;
        s.p = base + j * 128 + (w & 127); s.ld = 1024; break; }
    default: s.p = a.in[30] + ((size_t)l * NEXP + sub) * 1024 * 2048 + d; s.ld = 2048; break;
    }
    return s;
}
__device__ __forceinline__ void conv_item(Src s, const float* gain, int K, bf16* dst, int kb, int nb, LAS float* scr, int lane) {
    const int n = lane & 31, k0 = kb * 64;
#pragma unroll 8
    for (int i = 0; i < 32; ++i) { const int kk = 2 * i + (lane >> 5); float v = 0.f; if (s.p) { v = s.p[(size_t)(k0 + kk) * s.ld]; if (gain) v *= gain[k0 + kk]; } scr[kk * 33 + n] = v; }
    LDS_WAIT(); asm volatile("" ::: "memory");
    const int c = lane & 7;
#pragma unroll
    for (int j = 0; j < 4; ++j) { const int nn = (lane >> 3) + 8 * j; const LAS float* q = scr + (8 * c) * 33 + nn;
        u32x4 o; o.x = cvt_pk_bf16(q[0 * 33], q[1 * 33]); o.y = cvt_pk_bf16(q[2 * 33], q[3 * 33]); o.z = cvt_pk_bf16(q[4 * 33], q[5 * 33]); o.w = cvt_pk_bf16(q[6 * 33], q[7 * 33]);
        *(u32x4*)(dst + (size_t)(nb * 32 + nn) * K + k0 + 8 * c) = o; }
    LDS_WAIT(); asm volatile("" ::: "memory");
}
__device__ __forceinline__ void ph_conv(const Args& a, int l, LAS unsigned char* lds, int tid, int lane, int wave) {
    unsigned char* ws = a.ws;
    LAS float* scr = (LAS float*)(lds + wave * 16384);
    const int gw = blockIdx.x * NWAVES + wave, NGW = gridDim.x * NWAVES;
    constexpr int NM = 15;
    static constexpr int mK[NM]   = {2048, 768, 512, 6144, 192, 4096, 128, 1024, 2048, 2048, 2048, 512, 2048, 2048, 1024};
    static constexpr int mN[NM]   = {ZLD, 1536, 2048, 192, 192, 128, 128, 2048, 2048, 512, 1024, 2048, 256, 2048, 2048};
    static constexpr int mS[NM]   = {1, 1, 1, 1, 1, 1, 1, 3, 1, 1, 1, 1, 1, NEXP, NEXP};
    static constexpr int mG[NM]   = {2, 5, 6, -1, -1, -1, -1, -1, -1, 18, 19, -1, 23, 23, -1};
    static constexpr size_t mD[NM] = {WS_WIN, WS_WUQ, WS_WUKV, WS_WCK1, WS_WCK2, WS_WCV1, WS_WCV2, WS_WBR, WS_WOUT, WS_WMQ, WS_WMKV, WS_WMO, WS_WR, WS_WGU, WS_WD};
    int base = 0;
#pragma unroll 1
    for (int mt = 0; mt < NM; ++mt) {
        const int K = mK[mt], nkb = K / 64, nnb = mN[mt] / 32, per = nkb * nnb, tot = per * mS[mt];
        const float* gain = mG[mt] >= 0 ? a.in[mG[mt]] + (size_t)l * K : nullptr;
        int first = gw - (base % NGW); if (first < 0) first += NGW;
#pragma unroll 1
        for (int r = first; r < tot; r += NGW) {
            const int sub = r / per, q = r % per, kb = q / nnb, nb = q % nnb;
            const Src s = conv_src(a, l, mt, sub, nb * 32 + (lane & 31));
            conv_item(s, gain, K, (bf16*)(ws + mD[mt]) + (size_t)sub * mN[mt] * K, kb, nb, scr, lane);
        }
        base += tot;
    }
    float* c1p = (float*)(ws + WS_C1P);
    const int gt = blockIdx.x * 512 + tid, NGT = gridDim.x * 512;
    for (int i = gt; i < 96 * 192 + 64 * 128; i += NGT) {
        float s = 0.f;
        if (i < 96 * 192) { const int ch = i / 192, n = i % 192; const float* pe = a.in[9] + (size_t)l * 6144 + ch * 64; const float* w = a.in[11] + (size_t)l * 6144 * 192 + (size_t)ch * 64 * 192 + n;
            for (int k = 0; k < 64; ++k) s += pe[k] * w[(size_t)k * 192]; }
        else { const int j = i - 96 * 192, ch = j / 128, n = j % 128; const float* pe = a.in[10] + (size_t)l * 4096 + ch * 64; const float* w = a.in[13] + (size_t)l * 4096 * 128 + (size_t)ch * 64 * 128 + n;
            for (int k = 0; k < 64; ++k) s += pe[k] * w[(size_t)k * 128]; }
        c1p[i] = s;
    }
    float* brt = (float*)(ws + WS_BRT);
    if (gt < 64) brt[gt] = gt < 4 ? a.in[25][l * 4 + gt] : (gt < 36 ? a.in[27][l * 32 + gt - 4] : 0.f);
}

__device__ __forceinline__ void cumsum_item(int it, const float* zs, const float* bf, float* kb, int lane) {
    const int b = it >> 3, h = it & 7; const float bias = bf[h];
    float v[32]; float run = 0.f;
#pragma unroll
    for (int i = 0; i < 32; ++i) { const float x = zs[(size_t)(b * SEQ + lane * 32 + i) * 32 + h] + bias; const float ls = fminf(x, 0.f) - log1pf(__expf(-fabsf(x))); run += ls; v[i] = run; }
    float incl = run;
#pragma unroll
    for (int o = 1; o < 64; o <<= 1) { const float y = __int_as_float(__builtin_amdgcn_ds_bpermute(((lane - o) & 63) << 2, __float_as_int(incl))); if (lane >= o) incl += y; }
    const float excl = incl - run;
    float* dst = kb + (size_t)it * SEQ + lane * 32;
#pragma unroll
    for (int i = 0; i < 32; ++i) dst[i] = -(excl + v[i]) * LOG2E;
}

__device__ __forceinline__ float gelu_tanh(float x) { return 0.5f * x * (1.f + tanhf(0.7978845608028654f * (x + 0.044715f * x * x * x))); }
template <int DD>
__device__ __forceinline__ void compress_body(int b, int g, int ct, const bf16* zsrc  , const bf16* w1t, const bf16* w2t,
                                              const float* c1p, int nchunk, bf16* out, LAS unsigned char* lds, int tid, unsigned* dbgw) {
    constexpr int KD = 32 * DD, NCB = DD / 64, KH = KD / 2, NST = KH / 32, HP = DD + 8;
    const int lane = tid & 63, w = tid >> 6, cg = w & 3, kh = w >> 2, lr = lane & 15, kg = lane >> 4;
    LAS float* red = (LAS float*)lds;
    LAS float* c1s = (LAS float*)(lds + 32 * DD * 4);
    LAS bf16* hid = (LAS bf16*)(lds + 32 * DD * 4 + DD * 4);
    if (tid < DD) { float s = 0.f; for (int ch = 0; ch < nchunk; ++ch) s += c1p[ch * DD + tid]; c1s[tid] = s; }
    const bf16* abase[2];
#pragma unroll
    for (int rb = 0; rb < 2; ++rb) { int c = 32 * ct + 16 * rb + lr; c = c < 126 ? c : 126; abase[rb] = zsrc + (size_t)(b * SEQ + 16 * c) * ZLD + g * DD + 8 * kg; }
    const bf16* bbase = w1t + (size_t)(16 * cg * NCB + lr) * KD + 8 * kg;
    f32x4 acc[2][NCB];
#pragma unroll
    for (int rb = 0; rb < 2; ++rb)
#pragma unroll
        for (int cb = 0; cb < NCB; ++cb) acc[rb][cb] = (f32x4){0.f, 0.f, 0.f, 0.f};
#pragma unroll 2
    for (int s = 0; s < NST; ++s) {
        const int k0 = kh * KH + 32 * s, lrow = k0 / DD, dcol = k0 % DD;
        bf16x8 af[2], bfr[NCB];
#pragma unroll
        for (int rb = 0; rb < 2; ++rb) af[rb] = *(const bf16x8*)(abase[rb] + (size_t)lrow * ZLD + dcol);
#pragma unroll
        for (int cb = 0; cb < NCB; ++cb) bfr[cb] = *(const bf16x8*)(bbase + (size_t)(16 * cb) * KD + k0);
#pragma unroll
        for (int rb = 0; rb < 2; ++rb)
#pragma unroll
            for (int cb = 0; cb < NCB; ++cb) acc[rb][cb] = __builtin_amdgcn_mfma_f32_16x16x32_bf16(af[rb], bfr[cb], acc[rb][cb], 0, 0, 0);
    }
    if (kh == 1) {
#pragma unroll
        for (int rb = 0; rb < 2; ++rb)
#pragma unroll
            for (int cb = 0; cb < NCB; ++cb)
#pragma unroll
                for (int r = 0; r < 4; ++r) red[(16 * rb + 4 * kg + r) * DD + 16 * (cg * NCB + cb) + lr] = acc[rb][cb][r];
    }
    __syncthreads();
    if (kh == 0) {
#pragma unroll
        for (int rb = 0; rb < 2; ++rb)
#pragma unroll
            for (int cb = 0; cb < NCB; ++cb)
#pragma unroll
                for (int r = 0; r < 4; ++r) { const int row = 16 * rb + 4 * kg + r, col = 16 * (cg * NCB + cb) + lr;
                    const float x = acc[rb][cb][r] + red[row * DD + col] + c1s[col]; hid[row * HP + col] = f2bf(gelu_tanh(x));
#if defined(DEBUG_CODES)
                    if (!(fabsf(acc[rb][cb][r]) < 1e30f)) atomicOr(dbgw + 0, 1u); if (!(fabsf(red[row * DD + col]) < 1e30f)) atomicOr(dbgw + 1, 1u); if (!(fabsf(c1s[col]) < 1e30f)) atomicOr(dbgw + 2, 1u);
                    if (!(fabsf(gelu_tanh(x)) < 1e30f)) atomicOr(dbgw + 3, 1u);
#endif
                    }
    }
    __syncthreads();
    constexpr int NBLK = 2 * (DD / 16);
    for (int blk = w; blk < NBLK; blk += 8) {
        const int rb = blk & 1, cb = blk >> 1;
        f32x4 c4 = (f32x4){0.f, 0.f, 0.f, 0.f};
#pragma unroll
        for (int s = 0; s < DD / 32; ++s) {
            const bf16x8 af = *(const LAS bf16x8*)(hid + (16 * rb + lr) * HP + 32 * s + 8 * kg);
            const bf16x8 bfr = *(const bf16x8*)(w2t + (size_t)(16 * cb + lr) * DD + 32 * s + 8 * kg);
            c4 = __builtin_amdgcn_mfma_f32_16x16x32_bf16(af, bfr, c4, 0, 0, 0);
        }
#pragma unroll
        for (int r = 0; r < 4; ++r) { const int c = 32 * ct + 16 * rb + 4 * kg + r; out[((size_t)(b * 2 + g) * 128 + c) * DD + 16 * cb + lr] = c < 127 ? f2bf(c4[r]) : (bf16)0;
#if defined(DEBUG_CODES)
            if (!(fabsf(c4[r]) < 1e30f)) atomicOr(dbgw + 4, 1u);
#endif
        }
    }
    __syncthreads();
}

template <int DD>
__device__ __forceinline__ void compress_ref(int b, int g, int c, const bf16* zsrc, const bf16* w1t, const bf16* w2t, const float* c1p, int nchunk, bf16* out, LAS unsigned char* lds, int tid) {
    constexpr int KD = 32 * DD;
    LAS float* hid = (LAS float*)lds;
    if (tid < DD) {
        float s = 0.f; for (int ch = 0; ch < nchunk; ++ch) s += c1p[ch * DD + tid];
        const bf16* wr = w1t + (size_t)tid * KD;
        for (int l = 0; l < 32; ++l) { const bf16* zr = zsrc + (size_t)(b * SEQ + 16 * c + l) * ZLD + g * DD;
            for (int d = 0; d < DD; d += 8) { const u32x4 zv = *(const u32x4*)(zr + d), wv = *(const u32x4*)(wr + l * DD + d);
                s += bflo(zv.x) * bflo(wv.x) + bfhi(zv.x) * bfhi(wv.x) + bflo(zv.y) * bflo(wv.y) + bfhi(zv.y) * bfhi(wv.y) + bflo(zv.z) * bflo(wv.z) + bfhi(zv.z) * bfhi(wv.z) + bflo(zv.w) * bflo(wv.w) + bfhi(zv.w) * bfhi(wv.w); } }
        hid[tid] = bf2f(f2bf(gelu_tanh(s)));
    }
    __syncthreads();
    if (tid < DD) { float s = 0.f; const bf16* wr = w2t + (size_t)tid * DD; for (int j = 0; j < DD; ++j) s += hid[j] * bf2f(wr[j]); out[((size_t)(b * 2 + g) * 128 + c) * DD + tid] = f2bf(s); }
    __syncthreads();
}

constexpr float CS128 = 0.08838834764831845f * LOG2E, CS192 = 0.07216878364870323f * LOG2E;
constexpr int WBIG = 1 << 30;

__device__ __forceinline__ void fox_sub(int b, int h, int qt, const bf16* z, const float* kb, bf16* ofox, LAS unsigned char* lds, int tid) {
    const int lane = tid & 63, w = tid >> 6, tw0 = 256 * qt + 32 * w, t = tw0 + (lane & 31); const size_t row = (size_t)b * SEQ + t;
    bf16x8 qf[8]; att::load_q<128>(qf, z + row * ZLD + ZC_FQ + h * 128, lane);
    att::State st; att::state_init(st);
    att::attn_run<128, true, true, false, false>(lds, z + (size_t)b * SEQ * ZLD + ZC_FK + h * 128, ZLD, z + (size_t)b * SEQ * ZLD + ZC_FV + h * 128, ZLD, 0, 4 * (qt + 1),
                                                 qf, t, tw0, WBIG, kb + (size_t)(b * 8 + h) * SEQ, nullptr, 0u, CS128, st, tid);
    att::store_o<0>(st, 1.f / st.l, ofox + row * 1024 + h * 128, nullptr, lane);
}
__device__ __forceinline__ void mla_sub(int b, int h, int qt, const bf16* qm, const bf16* km, const bf16* vm, bf16* omla, LAS unsigned char* lds, int tid) {
    const int lane = tid & 63, w = tid >> 6, tw0 = 256 * qt + 32 * w, t = tw0 + (lane & 31); const size_t row = (size_t)b * SEQ + t;
    bf16x8 qf[12]; att::load_q<192>(qf, qm + row * 1536 + h * 192, lane);
    att::State st; att::state_init(st);
    att::attn_run<192, true, false, false, false>(lds, km + (size_t)b * SEQ * 1536 + h * 192, 1536, vm + (size_t)b * SEQ * 1024 + h * 128, 1024, 0, 4 * (qt + 1),
                                                  qf, t, tw0, WBIG, nullptr, nullptr, 0u, CS192, st, tid);
    att::store_o<0>(st, 1.f / st.l, omla + row * 1024 + h * 128, nullptr, lane);
}
__device__ __forceinline__ void mem_unit(int uid, const bf16* qmem, const bf16* kvmem, bf16* omem, LAS unsigned char* lds, int tid) {
    const int b = uid >> 5, h = (uid >> 3) & 3, qt = uid & 7;
    const int lane = tid & 63, w = tid >> 6, tw0 = 256 * qt + 32 * w, t = tw0 + (lane & 31); const size_t row = (size_t)b * SEQ + t;
    bf16x8 qf[8]; att::load_q<128>(qf, qmem + row * 512 + h * 128, lane);
    att::State st; att::state_init(st);
    att::attn_run<128, false, false, false, false>(lds, kvmem + (size_t)b * MEML * 1024 + h * 128, 1024, kvmem + (size_t)b * MEML * 1024 + 512 + h * 128, 1024, 0, 4,
                                                   qf, t, tw0, WBIG, nullptr, nullptr, 0u, CS128, st, tid);
    att::store_o<0>(st, 1.f / st.l, omem + row * 512 + h * 128, nullptr, lane);
}
__device__ __forceinline__ void nsa_tabs(const float* tabd, int g, LAS unsigned char* lds, int tid) {
    LAS float* tab = (LAS float*)(lds + att::TAB_OFF);
    for (int i = tid; i < 4 * 132; i += 512) tab[i] = tabd[g * 4 * 132 + i];
    __syncthreads();
}
__device__ __forceinline__ void nsa_win_unit(int uid, const bf16* z, const float* zs, const float* tabd, bf16* ow, LAS unsigned char* lds, int tid) {
    const int b = uid >> 6, g = (uid >> 5) & 1, qt = uid & 31;
    const int lane = tid & 63, w = tid >> 6, hh = w >> 1, head = g * 4 + hh, tw0 = 64 * qt + 32 * (w & 1), t = tw0 + (lane & 31); const size_t row = (size_t)b * SEQ + t;
    nsa_tabs(tabd, g, lds, tid);
    bf16x8 qf[12]; att::load_q<192>(qf, z + row * ZLD + ZC_NQ + head * 192, lane);
    att::State st; att::state_init(st);
    att::attn_run<192, true, false, true, false>(lds, z + (size_t)b * SEQ * ZLD + ZC_NKW + g * 192, ZLD, z + (size_t)b * SEQ * ZLD + ZC_NVW + g * 128, ZLD, qt >= 8 ? qt - 8 : 0, qt + 1,
                                                 qf, t, tw0, 512, nullptr, (const LAS float*)(lds + att::TAB_OFF) + hh * 132, 0u, CS192, st, tid);
    const float g2 = sigmoidf_(zs[row * 32 + 8 + head * 3 + 2]);
    att::store_o<0>(st, g2 / st.l, ow + row * 1024 + head * 128, nullptr, lane);
}
__device__ __forceinline__ void nsa_cmp_sub(int b, int g, int qt, const bf16* z, const float* zs, const float* tabd, const bf16* kc, const bf16* vc, bf16* ow, unsigned* rmaskg,
                                            LAS unsigned char* lds, int tid) {
    const int lane = tid & 63, w = tid >> 6, hh = w >> 1, head = g * 4 + hh, hf = w & 1, tw0 = 64 * qt + 32 * hf, t = tw0 + (lane & 31), hi = lane >> 5; const size_t row = (size_t)b * SEQ + t;
    const int rowl = 32 * hf + (lane & 31);
    nsa_tabs(tabd, g, lds, tid);
    const LAS float* tab = (const LAS float*)(lds + att::TAB_OFF) + hh * 132;
    {
        const bf16* Kc = kc + (size_t)(b * 2 + g) * 128 * 192; const bf16* Vc = vc + (size_t)(b * 2 + g) * 128 * 128;
        att::Stage<192> s0; att::StageOff<192> so; att::stage_offsets<192>(so, 192, 128, tid);
        att::stage_issue<192>(s0, so, Kc, 192, Vc, 128, 0); att::stage_write<192>(s0, lds, tid);
        att::stage_issue<192>(s0, so, Kc, 192, Vc, 128, 1); att::stage_write<192>(s0, lds + att::Geo<192>::BUF, tid);
    }
    __syncthreads();
    bf16x8 qf[12]; att::load_q<192>(qf, z + row * ZLD + ZC_NQ + head * 192, lane);
    att::State st; att::state_init(st);
    float impm[16], impt[1];
#pragma unroll
    for (int i = 0; i < 16; ++i) impm[i] = 0.f;
    impt[0] = 0.f;
    att::tile_compute<192, true, false, true, false, true, 0>(lds, 0, qf, t, tw0, 0x7fffffff, nullptr, tab, 0u, CS192, st, impm, impt, lane);
    att::tile_compute<192, true, false, true, false, true, 1>(lds + att::Geo<192>::BUF, 1, qf, t, tw0, 0x7fffffff, nullptr, tab, 0u, CS192, st, impm, impt, lane);
    __syncthreads();
    const float inv = st.l > 0.f ? 1.f / st.l : 0.f;
    LAS float* IA = (LAS float*)lds;
#pragma unroll
    for (int i = 0; i < 16; ++i) { const int n = 16 * (i >> 3) + 8 * ((i >> 2) & 1) + 2 * (i & 3) + hi; IA[(hh * 64 + rowl) * 33 + n] = impm[i] * inv; }
    const float g0 = sigmoidf_(zs[row * 32 + 8 + head * 3 + 0]);
    att::store_o<1>(st, g0 * inv, ow + row * 1024 + head * 128, nullptr, lane);
    __syncthreads();
    LAS float* imps = (LAS float*)(lds + att::IMPS_OFF);
    if (tid < 64) {
        const int r = tid;
        for (int n = 0; n < 32; ++n) { float s = 0.f;
            for (int q = 0; q < 4; ++q) s += IA[(q * 64 + r) * 33 + n];
            imps[r * 33 + n] = s; }
        const int cur = qt; unsigned mask;
        if (cur < 8) mask = (2u << cur) - 1u;
        else { mask = 1u | (1u << cur) | (1u << (cur - 1));
            for (int k = 0; k < 5; ++k) { int best = 1; float bv = -1.f;
                for (int n = 1; n <= cur - 2; ++n) { const float v = imps[r * 33 + n]; if (!((mask >> n) & 1u) && v > bv) { bv = v; best = n; } }
                mask |= 1u << best; } }
        rmaskg[(size_t)(b * 2 + g) * SEQ + 64 * qt + r] = mask;
    }
    __syncthreads();
}
__device__ __forceinline__ void nsa_sel_sub(int b, int g, int qt, const bf16* z, const float* zs, const float* tabd, const bf16* ow, const unsigned* rmaskg, bf16* onsa,
                                            LAS unsigned char* lds, int tid) {
    const int lane = tid & 63, w = tid >> 6, hh = w >> 1, head = g * 4 + hh, hf = w & 1, tw0 = 64 * qt + 32 * hf, t = tw0 + (lane & 31); const size_t row = (size_t)b * SEQ + t;
    nsa_tabs(tabd, g, lds, tid);
    const LAS float* tab = (const LAS float*)(lds + att::TAB_OFF) + hh * 132;
    bf16x8 qf[12]; att::load_q<192>(qf, z + row * ZLD + ZC_NQ + head * 192, lane);
    const unsigned rowmask = rmaskg[(size_t)(b * 2 + g) * SEQ + t];
    att::State st; att::state_init(st);
    att::attn_run<192, true, false, true, true>(lds, z + (size_t)b * SEQ * ZLD + ZC_NKS + g * 192, ZLD, z + (size_t)b * SEQ * ZLD + ZC_NVS + g * 128, ZLD, 0, qt + 1,
                                                qf, t, tw0, WBIG, nullptr, tab, rowmask, CS192, st, tid);
    const float g1 = sigmoidf_(zs[row * 32 + 8 + head * 3 + 1]);
    att::store_o<2>(st, g1 / st.l, onsa + row * 1024 + head * 128, ow + row * 1024 + head * 128, lane);
}

__device__ __forceinline__ void ph_route1(const float* logits, unsigned* cnt, int* asge, int* asgi, float* asgw, int tid) {
    for (int t = blockIdx.x * 512 + tid; t < NT; t += gridDim.x * 512) {
        const f32x4 gl = *(const f32x4*)(logits + (size_t)t * 64);
        int gs = 0; float gm = gl[0];
        if (gl[1] > gm) { gm = gl[1]; gs = 1; } if (gl[2] > gm) { gm = gl[2]; gs = 2; } if (gl[3] > gm) { gm = gl[3]; gs = 3; }
        const float pg = 1.f / (expf(gl[0] - gm) + expf(gl[1] - gm) + expf(gl[2] - gm) + expf(gl[3] - gm));
        const f32x4 e0 = *(const f32x4*)(logits + (size_t)t * 64 + 4 + gs * 8), e1 = *(const f32x4*)(logits + (size_t)t * 64 + 8 + gs * 8);
        float ev[8] = {e0[0], e0[1], e0[2], e0[3], e1[0], e1[1], e1[2], e1[3]};
        int j0 = 0; float v0 = ev[0];
#pragma unroll
        for (int j = 1; j < 8; ++j) if (ev[j] > v0) { v0 = ev[j]; j0 = j; }
        int j1 = -1; float v1 = -3.0e38f;
#pragma unroll
        for (int j = 0; j < 8; ++j) if (j != j0 && ev[j] > v1) { v1 = ev[j]; j1 = j; }
        const float x1 = expf(v1 - v0), w0 = pg / (1.f + x1), w1 = pg * x1 / (1.f + x1);
        const int ea = gs * 8 + j0, eb = gs * 8 + j1;
        asge[2 * t] = ea; asge[2 * t + 1] = eb; asgw[2 * t] = w0; asgw[2 * t + 1] = w1;
        asgi[2 * t] = (int)atomicAdd(cnt + ea, 1u); asgi[2 * t + 1] = (int)atomicAdd(cnt + eb, 1u);
    }
}
__device__ __forceinline__ void ph_route2(const unsigned* cnt, const int* asge, const int* asgi, const float* asgw, const float* rstd2, const bf16* hbf,
                                          int* pos, float* roww, float* rowr, int* tile, bf16* xg, LAS unsigned char* lds, int tid, int lane, int wave) {
    LAS int* ps = (LAS int*)lds;
    if (tid == 0) { int acc = 0;
#pragma unroll 1
        for (int e = 0; e < NEXP; ++e) { const int c = (int)cnt[e]; ps[e] = acc; ps[64 + e] = c; acc += ((c + 255) >> 8) << 8; } ps[32] = acc; }
    __syncthreads();
    if (blockIdx.x == 0 && tid == 0) { int rt = 0;
#pragma unroll 1
        for (int e = 0; e < NEXP; ++e) { const int n = (ps[e + 1] - ps[e]) >> 8;
#pragma unroll 1
            for (int i = 0; i < n; ++i) tile[rt++] = e; }
        tile[200] = rt;
#pragma unroll 1
        for (; rt < 200; ++rt) tile[rt] = -1; }
    const int gw = blockIdx.x * NWAVES + wave, NGW = gridDim.x * NWAVES;
    for (int it = gw; it < NT * 2; it += NGW) {
        const int e = asge[it], dest = ps[e] + asgi[it], t = it >> 1;
        if (lane == 0) { roww[dest] = asgw[it]; rowr[dest] = rstd2[t]; pos[it] = dest; }
        const u32x4* s = (const u32x4*)(hbf + (size_t)t * DM) + lane; u32x4* d = (u32x4*)(xg + (size_t)dest * DM) + lane;
#pragma unroll
        for (int j = 0; j < 4; ++j) d[64 * j] = s[64 * j];
    }
    for (int it = gw; it < NEXP * 256; it += NGW) {
        const int e = it >> 8, r = it & 255, c = ps[64 + e], pc = ps[e + 1] - ps[e] - c;
        if (r < pc) { const int dest = ps[e] + c + r; if (lane == 0) { roww[dest] = 0.f; rowr[dest] = 0.f; }
            u32x4* d = (u32x4*)(xg + (size_t)dest * DM) + lane;
#pragma unroll
            for (int j = 0; j < 4; ++j) d[64 * j] = (u32x4){0u, 0u, 0u, 0u}; }
    }
}
__device__ __forceinline__ void ph_combine(float* hf, const bf16* y, const int* pos, bf16* hbf, float* rstd0, const float* gfin, float* out, bool last, int lane, int wave) {
    const int gw = blockIdx.x * NWAVES + wave, NGW = gridDim.x * NWAVES;
    for (int t = gw; t < NT; t += NGW) {
        const int p0 = pos[2 * t], p1 = pos[2 * t + 1];
        f32x4* hr = (f32x4*)(hf + (size_t)t * DM) + lane; const u32x2* y0 = (const u32x2*)(y + (size_t)p0 * DM) + lane; const u32x2* y1 = (const u32x2*)(y + (size_t)p1 * DM) + lane;
        f32x4 v[8]; float s = 0.f;
#pragma unroll
        for (int j = 0; j < 8; ++j) { const u32x2 a = y0[64 * j], c = y1[64 * j]; f32x4 h = hr[64 * j];
            h[0] = (h[0] + bflo(a.x)) + bflo(c.x); h[1] = (h[1] + bfhi(a.x)) + bfhi(c.x); h[2] = (h[2] + bflo(a.y)) + bflo(c.y); h[3] = (h[3] + bfhi(a.y)) + bfhi(c.y);
            v[j] = h; s += dot4v(h); }
        s = wave_sum(s, lane); const float rs = rsqrtf(s * (1.f / 2048.f) + EPS);
        if (!last) {
            u32x2* o8 = (u32x2*)(hbf + (size_t)t * DM) + lane;
#pragma unroll
            for (int j = 0; j < 8; ++j) { hr[64 * j] = v[j]; u32x2 w; w.x = cvt_pk_bf16(v[j][0], v[j][1]); w.y = cvt_pk_bf16(v[j][2], v[j][3]); o8[64 * j] = w; }
            if (lane == 0) rstd0[t] = rs;
        } else {
            f32x4* orow = (f32x4*)(out + (size_t)t * DM) + lane; const f32x4* gr = (const f32x4*)gfin + lane;
#pragma unroll
            for (int j = 0; j < 8; ++j) orow[64 * j] = v[j] * rs * gr[64 * j];
        }
    }
}
#if defined(DEBUG_CODES)
__global__ void dbg_hash(const unsigned* p, size_t nwords, unsigned long long* slot) {
    unsigned long long s = 0;
    for (size_t i = (size_t)blockIdx.x * blockDim.x + threadIdx.x; i < nwords; i += (size_t)gridDim.x * blockDim.x) s += (unsigned long long)p[i] * (2ull * i + 1ull);
    for (int o = 32; o >= 1; o >>= 1) s += __shfl_xor(s, o);
    if ((threadIdx.x & 63) == 0) atomicAdd(slot, s);
}
__global__ void dbg_nonfinite(const void* p, size_t n, int is_bf16, unsigned* slot) {
    unsigned c = 0;
    for (size_t i = (size_t)blockIdx.x * blockDim.x + threadIdx.x; i < n; i += (size_t)gridDim.x * blockDim.x) {
        if (is_bf16) { const unsigned short v = ((const unsigned short*)p)[i]; c += ((v & 0x7f80u) == 0x7f80u) ? 1u : 0u; }
        else { const unsigned v = ((const unsigned*)p)[i]; c += ((v & 0x7f800000u) == 0x7f800000u) ? 1u : 0u; }
    }
    for (int o = 32; o >= 1; o >>= 1) c += __shfl_xor(c, o);
    if ((threadIdx.x & 63) == 0 && c) atomicAdd(slot, c);
}
__global__ void dbg_final(const unsigned long long* hash, const unsigned* nf, float* out, size_t n, int nst) {
    int code = 0;
    for (int s = 34; s <= nst && !code; ++s) if (hash[64 + s] != hash[128 + s]) code = s;
    for (int s = 1; s <= 33 && !code; ++s) if (hash[64 + s] != hash[128 + s]) code = s;
    for (int s = 34; s <= nst && !code; ++s) if (hash[s] != hash[64 + s]) code = 40 + s;
    for (int s = 1; s <= 33 && !code; ++s) if (hash[s] != hash[64 + s]) code = 40 + s;
    if (code == 0) return;
    const float c = sqrtf(0.1f * (float)code);
    for (size_t i = (size_t)blockIdx.x * blockDim.x + threadIdx.x; i < n; i += (size_t)gridDim.x * blockDim.x) out[i] = c;
}
__global__ void dbg_copy(const unsigned* src, unsigned* dst, int n) { if ((int)threadIdx.x < n && src[threadIdx.x]) dst[threadIdx.x] = 1u; }
struct DbgBuf { size_t off; size_t bytes; int kind; };
static void dbg_stage(hipStream_t st, unsigned char* ws, int run, int stage, const DbgBuf* b, int nb, float* out) {
    unsigned long long* hash = (unsigned long long*)(ws + WS_DBG); unsigned* nf = (unsigned*)(ws + WS_DBG + 2048);
    for (int i = 0; i < nb; ++i) {
        const void* p = b[i].off == (size_t)-1 ? (const void*)out : (const void*)(ws + b[i].off);
        hipLaunchKernelGGL(dbg_hash, dim3(1024), dim3(256), 0, st, (const unsigned*)p, b[i].bytes / 4, hash + run * 64 + stage);
        if (b[i].kind != 2) hipLaunchKernelGGL(dbg_nonfinite, dim3(1024), dim3(256), 0, st, p, b[i].kind ? b[i].bytes / 2 : b[i].bytes / 4, b[i].kind, nf + stage);
    }
}
#endif
__device__ __forceinline__ unsigned char* lws(unsigned char* p) { asm volatile("" : "+s"(p)); return p; }
#define ltid() (wave0 * 64 + llane())
constexpr int NPH_LAYER = 15, NPHASES = 1 + DEPTH * NPH_LAYER;
__global__ void __launch_bounds__(512, 2) fwd(Args a) {
    extern __shared__ __attribute__((aligned(16))) unsigned char lds_[];
    LAS unsigned char* lds = (LAS unsigned char*)lds_;
    const int tid = threadIdx.x; const int wave0 = __builtin_amdgcn_readfirstlane(tid >> 6);
    const int G = gridDim.x, bx = blockIdx.x;
    gu32* ctl = (gu32*)(a.ws + WS_CTL);
    for (int u = tid; u < (LDS_BYTES - LDSCTL_OFF) / 4; u += 512) ((LAS unsigned*)(lds + LDSCTL_OFF))[u] = 0u;
    __syncthreads();
    const int lo = a.ph_lo, hi = a.ph_hi;
    XcdBarrier bar; bar.bar = (unsigned*)ctl + CW_BAR; bar.x = 0; bar.st = nullptr;
    if (hi - lo > 1) bar = xcd_barrier_post((unsigned*)ctl + CW_BAR, (volatile LAS unsigned*)(lds + MISC_OFF) + 8);
#define IN(k) (lo <= (k) && (k) < hi)
#define SEAM(k) do { if (IN(k) && IN((k) + 1)) xcd_barrier(bar); } while (0)

#define hbf ((bf16*)(ws + WS_HBF))
#define hf ((float*)(ws + WS_HF))
#define z ((bf16*)(ws + WS_Z))
#define zs ((float*)(ws + WS_ZS))
#define zssq ((float*)(ws + WS_ZSSQ))
#define hssq ((float*)(ws + WS_HSSQ))
#define rstd0 ((float*)(ws + WS_RSTD0))
#define rstd2 ((float*)(ws + WS_RSTD2))
#define qm ((bf16*)(ws + WS_QM))
#define km ((bf16*)(ws + WS_KM))
#define vm ((bf16*)(ws + WS_VM))
#define kc ((bf16*)(ws + WS_KC))
#define vc ((bf16*)(ws + WS_VC))
#define kb ((float*)(ws + WS_KB))
#define o3 ((bf16*)(ws + WS_O3))
#define ow ((bf16*)(ws + WS_OW))
#define mpart ((float*)(ws + WS_MPART))
#define mbf ((bf16*)(ws + WS_MBF))
#define qmem ((bf16*)(ws + WS_QMEM))
#define kvmem ((bf16*)(ws + WS_KVMEM))
#define omem ((bf16*)(ws + WS_OMEM))
#define logits ((float*)(ws + WS_LOGIT))
#define rope ((const float*)(ws + WS_ROPE))
#define tabd ((const float*)(ws + WS_TABD))
#define asge ((int*)(ws + WS_ASGE))
#define asgi ((int*)(ws + WS_ASGI))
#define asgw ((float*)(ws + WS_ASGW))
#define pos ((int*)(ws + WS_POS))
#define roww ((float*)(ws + WS_ROWW))
#define rowr ((float*)(ws + WS_ROWR))
#define tile ((int*)(ws + WS_TILE))
#define xg ((bf16*)(ws + WS_XG))
#define hdn ((bf16*)(ws + WS_HDN))
#define yb ((bf16*)(ws + WS_Y))
#ifndef PHMASK
#define PHMASK 0xFFFFFFFFu
#endif
#define EN(k) ((PHMASK >> (k)) & 1u)
    if (EN(0) && IN(0)) { asm volatile("; PHMARK 0"); unsigned char* ws = lws(a.ws); (void)ws; { const int t_ = ltid(); ph_pre(a, t_, t_ & 63, __builtin_amdgcn_readfirstlane(t_ >> 6)); } }
    SEAM(0);
#pragma unroll 1
    for (int l = 0; l < DEPTH; ++l) {
        const int pb = 1 + NPH_LAYER * l;
        if (EN(1) && IN(pb + 0)) { asm volatile("; PHMARK 1"); unsigned char* ws = lws(a.ws); (void)ws; { const int t_ = ltid(); ph_conv(a, l, lds, t_, t_ & 63, __builtin_amdgcn_readfirstlane(t_ >> 6)); } }
        SEAM(pb + 0);
        if (EN(2) && IN(pb + 1)) { asm volatile("; PHMARK 2"); unsigned char* ws = lws(a.ws); (void)ws;
            if (EN(16)) { pg8::Gemm g{hbf, (const bf16*)(ws + WS_WIN), DM, DM}; pg8::StaticOrder S; S.init(NT, ZLD, G, bx);
              pg8::EpiWin E{z, zs, zssq, rstd0, km, rope}; pg8::gemm_phase(lds, g, S, E, ltid()); }
            if (EN(17)) { pg8::Gemm g{(const bf16*)(ws + WS_MEMBF), (const bf16*)(ws + WS_WMKV), DM, DM}; pg8::StaticOrder S; S.init(NB * MEML, 1024, G, G - 1 - bx);
              pg8::EpiRowScale E{kvmem, 1024, (const float*)(ws + WS_RSTDM), nullptr}; pg8::gemm_phase(lds, g, S, E, ltid()); }
        }
        SEAM(pb + 1);
        if (EN(3) && IN(pb + 2)) { asm volatile("; PHMARK 3"); unsigned char* ws = lws(a.ws); (void)ws;
            if (EN(18)) { pg8::Gemm g{z + ZC_MCQ, (const bf16*)(ws + WS_WUQ), ZLD, 768}; pg8::StaticOrder S; S.init(NT, 1536, G, bx);
              pg8::EpiMlaQ E{qm, zssq, rope}; pg8::gemm_phase(lds, g, S, E, ltid()); }
            if (EN(19)) { pg8::Gemm g{z + ZC_MCKV, (const bf16*)(ws + WS_WUKV), ZLD, 512}; pg8::StaticOrder S; S.init(NT, 2048, G, bx);
              pg8::EpiMlaKV E{km, vm, zssq}; pg8::gemm_phase(lds, g, S, E, ltid()); }
            if (EN(20)) for (int u = bx; u < 512; u += G) nsa_win_unit(u, z, zs, tabd, ow, lds, ltid());
            if (EN(21)) { const int t_ = ltid(); for (int it = (G - 1 - bx) * NWAVES + __builtin_amdgcn_readfirstlane(t_ >> 6); it < 64; it += G * NWAVES) cumsum_item(it, zs, a.in[4] + l * 8, kb, t_ & 63); }
#if defined(COMPRESS_REF)
            if (EN(22)) for (int u = bx; u < 2 * 16 * 128; u += G) {
                const int br = u >> 11, rem = u & 2047, bg = rem >> 7, c = rem & 127; const int t_ = ltid();
                if (c < 127) { if (br == 0) compress_ref<192>(bg >> 1, bg & 1, c, z + ZC_NKC, (const bf16*)(ws + WS_WCK1), (const bf16*)(ws + WS_WCK2), (const float*)(ws + WS_C1P), 96, kc, lds, t_);
                               else compress_ref<128>(bg >> 1, bg & 1, c, z + ZC_NVC, (const bf16*)(ws + WS_WCV1), (const bf16*)(ws + WS_WCV2), (const float*)(ws + WS_C1P) + 96 * 192, 64, vc, lds, t_); }
                else { bf16* o = (br == 0 ? kc + (size_t)bg * 128 * 192 + 127 * 192 : vc + (size_t)bg * 128 * 128 + 127 * 128); if (t_ < (br == 0 ? 192 : 128)) o[t_] = 0; }
            }
#else
            if (EN(22)) for (int u = G - 1 - bx; u < 128; u += G) {
                const int br = u >> 6, rem = u & 63, b = rem >> 3, g2 = (rem >> 2) & 1, ct = rem & 3;
                if (br == 0) compress_body<192>(b, g2, ct, z + ZC_NKC, (const bf16*)(ws + WS_WCK1), (const bf16*)(ws + WS_WCK2), (const float*)(ws + WS_C1P), 96, kc, lds, ltid(), (unsigned*)ctl + CW_CHK);
                else compress_body<128>(b, g2, ct, z + ZC_NVC, (const bf16*)(ws + WS_WCV1), (const bf16*)(ws + WS_WCV2), (const float*)(ws + WS_C1P) + 96 * 192, 64, vc, lds, ltid(), (unsigned*)ctl + CW_CHK + 8);
            }
#endif
        }
        SEAM(pb + 2);
        if (EN(4) && IN(pb + 3)) { asm volatile("; PHMARK 4"); unsigned char* ws = lws(a.ws); (void)ws;
            if (EN(23)) for (int u = bx; u < 256; u += G) { const int bh = u >> 2, p = u & 3; fox_sub(bh >> 3, bh & 7, 7 - p, z, kb, o3, lds, ltid()); fox_sub(bh >> 3, bh & 7, p, z, kb, o3, lds, ltid()); }
            if (EN(24)) for (int u = bx; u < 256; u += G) { const int bh = u >> 2, p = u & 3; mla_sub(bh >> 3, bh & 7, 7 - p, qm, km, vm, o3 + (size_t)NT * 1024, lds, ltid()); mla_sub(bh >> 3, bh & 7, p, qm, km, vm, o3 + (size_t)NT * 1024, lds, ltid()); }
            if (EN(25)) for (int u = bx; u < 256; u += G) { const int b = u >> 5, g2 = (u >> 4) & 1, p = u & 15;
                nsa_cmp_sub(b, g2, 31 - p, z, zs, tabd, kc, vc, ow, (unsigned*)(ws + WS_RMASK), lds, ltid()); nsa_cmp_sub(b, g2, p, z, zs, tabd, kc, vc, ow, (unsigned*)(ws + WS_RMASK), lds, ltid()); }
            if (EN(26)) for (int u = bx; u < 256; u += G) { const int b = u >> 5, g2 = (u >> 4) & 1, p = u & 15;
                nsa_sel_sub(b, g2, 31 - p, z, zs, tabd, ow, (const unsigned*)(ws + WS_RMASK), o3 + (size_t)2 * NT * 1024, lds, ltid());
                nsa_sel_sub(b, g2, p, z, zs, tabd, ow, (const unsigned*)(ws + WS_RMASK), o3 + (size_t)2 * NT * 1024, lds, ltid()); }
        }
        SEAM(pb + 3);
        if (EN(5) && IN(pb + 4)) { asm volatile("; PHMARK 5"); unsigned char* ws = lws(a.ws); (void)ws;
            pg8::Gemm g{o3, (const bf16*)(ws + WS_WBR), 1024, 1024}; pg8::BranchOrder S; S.init(G, bx);
            pg8::EpiBranch E{z, mpart, mbf}; pg8::gemm_phase(lds, g, S, E, ltid());
        }
        SEAM(pb + 4);
        if (EN(6) && IN(pb + 5)) { asm volatile("; PHMARK 6"); unsigned char* ws = lws(a.ws); (void)ws;
            pg8::Gemm g{mbf, (const bf16*)(ws + WS_WOUT), DM, DM}; pg8::StaticOrder S; S.init(NT, DM, G, bx);
            pg8::EpiResid E{l == 0 ? a.in[0] : (const float*)hf, hf, hbf, hssq}; pg8::gemm_phase(lds, g, S, E, ltid());
        }
        SEAM(pb + 5);
        if (EN(7) && IN(pb + 6)) { asm volatile("; PHMARK 7"); unsigned char* ws = lws(a.ws); (void)ws;
            pg8::Gemm g{hbf, (const bf16*)(ws + WS_WMQ), DM, DM}; pg8::StaticOrder S; S.init(NT, 512, G, bx);
            pg8::EpiRowScale E{qmem, 512, nullptr, hssq}; pg8::gemm_phase(lds, g, S, E, ltid());
        }
        SEAM(pb + 6);
        if (EN(8) && IN(pb + 7)) { asm volatile("; PHMARK 8"); unsigned char* ws = lws(a.ws); (void)ws; for (int u = bx; u < 256; u += G) mem_unit(u, qmem, kvmem, omem, lds, ltid()); }
        SEAM(pb + 7);
        if (EN(9) && IN(pb + 8)) { asm volatile("; PHMARK 9"); unsigned char* ws = lws(a.ws); (void)ws;
            pg8::Gemm g{omem, (const bf16*)(ws + WS_WMO), 512, 512}; pg8::StaticOrder S; S.init(NT, DM, G, bx);
            pg8::EpiResid E{hf, hf, hbf, hssq}; pg8::gemm_phase(lds, g, S, E, ltid());
        }
        SEAM(pb + 8);
        if (EN(10) && IN(pb + 9)) { asm volatile("; PHMARK 10"); unsigned char* ws = lws(a.ws); (void)ws;
            pg8::Gemm g{hbf, (const bf16*)(ws + WS_WR), DM, DM}; pg8::StaticOrder S; S.init(NT, 256, G, bx);
            pg8::EpiRouter E{logits, hssq, (const float*)(ws + WS_BRT), rstd2}; pg8::gemm_phase(lds, g, S, E, ltid());
        }
        SEAM(pb + 9);
        if (EN(11) && IN(pb + 10)) { asm volatile("; PHMARK 11"); unsigned char* ws = lws(a.ws); (void)ws; ph_route1(logits, (unsigned*)ctl + CW_CNT + l * 64, asge, asgi, asgw, ltid()); }
        SEAM(pb + 10);
        if (EN(12) && IN(pb + 11)) { asm volatile("; PHMARK 12"); unsigned char* ws = lws(a.ws); (void)ws; const int t_ = ltid(); ph_route2((const unsigned*)ctl + CW_CNT + l * 64, asge, asgi, asgw, rstd2, hbf, pos, roww, rowr, tile, xg, lds, t_, t_ & 63, __builtin_amdgcn_readfirstlane(t_ >> 6)); __syncthreads(); }
        SEAM(pb + 11);
        if (EN(13) && IN(pb + 12)) { asm volatile("; PHMARK 13"); unsigned char* ws = lws(a.ws); (void)ws;
            pg8::Gemm g{xg, (const bf16*)(ws + WS_WGU), DM, DM}; pg8::MoeOrder S; S.init(tile, G, bx);
            pg8::EpiGateUp E{hdn, rowr}; pg8::gemm_phase(lds, g, S, E, ltid());
        }
        SEAM(pb + 12);
        if (EN(14) && IN(pb + 13)) { asm volatile("; PHMARK 14"); unsigned char* ws = lws(a.ws); (void)ws;
            pg8::Gemm g{hdn, (const bf16*)(ws + WS_WD), DEXP, DEXP}; pg8::MoeOrder S; S.init(tile, G, bx);
            pg8::EpiDown E{yb, roww}; pg8::gemm_phase(lds, g, S, E, ltid());
        }
        SEAM(pb + 13);
        if (EN(15) && IN(pb + 14)) { asm volatile("; PHMARK 15"); unsigned char* ws = lws(a.ws); (void)ws; { const int t_ = ltid(); ph_combine(hf, yb, pos, hbf, rstd0, a.in[31], a.out, l == DEPTH - 1, t_ & 63, __builtin_amdgcn_readfirstlane(t_ >> 6)); } }
        SEAM(pb + 14);
    }
#undef IN
#undef SEAM
#undef hbf
#undef hf
#undef z
#undef zs
#undef zssq
#undef hssq
#undef rstd0
#undef rstd2
#undef qm
#undef km
#undef vm
#undef kc
#undef vc
#undef kb
#undef o3
#undef ow
#undef mpart
#undef mbf
#undef qmem
#undef kvmem
#undef omem
#undef logits
#undef rope
#undef tabd
#undef asge
#undef asgi
#undef asgw
#undef pos
#undef roww
#undef rowr
#undef tile
#undef xg
#undef hdn
#undef yb
}

#ifndef N_LAUNCH_MODE
#define N_LAUNCH_MODE 1
#endif
extern "C" void kernel_launch(void* const* d_in, const int* in_sizes, int n_in, void* d_out, int out_size, void* d_ws, size_t ws_size, hipStream_t stream) {
    static int grid = 0;
    if (grid == 0) {
        if (n_in != 32 || out_size != NT * DM || ws_size < WS_END) { fprintf(stderr, "kernel_launch: unexpected shapes (n_in %d out %d ws %zu need %zu)\n", n_in, out_size, ws_size, (size_t)WS_END); grid = -1; return; }
        int dev = 0, cus = 0, per_cu = 0;
        if (hipGetDevice(&dev) != hipSuccess || hipDeviceGetAttribute(&cus, hipDeviceAttributeMultiprocessorCount, dev) != hipSuccess) { grid = -1; return; }
        if (hipFuncSetAttribute((const void*)fwd, hipFuncAttributeMaxDynamicSharedMemorySize, LDS_BYTES) != hipSuccess) { fprintf(stderr, "kernel_launch: hipFuncSetAttribute failed\n"); grid = -1; return; }
        if (hipOccupancyMaxActiveBlocksPerMultiprocessor(&per_cu, (const void*)fwd, 512, LDS_BYTES) != hipSuccess || per_cu < 1) fprintf(stderr, "kernel_launch: occupancy query says %d\n", per_cu);
        (void)hipGetLastError();
        grid = cus;
    }
    if (grid < 0) return;
    Args a{};
    for (int i = 0; i < 32; ++i) a.in[i] = (const float*)d_in[i];
    a.out = (float*)d_out; a.ws = (unsigned char*)d_ws; a.dbg = 0; a.pad = 0;
#if defined(DEBUG_CODES)
    unsigned char* ws = (unsigned char*)d_ws;
    (void)hipMemsetAsync(ws, 0xAA, WS_END, stream);
    (void)hipMemsetAsync(ws + WS_DBG, 0, 4096, stream);
    for (int run = 0; run < 3; ++run) {
        (void)hipMemsetAsync((char*)d_ws + WS_CTL, 0, CTL_ZERO_BYTES, stream);
        for (int p = 0; p < NPHASES; ++p) {
            a.ph_lo = p; a.ph_hi = p + 1; hipLaunchKernelGGL(fwd, dim3(grid), dim3(512), LDS_BYTES, stream, a);
            const int l = p == 0 ? 0 : (p - 1) / NPH_LAYER, j = p == 0 ? -1 : (p - 1) % NPH_LAYER;
            auto one = [&](int stage, size_t off, size_t bytes, int kind) { const DbgBuf b[] = {{off, bytes, kind}}; dbg_stage(stream, ws, run, stage, b, 1, a.out); };
            if (l == 0) {
                if (j == 0) { one(34, WS_WIN, (size_t)ZLD * DM * 2, 1); one(35, WS_WCK1, (size_t)192 * 6144 * 2, 1); one(36, WS_WCK2, (size_t)192 * 192 * 2, 1); one(37, WS_C1P, (size_t)(96 * 192 + 64 * 128) * 4, 0);
                              one(38, WS_WCV1, (size_t)128 * 4096 * 2, 1); one(39, WS_ROPE, (size_t)2048 * 64 * 4, 0); }
                if (j == 1) { one(1, WS_Z, (size_t)NT * ZLD * 2, 1); one(2, WS_ZS, (size_t)NT * 32 * 4, 0); one(3, WS_KVMEM, (size_t)2048 * 1024 * 2, 1); }
                if (j == 2) { hipLaunchKernelGGL(dbg_copy, dim3(1), dim3(64), 0, stream, (const unsigned*)(ws + WS_CTL) + CW_CHK, (unsigned*)(ws + WS_DBG + 2048) + 48, 16); one(4, WS_QM, (size_t)NT * 1536 * 2, 1); one(5, WS_KM, (size_t)NT * 1536 * 2, 1); one(6, WS_VM, (size_t)NT * 1024 * 2, 1); one(7, WS_OW, (size_t)NT * 1024 * 2, 1);
                              one(8, WS_KB, (size_t)64 * 2048 * 4, 0); one(9, WS_KC, (size_t)16 * 128 * 192 * 2, 1); one(10, WS_VC, (size_t)16 * 128 * 128 * 2, 1); }
                if (j == 3) { one(11, WS_O3, (size_t)NT * 1024 * 2, 1); one(12, WS_O3 + (size_t)NT * 1024 * 2, (size_t)NT * 1024 * 2, 1); one(13, WS_RMASK, (size_t)16 * 2048 * 4, 2);
                              one(14, WS_O3 + (size_t)2 * NT * 1024 * 2, (size_t)NT * 1024 * 2, 1); one(15, WS_OW, (size_t)NT * 1024 * 2, 1); }
                if (j == 4) one(16, WS_MBF, (size_t)NT * DM * 2, 1);
                if (j == 5) { one(17, WS_HF, (size_t)NT * DM * 4, 0); one(18, WS_HBF, (size_t)NT * DM * 2, 1); one(19, WS_HSSQ, (size_t)NT * 32 * 4, 0); }
                if (j == 6) one(20, WS_QMEM, (size_t)NT * 512 * 2, 1);
                if (j == 7) one(21, WS_OMEM, (size_t)NT * 512 * 2, 1);
                if (j == 8) { one(22, WS_HF, (size_t)NT * DM * 4, 0); one(23, WS_HBF, (size_t)NT * DM * 2, 1); one(24, WS_HSSQ, (size_t)NT * 32 * 4, 0); }
                if (j == 9) { one(25, WS_LOGIT, (size_t)NT * 64 * 4, 0); one(26, WS_RSTD2, (size_t)NT * 4, 0); }
                if (j == 10) { one(27, WS_ASGE, (size_t)NT * 2 * 4, 2); one(28, WS_ASGW, (size_t)NT * 2 * 4, 0); }
                if (j == 11) one(29, WS_TILE, (size_t)201 * 4, 2);
                if (j == 14) { one(30, WS_HF, (size_t)NT * DM * 4, 0); one(31, WS_HBF, (size_t)NT * DM * 2, 1); one(32, WS_RSTD0, (size_t)NT * 4, 0); }
            } else if (j == 14) one(33, (size_t)-1, (size_t)NT * DM * 4, 0);
        }
    }
    hipLaunchKernelGGL(dbg_final, dim3(1024), dim3(256), 0, stream, (const unsigned long long*)(ws + WS_DBG), (const unsigned*)(ws + WS_DBG + 2048), a.out, (size_t)NT * DM, 39);
#else
    (void)hipMemsetAsync((char*)d_ws + WS_CTL, 0, CTL_ZERO_BYTES, stream);
#if N_LAUNCH_MODE == 0
    a.ph_lo = 0; a.ph_hi = NPHASES;
    hipLaunchKernelGGL(fwd, dim3(grid), dim3(512), LDS_BYTES, stream, a);
#else
    for (int p = 0; p < NPHASES; ++p) { a.ph_lo = p; a.ph_hi = p + 1; hipLaunchKernelGGL(fwd, dim3(grid), dim3(512), LDS_BYTES, stream, a); }
#endif
#endif
}
```

```cpp
#define N_LAUNCH_MODE 0
#include <hip/hip_runtime.h>
#include <cstdio>
#include <cstdint>

#define LAS __attribute__((address_space(3)))
#define GAS __attribute__((address_space(1)))
typedef unsigned short bf16;
typedef short bf16x8 __attribute__((ext_vector_type(8)));
typedef short s16x4 __attribute__((ext_vector_type(4)));
typedef short v4i16_t __attribute__((ext_vector_type(4)));
typedef float f32x2 __attribute__((ext_vector_type(2)));
typedef float f32x4 __attribute__((ext_vector_type(4)));
typedef float f32x16 __attribute__((ext_vector_type(16)));
typedef unsigned u32x2 __attribute__((ext_vector_type(2)));
typedef unsigned u32x4 __attribute__((ext_vector_type(4)));
typedef GAS unsigned gu32;

constexpr int DM = 2048, NB = 8, SEQ = 2048, DEPTH = 2, NT = NB * SEQ;
constexpr int MEML = 256;
constexpr float EPS = 1e-6f;
constexpr int D_IN = 14048, ZLD = 14080;
constexpr int ZC_FQ = 0, ZC_FK = 1024, ZC_FV = 2048, ZC_MCQ = 3072, ZC_MCKV = 3840, ZC_MKR = 4352, ZC_NQ = 4416, ZC_NKC = 5952, ZC_NVC = 6336,
              ZC_NKS = 6592, ZC_NVS = 6976, ZC_NKW = 7232, ZC_NVW = 7616, ZC_MG = 7872, ZC_FF = 14016, ZC_NGT = 14024;
constexpr int NEXP = 32, DEXP = 1024, PMAX = 40960;
constexpr float LOG2E = 1.4426950408889634f;

constexpr size_t MiB = 1u << 20;
constexpr size_t al256(size_t x) { return (x + 255) & ~(size_t)255; }
constexpr size_t WS_CTL = 0, CTL_ZERO_BYTES = 1 * MiB;
constexpr size_t WS_WIN  = 1 * MiB;
constexpr size_t WS_WUQ  = WS_WIN  + al256((size_t)ZLD * DM * 2);
constexpr size_t WS_WUKV = WS_WUQ  + al256((size_t)1536 * 768 * 2);
constexpr size_t WS_WCK1 = WS_WUKV + al256((size_t)2048 * 512 * 2);
constexpr size_t WS_WCK2 = WS_WCK1 + al256((size_t)192 * 6144 * 2);
constexpr size_t WS_WCV1 = WS_WCK2 + al256((size_t)192 * 192 * 2);
constexpr size_t WS_WCV2 = WS_WCV1 + al256((size_t)128 * 4096 * 2);
constexpr size_t WS_WBR  = WS_WCV2 + al256((size_t)128 * 128 * 2);
constexpr size_t WS_WOUT = WS_WBR  + al256((size_t)3 * 2048 * 1024 * 2);
constexpr size_t WS_WMQ  = WS_WOUT + al256((size_t)2048 * 2048 * 2);
constexpr size_t WS_WMKV = WS_WMQ  + al256((size_t)512 * 2048 * 2);
constexpr size_t WS_WMO  = WS_WMKV + al256((size_t)1024 * 2048 * 2);
constexpr size_t WS_WR   = WS_WMO  + al256((size_t)2048 * 512 * 2);
constexpr size_t WS_WGU  = WS_WR   + al256((size_t)256 * 2048 * 2);
constexpr size_t WS_WD   = WS_WGU  + al256((size_t)NEXP * 2048 * 2048 * 2);
constexpr size_t WS_ACT  = WS_WD   + al256((size_t)NEXP * 2048 * 1024 * 2);
constexpr size_t WS_HBF  = WS_ACT;
constexpr size_t WS_HF   = WS_HBF  + al256((size_t)NT * DM * 2);
constexpr size_t WS_Z    = WS_HF   + al256((size_t)NT * DM * 4);
constexpr size_t WS_XG   = WS_Z;
constexpr size_t WS_HDN  = WS_XG   + al256((size_t)PMAX * 2048 * 2);
constexpr size_t WS_Y    = WS_HDN  + al256((size_t)PMAX * 1024 * 2);
constexpr size_t WS_ZEND = WS_Z    + al256((size_t)NT * ZLD * 2);
static_assert(WS_Y + (size_t)PMAX * 2048 * 2 <= WS_ZEND, "MoE overlay fits in z");
constexpr size_t WS_ZS   = WS_ZEND;
constexpr size_t WS_ZSSQ = WS_ZS   + al256((size_t)NT * 32 * 4);
constexpr size_t WS_HSSQ = WS_ZSSQ + al256((size_t)NT * 32 * 4);
constexpr size_t WS_RSTD0= WS_HSSQ + al256((size_t)NT * 32 * 4);
constexpr size_t WS_RSTD2= WS_RSTD0+ al256((size_t)NT * 4);
constexpr size_t WS_QM   = WS_RSTD2+ al256((size_t)NT * 4);
constexpr size_t WS_KM   = WS_QM   + al256((size_t)NT * 1536 * 2);
constexpr size_t WS_VM   = WS_KM   + al256((size_t)NT * 1536 * 2);
constexpr size_t WS_KC   = WS_VM   + al256((size_t)NT * 1024 * 2);
constexpr size_t WS_VC   = WS_KC   + al256((size_t)16 * 128 * 192 * 2);
constexpr size_t WS_KB   = WS_VC   + al256((size_t)16 * 128 * 128 * 2);
constexpr size_t WS_O3   = WS_KB   + al256((size_t)64 * 2048 * 4);
constexpr size_t WS_OW   = WS_O3   + al256((size_t)3 * NT * 1024 * 2);
constexpr size_t WS_MPART= WS_OW   + al256((size_t)NT * 1024 * 2);
constexpr size_t WS_MBF  = WS_MPART+ al256((size_t)NT * DM * 4);
constexpr size_t WS_QMEM = WS_MBF  + al256((size_t)NT * DM * 2);
constexpr size_t WS_KVMEM= WS_QMEM + al256((size_t)NT * 512 * 2);
constexpr size_t WS_OMEM = WS_KVMEM+ al256((size_t)2048 * 1024 * 2);
constexpr size_t WS_LOGIT= WS_OMEM + al256((size_t)NT * 512 * 2);
constexpr size_t WS_MEMBF= WS_LOGIT+ al256((size_t)NT * 64 * 4);
constexpr size_t WS_RSTDM= WS_MEMBF+ al256((size_t)2048 * 2048 * 2);
constexpr size_t WS_ROPE = WS_RSTDM+ al256((size_t)2048 * 4);
constexpr size_t WS_TABD = WS_ROPE + al256((size_t)2048 * 64 * 4);
constexpr size_t WS_C1P  = WS_TABD + al256((size_t)8 * 132 * 4);
constexpr size_t WS_BRT  = WS_C1P  + al256((size_t)(96 * 192 + 64 * 128) * 4);
constexpr size_t WS_ASGE = WS_BRT  + al256(64 * 4);
constexpr size_t WS_ASGI = WS_ASGE + al256((size_t)NT * 2 * 4);
constexpr size_t WS_ASGW = WS_ASGI + al256((size_t)NT * 2 * 4);
constexpr size_t WS_POS  = WS_ASGW + al256((size_t)NT * 2 * 4);
constexpr size_t WS_ROWW = WS_POS  + al256((size_t)NT * 2 * 4);
constexpr size_t WS_ROWR = WS_ROWW + al256((size_t)PMAX * 4);
constexpr size_t WS_TILE = WS_ROWR + al256((size_t)PMAX * 4);
constexpr size_t WS_RMASK= WS_TILE + al256(256 * 4);
constexpr size_t WS_DBG  = WS_RMASK+ al256((size_t)16 * 2048 * 4);
constexpr size_t WS_END  = WS_DBG  + al256(4096);
static_assert(WS_END <= (size_t)2048 * MiB, "workspace budget");

constexpr int CW_BAR = 4096;
constexpr int CW_CNT = 8192;
constexpr int CW_CHK = 12288;

constexpr int RING_BYTES = 131072;
constexpr int LDSCTL_OFF = RING_BYTES, MISC_OFF = LDSCTL_OFF + 320;
constexpr int LDS_BYTES = 147456;
constexpr int NWAVES = 8;

#define RLX_AGENT __ATOMIC_RELAXED, __HIP_MEMORY_SCOPE_AGENT
#define LDS_WAIT() asm volatile("s_waitcnt lgkmcnt(0)" ::: "memory")
#define VM_WAIT() asm volatile("s_waitcnt vmcnt(0)" ::: "memory")

typedef __bf16 bf16x2_t __attribute__((ext_vector_type(2)));
__device__ __forceinline__ unsigned cvt_pk_bf16(float lo, float hi) { const f32x2 v = {lo, hi}; const bf16x2_t b = __builtin_convertvector(v, bf16x2_t); return __builtin_bit_cast(unsigned, b); }
__device__ __forceinline__ float bf2f(unsigned short b) { return __uint_as_float(((unsigned)b) << 16); }
__device__ __forceinline__ float bflo(unsigned w) { return __uint_as_float(w << 16); }
__device__ __forceinline__ float bfhi(unsigned w) { return __uint_as_float(w & 0xffff0000u); }
__device__ __forceinline__ unsigned short f2bf(float f) { return (unsigned short)(cvt_pk_bf16(f, 0.f) & 0xffffu); }
__device__ __forceinline__ int llane() { int l; asm volatile("v_mbcnt_lo_u32_b32 %0, -1, 0\n\tv_mbcnt_hi_u32_b32 %0, -1, %0" : "=v"(l)); return l; }
__device__ __forceinline__ float shx(float v, int mask, int lane) { return __int_as_float(__builtin_amdgcn_ds_bpermute((lane ^ mask) << 2, __float_as_int(v))); }
__device__ __forceinline__ float wave_sum(float v, int lane) {
#pragma unroll
    for (int o = 1; o < 64; o <<= 1) v += shx(v, o, lane);
    return v;
}
__device__ __forceinline__ float dot4v(f32x4 a) { return (a[0] * a[0] + a[1] * a[1]) + (a[2] * a[2] + a[3] * a[3]); }
__device__ __forceinline__ float sigmoidf_(float x) { return 1.f / (1.f + __expf(-x)); }

#define XB_TMO      128
#define XB_XCNT(j)  (256  + 64 * (j))
#define XB_XSUB(j)  (1280 + 64 * (j))
#define XB_XGEN(j)  (2304 + 64 * (j))
#define XB_TOP      3328
#define XB_TOPGEN   3392
#define XCD_BAR_WORDS 3456
#define XB_SPIN_CAP (1u << 18)
__device__ __forceinline__ unsigned xb_ld(unsigned* p)              { return __hip_atomic_load(p, __ATOMIC_RELAXED, __HIP_MEMORY_SCOPE_AGENT); }
__device__ __forceinline__ unsigned xb_add(unsigned* p, unsigned v) { return __hip_atomic_fetch_add(p, v, __ATOMIC_RELAXED, __HIP_MEMORY_SCOPE_AGENT); }
__device__ __forceinline__ unsigned xb_xcc_id() { return (unsigned)__builtin_amdgcn_s_getreg((3 << 11) | 20) & 0xFu; }
#define XB_SPIN(cond, bar) do { unsigned _sp = 0; while (cond) { __builtin_amdgcn_s_sleep(1); \
    if ((++_sp & 255u) == 0u) { if (xb_ld(&(bar)[XB_TMO])) break; if (_sp > XB_SPIN_CAP) { atomicAdd(&(bar)[XB_TMO], 1u); break; } } } } while (0)
struct XcdBarrier { unsigned* bar; unsigned x; volatile LAS unsigned* st; };
__device__ __forceinline__ XcdBarrier xcd_barrier_post(unsigned* bar, volatile LAS unsigned* st) {
    XcdBarrier b; b.bar = bar; b.x = xb_xcc_id(); b.st = st;
    if (threadIdx.x == 0) (void)xb_add(&bar[XB_XCNT(b.x)], 1u);
    return b;
}
__device__ __forceinline__ void xcd_barrier_complete(unsigned* bar, unsigned x, unsigned& nloc, unsigned& nx) {
    const unsigned G = gridDim.x * gridDim.y * gridDim.z;
    unsigned sum, cnt, mine, sp = 0u;
    for (;;) {
        sum = 0u; cnt = 0u; mine = 0u;
#pragma unroll
        for (unsigned j = 0; j < 16; ++j) { const unsigned c = xb_ld(&bar[XB_XCNT(j)]); sum += c; cnt += (c > 0u) ? 1u : 0u; mine = (j == x) ? c : mine; }
        if (sum == G) break;
        __builtin_amdgcn_s_sleep(1);
        if ((++sp & 255u) == 0u) { if (xb_ld(&bar[XB_TMO])) break; if (sp > XB_SPIN_CAP) { atomicAdd(&bar[XB_TMO], 1u); break; } }
    }
    nloc = mine > 0u ? mine : 1u; nx = cnt > 0u ? cnt : 1u;
}
__device__ __forceinline__ void xcd_barrier(const XcdBarrier& b) {
    asm volatile("s_waitcnt vmcnt(0)" ::: "memory");
    __syncthreads();
    if (threadIdx.x == 0) {
        unsigned* bar = b.bar;
        __builtin_amdgcn_s_waitcnt(0);
        unsigned nloc = b.st[0], nx = b.st[1];
        if (nloc == 0u) { xcd_barrier_complete(bar, b.x, nloc, nx); b.st[0] = nloc; b.st[1] = nx; }
        const unsigned old = xb_add(&bar[XB_XSUB(b.x)], 1u);
        const unsigned gen = old / nloc;
        if (old + 1u == (gen + 1u) * nloc) {
            __builtin_amdgcn_fence(__ATOMIC_RELEASE, "agent");
            asm volatile("s_waitcnt vmcnt(0)" ::: "memory");
            const unsigned og = xb_add(&bar[XB_TOP], 1u);
            const unsigned tg = og / nx;
            if (og + 1u == (tg + 1u) * nx) xb_add(&bar[XB_TOPGEN], 1u);
            else XB_SPIN(xb_ld(&bar[XB_TOPGEN]) == tg, bar);
            __builtin_amdgcn_fence(__ATOMIC_ACQUIRE, "agent");
            xb_add(&bar[XB_XGEN(b.x)], 1u);
            asm volatile("s_waitcnt vmcnt(0)" ::: "memory");
        } else {
            XB_SPIN(xb_ld(&bar[XB_XGEN(b.x)]) == gen, bar);
            __builtin_amdgcn_fence(__ATOMIC_ACQUIRE, "agent");
            asm volatile("s_waitcnt vmcnt(0)" ::: "memory");
        }
    }
    __syncthreads();
}
namespace pg8 {
constexpr int BM = 256, BK = 64, HALF = 128, HTB = HALF * BK * 2, STAGE_BYTES = 8 * HTB, NXCD = 8, WGM = 8;
__host__ __device__ __forceinline__ int lds_byte(int r, int c) { const int st = (r >> 4) * 2 + (c >> 5), rr = r & 15, cc = c & 31, ob = rr * 64 + cc * 2; return st * 1024 + (ob ^ (((ob >> 9) & 1) << 5)); }
__host__ __device__ __forceinline__ void stage_rc(int b, int& R, int& C) { const int st = b / 1024, sb = b % 1024, swz = sb ^ (((sb >> 9) & 1) << 5); R = (st >> 1) * 16 + swz / 64; C = (st & 1) * 32 + (swz % 64) / 2; }
__host__ __device__ __forceinline__ int perm32(int rho) { const int n = rho >> 4, i = rho & 15; return 8 * (i >> 2) + 4 * n + (i & 3); }

struct Unit { int pm, pn; };
struct Gemm { const bf16* A; const bf16* Bt; int lda; int K; };

struct StaticOrder {
    int nM, nN, nwg, G, c;
    __device__ void init(int M, int N, int G_, int c_) { nM = M / BM; nN = N / BM; nwg = nM * nN; G = G_; c = c_; }
    __device__ __forceinline__ bool next(int i, Unit& u) const {
        const long L = (long)i * G + c; if (L >= nwg) return false;
        int wgid = (int)L; { const int q = nwg / NXCD, r = nwg % NXCD, xcd = wgid % NXCD, off = wgid / NXCD; wgid = (xcd < r ? xcd * (q + 1) : r * (q + 1) + (xcd - r) * q) + off; }
        const int nig = WGM * nN, gid = wgid / nig, fm = gid * WGM, gsz = (nM - fm) < WGM ? (nM - fm) : WGM;
        u.pm = fm + ((wgid % nig) % gsz); u.pn = (wgid % nig) / gsz; return true;
    }
};
struct BranchOrder {
    StaticOrder S;
    __device__ void init(int G_, int c_) { S.init(NT, 2048, G_, c_); }
    __device__ __forceinline__ bool next(int i, Unit& u) const {
        Unit t; if (!S.next(i / 3, t)) return false; const int n = i % 3;
        u.pm = n * 64 + t.pm; u.pn = n * 8 + t.pn; return true;
    }
};
struct MoeOrder {
    const int* tile_e; int nunits, G, c;
    __device__ void init(const int* tab, int G_, int c_) { tile_e = tab; nunits = tab[200] * 8; G = G_; c = c_; }
    __device__ __forceinline__ bool next(int i, Unit& u) const {
        const int L = i * G + c; if (L >= nunits) return false;
        const int rt = L >> 3, j = L & 7; u.pm = rt; u.pn = tile_e[rt] * 8 + j; return true;
    }
};

template <class Epi, class Sched>
__device__ __forceinline__ void gemm_phase(LAS unsigned char* lds, const Gemm g, const Sched& S, const Epi& E, int tid) {
    const int wid = __builtin_amdgcn_readfirstlane(tid >> 6), lane = tid & 63, wr = wid >> 2, wc = wid & 3, fr = lane & 15, fq = lane >> 4;
    const int K = g.K, nt = K / BK, lda = g.lda;
    unsigned voffA[2], voffB[2];
#pragma unroll
    for (int i = 0; i < 2; ++i) { int R, C; stage_rc(tid * 16 + i * 8192, R, C); const int Rb = Epi::PERM ? ((R & ~31) + perm32(R & 31)) : R;
        voffA[i] = (unsigned)(R * lda + C) * 2u; voffB[i] = (unsigned)(Rb * K + C) * 2u; }
    const size_t kstep = (size_t)(BK * 2);
    const size_t hstepA = (size_t)HALF * lda * 2, hstepB = (size_t)HALF * K * 2;
    const size_t tstepA = 2 * hstepA, tstepB = 2 * hstepB;
    const unsigned ldsw = (unsigned)wid * 1024u;
    const int aoff = lds_byte(wr * 64 + fr, fq * 8), boff = lds_byte(wc * 32 + fr, fq * 8);
#define PG8_SA(b, h) (((b) * 2 + (h)) * HTB)
#define PG8_SB(b, h) ((4 + (b) * 2 + (h)) * HTB)
#define PG8_STAGE(bufoff, gbase, voff) do { _Pragma("unroll") for (int _i = 0; _i < 2; ++_i) \
        __builtin_amdgcn_global_load_lds((const unsigned*)((const char*)(gbase) + (voff)[_i]), (LAS unsigned*)(lds + (bufoff) + ldsw + _i * 8192), 16, 0, 0); } while (0)
#define PG8_LDA(dst, b, h) do { _Pragma("unroll") for (int m = 0; m < 4; ++m) _Pragma("unroll") for (int k = 0; k < 2; ++k) dst[m][k] = *(const LAS bf16x8*)(lds + PG8_SA(b, h) + aoff + m * 2048 + k * 1024); } while (0)
#define PG8_LDB(dst, b, h) do { _Pragma("unroll") for (int n = 0; n < 2; ++n) _Pragma("unroll") for (int k = 0; k < 2; ++k) dst[n][k] = *(const LAS bf16x8*)(lds + PG8_SB(b, h) + boff + n * 2048 + k * 1024); } while (0)
#define PG8_MMA(ai, bj, At, Bt) do { __builtin_amdgcn_s_setprio(1); _Pragma("unroll") for (int m = 0; m < 4; ++m) _Pragma("unroll") for (int n = 0; n < 2; ++n) _Pragma("unroll") for (int k = 0; k < 2; ++k) \
        acc[ai][bj][m][n] = __builtin_amdgcn_mfma_f32_16x16x32_bf16(Bt[n][k], At[m][k], acc[ai][bj][m][n], 0, 0, 0); __builtin_amdgcn_s_setprio(0); } while (0)
#define PG8_WAIT_V(n) asm volatile("s_waitcnt vmcnt(" #n ")" ::: "memory")
#define PG8_WAIT_L(n) asm volatile("s_waitcnt lgkmcnt(" #n ")" ::: "memory")
#define PG8_BAR __builtin_amdgcn_s_barrier()
#define PG8_SCHED __builtin_amdgcn_sched_barrier(0)
    Unit cur, nxt; int ui = 0;
    if (!S.next(0, cur)) return;
    f32x4 acc[2][2][4][2];
#pragma unroll
    for (int a = 0; a < 2; ++a)
#pragma unroll
        for (int b = 0; b < 2; ++b)
#pragma unroll
            for (int m = 0; m < 4; ++m)
#pragma unroll
                for (int n = 0; n < 2; ++n) acc[a][b][m][n] = (f32x4){0.f, 0.f, 0.f, 0.f};
    bf16x8 At[4][2], B0[2][2], B1[2][2];
    const char* cA = (const char*)g.A + (size_t)cur.pm * tstepA; const char* cB = (const char*)g.Bt + (size_t)cur.pn * tstepB;
    PG8_STAGE(PG8_SB(0, 0), cB, voffB); PG8_STAGE(PG8_SB(0, 1), cB + hstepB, voffB); PG8_STAGE(PG8_SA(0, 0), cA, voffA); PG8_STAGE(PG8_SA(0, 1), cA + hstepA, voffA);
    if (wr == 1) PG8_BAR;
    PG8_WAIT_V(2); PG8_BAR;
    PG8_STAGE(PG8_SB(1, 0), cB + kstep, voffB); PG8_STAGE(PG8_SA(1, 0), cA + kstep, voffA); PG8_STAGE(PG8_SB(1, 1), cB + hstepB + kstep, voffB);
    PG8_WAIT_V(6); PG8_BAR;
    for (;;) {
        const bool has_next = S.next(ui + 1, nxt);
        const char* nA = has_next ? (const char*)g.A + (size_t)nxt.pm * tstepA : cA; const char* nB = has_next ? (const char*)g.Bt + (size_t)nxt.pn * tstepB : cB;
        for (int t = 0; t < nt; t += 2) {
            const bool last = (t == nt - 2);
            const char* a1 = cA + (size_t)(t + 1) * kstep;
            const char* a2 = last ? nA : cA + (size_t)(t + 2) * kstep; const char* b2 = last ? nB : cB + (size_t)(t + 2) * kstep;
            const char* a3 = a2 + kstep; const char* b3 = b2 + kstep;
            PG8_LDB(B0, 0, 0); PG8_LDB(B1, 0, 1); PG8_SCHED; PG8_LDA(At, 0, 0); PG8_STAGE(PG8_SA(1, 1), a1 + hstepA, voffA);
            PG8_WAIT_V(8); PG8_WAIT_L(0); PG8_BAR; PG8_MMA(0, 0, At, B0); PG8_MMA(0, 1, At, B1); PG8_BAR; PG8_SCHED;
            PG8_LDA(At, 0, 1); PG8_STAGE(PG8_SB(0, 0), b2, voffB); PG8_STAGE(PG8_SB(0, 1), b2 + hstepB, voffB); PG8_STAGE(PG8_SA(0, 0), a2, voffA);
            PG8_WAIT_V(8); PG8_WAIT_L(0); PG8_BAR; PG8_MMA(1, 0, At, B0); PG8_MMA(1, 1, At, B1); PG8_BAR; PG8_SCHED;
            PG8_LDB(B0, 1, 0); PG8_LDB(B1, 1, 1); PG8_SCHED; PG8_LDA(At, 1, 0); PG8_STAGE(PG8_SA(0, 1), a2 + hstepA, voffA);
            PG8_WAIT_V(8); PG8_WAIT_L(0); PG8_BAR; PG8_MMA(0, 0, At, B0); PG8_MMA(0, 1, At, B1); PG8_BAR; PG8_SCHED;
            PG8_LDA(At, 1, 1); PG8_STAGE(PG8_SB(1, 0), b3, voffB); PG8_STAGE(PG8_SB(1, 1), b3 + hstepB, voffB); PG8_STAGE(PG8_SA(1, 0), a3, voffA);
            PG8_WAIT_V(8); PG8_WAIT_L(0); PG8_BAR; PG8_MMA(1, 0, At, B0); PG8_MMA(1, 1, At, B1); PG8_BAR; PG8_SCHED;
        }
        if (wr == 0) PG8_BAR;
        { const int t2 = llane(); E(acc, cur, wr, wc, t2 & 15, t2 >> 4); }
        if (!has_next) break;
#pragma unroll
        for (int a = 0; a < 2; ++a)
#pragma unroll
            for (int b = 0; b < 2; ++b)
#pragma unroll
                for (int m = 0; m < 4; ++m)
#pragma unroll
                    for (int n = 0; n < 2; ++n) acc[a][b][m][n] = (f32x4){0.f, 0.f, 0.f, 0.f};
        cur = nxt; cA = nA; cB = nB; ++ui;
        if (wr == 1) PG8_BAR;
    }
    PG8_WAIT_V(0);
    PG8_BAR;
#undef PG8_SA
#undef PG8_SB
#undef PG8_STAGE
#undef PG8_LDA
#undef PG8_LDB
#undef PG8_MMA
#undef PG8_WAIT_V
#undef PG8_WAIT_L
#undef PG8_BAR
#undef PG8_SCHED
}

typedef const f32x4 (&AccRef)[2][2][4][2];
__device__ __forceinline__ u32x4 pack8(f32x4 a, f32x4 b) { u32x4 w; w.x = cvt_pk_bf16(a[0], a[1]); w.y = cvt_pk_bf16(a[2], a[3]); w.z = cvt_pk_bf16(b[0], b[1]); w.w = cvt_pk_bf16(b[2], b[3]); return w; }
__device__ __forceinline__ float dot4(f32x4 a) { return (a[0] * a[0] + a[1] * a[1]) + (a[2] * a[2] + a[3] * a[3]); }
__device__ __forceinline__ float red_fq_(float s, int lane) { s += shx(s, 16, lane); s += shx(s, 32, lane); return s; }
#define red_fq(s) red_fq_((s), fr + 16 * fq)
__device__ __forceinline__ f32x4 rope4(f32x4 v, f32x4 cs) { return (f32x4){v[0] * cs[0] - v[1] * cs[1], v[1] * cs[0] + v[0] * cs[1], v[2] * cs[2] - v[3] * cs[3], v[3] * cs[2] + v[2] * cs[3]}; }

struct EpiWin {
    static constexpr bool PERM = true;
    bf16* z; float* zs; float* zssq; const float* rstd; bf16* km; const float* rope;
    __device__ __forceinline__ void operator()(AccRef acc, const Unit& u, int wr, int wc, int fr, int fq) const {
        const int row0 = u.pm * BM + wr * 64 + fr, colw = u.pn * BM + wc * 32 + 8 * fq;
        const bool do_ssq = (u.pn >= 12 && u.pn <= 16), do_rope = (u.pn == 17 && wc < 2), do_side = (u.pn == 54 && wc == 2);
#pragma unroll
        for (int ai = 0; ai < 2; ++ai)
#pragma unroll
            for (int m = 0; m < 4; ++m) {
                const int row = row0 + ai * HALF + m * 16; const float rs = rstd[row]; float sq = 0.f;
#pragma unroll
                for (int bj = 0; bj < 2; ++bj) {
                    f32x4 v0 = acc[ai][bj][m][0] * rs, v1 = acc[ai][bj][m][1] * rs;
                    if (bj == 0 && do_rope) {
                        const float* rp = rope + ((size_t)(row & (SEQ - 1)) * 32 + 16 * wc + 4 * fq) * 2;
                        v0 = rope4(v0, *(const f32x4*)rp); v1 = rope4(v1, *(const f32x4*)(rp + 4));
                        const u32x4 w = pack8(v0, v1);
#pragma unroll
                        for (int hh = 0; hh < 8; ++hh) *(u32x4*)(km + (size_t)row * 1536 + hh * 192 + 128 + 32 * wc + 8 * fq) = w;
                    }
                    sq += dot4(v0) + dot4(v1);
                    *(u32x4*)(z + (size_t)row * ZLD + colw + bj * HALF) = pack8(v0, v1);
                    if (bj == 1 && do_side) { float* sp = zs + (size_t)row * 32 + 8 * fq; *(f32x4*)sp = v0; *(f32x4*)(sp + 4) = v1; }
                }
                if (do_ssq) { sq = red_fq(sq); if (fq == 0) zssq[(size_t)row * 32 + (u.pn - 12) * 4 + wc] = sq; }
            }
    }
};
struct EpiMlaQ {
    static constexpr bool PERM = true;
    bf16* qm; const float* zssq; const float* rope;
    __device__ __forceinline__ void operator()(AccRef acc, const Unit& u, int wr, int wc, int fr, int fq) const {
        const int row0 = u.pm * BM + wr * 64 + fr;
#pragma unroll
        for (int ai = 0; ai < 2; ++ai)
#pragma unroll
            for (int m = 0; m < 4; ++m) {
                const int row = row0 + ai * HALF + m * 16;
                float s = 0.f; if (fq < 3) { const f32x4 p = *(const f32x4*)(zssq + (size_t)row * 32 + 4 * fq); s = (p[0] + p[1]) + (p[2] + p[3]); }
                s = red_fq(s); const float rs = rsqrtf(s * (1.f / 768.f) + EPS);
#pragma unroll
                for (int bj = 0; bj < 2; ++bj) {
                    const int cb = u.pn * BM + bj * HALF + wc * 32, within = cb % 192;
                    f32x4 v0 = acc[ai][bj][m][0] * rs, v1 = acc[ai][bj][m][1] * rs;
                    if (within >= 128) {
                        const float* rp = rope + ((size_t)(row & (SEQ - 1)) * 32 + (within - 128) / 2 + 4 * fq) * 2;
                        v0 = rope4(v0, *(const f32x4*)rp); v1 = rope4(v1, *(const f32x4*)(rp + 4));
                    }
                    *(u32x4*)(qm + (size_t)row * 1536 + cb + 8 * fq) = pack8(v0, v1);
                }
            }
    }
};
struct EpiMlaKV {
    static constexpr bool PERM = true;
    bf16* km; bf16* vm; const float* zssq;
    __device__ __forceinline__ void operator()(AccRef acc, const Unit& u, int wr, int wc, int fr, int fq) const {
        const int row0 = u.pm * BM + wr * 64 + fr;
#pragma unroll
        for (int ai = 0; ai < 2; ++ai)
#pragma unroll
            for (int m = 0; m < 4; ++m) {
                const int row = row0 + ai * HALF + m * 16;
                float s = 0.f; if (fq < 2) { const f32x4 p = *(const f32x4*)(zssq + (size_t)row * 32 + 12 + 4 * fq); s = (p[0] + p[1]) + (p[2] + p[3]); }
                s = red_fq(s); const float rs = rsqrtf(s * (1.f / 512.f) + EPS);
                *(u32x4*)(km + (size_t)row * 1536 + u.pn * 192 + wc * 32 + 8 * fq) = pack8(acc[ai][0][m][0] * rs, acc[ai][0][m][1] * rs);
                *(u32x4*)(vm + (size_t)row * 1024 + u.pn * 128 + wc * 32 + 8 * fq) = pack8(acc[ai][1][m][0] * rs, acc[ai][1][m][1] * rs);
            }
    }
};
struct EpiRowScale {
    static constexpr bool PERM = true;
    bf16* O; int ldc; const float* rstd;
    const float* hssq;
    __device__ __forceinline__ void operator()(AccRef acc, const Unit& u, int wr, int wc, int fr, int fq) const {
        const int row0 = u.pm * BM + wr * 64 + fr, colw = u.pn * BM + wc * 32 + 8 * fq;
#pragma unroll
        for (int ai = 0; ai < 2; ++ai)
#pragma unroll
            for (int m = 0; m < 4; ++m) {
                const int row = row0 + ai * HALF + m * 16; float rs;
                if (rstd) rs = rstd[row];
                else { const f32x4 p = *(const f32x4*)(hssq + (size_t)row * 32 + 8 * fq), q = *(const f32x4*)(hssq + (size_t)row * 32 + 8 * fq + 4);
                       float s = ((p[0] + p[1]) + (p[2] + p[3])) + ((q[0] + q[1]) + (q[2] + q[3])); s = red_fq(s); rs = rsqrtf(s * (1.f / 2048.f) + EPS); }
#pragma unroll
                for (int bj = 0; bj < 2; ++bj) *(u32x4*)(O + (size_t)row * ldc + colw + bj * HALF) = pack8(acc[ai][bj][m][0] * rs, acc[ai][bj][m][1] * rs);
            }
    }
};
struct EpiBranch {
    static constexpr bool PERM = true;
    const bf16* z; float* mpart; bf16* mbf;
    __device__ __forceinline__ void operator()(AccRef acc, const Unit& u, int wr, int wc, int fr, int fq) const {
        const int n3 = u.pn >> 3, pnl = u.pn & 7, pml = u.pm & 63;
        const int row0 = pml * BM + wr * 64 + fr, colw = pnl * BM + wc * 32 + 8 * fq;
#pragma unroll
        for (int ai = 0; ai < 2; ++ai)
#pragma unroll
            for (int m = 0; m < 4; ++m) {
                const int row = row0 + ai * HALF + m * 16;
#pragma unroll
                for (int bj = 0; bj < 2; ++bj) {
                    const int col = colw + bj * HALF;
                    const u32x4 gw = *(const u32x4*)(z + (size_t)row * ZLD + ZC_MG + n3 * 2048 + col);
                    f32x4 g0 = (f32x4){sigmoidf_(bflo(gw.x)), sigmoidf_(bfhi(gw.x)), sigmoidf_(bflo(gw.y)), sigmoidf_(bfhi(gw.y))};
                    f32x4 g1 = (f32x4){sigmoidf_(bflo(gw.z)), sigmoidf_(bfhi(gw.z)), sigmoidf_(bflo(gw.w)), sigmoidf_(bfhi(gw.w))};
                    f32x4 v0 = acc[ai][bj][m][0] * g0, v1 = acc[ai][bj][m][1] * g1;
                    float* pp = mpart + (size_t)row * 2048 + col;
                    if (n3 > 0) { v0 += *(const f32x4*)pp; v1 += *(const f32x4*)(pp + 4); }
                    if (n3 < 2) { *(f32x4*)pp = v0; *(f32x4*)(pp + 4) = v1; }
                    else *(u32x4*)(mbf + (size_t)row * 2048 + col) = pack8(v0, v1);
                }
            }
    }
};
struct EpiResid {
    static constexpr bool PERM = true;
    const float* base; float* hf; bf16* hbf; float* hssq;
    __device__ __forceinline__ void operator()(AccRef acc, const Unit& u, int wr, int wc, int fr, int fq) const {
        const int row0 = u.pm * BM + wr * 64 + fr, colw = u.pn * BM + wc * 32 + 8 * fq;
#pragma unroll
        for (int ai = 0; ai < 2; ++ai)
#pragma unroll
            for (int m = 0; m < 4; ++m) {
                const int row = row0 + ai * HALF + m * 16; float sq = 0.f;
#pragma unroll
                for (int bj = 0; bj < 2; ++bj) {
                    const size_t off = (size_t)row * 2048 + colw + bj * HALF;
                    const f32x4 v0 = acc[ai][bj][m][0] + *(const f32x4*)(base + off), v1 = acc[ai][bj][m][1] + *(const f32x4*)(base + off + 4);
                    *(f32x4*)(hf + off) = v0; *(f32x4*)(hf + off + 4) = v1; *(u32x4*)(hbf + off) = pack8(v0, v1);
                    sq += dot4(v0) + dot4(v1);
                }
                sq = red_fq(sq); if (fq == 0) hssq[(size_t)row * 32 + u.pn * 4 + wc] = sq;
            }
    }
};
struct EpiRouter {
    static constexpr bool PERM = false;
    float* logits; const float* hssq; const float* bias; float* rstd2;
    __device__ __forceinline__ void operator()(AccRef acc, const Unit& u, int wr, int wc, int fr, int fq) const {
        const int row0 = u.pm * BM + wr * 64 + fr;
#pragma unroll
        for (int ai = 0; ai < 2; ++ai)
#pragma unroll
            for (int m = 0; m < 4; ++m) {
                const int row = row0 + ai * HALF + m * 16;
                const f32x4 p = *(const f32x4*)(hssq + (size_t)row * 32 + 8 * fq), q = *(const f32x4*)(hssq + (size_t)row * 32 + 8 * fq + 4);
                float s = ((p[0] + p[1]) + (p[2] + p[3])) + ((q[0] + q[1]) + (q[2] + q[3])); s = red_fq(s); const float rs = rsqrtf(s * (1.f / 2048.f) + EPS);
                if (wc == 0 && fq == 0) rstd2[row] = rs;
                if (wc < 2) {
#pragma unroll
                    for (int n = 0; n < 2; ++n) { const int col = wc * 32 + 16 * n + 4 * fq; *(f32x4*)(logits + (size_t)row * 64 + col) = acc[ai][0][m][n] * rs + *(const f32x4*)(bias + col); }
                }
            }
    }
};
struct EpiGateUp {
    static constexpr bool PERM = true;
    bf16* hdn; const float* rowr;
    __device__ __forceinline__ void operator()(AccRef acc, const Unit& u, int wr, int wc, int fr, int fq) const {
        const int row0 = u.pm * BM + wr * 64 + fr, col = (u.pn & 7) * 128 + wc * 32 + 8 * fq;
#pragma unroll
        for (int ai = 0; ai < 2; ++ai)
#pragma unroll
            for (int m = 0; m < 4; ++m) {
                const int row = row0 + ai * HALF + m * 16; const float rs = rowr[row];
                f32x4 o[2];
#pragma unroll
                for (int n = 0; n < 2; ++n) { const f32x4 g = acc[ai][0][m][n] * rs, up = acc[ai][1][m][n] * rs;
#pragma unroll
                    for (int j = 0; j < 4; ++j) o[n][j] = g[j] * sigmoidf_(g[j]) * up[j]; }
                *(u32x4*)(hdn + (size_t)row * 1024 + col) = pack8(o[0], o[1]);
            }
    }
};
struct EpiDown {
    static constexpr bool PERM = true;
    bf16* y; const float* roww;
    __device__ __forceinline__ void operator()(AccRef acc, const Unit& u, int wr, int wc, int fr, int fq) const {
        const int row0 = u.pm * BM + wr * 64 + fr, colw = (u.pn & 7) * BM + wc * 32 + 8 * fq;
#pragma unroll
        for (int ai = 0; ai < 2; ++ai)
#pragma unroll
            for (int m = 0; m < 4; ++m) {
                const int row = row0 + ai * HALF + m * 16; const float w = roww[row];
#pragma unroll
                for (int bj = 0; bj < 2; ++bj) *(u32x4*)(y + (size_t)row * 2048 + colw + bj * HALF) = pack8(acc[ai][bj][m][0] * w, acc[ai][bj][m][1] * w);
            }
    }
};
}
namespace att {
constexpr int VSTR = 320;
template <int DK> struct Geo { static constexpr int KSTR = DK * 2 + 16, KBYTES = 64 * KSTR, VBYTES = 64 * VSTR, BUF = KBYTES + VBYTES, NKL = DK / 64; };
constexpr int ATT_LDS = 2 * Geo<192>::BUF;
constexpr int TAB_OFF = ATT_LDS;
constexpr int RMASK_OFF = TAB_OFF + 4 * 132 * 4;
constexpr int IMPS_OFF = RMASK_OFF + 256;
static_assert(IMPS_OFF + 64 * 33 * 4 <= RING_BYTES, "attention LDS");

__device__ __forceinline__ s16x4 vtr(const LAS unsigned char* p) { return __builtin_bit_cast(s16x4, __builtin_amdgcn_ds_read_tr16_b64_v4i16((LAS v4i16_t*)p)); }
__device__ __forceinline__ float half_max(float v) { auto rr = __builtin_amdgcn_permlane32_swap(__float_as_uint(v), __float_as_uint(v), false, false); return fmaxf(__uint_as_float(rr[0]), __uint_as_float(rr[1])); }
__device__ __forceinline__ float half_sum(float v) { auto rr = __builtin_amdgcn_permlane32_swap(__float_as_uint(v), __float_as_uint(v), false, false); return __uint_as_float(rr[0]) + __uint_as_float(rr[1]); }

template <int DK> struct Stage { u32x4 k[DK / 64]; u32x4 v[2]; };
template <int DK> struct StageOff { unsigned k[DK / 64]; unsigned v[2]; };
template <int DK> __device__ __forceinline__ void stage_offsets(StageOff<DK>& so, int ldk, int ldv, int tid) {
    constexpr int CPR = DK / 8;
#pragma unroll
    for (int i = 0; i < DK / 64; ++i) { const int c = tid + 512 * i, row = c / CPR, cc = c % CPR; so.k[i] = (unsigned)(row * ldk + cc * 8) * 2u; }
#pragma unroll
    for (int i = 0; i < 2; ++i) { const int c = tid + 512 * i, row = c >> 4, cc = c & 15; so.v[i] = (unsigned)(row * ldv + cc * 8) * 2u; }
}
template <int DK> __device__ __forceinline__ void stage_issue(Stage<DK>& s, const StageOff<DK>& so, const bf16* Kg, int ldk, const bf16* Vg, int ldv, int jt) {
    const char* kt = (const char*)(Kg + (size_t)(64 * jt) * ldk); const char* vt = (const char*)(Vg + (size_t)(64 * jt) * ldv);
#pragma unroll
    for (int i = 0; i < DK / 64; ++i) s.k[i] = *(const u32x4*)(kt + so.k[i]);
#pragma unroll
    for (int i = 0; i < 2; ++i) s.v[i] = *(const u32x4*)(vt + so.v[i]);
}
template <int DK> __device__ __forceinline__ void stage_write(const Stage<DK>& s, LAS unsigned char* buf, int tid) {
    constexpr int CPR = DK / 8;
#pragma unroll
    for (int i = 0; i < DK / 64; ++i) { const int c = tid + 512 * i, row = c / CPR, cc = c % CPR; *(LAS u32x4*)(buf + row * Geo<DK>::KSTR + cc * 16) = s.k[i]; }
#pragma unroll
    for (int i = 0; i < 2; ++i) { const int c = tid + 512 * i, row = c >> 4, cc = c & 15; *(LAS u32x4*)(buf + Geo<DK>::KBYTES + row * VSTR + cc * 16) = s.v[i]; }
}

struct State { f32x16 o[4]; float m, l; };
__device__ __forceinline__ void state_init(State& s) {
#pragma unroll
    for (int d = 0; d < 4; ++d)
#pragma unroll
        for (int r = 0; r < 16; ++r) s.o[d][r] = 0.f;
    s.m = -1e30f; s.l = 0.f;
}

template <int DK, bool MASK, bool KBIAS, bool T5, bool SEL, bool CMP, int CT, int HF>
__device__ __forceinline__ void half_compute(const LAS unsigned char* buf, int jt, const bf16x8 (&qf)[DK / 16], int t, int tw0, int W,
                                             const float* kbias, const LAS float* tab, bool rowon, float cs, State& st,
                                             float (&impm)[16], float (&impt)[1], int lane) {
    constexpr int KSTR = Geo<DK>::KSTR, KS = CMP ? 16 : 1;
    const int hi = lane >> 5, l31 = lane & 31;
    const int pk0 = (CMP ? (1024 * jt + 31) : 64 * jt) + 32 * KS * HF, pk1 = pk0 + 31 * KS;
    const int dmin = tw0 - pk1, dmax = tw0 + 31 - pk0;
    if (MASK && (dmax < 0 || dmin >= W)) return;
    f32x4 kbv[4];
    if (KBIAS) {
#pragma unroll
        for (int a = 0; a < 4; ++a) kbv[a] = *(const f32x4*)(kbias + 64 * jt + 32 * HF + 8 * a + 4 * hi);
    }
    f32x16 p;
#pragma unroll
    for (int r = 0; r < 16; ++r) p[r] = 0.f;
    const LAS unsigned char* kp = buf + (32 * HF + l31) * KSTR + hi * 16;
#pragma unroll
    for (int kk = 0; kk < DK / 16; ++kk) {
        const bf16x8 k0 = *(const LAS bf16x8*)(kp + kk * 32);
        p = __builtin_amdgcn_mfma_f32_32x32x16_bf16(k0, qf[kk], p, 0, 0, 0);
        if ((kk & 3) == 3) __builtin_amdgcn_sched_barrier(0);
    }
    const int dq = t - pk0 - 4 * hi * KS;
    const bool need_mask = MASK && (dmin < 0 || dmax >= W);
    const float NEG = -__builtin_inff();
    if (T5 && dmin < 128) {
#pragma unroll
        for (int r = 0; r < 16; ++r) { const int c = (r & 3) + 8 * (r >> 2); const int d0 = dq - KS * c; p[r] = fmaf(p[r], cs, tab[min(max(d0, 0), 128)]); }
    } else {
        const float cfar = T5 ? tab[128] : 0.f;
#pragma unroll
        for (int r = 0; r < 16; ++r) { float b0 = cfar; if (KBIAS) b0 = kbv[r >> 2][r & 3]; p[r] = fmaf(p[r], cs, b0); }
    }
    if (need_mask) {
#pragma unroll
        for (int r = 0; r < 16; ++r) { const int c = (r & 3) + 8 * (r >> 2); if ((unsigned)(dq - KS * c) >= (unsigned)W) p[r] = NEG; }
    }
    if (SEL) { if (!rowon) {
#pragma unroll
        for (int r = 0; r < 16; ++r) p[r] = NEG; } }
    float pm = p[0];
#pragma unroll
    for (int r = 1; r < 16; ++r) pm = fmaxf(pm, p[r]);
    pm = half_max(pm);
    const float mn = fmaxf(st.m, pm), alpha = __builtin_amdgcn_exp2f(st.m - mn);
    st.m = mn;
    float ps = 0.f;
#pragma unroll
    for (int r = 0; r < 16; ++r) { p[r] = __builtin_amdgcn_exp2f(p[r] - mn); ps += p[r]; }
    ps = half_sum(ps);
    st.l = st.l * alpha + ps;
    if (!__all(alpha == 1.f ? 1 : 0)) {
#pragma unroll
        for (int d = 0; d < 4; ++d)
#pragma unroll
            for (int r = 0; r < 16; ++r) st.o[d][r] *= alpha;
        if (CMP) {
#pragma unroll
            for (int i = 0; i < 16; ++i) impm[i] *= alpha;
            impt[0] *= alpha;
        }
    }
    if (CMP) {
        float ot[4];
#pragma unroll
        for (int a = 0; a < 4; ++a) { const float tl = p[4 * a + 3]; auto rr = __builtin_amdgcn_permlane32_swap(__float_as_uint(tl), __float_as_uint(tl), false, false);
            ot[a] = hi ? __uint_as_float(rr[0]) : __uint_as_float(rr[1]); }
#pragma unroll
        for (int a = 0; a < 4; ++a) { const float prev = hi ? ot[a] : (a == 0 ? impt[0] : ot[a > 0 ? a - 1 : 0]);
            impm[CT * 8 + HF * 4 + a] = 2.f * (p[4 * a] + p[4 * a + 1] + p[4 * a + 2]) + p[4 * a + 3] + prev; }
        impt[0] = ot[3];
    }
    bf16x8 pa[2];
    { u32x4 w;
      w.x = cvt_pk_bf16(p[0], p[1]); w.y = cvt_pk_bf16(p[2], p[3]); w.z = cvt_pk_bf16(p[4], p[5]); w.w = cvt_pk_bf16(p[6], p[7]); pa[0] = __builtin_bit_cast(bf16x8, w);
      w.x = cvt_pk_bf16(p[8], p[9]); w.y = cvt_pk_bf16(p[10], p[11]); w.z = cvt_pk_bf16(p[12], p[13]); w.w = cvt_pk_bf16(p[14], p[15]); pa[1] = __builtin_bit_cast(bf16x8, w); }
    const LAS unsigned char* vp = buf + Geo<DK>::KBYTES + (32 * HF + 4 * hi + ((lane & 15) >> 2)) * VSTR + (16 * ((lane >> 4) & 1) + 4 * (lane & 3)) * 2;
#pragma unroll
    for (int s = 0; s < 2; ++s)
#pragma unroll
        for (int db = 0; db < 4; ++db) {
            const s16x4 lo = vtr(vp + 16 * s * VSTR + 64 * db), hi4 = vtr(vp + (16 * s + 8) * VSTR + 64 * db);
            const bf16x8 vf = (bf16x8){lo[0], lo[1], lo[2], lo[3], hi4[0], hi4[1], hi4[2], hi4[3]};
            st.o[db] = __builtin_amdgcn_mfma_f32_32x32x16_bf16(vf, pa[s], st.o[db], 0, 0, 0);
            if (db == 3) __builtin_amdgcn_sched_barrier(0);
        }
}
template <int DK, bool MASK, bool KBIAS, bool T5, bool SEL, bool CMP, int CT>
__device__ __forceinline__ void tile_compute(const LAS unsigned char* buf, int jt, const bf16x8 (&qf)[DK / 16], int t, int tw0, int W,
                                             const float* kbias, const LAS float* tab, unsigned rowmask, float cs, State& st,
                                             float (&impm)[16], float (&impt)[1], int lane) {
    bool rowon = true;
    if (SEL) { rowon = ((rowmask >> jt) & 1u) != 0u; if (!__any(rowon ? 1 : 0)) return; }
    half_compute<DK, MASK, KBIAS, T5, SEL, CMP, CT, 0>(buf, jt, qf, t, tw0, W, kbias, tab, rowon, cs, st, impm, impt, lane);
    half_compute<DK, MASK, KBIAS, T5, SEL, CMP, CT, 1>(buf, jt, qf, t, tw0, W, kbias, tab, rowon, cs, st, impm, impt, lane);
}

template <int DK, bool MASK, bool KBIAS, bool T5, bool SEL>
__device__ __forceinline__ void attn_run(LAS unsigned char* lds, const bf16* Kg, int ldk, const bf16* Vg, int ldv, int jt_lo, int jt_hi,
                                         const bf16x8 (&qf)[DK / 16], int t, int tw0, int W, const float* kbias, const LAS float* tab,
                                         unsigned rowmask, float cs, State& st, int tid) {
    const int lane = tid & 63;
    float dm0[16], dm1[1];
    Stage<DK> sg;
    { StageOff<DK> so; stage_offsets<DK>(so, ldk, ldv, tid); stage_issue<DK>(sg, so, Kg, ldk, Vg, ldv, jt_lo); }
    stage_write<DK>(sg, lds, tid);
    LDS_WAIT(); __syncthreads();
    for (int jt = jt_lo; jt < jt_hi; ++jt) {
        const int cur = (jt - jt_lo) & 1;
        const bool more = jt + 1 < jt_hi;
        int tid_ = tid; asm volatile("" : "+v"(tid_));
        if (more) { StageOff<DK> so; stage_offsets<DK>(so, ldk, ldv, tid_); stage_issue<DK>(sg, so, Kg, ldk, Vg, ldv, jt + 1); }
        tile_compute<DK, MASK, KBIAS, T5, SEL, false, 0>(lds + cur * Geo<DK>::BUF, jt, qf, t, tw0, W, kbias, tab, rowmask, cs, st, dm0, dm1, lane);
        if (more) stage_write<DK>(sg, lds + (cur ^ 1) * Geo<DK>::BUF, tid_);
        LDS_WAIT(); __syncthreads();
    }
}

template <int DK> __device__ __forceinline__ void load_q(bf16x8 (&qf)[DK / 16], const bf16* qrow, int lane) {
#pragma unroll
    for (int kk = 0; kk < DK / 16; ++kk) qf[kk] = *(const bf16x8*)(qrow + 16 * kk + 8 * (lane >> 5));
}
template <int MODE> __device__ __forceinline__ void store_o(const State& st, float sc, bf16* orow, const bf16* addrow, int lane) {
    const int hi = lane >> 5;
#pragma unroll
    for (int db = 0; db < 4; ++db)
#pragma unroll
        for (int rg = 0; rg < 4; ++rg) {
            const int d = 32 * db + 8 * rg + 4 * hi;
            float v0 = st.o[db][4 * rg] * sc, v1 = st.o[db][4 * rg + 1] * sc, v2 = st.o[db][4 * rg + 2] * sc, v3 = st.o[db][4 * rg + 3] * sc;
            if (MODE != 0) { const u32x2 a = *(const u32x2*)((MODE == 1 ? (const bf16*)orow : addrow) + d); v0 += bflo(a.x); v1 += bfhi(a.x); v2 += bflo(a.y); v3 += bfhi(a.y); }
            u32x2 w; w.x = cvt_pk_bf16(v0, v1); w.y = cvt_pk_bf16(v2, v3);
            *(u32x2*)(orow + d) = w;
        }
}
}
struct Args { const float* in[32]; float* out; unsigned char* ws; int ph_lo, ph_hi, dbg, pad; };

__device__ __forceinline__ float row_to_bf16(const float* xrow, bf16* orow, int lane) {
    const f32x4* xr = (const f32x4*)xrow + lane; f32x4 v[8]; float s = 0.f;
#pragma unroll
    for (int j = 0; j < 8; ++j) { v[j] = xr[64 * j]; s += dot4v(v[j]); }
    s = wave_sum(s, lane);
    u32x2* o8 = (u32x2*)orow + lane;
#pragma unroll
    for (int j = 0; j < 8; ++j) { u32x2 w; w.x = cvt_pk_bf16(v[j][0], v[j][1]); w.y = cvt_pk_bf16(v[j][2], v[j][3]); o8[64 * j] = w; }
    return rsqrtf(s * (1.f / 2048.f) + EPS);
}

__device__ __forceinline__ int t5_bucket(int d) {
    if (d < 16) return d;
    const float df = (float)d;
    int large = 16 + (int)(logf(df / 16.f) / logf(8.f) * 16.f);
    return large < 31 ? large : 31;
}

__device__ __forceinline__ void ph_pre(const Args& a, int tid, int lane, int wave) {
    unsigned char* ws = a.ws;
    const int gw = blockIdx.x * NWAVES + wave, NGW = gridDim.x * NWAVES;
    const int gt = blockIdx.x * 512 + tid, NGT = gridDim.x * 512;
    bf16* hbf = (bf16*)(ws + WS_HBF); float* rstd0 = (float*)(ws + WS_RSTD0);
    for (int row = gw; row < NT; row += NGW) { const float r = row_to_bf16(a.in[0] + (size_t)row * DM, hbf + (size_t)row * DM, lane); if (lane == 0) rstd0[row] = r; }
    bf16* membf = (bf16*)(ws + WS_MEMBF); float* rstdm = (float*)(ws + WS_RSTDM);
    for (int row = gw; row < NB * MEML; row += NGW) { const float r = row_to_bf16(a.in[1] + (size_t)row * DM, membf + (size_t)row * DM, lane); if (lane == 0) rstdm[row] = r; }
    float* rope = (float*)(ws + WS_ROPE);
    for (int i = gt; i < SEQ * 32; i += NGT) { const int pos = i >> 5, k = i & 31; const float inv = powf(10000.f, -(float)k / 32.f); const float ang = (float)pos * inv; rope[2 * i] = cosf(ang); rope[2 * i + 1] = sinf(ang); }
    float* tabd = (float*)(ws + WS_TABD);
    for (int i = gt; i < 8 * 132; i += NGT) { const int h = i / 132, d = i % 132; tabd[i] = (d <= 128) ? a.in[15][t5_bucket(d) * 8 + h] * LOG2E : 0.f; }
}

struct Src { const float* p; int ld; };
__device__ __forceinline__ Src conv_src(const Args& a, int l, int mat, int sub, int d) {
    Src s; s.p = nullptr; s.ld = 0;
    switch (mat) {
    case 0: { int c;
        if (d < 3072) c = d; else if (d < 3840) c = 3080 + (d - 3072); else if (d < 4352) c = 3848 + (d - 3840);
        else if (d < 4416) { const int j = d - 4352, i = j >> 1; c = 4360 + ((j & 1) ? 32 + i : i); }
        else if (d < 7872) c = 4424 + (d - 4416); else if (d < 14016) c = 7904 + (d - 7872);
        else if (d < 14024) c = 3072 + (d - 14016); else if (d < 14048) c = 7880 + (d - 14024); else c = -1;
        if (c >= 0) { s.p = a.in[3] + (size_t)l * DM * D_IN + c; s.ld = D_IN; } break; }
    case 1: { const int hd = d / 192, w = d % 192; int c = d; if (w >= 128) { const int j = w - 128, i = j >> 1; c = hd * 192 + 128 + ((j & 1) ? 32 + i : i); }
        s.p = a.in[7] + (size_t)l * 768 * 1536 + c; s.ld = 1536; break; }
    case 2: s.p = a.in[8] + (size_t)l * 512 * 2048 + d; s.ld = 2048; break;
    case 3: s.p = a.in[11] + (size_t)l * 6144 * 192 + d; s.ld = 192; break;
    case 4: s.p = a.in[12] + (size_t)l * 192 * 192 + d; s.ld = 192; break;
    case 5: s.p = a.in[13] + (size_t)l * 4096 * 128 + d; s.ld = 128; break;
    case 6: s.p = a.in[14] + (size_t)l * 128 * 128 + d; s.ld = 128; break;
    case 7: s.p = a.in[16] + ((size_t)l * 3 + sub) * 1024 * 2048 + d; s.ld = 2048; break;
    case 8: s.p = a.in[17] + (size_t)l * 2048 * 2048 + d; s.ld = 2048; break;
    case 9: s.p = a.in[20] + (size_t)l * 2048 * 512 + d; s.ld = 512; break;
    case 10: s.p = a.in[21] + (size_t)l * 2048 * 1024 + d; s.ld = 1024; break;
    case 11: s.p = a.in[22] + (size_t)l * 512 * 2048 + d; s.ld = 2048; break;
    case 12: if (d < 4) { s.p = a.in[24] + (size_t)l * 2048 * 4 + d; s.ld = 4; } else if (d < 36) { s.p = a.in[26] + (size_t)l * 2048 * 32 + (d - 4); s.ld = 32; } break;
    case 13: { const int j = d >> 8, w = d & 255; const float* base = (w < 128 ? a.in[28] : a.in[29]) + ((size_t)l * NEXP + sub) * 2048 * 1024;
        s.p = base + j * 128 + (w & 127); s.ld = 1024; break; }
    default: s.p = a.in[30] + ((size_t)l * NEXP + sub) * 1024 * 2048 + d; s.ld = 2048; break;
    }
    return s;
}
__device__ __forceinline__ void conv_item(Src s, const float* gain, int K, bf16* dst, int kb, int nb, LAS float* scr, int lane) {
    const int n = lane & 31, k0 = kb * 64;
#pragma unroll 8
    for (int i = 0; i < 32; ++i) { const int kk = 2 * i + (lane >> 5); float v = 0.f; if (s.p) { v = s.p[(size_t)(k0 + kk) * s.ld]; if (gain) v *= gain[k0 + kk]; } scr[kk * 33 + n] = v; }
    LDS_WAIT(); asm volatile("" ::: "memory");
    const int c = lane & 7;
#pragma unroll
    for (int j = 0; j < 4; ++j) { const int nn = (lane >> 3) + 8 * j; const LAS float* q = scr + (8 * c) * 33 + nn;
        u32x4 o; o.x = cvt_pk_bf16(q[0 * 33], q[1 * 33]); o.y = cvt_pk_bf16(q[2 * 33], q[3 * 33]); o.z = cvt_pk_bf16(q[4 * 33], q[5 * 33]); o.w = cvt_pk_bf16(q[6 * 33], q[7 * 33]);
        *(u32x4*)(dst + (size_t)(nb * 32 + nn) * K + k0 + 8 * c) = o; }
    LDS_WAIT(); asm volatile("" ::: "memory");
}
__device__ __forceinline__ void ph_conv(const Args& a, int l, LAS unsigned char* lds, int tid, int lane, int wave) {
    unsigned char* ws = a.ws;
    LAS float* scr = (LAS float*)(lds + wave * 16384);
    const int gw = blockIdx.x * NWAVES + wave, NGW = gridDim.x * NWAVES;
    constexpr int NM = 15;
    static constexpr int mK[NM]   = {2048, 768, 512, 6144, 192, 4096, 128, 1024, 2048, 2048, 2048, 512, 2048, 2048, 1024};
    static constexpr int mN[NM]   = {ZLD, 1536, 2048, 192, 192, 128, 128, 2048, 2048, 512, 1024, 2048, 256, 2048, 2048};
    static constexpr int mS[NM]   = {1, 1, 1, 1, 1, 1, 1, 3, 1, 1, 1, 1, 1, NEXP, NEXP};
    static constexpr int mG[NM]   = {2, 5, 6, -1, -1, -1, -1, -1, -1, 18, 19, -1, 23, 23, -1};
    static constexpr size_t mD[NM] = {WS_WIN, WS_WUQ, WS_WUKV, WS_WCK1, WS_WCK2, WS_WCV1, WS_WCV2, WS_WBR, WS_WOUT, WS_WMQ, WS_WMKV, WS_WMO, WS_WR, WS_WGU, WS_WD};
    int base = 0;
#pragma unroll 1
    for (int mt = 0; mt < NM; ++mt) {
        const int K = mK[mt], nkb = K / 64, nnb = mN[mt] / 32, per = nkb * nnb, tot = per * mS[mt];
        const float* gain = mG[mt] >= 0 ? a.in[mG[mt]] + (size_t)l * K : nullptr;
        int first = gw - (base % NGW); if (first < 0) first += NGW;
#pragma unroll 1
        for (int r = first; r < tot; r += NGW) {
            const int sub = r / per, q = r % per, kb = q / nnb, nb = q % nnb;
            const Src s = conv_src(a, l, mt, sub, nb * 32 + (lane & 31));
            conv_item(s, gain, K, (bf16*)(ws + mD[mt]) + (size_t)sub * mN[mt] * K, kb, nb, scr, lane);
        }
        base += tot;
    }
    float* c1p = (float*)(ws + WS_C1P);
    const int gt = blockIdx.x * 512 + tid, NGT = gridDim.x * 512;
    for (int i = gt; i < 96 * 192 + 64 * 128; i += NGT) {
        float s = 0.f;
        if (i < 96 * 192) { const int ch = i / 192, n = i % 192; const float* pe = a.in[9] + (size_t)l * 6144 + ch * 64; const float* w = a.in[11] + (size_t)l * 6144 * 192 + (size_t)ch * 64 * 192 + n;
            for (int k = 0; k < 64; ++k) s += pe[k] * w[(size_t)k * 192]; }
        else { const int j = i - 96 * 192, ch = j / 128, n = j % 128; const float* pe = a.in[10] + (size_t)l * 4096 + ch * 64; const float* w = a.in[13] + (size_t)l * 4096 * 128 + (size_t)ch * 64 * 128 + n;
            for (int k = 0; k < 64; ++k) s += pe[k] * w[(size_t)k * 128]; }
        c1p[i] = s;
    }
    float* brt = (float*)(ws + WS_BRT);
    if (gt < 64) brt[gt] = gt < 4 ? a.in[25][l * 4 + gt] : (gt < 36 ? a.in[27][l * 32 + gt - 4] : 0.f);
}

__device__ __forceinline__ void cumsum_item(int it, const float* zs, const float* bf, float* kb, int lane) {
    const int b = it >> 3, h = it & 7; const float bias = bf[h];
    float v[32]; float run = 0.f;
#pragma unroll
    for (int i = 0; i < 32; ++i) { const float x = zs[(size_t)(b * SEQ + lane * 32 + i) * 32 + h] + bias; const float ls = fminf(x, 0.f) - log1pf(__expf(-fabsf(x))); run += ls; v[i] = run; }
    float incl = run;
#pragma unroll
    for (int o = 1; o < 64; o <<= 1) { const float y = __int_as_float(__builtin_amdgcn_ds_bpermute(((lane - o) & 63) << 2, __float_as_int(incl))); if (lane >= o) incl += y; }
    const float excl = incl - run;
    float* dst = kb + (size_t)it * SEQ + lane * 32;
#pragma unroll
    for (int i = 0; i < 32; ++i) dst[i] = -(excl + v[i]) * LOG2E;
}

__device__ __forceinline__ float gelu_tanh(float x) { return 0.5f * x * (1.f + tanhf(0.7978845608028654f * (x + 0.044715f * x * x * x))); }
template <int DD>
__device__ __forceinline__ void compress_body(int b, int g, int ct, const bf16* zsrc  , const bf16* w1t, const bf16* w2t,
                                              const float* c1p, int nchunk, bf16* out, LAS unsigned char* lds, int tid, unsigned* dbgw) {
    constexpr int KD = 32 * DD, NCB = DD / 64, KH = KD / 2, NST = KH / 32, HP = DD + 8;
    const int lane = tid & 63, w = tid >> 6, cg = w & 3, kh = w >> 2, lr = lane & 15, kg = lane >> 4;
    LAS float* red = (LAS float*)lds;
    LAS float* c1s = (LAS float*)(lds + 32 * DD * 4);
    LAS bf16* hid = (LAS bf16*)(lds + 32 * DD * 4 + DD * 4);
    if (tid < DD) { float s = 0.f; for (int ch = 0; ch < nchunk; ++ch) s += c1p[ch * DD + tid]; c1s[tid] = s; }
    const bf16* abase[2];
#pragma unroll
    for (int rb = 0; rb < 2; ++rb) { int c = 32 * ct + 16 * rb + lr; c = c < 126 ? c : 126; abase[rb] = zsrc + (size_t)(b * SEQ + 16 * c) * ZLD + g * DD + 8 * kg; }
    const bf16* bbase = w1t + (size_t)(16 * cg * NCB + lr) * KD + 8 * kg;
    f32x4 acc[2][NCB];
#pragma unroll
    for (int rb = 0; rb < 2; ++rb)
#pragma unroll
        for (int cb = 0; cb < NCB; ++cb) acc[rb][cb] = (f32x4){0.f, 0.f, 0.f, 0.f};
#pragma unroll 2
    for (int s = 0; s < NST; ++s) {
        const int k0 = kh * KH + 32 * s, lrow = k0 / DD, dcol = k0 % DD;
        bf16x8 af[2], bfr[NCB];
#pragma unroll
        for (int rb = 0; rb < 2; ++rb) af[rb] = *(const bf16x8*)(abase[rb] + (size_t)lrow * ZLD + dcol);
#pragma unroll
        for (int cb = 0; cb < NCB; ++cb) bfr[cb] = *(const bf16x8*)(bbase + (size_t)(16 * cb) * KD + k0);
#pragma unroll
        for (int rb = 0; rb < 2; ++rb)
#pragma unroll
            for (int cb = 0; cb < NCB; ++cb) acc[rb][cb] = __builtin_amdgcn_mfma_f32_16x16x32_bf16(af[rb], bfr[cb], acc[rb][cb], 0, 0, 0);
    }
    if (kh == 1) {
#pragma unroll
        for (int rb = 0; rb < 2; ++rb)
#pragma unroll
            for (int cb = 0; cb < NCB; ++cb)
#pragma unroll
                for (int r = 0; r < 4; ++r) red[(16 * rb + 4 * kg + r) * DD + 16 * (cg * NCB + cb) + lr] = acc[rb][cb][r];
    }
    LDS_WAIT(); __syncthreads();
    if (kh == 0) {
#pragma unroll
        for (int rb = 0; rb < 2; ++rb)
#pragma unroll
            for (int cb = 0; cb < NCB; ++cb)
#pragma unroll
                for (int r = 0; r < 4; ++r) { const int row = 16 * rb + 4 * kg + r, col = 16 * (cg * NCB + cb) + lr;
                    const float x = acc[rb][cb][r] + red[row * DD + col] + c1s[col]; hid[row * HP + col] = f2bf(gelu_tanh(x));
                    }
    }
    LDS_WAIT(); __syncthreads();
#if defined(COMPRESS_S2_SCALAR)
    for (int o = tid; o < 32 * DD; o += 512) { const int row = o / DD, col = o % DD; float s2 = 0.f; const bf16* wr = w2t + (size_t)col * DD;
        for (int j = 0; j < DD; ++j) s2 += bf2f(hid[row * HP + j]) * bf2f(wr[j]);
        const int c = 32 * ct + row; out[((size_t)(b * 2 + g) * 128 + c) * DD + col] = c < 127 ? f2bf(s2) : (bf16)0; }
#else
    constexpr int NBLK = 2 * (DD / 16);
    for (int blk = w; blk < NBLK; blk += 8) {
        const int rb = blk & 1, cb = blk >> 1;
        f32x4 c4 = (f32x4){0.f, 0.f, 0.f, 0.f};
#pragma unroll
        for (int s = 0; s < DD / 32; ++s) {
            const bf16x8 af = *(const LAS bf16x8*)(hid + (16 * rb + lr) * HP + 32 * s + 8 * kg);
            const bf16x8 bfr = *(const bf16x8*)(w2t + (size_t)(16 * cb + lr) * DD + 32 * s + 8 * kg);
            c4 = __builtin_amdgcn_mfma_f32_16x16x32_bf16(af, bfr, c4, 0, 0, 0);
            asm volatile("" :: "v"(af), "v"(bfr));
        }
#pragma unroll
        for (int r = 0; r < 4; ++r) { const int c = 32 * ct + 16 * rb + 4 * kg + r; out[((size_t)(b * 2 + g) * 128 + c) * DD + 16 * cb + lr] = c < 127 ? f2bf(c4[r]) : (bf16)0; }
    }
#endif
    LDS_WAIT(); __syncthreads();
}

template <int DD>
__device__ __forceinline__ void compress_ref(int b, int g, int c, const bf16* zsrc, const bf16* w1t, const bf16* w2t, const float* c1p, int nchunk, bf16* out, LAS unsigned char* lds, int tid) {
    constexpr int KD = 32 * DD;
    LAS float* hid = (LAS float*)lds;
    if (tid < DD) {
        float s = 0.f; for (int ch = 0; ch < nchunk; ++ch) s += c1p[ch * DD + tid];
        const bf16* wr = w1t + (size_t)tid * KD;
        for (int l = 0; l < 32; ++l) { const bf16* zr = zsrc + (size_t)(b * SEQ + 16 * c + l) * ZLD + g * DD;
            for (int d = 0; d < DD; d += 8) { const u32x4 zv = *(const u32x4*)(zr + d), wv = *(const u32x4*)(wr + l * DD + d);
                s += bflo(zv.x) * bflo(wv.x) + bfhi(zv.x) * bfhi(wv.x) + bflo(zv.y) * bflo(wv.y) + bfhi(zv.y) * bfhi(wv.y) + bflo(zv.z) * bflo(wv.z) + bfhi(zv.z) * bfhi(wv.z) + bflo(zv.w) * bflo(wv.w) + bfhi(zv.w) * bfhi(wv.w); } }
        hid[tid] = bf2f(f2bf(gelu_tanh(s)));
    }
    LDS_WAIT(); __syncthreads();
    if (tid < DD) { float s = 0.f; const bf16* wr = w2t + (size_t)tid * DD; for (int j = 0; j < DD; ++j) s += hid[j] * bf2f(wr[j]); out[((size_t)(b * 2 + g) * 128 + c) * DD + tid] = f2bf(s); }
    LDS_WAIT(); __syncthreads();
}

constexpr float CS128 = 0.08838834764831845f * LOG2E, CS192 = 0.07216878364870323f * LOG2E;
constexpr int WBIG = 1 << 30;

__device__ __forceinline__ void fox_sub(int b, int h, int qt, const bf16* z, const float* kb, bf16* ofox, LAS unsigned char* lds, int tid) {
    const int lane = tid & 63, w = tid >> 6, tw0 = 256 * qt + 32 * w, t = tw0 + (lane & 31); const size_t row = (size_t)b * SEQ + t;
    bf16x8 qf[8]; att::load_q<128>(qf, z + row * ZLD + ZC_FQ + h * 128, lane);
    att::State st; att::state_init(st);
    att::attn_run<128, true, true, false, false>(lds, z + (size_t)b * SEQ * ZLD + ZC_FK + h * 128, ZLD, z + (size_t)b * SEQ * ZLD + ZC_FV + h * 128, ZLD, 0, 4 * (qt + 1),
                                                 qf, t, tw0, WBIG, kb + (size_t)(b * 8 + h) * SEQ, nullptr, 0u, CS128, st, tid);
    att::store_o<0>(st, 1.f / st.l, ofox + row * 1024 + h * 128, nullptr, lane);
}
__device__ __forceinline__ void mla_sub(int b, int h, int qt, const bf16* qm, const bf16* km, const bf16* vm, bf16* omla, LAS unsigned char* lds, int tid) {
    const int lane = tid & 63, w = tid >> 6, tw0 = 256 * qt + 32 * w, t = tw0 + (lane & 31); const size_t row = (size_t)b * SEQ + t;
    bf16x8 qf[12]; att::load_q<192>(qf, qm + row * 1536 + h * 192, lane);
    att::State st; att::state_init(st);
    att::attn_run<192, true, false, false, false>(lds, km + (size_t)b * SEQ * 1536 + h * 192, 1536, vm + (size_t)b * SEQ * 1024 + h * 128, 1024, 0, 4 * (qt + 1),
                                                  qf, t, tw0, WBIG, nullptr, nullptr, 0u, CS192, st, tid);
    att::store_o<0>(st, 1.f / st.l, omla + row * 1024 + h * 128, nullptr, lane);
}
__device__ __forceinline__ void mem_unit(int uid, const bf16* qmem, const bf16* kvmem, bf16* omem, LAS unsigned char* lds, int tid) {
    const int b = uid >> 5, h = (uid >> 3) & 3, qt = uid & 7;
    const int lane = tid & 63, w = tid >> 6, tw0 = 256 * qt + 32 * w, t = tw0 + (lane & 31); const size_t row = (size_t)b * SEQ + t;
    bf16x8 qf[8]; att::load_q<128>(qf, qmem + row * 512 + h * 128, lane);
    att::State st; att::state_init(st);
    att::attn_run<128, false, false, false, false>(lds, kvmem + (size_t)b * MEML * 1024 + h * 128, 1024, kvmem + (size_t)b * MEML * 1024 + 512 + h * 128, 1024, 0, 4,
                                                   qf, t, tw0, WBIG, nullptr, nullptr, 0u, CS128, st, tid);
    att::store_o<0>(st, 1.f / st.l, omem + row * 512 + h * 128, nullptr, lane);
}
__device__ __forceinline__ void nsa_tabs(const float* tabd, int g, LAS unsigned char* lds, int tid) {
    LAS float* tab = (LAS float*)(lds + att::TAB_OFF);
    for (int i = tid; i < 4 * 132; i += 512) tab[i] = tabd[g * 4 * 132 + i];
    LDS_WAIT(); __syncthreads();
}
__device__ __forceinline__ void nsa_win_unit(int uid, const bf16* z, const float* zs, const float* tabd, bf16* ow, LAS unsigned char* lds, int tid) {
    const int b = uid >> 6, g = (uid >> 5) & 1, qt = uid & 31;
    const int lane = tid & 63, w = tid >> 6, hh = w >> 1, head = g * 4 + hh, tw0 = 64 * qt + 32 * (w & 1), t = tw0 + (lane & 31); const size_t row = (size_t)b * SEQ + t;
    nsa_tabs(tabd, g, lds, tid);
    bf16x8 qf[12]; att::load_q<192>(qf, z + row * ZLD + ZC_NQ + head * 192, lane);
    att::State st; att::state_init(st);
    att::attn_run<192, true, false, true, false>(lds, z + (size_t)b * SEQ * ZLD + ZC_NKW + g * 192, ZLD, z + (size_t)b * SEQ * ZLD + ZC_NVW + g * 128, ZLD, qt >= 8 ? qt - 8 : 0, qt + 1,
                                                 qf, t, tw0, 512, nullptr, (const LAS float*)(lds + att::TAB_OFF) + hh * 132, 0u, CS192, st, tid);
    const float g2 = sigmoidf_(zs[row * 32 + 8 + head * 3 + 2]);
    att::store_o<0>(st, g2 / st.l, ow + row * 1024 + head * 128, nullptr, lane);
}
__device__ __forceinline__ void nsa_cmp_sub(int b, int g, int qt, const bf16* z, const float* zs, const float* tabd, const bf16* kc, const bf16* vc, bf16* ow, unsigned* rmaskg,
                                            LAS unsigned char* lds, int tid) {
    const int lane = tid & 63, w = tid >> 6, hh = w >> 1, head = g * 4 + hh, hf = w & 1, tw0 = 64 * qt + 32 * hf, t = tw0 + (lane & 31), hi = lane >> 5; const size_t row = (size_t)b * SEQ + t;
    const int rowl = 32 * hf + (lane & 31);
    nsa_tabs(tabd, g, lds, tid);
    const LAS float* tab = (const LAS float*)(lds + att::TAB_OFF) + hh * 132;
    {
        const bf16* Kc = kc + (size_t)(b * 2 + g) * 128 * 192; const bf16* Vc = vc + (size_t)(b * 2 + g) * 128 * 128;
        att::Stage<192> s0; att::StageOff<192> so; att::stage_offsets<192>(so, 192, 128, tid);
        att::stage_issue<192>(s0, so, Kc, 192, Vc, 128, 0); att::stage_write<192>(s0, lds, tid);
        att::stage_issue<192>(s0, so, Kc, 192, Vc, 128, 1); att::stage_write<192>(s0, lds + att::Geo<192>::BUF, tid);
    }
    LDS_WAIT(); __syncthreads();
    bf16x8 qf[12]; att::load_q<192>(qf, z + row * ZLD + ZC_NQ + head * 192, lane);
    att::State st; att::state_init(st);
    float impm[16], impt[1];
#pragma unroll
    for (int i = 0; i < 16; ++i) impm[i] = 0.f;
    impt[0] = 0.f;
    att::tile_compute<192, true, false, true, false, true, 0>(lds, 0, qf, t, tw0, 0x7fffffff, nullptr, tab, 0u, CS192, st, impm, impt, lane);
    att::tile_compute<192, true, false, true, false, true, 1>(lds + att::Geo<192>::BUF, 1, qf, t, tw0, 0x7fffffff, nullptr, tab, 0u, CS192, st, impm, impt, lane);
    LDS_WAIT(); __syncthreads();
    const float inv = st.l > 0.f ? 1.f / st.l : 0.f;
    LAS float* IA = (LAS float*)lds;
#pragma unroll
    for (int i = 0; i < 16; ++i) { const int n = 16 * (i >> 3) + 8 * ((i >> 2) & 1) + 2 * (i & 3) + hi; IA[(hh * 64 + rowl) * 33 + n] = impm[i] * inv; }
    const float g0 = sigmoidf_(zs[row * 32 + 8 + head * 3 + 0]);
    att::store_o<1>(st, g0 * inv, ow + row * 1024 + head * 128, nullptr, lane);
    LDS_WAIT(); __syncthreads();
    LAS float* imps = (LAS float*)(lds + att::IMPS_OFF);
    if (tid < 64) {
        const int r = tid;
        for (int n = 0; n < 32; ++n) { float s = 0.f;
            for (int q = 0; q < 4; ++q) s += IA[(q * 64 + r) * 33 + n];
            imps[r * 33 + n] = s; }
        const int cur = qt; unsigned mask;
        if (cur < 8) mask = (2u << cur) - 1u;
        else { mask = 1u | (1u << cur) | (1u << (cur - 1));
            for (int k = 0; k < 5; ++k) { int best = 1; float bv = -1.f;
                for (int n = 1; n <= cur - 2; ++n) { const float v = imps[r * 33 + n]; if (!((mask >> n) & 1u) && v > bv) { bv = v; best = n; } }
                mask |= 1u << best; } }
        rmaskg[(size_t)(b * 2 + g) * SEQ + 64 * qt + r] = mask;
    }
    VM_WAIT(); LDS_WAIT(); __syncthreads();
}
__device__ __forceinline__ void nsa_sel_sub(int b, int g, int qt, const bf16* z, const float* zs, const float* tabd, const bf16* ow, const unsigned* rmaskg, bf16* onsa,
                                            LAS unsigned char* lds, int tid) {
    const int lane = tid & 63, w = tid >> 6, hh = w >> 1, head = g * 4 + hh, hf = w & 1, tw0 = 64 * qt + 32 * hf, t = tw0 + (lane & 31); const size_t row = (size_t)b * SEQ + t;
    nsa_tabs(tabd, g, lds, tid);
    const LAS float* tab = (const LAS float*)(lds + att::TAB_OFF) + hh * 132;
    bf16x8 qf[12]; att::load_q<192>(qf, z + row * ZLD + ZC_NQ + head * 192, lane);
    const unsigned rowmask = rmaskg[(size_t)(b * 2 + g) * SEQ + t];
    att::State st; att::state_init(st);
    att::attn_run<192, true, false, true, true>(lds, z + (size_t)b * SEQ * ZLD + ZC_NKS + g * 192, ZLD, z + (size_t)b * SEQ * ZLD + ZC_NVS + g * 128, ZLD, 0, qt + 1,
                                                qf, t, tw0, WBIG, nullptr, tab, rowmask, CS192, st, tid);
    const float g1 = sigmoidf_(zs[row * 32 + 8 + head * 3 + 1]);
    att::store_o<2>(st, g1 / st.l, onsa + row * 1024 + head * 128, ow + row * 1024 + head * 128, lane);
}

__device__ __forceinline__ void ph_route1(const float* logits, unsigned* cnt, int* asge, int* asgi, float* asgw, int tid) {
    for (int t = blockIdx.x * 512 + tid; t < NT; t += gridDim.x * 512) {
        const f32x4 gl = *(const f32x4*)(logits + (size_t)t * 64);
        int gs = 0; float gm = gl[0];
        if (gl[1] > gm) { gm = gl[1]; gs = 1; } if (gl[2] > gm) { gm = gl[2]; gs = 2; } if (gl[3] > gm) { gm = gl[3]; gs = 3; }
        const float pg = 1.f / (expf(gl[0] - gm) + expf(gl[1] - gm) + expf(gl[2] - gm) + expf(gl[3] - gm));
        const f32x4 e0 = *(const f32x4*)(logits + (size_t)t * 64 + 4 + gs * 8), e1 = *(const f32x4*)(logits + (size_t)t * 64 + 8 + gs * 8);
        float ev[8] = {e0[0], e0[1], e0[2], e0[3], e1[0], e1[1], e1[2], e1[3]};
        int j0 = 0; float v0 = ev[0];
#pragma unroll
        for (int j = 1; j < 8; ++j) if (ev[j] > v0) { v0 = ev[j]; j0 = j; }
        int j1 = -1; float v1 = -3.0e38f;
#pragma unroll
        for (int j = 0; j < 8; ++j) if (j != j0 && ev[j] > v1) { v1 = ev[j]; j1 = j; }
        const float x1 = expf(v1 - v0), w0 = pg / (1.f + x1), w1 = pg * x1 / (1.f + x1);
        const int ea = gs * 8 + j0, eb = gs * 8 + j1;
        asge[2 * t] = ea; asge[2 * t + 1] = eb; asgw[2 * t] = w0; asgw[2 * t + 1] = w1;
        asgi[2 * t] = (int)atomicAdd(cnt + ea, 1u); asgi[2 * t + 1] = (int)atomicAdd(cnt + eb, 1u);
    }
}
__device__ __forceinline__ void ph_route2(const unsigned* cnt, const int* asge, const int* asgi, const float* asgw, const float* rstd2, const bf16* hbf,
                                          int* pos, float* roww, float* rowr, int* tile, bf16* xg, LAS unsigned char* lds, int tid, int lane, int wave) {
    LAS int* ps = (LAS int*)lds;
    if (tid == 0) { int acc = 0;
#pragma unroll 1
        for (int e = 0; e < NEXP; ++e) { const int c = (int)cnt[e]; ps[e] = acc; ps[64 + e] = c; acc += ((c + 255) >> 8) << 8; } ps[32] = acc; }
    LDS_WAIT(); __syncthreads();
    if (blockIdx.x == 0 && tid == 0) { int rt = 0;
#pragma unroll 1
        for (int e = 0; e < NEXP; ++e) { const int n = (ps[e + 1] - ps[e]) >> 8;
#pragma unroll 1
            for (int i = 0; i < n; ++i) tile[rt++] = e; }
        tile[200] = rt;
#pragma unroll 1
        for (; rt < 200; ++rt) tile[rt] = -1; }
    const int gw = blockIdx.x * NWAVES + wave, NGW = gridDim.x * NWAVES;
    for (int it = gw; it < NT * 2; it += NGW) {
        const int e = asge[it], dest = ps[e] + asgi[it], t = it >> 1;
        if (lane == 0) { roww[dest] = asgw[it]; rowr[dest] = rstd2[t]; pos[it] = dest; }
        const u32x4* s = (const u32x4*)(hbf + (size_t)t * DM) + lane; u32x4* d = (u32x4*)(xg + (size_t)dest * DM) + lane;
#pragma unroll
        for (int j = 0; j < 4; ++j) d[64 * j] = s[64 * j];
    }
    for (int it = gw; it < NEXP * 256; it += NGW) {
        const int e = it >> 8, r = it & 255, c = ps[64 + e], pc = ps[e + 1] - ps[e] - c;
        if (r < pc) { const int dest = ps[e] + c + r; if (lane == 0) { roww[dest] = 0.f; rowr[dest] = 0.f; }
            u32x4* d = (u32x4*)(xg + (size_t)dest * DM) + lane;
#pragma unroll
            for (int j = 0; j < 4; ++j) d[64 * j] = (u32x4){0u, 0u, 0u, 0u}; }
    }
}
__device__ __forceinline__ void ph_combine(float* hf, const bf16* y, const int* pos, bf16* hbf, float* rstd0, const float* gfin, float* out, bool last, int lane, int wave) {
    const int gw = blockIdx.x * NWAVES + wave, NGW = gridDim.x * NWAVES;
    for (int t = gw; t < NT; t += NGW) {
        const int p0 = pos[2 * t], p1 = pos[2 * t + 1];
        f32x4* hr = (f32x4*)(hf + (size_t)t * DM) + lane; const u32x2* y0 = (const u32x2*)(y + (size_t)p0 * DM) + lane; const u32x2* y1 = (const u32x2*)(y + (size_t)p1 * DM) + lane;
        f32x4 v[8]; float s = 0.f;
#pragma unroll
        for (int j = 0; j < 8; ++j) { const u32x2 a = y0[64 * j], c = y1[64 * j]; f32x4 h = hr[64 * j];
            h[0] = (h[0] + bflo(a.x)) + bflo(c.x); h[1] = (h[1] + bfhi(a.x)) + bfhi(c.x); h[2] = (h[2] + bflo(a.y)) + bflo(c.y); h[3] = (h[3] + bfhi(a.y)) + bfhi(c.y);
            v[j] = h; s += dot4v(h); }
        s = wave_sum(s, lane); const float rs = rsqrtf(s * (1.f / 2048.f) + EPS);
        if (!last) {
            u32x2* o8 = (u32x2*)(hbf + (size_t)t * DM) + lane;
#pragma unroll
            for (int j = 0; j < 8; ++j) { hr[64 * j] = v[j]; u32x2 w; w.x = cvt_pk_bf16(v[j][0], v[j][1]); w.y = cvt_pk_bf16(v[j][2], v[j][3]); o8[64 * j] = w; }
            if (lane == 0) rstd0[t] = rs;
        } else {
            f32x4* orow = (f32x4*)(out + (size_t)t * DM) + lane; const f32x4* gr = (const f32x4*)gfin + lane;
#pragma unroll
            for (int j = 0; j < 8; ++j) orow[64 * j] = v[j] * rs * gr[64 * j];
        }
    }
}
#if defined(DEBUG_CODES)
__global__ void dbg_hash(const unsigned* p, size_t nwords, unsigned long long* slot) {
    unsigned long long s = 0;
    for (size_t i = (size_t)blockIdx.x * blockDim.x + threadIdx.x; i < nwords; i += (size_t)gridDim.x * blockDim.x) s += (unsigned long long)p[i] * (2ull * i + 1ull);
    for (int o = 32; o >= 1; o >>= 1) s += __shfl_xor(s, o);
    if ((threadIdx.x & 63) == 0) atomicAdd(slot, s);
}
__global__ void dbg_nonfinite(const void* p, size_t n, int is_bf16, unsigned* slot) {
    unsigned c = 0;
    for (size_t i = (size_t)blockIdx.x * blockDim.x + threadIdx.x; i < n; i += (size_t)gridDim.x * blockDim.x) {
        if (is_bf16) { const unsigned short v = ((const unsigned short*)p)[i]; c += ((v & 0x7f80u) == 0x7f80u) ? 1u : 0u; }
        else { const unsigned v = ((const unsigned*)p)[i]; c += ((v & 0x7f800000u) == 0x7f800000u) ? 1u : 0u; }
    }
    for (int o = 32; o >= 1; o >>= 1) c += __shfl_xor(c, o);
    if ((threadIdx.x & 63) == 0 && c) atomicAdd(slot, c);
}
__global__ void dbg_final(const unsigned long long* hash, const unsigned* nf, float* out, size_t n, int nst) {
    int code = 0;
    for (int s = 34; s <= nst && !code; ++s) if (hash[64 + s] != hash[128 + s]) code = s;
    for (int s = 1; s <= 33 && !code; ++s) if (hash[64 + s] != hash[128 + s]) code = s;
    for (int s = 34; s <= nst && !code; ++s) if (hash[s] != hash[64 + s]) code = 40 + s;
    for (int s = 1; s <= 33 && !code; ++s) if (hash[s] != hash[64 + s]) code = 40 + s;
    if (code == 0) return;
    const float c = sqrtf(0.1f * (float)code);
    for (size_t i = (size_t)blockIdx.x * blockDim.x + threadIdx.x; i < n; i += (size_t)gridDim.x * blockDim.x) out[i] = c;
}
__global__ void dbg_copy(const unsigned* src, unsigned* dst, int n) { if ((int)threadIdx.x < n && src[threadIdx.x]) dst[threadIdx.x] = 1u; }
struct DbgBuf { size_t off; size_t bytes; int kind; };
static void dbg_stage(hipStream_t st, unsigned char* ws, int run, int stage, const DbgBuf* b, int nb, float* out) {
    unsigned long long* hash = (unsigned long long*)(ws + WS_DBG); unsigned* nf = (unsigned*)(ws + WS_DBG + 2048);
    for (int i = 0; i < nb; ++i) {
        const void* p = b[i].off == (size_t)-1 ? (const void*)out : (const void*)(ws + b[i].off);
        hipLaunchKernelGGL(dbg_hash, dim3(1024), dim3(256), 0, st, (const unsigned*)p, b[i].bytes / 4, hash + run * 64 + stage);
        if (b[i].kind != 2) hipLaunchKernelGGL(dbg_nonfinite, dim3(1024), dim3(256), 0, st, p, b[i].kind ? b[i].bytes / 2 : b[i].bytes / 4, b[i].kind, nf + stage);
    }
}
#endif
__device__ __forceinline__ GAS unsigned char* lws(unsigned char* p) { unsigned long long v = (unsigned long long)p; asm volatile("" : "+s"(v)); return (GAS unsigned char*)v; }
#define ltid() (wave0 * 64 + llane())
constexpr int NPH_LAYER = 15, NPHASES = 1 + DEPTH * NPH_LAYER;
__global__ void __launch_bounds__(512, 2) fwd(Args a) {
    extern __shared__ __attribute__((aligned(16))) unsigned char lds_[];
    LAS unsigned char* lds = (LAS unsigned char*)lds_;
    const int tid = threadIdx.x; const int wave0 = __builtin_amdgcn_readfirstlane(tid >> 6);
    const int G = gridDim.x, bx = blockIdx.x;
    gu32* ctl = (gu32*)(a.ws + WS_CTL);
    for (int u = tid; u < (LDS_BYTES - LDSCTL_OFF) / 4; u += 512) ((LAS unsigned*)(lds + LDSCTL_OFF))[u] = 0u;
    __syncthreads();
    const int lo = a.ph_lo, hi = a.ph_hi;
    XcdBarrier bar; bar.bar = (unsigned*)ctl + CW_BAR; bar.x = 0; bar.st = nullptr;
    if (hi - lo > 1) bar = xcd_barrier_post((unsigned*)ctl + CW_BAR, (volatile LAS unsigned*)(lds + MISC_OFF) + 8);
#define IN(k) (lo <= (k) && (k) < hi)
#define SEAM(k) do { if (IN(k) && IN((k) + 1)) xcd_barrier(bar); } while (0)

#define hbf ((bf16*)(ws + WS_HBF))
#define hf ((float*)(ws + WS_HF))
#define z ((bf16*)(ws + WS_Z))
#define zs ((float*)(ws + WS_ZS))
#define zssq ((float*)(ws + WS_ZSSQ))
#define hssq ((float*)(ws + WS_HSSQ))
#define rstd0 ((float*)(ws + WS_RSTD0))
#define rstd2 ((float*)(ws + WS_RSTD2))
#define qm ((bf16*)(ws + WS_QM))
#define km ((bf16*)(ws + WS_KM))
#define vm ((bf16*)(ws + WS_VM))
#define kc ((bf16*)(ws + WS_KC))
#define vc ((bf16*)(ws + WS_VC))
#define kb ((float*)(ws + WS_KB))
#define o3 ((bf16*)(ws + WS_O3))
#define ow ((bf16*)(ws + WS_OW))
#define mpart ((float*)(ws + WS_MPART))
#define mbf ((bf16*)(ws + WS_MBF))
#define qmem ((bf16*)(ws + WS_QMEM))
#define kvmem ((bf16*)(ws + WS_KVMEM))
#define omem ((bf16*)(ws + WS_OMEM))
#define logits ((float*)(ws + WS_LOGIT))
#define rope ((const float*)(ws + WS_ROPE))
#define tabd ((const float*)(ws + WS_TABD))
#define asge ((int*)(ws + WS_ASGE))
#define asgi ((int*)(ws + WS_ASGI))
#define asgw ((float*)(ws + WS_ASGW))
#define pos ((int*)(ws + WS_POS))
#define roww ((float*)(ws + WS_ROWW))
#define rowr ((float*)(ws + WS_ROWR))
#define tile ((int*)(ws + WS_TILE))
#define xg ((bf16*)(ws + WS_XG))
#define hdn ((bf16*)(ws + WS_HDN))
#define yb ((bf16*)(ws + WS_Y))
#ifndef PHMASK
#define PHMASK 0xFFFFFFFFu
#endif
#define EN(k) ((PHMASK >> (k)) & 1u)
    if (EN(0) && IN(0)) { asm volatile("; PHMARK 0"); GAS unsigned char* ws = lws(a.ws); (void)ws; { const int t_ = ltid(); ph_pre(a, t_, t_ & 63, __builtin_amdgcn_readfirstlane(t_ >> 6)); } }
    SEAM(0);
#pragma unroll 1
    for (int l = 0; l < DEPTH; ++l) {
        const int pb = 1 + NPH_LAYER * l;
        if (EN(1) && IN(pb + 0)) { asm volatile("; PHMARK 1"); GAS unsigned char* ws = lws(a.ws); (void)ws; { const int t_ = ltid(); ph_conv(a, l, lds, t_, t_ & 63, __builtin_amdgcn_readfirstlane(t_ >> 6)); } }
        SEAM(pb + 0);
        if (EN(2) && IN(pb + 1)) { asm volatile("; PHMARK 2"); GAS unsigned char* ws = lws(a.ws); (void)ws;
            if (EN(16)) { pg8::Gemm g{hbf, (const bf16*)(ws + WS_WIN), DM, DM}; pg8::StaticOrder S; S.init(NT, ZLD, G, bx);
              pg8::EpiWin E{z, zs, zssq, rstd0, km, rope}; pg8::gemm_phase(lds, g, S, E, ltid()); }
            if (EN(17)) { pg8::Gemm g{(const bf16*)(ws + WS_MEMBF), (const bf16*)(ws + WS_WMKV), DM, DM}; pg8::StaticOrder S; S.init(NB * MEML, 1024, G, G - 1 - bx);
              pg8::EpiRowScale E{kvmem, 1024, (const float*)(ws + WS_RSTDM), nullptr}; pg8::gemm_phase(lds, g, S, E, ltid()); }
        }
        SEAM(pb + 1);
        if (EN(3) && IN(pb + 2)) { asm volatile("; PHMARK 3"); GAS unsigned char* ws = lws(a.ws); (void)ws;
            if (EN(18)) { pg8::Gemm g{z + ZC_MCQ, (const bf16*)(ws + WS_WUQ), ZLD, 768}; pg8::StaticOrder S; S.init(NT, 1536, G, bx);
              pg8::EpiMlaQ E{qm, zssq, rope}; pg8::gemm_phase(lds, g, S, E, ltid()); }
            if (EN(19)) { pg8::Gemm g{z + ZC_MCKV, (const bf16*)(ws + WS_WUKV), ZLD, 512}; pg8::StaticOrder S; S.init(NT, 2048, G, bx);
              pg8::EpiMlaKV E{km, vm, zssq}; pg8::gemm_phase(lds, g, S, E, ltid()); }
            if (EN(20)) for (int u = bx; u < 512; u += G) nsa_win_unit(u, z, zs, tabd, ow, lds, ltid());
            if (EN(21)) { const int t_ = ltid(); for (int it = (G - 1 - bx) * NWAVES + __builtin_amdgcn_readfirstlane(t_ >> 6); it < 64; it += G * NWAVES) cumsum_item(it, zs, a.in[4] + l * 8, kb, t_ & 63); }
#if defined(COMPRESS_REF)
            if (EN(22)) for (int u = bx; u < 2 * 16 * 128; u += G) {
                const int br = u >> 11, rem = u & 2047, bg = rem >> 7, c = rem & 127; const int t_ = ltid();
                if (c < 127) { if (br == 0) compress_ref<192>(bg >> 1, bg & 1, c, z + ZC_NKC, (const bf16*)(ws + WS_WCK1), (const bf16*)(ws + WS_WCK2), (const float*)(ws + WS_C1P), 96, kc, lds, t_);
                               else compress_ref<128>(bg >> 1, bg & 1, c, z + ZC_NVC, (const bf16*)(ws + WS_WCV1), (const bf16*)(ws + WS_WCV2), (const float*)(ws + WS_C1P) + 96 * 192, 64, vc, lds, t_); }
                else { bf16* o = (br == 0 ? kc + (size_t)bg * 128 * 192 + 127 * 192 : vc + (size_t)bg * 128 * 128 + 127 * 128); if (t_ < (br == 0 ? 192 : 128)) o[t_] = 0; }
            }
#else
            if (EN(22)) for (int u = G - 1 - bx; u < 128; u += G) {
                const int br = u >> 6, rem = u & 63, b = rem >> 3, g2 = (rem >> 2) & 1, ct = rem & 3;
                if (br == 0) compress_body<192>(b, g2, ct, z + ZC_NKC, (const bf16*)(ws + WS_WCK1), (const bf16*)(ws + WS_WCK2), (const float*)(ws + WS_C1P), 96, kc, lds, ltid(), (unsigned*)ctl + CW_CHK);
                else compress_body<128>(b, g2, ct, z + ZC_NVC, (const bf16*)(ws + WS_WCV1), (const bf16*)(ws + WS_WCV2), (const float*)(ws + WS_C1P) + 96 * 192, 64, vc, lds, ltid(), (unsigned*)ctl + CW_CHK + 8);
            }
#endif
        }
        SEAM(pb + 2);
        if (EN(4) && IN(pb + 3)) { asm volatile("; PHMARK 4"); GAS unsigned char* ws = lws(a.ws); (void)ws;
            if (EN(23)) for (int u = bx; u < 256; u += G) { const int bh = u >> 2, p = u & 3; fox_sub(bh >> 3, bh & 7, 7 - p, z, kb, o3, lds, ltid()); fox_sub(bh >> 3, bh & 7, p, z, kb, o3, lds, ltid()); }
            if (EN(24)) for (int u = bx; u < 256; u += G) { const int bh = u >> 2, p = u & 3; mla_sub(bh >> 3, bh & 7, 7 - p, qm, km, vm, o3 + (size_t)NT * 1024, lds, ltid()); mla_sub(bh >> 3, bh & 7, p, qm, km, vm, o3 + (size_t)NT * 1024, lds, ltid()); }
            if (EN(25)) for (int u = bx; u < 256; u += G) { const int b = u >> 5, g2 = (u >> 4) & 1, p = u & 15;
                nsa_cmp_sub(b, g2, 31 - p, z, zs, tabd, kc, vc, ow, (unsigned*)(ws + WS_RMASK), lds, ltid()); nsa_cmp_sub(b, g2, p, z, zs, tabd, kc, vc, ow, (unsigned*)(ws + WS_RMASK), lds, ltid()); }
            if (EN(26)) for (int u = bx; u < 256; u += G) { const int b = u >> 5, g2 = (u >> 4) & 1, p = u & 15;
                nsa_sel_sub(b, g2, 31 - p, z, zs, tabd, ow, (const unsigned*)(ws + WS_RMASK), o3 + (size_t)2 * NT * 1024, lds, ltid());
                nsa_sel_sub(b, g2, p, z, zs, tabd, ow, (const unsigned*)(ws + WS_RMASK), o3 + (size_t)2 * NT * 1024, lds, ltid()); }
        }
        SEAM(pb + 3);
        if (EN(5) && IN(pb + 4)) { asm volatile("; PHMARK 5"); GAS unsigned char* ws = lws(a.ws); (void)ws;
            pg8::Gemm g{o3, (const bf16*)(ws + WS_WBR), 1024, 1024}; pg8::BranchOrder S; S.init(G, bx);
            pg8::EpiBranch E{z, mpart, mbf}; pg8::gemm_phase(lds, g, S, E, ltid());
        }
        SEAM(pb + 4);
        if (EN(6) && IN(pb + 5)) { asm volatile("; PHMARK 6"); GAS unsigned char* ws = lws(a.ws); (void)ws;
            pg8::Gemm g{mbf, (const bf16*)(ws + WS_WOUT), DM, DM}; pg8::StaticOrder S; S.init(NT, DM, G, bx);
            pg8::EpiResid E{l == 0 ? a.in[0] : (const float*)hf, hf, hbf, hssq}; pg8::gemm_phase(lds, g, S, E, ltid());
        }
        SEAM(pb + 5);
        if (EN(7) && IN(pb + 6)) { asm volatile("; PHMARK 7"); GAS unsigned char* ws = lws(a.ws); (void)ws;
            pg8::Gemm g{hbf, (const bf16*)(ws + WS_WMQ), DM, DM}; pg8::StaticOrder S; S.init(NT, 512, G, bx);
            pg8::EpiRowScale E{qmem, 512, nullptr, hssq}; pg8::gemm_phase(lds, g, S, E, ltid());
        }
        SEAM(pb + 6);
        if (EN(8) && IN(pb + 7)) { asm volatile("; PHMARK 8"); GAS unsigned char* ws = lws(a.ws); (void)ws; for (int u = bx; u < 256; u += G) mem_unit(u, qmem, kvmem, omem, lds, ltid()); }
        SEAM(pb + 7);
        if (EN(9) && IN(pb + 8)) { asm volatile("; PHMARK 9"); GAS unsigned char* ws = lws(a.ws); (void)ws;
            pg8::Gemm g{omem, (const bf16*)(ws + WS_WMO), 512, 512}; pg8::StaticOrder S; S.init(NT, DM, G, bx);
            pg8::EpiResid E{hf, hf, hbf, hssq}; pg8::gemm_phase(lds, g, S, E, ltid());
        }
        SEAM(pb + 8);
        if (EN(10) && IN(pb + 9)) { asm volatile("; PHMARK 10"); GAS unsigned char* ws = lws(a.ws); (void)ws;
            pg8::Gemm g{hbf, (const bf16*)(ws + WS_WR), DM, DM}; pg8::StaticOrder S; S.init(NT, 256, G, bx);
            pg8::EpiRouter E{logits, hssq, (const float*)(ws + WS_BRT), rstd2}; pg8::gemm_phase(lds, g, S, E, ltid());
        }
        SEAM(pb + 9);
        if (EN(11) && IN(pb + 10)) { asm volatile("; PHMARK 11"); GAS unsigned char* ws = lws(a.ws); (void)ws; ph_route1(logits, (unsigned*)ctl + CW_CNT + l * 64, asge, asgi, asgw, ltid()); }
        SEAM(pb + 10);
        if (EN(12) && IN(pb + 11)) { asm volatile("; PHMARK 12"); GAS unsigned char* ws = lws(a.ws); (void)ws; const int t_ = ltid(); ph_route2((const unsigned*)ctl + CW_CNT + l * 64, asge, asgi, asgw, rstd2, hbf, pos, roww, rowr, tile, xg, lds, t_, t_ & 63, __builtin_amdgcn_readfirstlane(t_ >> 6)); LDS_WAIT(); __syncthreads(); }
        SEAM(pb + 11);
        if (EN(13) && IN(pb + 12)) { asm volatile("; PHMARK 13"); GAS unsigned char* ws = lws(a.ws); (void)ws;
            pg8::Gemm g{xg, (const bf16*)(ws + WS_WGU), DM, DM}; pg8::MoeOrder S; S.init(tile, G, bx);
            pg8::EpiGateUp E{hdn, rowr}; pg8::gemm_phase(lds, g, S, E, ltid());
        }
        SEAM(pb + 12);
        if (EN(14) && IN(pb + 13)) { asm volatile("; PHMARK 14"); GAS unsigned char* ws = lws(a.ws); (void)ws;
            pg8::Gemm g{hdn, (const bf16*)(ws + WS_WD), DEXP, DEXP}; pg8::MoeOrder S; S.init(tile, G, bx);
            pg8::EpiDown E{yb, roww}; pg8::gemm_phase(lds, g, S, E, ltid());
        }
        SEAM(pb + 13);
        if (EN(15) && IN(pb + 14)) { asm volatile("; PHMARK 15"); GAS unsigned char* ws = lws(a.ws); (void)ws; { const int t_ = ltid(); ph_combine(hf, yb, pos, hbf, rstd0, a.in[31], a.out, l == DEPTH - 1, t_ & 63, __builtin_amdgcn_readfirstlane(t_ >> 6)); } }
        SEAM(pb + 14);
    }
#undef IN
#undef SEAM
#undef hbf
#undef hf
#undef z
#undef zs
#undef zssq
#undef hssq
#undef rstd0
#undef rstd2
#undef qm
#undef km
#undef vm
#undef kc
#undef vc
#undef kb
#undef o3
#undef ow
#undef mpart
#undef mbf
#undef qmem
#undef kvmem
#undef omem
#undef logits
#undef rope
#undef tabd
#undef asge
#undef asgi
#undef asgw
#undef pos
#undef roww
#undef rowr
#undef tile
#undef xg
#undef hdn
#undef yb
}

#ifndef N_LAUNCH_MODE
#define N_LAUNCH_MODE 1
#endif
extern "C" void kernel_launch(void* const* d_in, const int* in_sizes, int n_in, void* d_out, int out_size, void* d_ws, size_t ws_size, hipStream_t stream) {
    static int grid = 0;
    if (grid == 0) {
        if (n_in != 32 || out_size != NT * DM || ws_size < WS_END) { fprintf(stderr, "kernel_launch: unexpected shapes (n_in %d out %d ws %zu need %zu)\n", n_in, out_size, ws_size, (size_t)WS_END); grid = -1; return; }
        int dev = 0, cus = 0, per_cu = 0;
        if (hipGetDevice(&dev) != hipSuccess || hipDeviceGetAttribute(&cus, hipDeviceAttributeMultiprocessorCount, dev) != hipSuccess) { grid = -1; return; }
        if (hipFuncSetAttribute((const void*)fwd, hipFuncAttributeMaxDynamicSharedMemorySize, LDS_BYTES) != hipSuccess) { fprintf(stderr, "kernel_launch: hipFuncSetAttribute failed\n"); grid = -1; return; }
        if (hipOccupancyMaxActiveBlocksPerMultiprocessor(&per_cu, (const void*)fwd, 512, LDS_BYTES) != hipSuccess || per_cu < 1) fprintf(stderr, "kernel_launch: occupancy query says %d\n", per_cu);
        (void)hipGetLastError();
        grid = cus;
    }
    if (grid < 0) return;
    Args a{};
    for (int i = 0; i < 32; ++i) a.in[i] = (const float*)d_in[i];
    a.out = (float*)d_out; a.ws = (unsigned char*)d_ws; a.dbg = 0; a.pad = 0;
#if defined(DEBUG_CODES)
    unsigned char* ws = (unsigned char*)d_ws;
    (void)hipMemsetAsync(ws, 0xAA, WS_END, stream);
    (void)hipMemsetAsync(ws + WS_DBG, 0, 4096, stream);
    for (int run = 0; run < 3; ++run) {
        (void)hipMemsetAsync((char*)d_ws + WS_CTL, 0, CTL_ZERO_BYTES, stream);
        for (int p = 0; p < NPHASES; ++p) {
            a.ph_lo = p; a.ph_hi = p + 1; hipLaunchKernelGGL(fwd, dim3(grid), dim3(512), LDS_BYTES, stream, a);
            const int l = p == 0 ? 0 : (p - 1) / NPH_LAYER, j = p == 0 ? -1 : (p - 1) % NPH_LAYER;
            auto one = [&](int stage, size_t off, size_t bytes, int kind) { const DbgBuf b[] = {{off, bytes, kind}}; dbg_stage(stream, ws, run, stage, b, 1, a.out); };
            if (l == 0) {
                if (j == 0) { one(34, WS_WIN, (size_t)ZLD * DM * 2, 1); one(35, WS_WCK1, (size_t)192 * 6144 * 2, 1); one(36, WS_WCK2, (size_t)192 * 192 * 2, 1); one(37, WS_C1P, (size_t)(96 * 192 + 64 * 128) * 4, 0);
                              one(38, WS_WCV1, (size_t)128 * 4096 * 2, 1); one(39, WS_ROPE, (size_t)2048 * 64 * 4, 0); }
                if (j == 1) { one(1, WS_Z, (size_t)NT * ZLD * 2, 1); one(2, WS_ZS, (size_t)NT * 32 * 4, 0); one(3, WS_KVMEM, (size_t)2048 * 1024 * 2, 1); }
                if (j == 2) { hipLaunchKernelGGL(dbg_copy, dim3(1), dim3(64), 0, stream, (const unsigned*)(ws + WS_CTL) + CW_CHK, (unsigned*)(ws + WS_DBG + 2048) + 48, 16); one(4, WS_QM, (size_t)NT * 1536 * 2, 1); one(5, WS_KM, (size_t)NT * 1536 * 2, 1); one(6, WS_VM, (size_t)NT * 1024 * 2, 1); one(7, WS_OW, (size_t)NT * 1024 * 2, 1);
                              one(8, WS_KB, (size_t)64 * 2048 * 4, 0); one(9, WS_KC, (size_t)16 * 128 * 192 * 2, 1); one(10, WS_VC, (size_t)16 * 128 * 128 * 2, 1); }
                if (j == 3) { one(11, WS_O3, (size_t)NT * 1024 * 2, 1); one(12, WS_O3 + (size_t)NT * 1024 * 2, (size_t)NT * 1024 * 2, 1); one(13, WS_RMASK, (size_t)16 * 2048 * 4, 2);
                              one(14, WS_O3 + (size_t)2 * NT * 1024 * 2, (size_t)NT * 1024 * 2, 1); one(15, WS_OW, (size_t)NT * 1024 * 2, 1); }
                if (j == 4) one(16, WS_MBF, (size_t)NT * DM * 2, 1);
                if (j == 5) { one(17, WS_HF, (size_t)NT * DM * 4, 0); one(18, WS_HBF, (size_t)NT * DM * 2, 1); one(19, WS_HSSQ, (size_t)NT * 32 * 4, 0); }
                if (j == 6) one(20, WS_QMEM, (size_t)NT * 512 * 2, 1);
                if (j == 7) one(21, WS_OMEM, (size_t)NT * 512 * 2, 1);
                if (j == 8) { one(22, WS_HF, (size_t)NT * DM * 4, 0); one(23, WS_HBF, (size_t)NT * DM * 2, 1); one(24, WS_HSSQ, (size_t)NT * 32 * 4, 0); }
                if (j == 9) { one(25, WS_LOGIT, (size_t)NT * 64 * 4, 0); one(26, WS_RSTD2, (size_t)NT * 4, 0); }
                if (j == 10) { one(27, WS_ASGE, (size_t)NT * 2 * 4, 2); one(28, WS_ASGW, (size_t)NT * 2 * 4, 0); }
                if (j == 11) one(29, WS_TILE, (size_t)201 * 4, 2);
                if (j == 14) { one(30, WS_HF, (size_t)NT * DM * 4, 0); one(31, WS_HBF, (size_t)NT * DM * 2, 1); one(32, WS_RSTD0, (size_t)NT * 4, 0); }
            } else if (j == 14) one(33, (size_t)-1, (size_t)NT * DM * 4, 0);
        }
    }
    hipLaunchKernelGGL(dbg_final, dim3(1024), dim3(256), 0, stream, (const unsigned long long*)(ws + WS_DBG), (const unsigned*)(ws + WS_DBG + 2048), a.out, (size_t)NT * DM, 39);
#else
    (void)hipMemsetAsync((char*)d_ws + WS_CTL, 0, CTL_ZERO_BYTES, stream);
#if N_LAUNCH_MODE == 0
    a.ph_lo = 0; a.ph_hi = NPHASES;
    hipLaunchKernelGGL(fwd, dim3(grid), dim3(512), LDS_BYTES, stream, a);
#else
    for (int p = 0; p < NPHASES; ++p) { a.ph_lo = p; a.ph_hi = p + 1; hipLaunchKernelGGL(fwd, dim3(grid), dim3(512), LDS_BYTES, stream, a); }
#endif
#endif
}
```

```cpp
#define N_LAUNCH_MODE 0
#ifndef F8_GU
#define F8_GU 1
#endif
#ifndef F8_DN
#define F8_DN 1
#endif
#ifndef F8_OUT
#define F8_OUT 1
#endif
#include <hip/hip_runtime.h>
#include <cstdio>
#include <cstdint>

#define LAS __attribute__((address_space(3)))
#define GAS __attribute__((address_space(1)))
typedef unsigned short bf16;
typedef short bf16x8 __attribute__((ext_vector_type(8)));
typedef short s16x4 __attribute__((ext_vector_type(4)));
typedef short v4i16_t __attribute__((ext_vector_type(4)));
typedef float f32x2 __attribute__((ext_vector_type(2)));
typedef float f32x4 __attribute__((ext_vector_type(4)));
typedef float f32x16 __attribute__((ext_vector_type(16)));
typedef unsigned u32x2 __attribute__((ext_vector_type(2)));
typedef int i32x4 __attribute__((ext_vector_type(4)));
typedef int i32x8 __attribute__((ext_vector_type(8)));
typedef unsigned u32x4 __attribute__((ext_vector_type(4)));
typedef GAS unsigned gu32;

constexpr int DM = 2048, NB = 8, SEQ = 2048, DEPTH = 2, NT = NB * SEQ;
constexpr int MEML = 256;
constexpr float EPS = 1e-6f;
constexpr int D_IN = 14048, ZLD = 14080;
constexpr int ZC_FQ = 0, ZC_FK = 1024, ZC_FV = 2048, ZC_MCQ = 3072, ZC_MCKV = 3840, ZC_MKR = 4352, ZC_NQ = 4416, ZC_NKC = 5952, ZC_NVC = 6336,
              ZC_NKS = 6592, ZC_NVS = 6976, ZC_NKW = 7232, ZC_NVW = 7616, ZC_MG = 7872, ZC_FF = 14016, ZC_NGT = 14024;
constexpr int NEXP = 32, DEXP = 1024, PMAX = 40960;
constexpr float LOG2E = 1.4426950408889634f;

constexpr size_t MiB = 1u << 20;
constexpr size_t al256(size_t x) { return (x + 255) & ~(size_t)255; }
constexpr size_t WS_CTL = 0, CTL_ZERO_BYTES = 1 * MiB;
constexpr size_t WS_WIN  = 1 * MiB;
constexpr size_t WS_WUQ  = WS_WIN  + al256((size_t)ZLD * DM * 2);
constexpr size_t WS_WUKV = WS_WUQ  + al256((size_t)1536 * 768 * 2);
constexpr size_t WS_WCK1 = WS_WUKV + al256((size_t)2048 * 512 * 2);
constexpr size_t WS_WCK2 = WS_WCK1 + al256((size_t)192 * 6144 * 2);
constexpr size_t WS_WCV1 = WS_WCK2 + al256((size_t)192 * 192 * 2);
constexpr size_t WS_WCV2 = WS_WCV1 + al256((size_t)128 * 4096 * 2);
constexpr size_t WS_WBR  = WS_WCV2 + al256((size_t)128 * 128 * 2);
constexpr size_t WS_WOUT = WS_WBR  + al256((size_t)3 * 2048 * 1024 * 2);
constexpr size_t WS_WMQ  = WS_WOUT + al256((size_t)2048 * 2048 * 2);
constexpr size_t WS_WMKV = WS_WMQ  + al256((size_t)512 * 2048 * 2);
constexpr size_t WS_WMO  = WS_WMKV + al256((size_t)1024 * 2048 * 2);
constexpr size_t WS_WR   = WS_WMO  + al256((size_t)2048 * 512 * 2);
constexpr size_t WS_WGU  = WS_WR   + al256((size_t)256 * 2048 * 2);
constexpr size_t WS_WD   = WS_WGU  + al256((size_t)NEXP * 2048 * 2048 * 2);
constexpr size_t WS_ACT  = WS_WD   + al256((size_t)NEXP * 2048 * 1024 * 2);
constexpr size_t WS_HBF  = WS_ACT;
constexpr size_t WS_HF   = WS_HBF  + al256((size_t)NT * DM * 2);
constexpr size_t WS_Z    = WS_HF   + al256((size_t)NT * DM * 4);
constexpr size_t WS_XG   = WS_Z;
constexpr size_t WS_HDN  = WS_XG   + al256((size_t)PMAX * 2048 * 2);
constexpr size_t WS_Y    = WS_HDN  + al256((size_t)PMAX * 1024 * 2);
constexpr size_t WS_ZEND = WS_Z    + al256((size_t)NT * ZLD * 2);
static_assert(WS_Y + (size_t)PMAX * 2048 * 2 <= WS_ZEND, "MoE overlay fits in z");
constexpr size_t WS_ZS   = WS_ZEND;
constexpr size_t WS_ZSSQ = WS_ZS   + al256((size_t)NT * 32 * 4);
constexpr size_t WS_HSSQ = WS_ZSSQ + al256((size_t)NT * 32 * 4);
constexpr size_t WS_RSTD0= WS_HSSQ + al256((size_t)NT * 32 * 4);
constexpr size_t WS_RSTD2= WS_RSTD0+ al256((size_t)NT * 4);
constexpr size_t WS_QM   = WS_RSTD2+ al256((size_t)NT * 4);
constexpr size_t WS_KM   = WS_QM   + al256((size_t)NT * 1536 * 2);
constexpr size_t WS_VM   = WS_KM   + al256((size_t)NT * 1536 * 2);
constexpr size_t WS_KC   = WS_VM   + al256((size_t)NT * 1024 * 2);
constexpr size_t WS_VC   = WS_KC   + al256((size_t)16 * 128 * 192 * 2);
constexpr size_t WS_KB   = WS_VC   + al256((size_t)16 * 128 * 128 * 2);
constexpr size_t WS_O3   = WS_KB   + al256((size_t)64 * 2048 * 4);
constexpr size_t WS_OW   = WS_O3   + al256((size_t)3 * NT * 1024 * 2);
constexpr size_t WS_MPART= WS_OW   + al256((size_t)NT * 1024 * 2);
constexpr size_t WS_MBF  = WS_MPART+ al256((size_t)NT * DM * 4);
constexpr size_t WS_QMEM = WS_MBF  + al256((size_t)NT * DM * 2);
constexpr size_t WS_KVMEM= WS_QMEM + al256((size_t)NT * 512 * 2);
constexpr size_t WS_OMEM = WS_KVMEM+ al256((size_t)2048 * 1024 * 2);
constexpr size_t WS_LOGIT= WS_OMEM + al256((size_t)NT * 512 * 2);
constexpr size_t WS_MEMBF= WS_LOGIT+ al256((size_t)4 * NT * 64 * 4);
constexpr size_t WS_RSTDM= WS_MEMBF+ al256((size_t)2048 * 2048 * 2);
constexpr size_t WS_ROPE = WS_RSTDM+ al256((size_t)2048 * 4);
constexpr size_t WS_TABD = WS_ROPE + al256((size_t)2048 * 64 * 4);
constexpr size_t WS_C1P  = WS_TABD + al256((size_t)8 * 132 * 4);
constexpr size_t WS_BRT  = WS_C1P  + al256((size_t)(96 * 192 + 64 * 128) * 4);
constexpr size_t WS_ASGE = WS_BRT  + al256(2 * 64 * 4);
constexpr size_t WS_ASGI = WS_ASGE + al256((size_t)NT * 2 * 4);
constexpr size_t WS_ASGW = WS_ASGI + al256((size_t)NT * 2 * 4);
constexpr size_t WS_POS  = WS_ASGW + al256((size_t)NT * 2 * 4);
constexpr size_t WS_ROWW = WS_POS  + al256((size_t)NT * 2 * 4);
constexpr size_t WS_ROWR = WS_ROWW + al256((size_t)PMAX * 4);
constexpr size_t WS_TILE = WS_ROWR + al256((size_t)PMAX * 4);
constexpr size_t WS_RMASK= WS_TILE + al256(256 * 4);
constexpr size_t WS_DBG  = WS_RMASK+ al256((size_t)16 * 2048 * 4);
constexpr size_t WS_H8   = WS_DBG  + al256(4096);
constexpr size_t WS_WG8  = WS_H8   + al256((size_t)NT * DM);
constexpr size_t WS_END  = WS_WG8  + al256((size_t)23 * 256 * DM);
static_assert(WS_END <= (size_t)2048 * MiB, "workspace budget");

constexpr int CW_BAR = 4096;
constexpr int CW_CNT = 8192;
constexpr int F8_T0 = 31, F8_NT = 23;
constexpr int CONV_N_ATT = 40;
constexpr int CW_WQ = 24576;
constexpr int CW_CHK = 12288;

constexpr int RING_BYTES = 131072;
constexpr int LDSCTL_OFF = 143360, MISC_OFF = LDSCTL_OFF + 320;
constexpr int LDS_BYTES = 147456;
constexpr int NWAVES = 8;

#define RLX_AGENT __ATOMIC_RELAXED, __HIP_MEMORY_SCOPE_AGENT
#define LDS_WAIT() asm volatile("s_waitcnt lgkmcnt(0)" ::: "memory")
#define VM_WAIT() asm volatile("s_waitcnt vmcnt(0)" ::: "memory")

typedef __bf16 bf16x2_t __attribute__((ext_vector_type(2)));
__device__ __forceinline__ unsigned cvt_pk_bf16(float lo, float hi) { const f32x2 v = {lo, hi}; const bf16x2_t b = __builtin_convertvector(v, bf16x2_t); return __builtin_bit_cast(unsigned, b); }
__device__ __forceinline__ float clamp_e4m3(float x) { return __builtin_amdgcn_fmed3f(x, -448.f, 448.f); }
__device__ __forceinline__ unsigned pk4_fp8(float a, float b, float c, float d) { int w = 0; w = __builtin_amdgcn_cvt_pk_fp8_f32(clamp_e4m3(a), clamp_e4m3(b), w, false); w = __builtin_amdgcn_cvt_pk_fp8_f32(clamp_e4m3(c), clamp_e4m3(d), w, true); return (unsigned)w; }
__device__ __forceinline__ float bf2f(unsigned short b) { return __uint_as_float(((unsigned)b) << 16); }
__device__ __forceinline__ float bflo(unsigned w) { return __uint_as_float(w << 16); }
__device__ __forceinline__ float bfhi(unsigned w) { return __uint_as_float(w & 0xffff0000u); }
__device__ __forceinline__ unsigned short f2bf(float f) { return (unsigned short)(cvt_pk_bf16(f, 0.f) & 0xffffu); }
__device__ __forceinline__ int llane() { int l; asm volatile("v_mbcnt_lo_u32_b32 %0, -1, 0\n\tv_mbcnt_hi_u32_b32 %0, -1, %0" : "=v"(l)); return l; }
__device__ __forceinline__ float shx(float v, int mask, int lane) { return __int_as_float(__builtin_amdgcn_ds_bpermute((lane ^ mask) << 2, __float_as_int(v))); }
__device__ __forceinline__ float wave_sum(float v, int lane) {
#pragma unroll
    for (int o = 1; o < 64; o <<= 1) v += shx(v, o, lane);
    return v;
}
__device__ __forceinline__ float dot4v(f32x4 a) { return (a[0] * a[0] + a[1] * a[1]) + (a[2] * a[2] + a[3] * a[3]); }
__device__ __forceinline__ float sigmoidf_(float x) { return __builtin_amdgcn_rcpf(1.f + __builtin_amdgcn_exp2f(-LOG2E * x)); }

#define XB_TMO      128
#define XB_XCNT(j)  (256  + 64 * (j))
#define XB_XSUB(j)  (1280 + 64 * (j))
#define XB_XGEN(j)  (2304 + 64 * (j))
#define XB_TOP      3328
#define XB_TOPGEN   3392
#define XCD_BAR_WORDS 3456
#define XB_SPIN_CAP (1u << 18)
__device__ __forceinline__ unsigned xb_ld(unsigned* p)              { return __hip_atomic_load(p, __ATOMIC_RELAXED, __HIP_MEMORY_SCOPE_AGENT); }
__device__ __forceinline__ unsigned xb_add(unsigned* p, unsigned v) { return __hip_atomic_fetch_add(p, v, __ATOMIC_RELAXED, __HIP_MEMORY_SCOPE_AGENT); }
__device__ __forceinline__ unsigned xb_xcc_id() { return (unsigned)__builtin_amdgcn_s_getreg((3 << 11) | 20) & 0xFu; }
#define XB_SPIN(cond, bar) do { unsigned _sp = 0; while (cond) { __builtin_amdgcn_s_sleep(1); \
    if ((++_sp & 255u) == 0u) { if (xb_ld(&(bar)[XB_TMO])) break; if (_sp > XB_SPIN_CAP) { atomicAdd(&(bar)[XB_TMO], 1u); break; } } } } while (0)
struct XcdBarrier { unsigned* bar; unsigned x; volatile LAS unsigned* st; };
__device__ __forceinline__ XcdBarrier xcd_barrier_post(unsigned* bar, volatile LAS unsigned* st) {
    XcdBarrier b; b.bar = bar; b.x = xb_xcc_id(); b.st = st;
    if (threadIdx.x == 0) (void)xb_add(&bar[XB_XCNT(b.x)], 1u);
    return b;
}
__device__ __forceinline__ void xcd_barrier_complete(unsigned* bar, unsigned x, unsigned& nloc, unsigned& nx) {
    const unsigned G = gridDim.x * gridDim.y * gridDim.z;
    unsigned sum, cnt, mine, sp = 0u;
    for (;;) {
        sum = 0u; cnt = 0u; mine = 0u;
#pragma unroll
        for (unsigned j = 0; j < 16; ++j) { const unsigned c = xb_ld(&bar[XB_XCNT(j)]); sum += c; cnt += (c > 0u) ? 1u : 0u; mine = (j == x) ? c : mine; }
        if (sum == G) break;
        __builtin_amdgcn_s_sleep(1);
        if ((++sp & 255u) == 0u) { if (xb_ld(&bar[XB_TMO])) break; if (sp > XB_SPIN_CAP) { atomicAdd(&bar[XB_TMO], 1u); break; } }
    }
    nloc = mine > 0u ? mine : 1u; nx = cnt > 0u ? cnt : 1u;
}
__device__ __forceinline__ void xcd_barrier(const XcdBarrier& b) {
    asm volatile("s_waitcnt vmcnt(0)" ::: "memory");
    __syncthreads();
    if (threadIdx.x == 0) {
        unsigned* bar = b.bar;
        __builtin_amdgcn_s_waitcnt(0);
        unsigned nloc = b.st[0], nx = b.st[1];
        if (nloc == 0u) { xcd_barrier_complete(bar, b.x, nloc, nx); b.st[0] = nloc; b.st[1] = nx; }
        const unsigned old = xb_add(&bar[XB_XSUB(b.x)], 1u);
        const unsigned gen = old / nloc;
        if (old + 1u == (gen + 1u) * nloc) {
            __builtin_amdgcn_fence(__ATOMIC_RELEASE, "agent");
            asm volatile("s_waitcnt vmcnt(0)" ::: "memory");
            const unsigned og = xb_add(&bar[XB_TOP], 1u);
            const unsigned tg = og / nx;
            if (og + 1u == (tg + 1u) * nx) xb_add(&bar[XB_TOPGEN], 1u);
            else XB_SPIN(xb_ld(&bar[XB_TOPGEN]) == tg, bar);
            __builtin_amdgcn_fence(__ATOMIC_ACQUIRE, "agent");
            xb_add(&bar[XB_XGEN(b.x)], 1u);
            asm volatile("s_waitcnt vmcnt(0)" ::: "memory");
        } else {
            XB_SPIN(xb_ld(&bar[XB_XGEN(b.x)]) == gen, bar);
            __builtin_amdgcn_fence(__ATOMIC_ACQUIRE, "agent");
            asm volatile("s_waitcnt vmcnt(0)" ::: "memory");
        }
    }
    __syncthreads();
}
namespace pg8 {
constexpr int BM = 256, BK = 64, HALF = 128, HTB = HALF * BK * 2, STAGE_BYTES = 8 * HTB, NXCD = 8, WGM = 4;
__host__ __device__ __forceinline__ int lds_byte(int r, int c) { const int st = (r >> 4) * 2 + (c >> 5), rr = r & 15, cc = c & 31, ob = rr * 64 + cc * 2; return st * 1024 + (ob ^ (((ob >> 9) & 1) << 5)); }
__host__ __device__ __forceinline__ void stage_rc(int b, int& R, int& C) { const int st = b / 1024, sb = b % 1024, swz = sb ^ (((sb >> 9) & 1) << 5); R = (st >> 1) * 16 + swz / 64; C = (st & 1) * 32 + (swz % 64) / 2; }
__host__ __device__ __forceinline__ int perm32(int rho) { const int n = rho >> 4, i = rho & 15; return 8 * (i >> 2) + 4 * n + (i & 3); }

struct Unit { int pm, pn; };
struct Gemm { const bf16* A; const bf16* Bt; int lda; int K; int ldb = 0; };

struct StaticOrder {
    static constexpr bool GATHER = false;
    int nM, nN, nwg, G, c;
    __device__ void init(int M, int N, int G_, int c_) { nM = M / BM; nN = N / BM; nwg = nM * nN; G = G_; c = c_; }
    __device__ __forceinline__ bool next(int i, Unit& u) const {
        const long L = (long)i * G + c; if (L >= nwg) return false;
        int wgid = (int)L; { const int q = nwg / NXCD, r = nwg % NXCD, xcd = wgid % NXCD, off = wgid / NXCD; wgid = (xcd < r ? xcd * (q + 1) : r * (q + 1) + (xcd - r) * q) + off; }
        const int nig = WGM * nN, gid = wgid / nig, fm = gid * WGM, gsz = (nM - fm) < WGM ? (nM - fm) : WGM;
        u.pm = fm + ((wgid % nig) % gsz); u.pn = (wgid % nig) / gsz; return true;
    }
};
struct WinOrder : StaticOrder {
    __device__ __forceinline__ bool next(int i, Unit& u) const { if (!StaticOrder::next(i, u)) return false; if (u.pn >= F8_T0) u.pn += F8_NT; return true; }
};
struct BranchOrder {
    StaticOrder S;
    __device__ void init(int G_, int c_) { S.init(NT, 2048, G_, c_); }
    __device__ __forceinline__ bool next(int i, Unit& u) const {
        Unit t; if (!S.next(i / 3, t)) return false; const int n = i % 3;
        u.pm = n * 64 + t.pm; u.pn = n * 8 + t.pn; return true;
    }
};
struct MoeOrder {
    static constexpr bool GATHER = false;
    const int* tile_e; int rt0, nk, rw;
    __device__ __forceinline__ void init(const int* tab, int G_, int c_) {
        tile_e = tab; const int nt = tab[200]; const bool x8 = (G_ & 7) == 0;
        const int t8 = (nt + 7) >> 3, r0 = x8 ? (c_ & 7) * t8 : 0; int cnt = nt - r0; cnt = cnt < 0 ? 0 : ((x8 && cnt > t8) ? t8 : cnt);
        rt0 = r0; nk = cnt * 8; rw = x8 ? (((G_ >> 3) << 16) | (c_ >> 3)) : ((G_ << 16) | c_);
    }
    __device__ __forceinline__ bool next(int i, Unit& u) const {
        const int k = i * (rw >> 16) + (rw & 0xffff); if (k >= nk) return false;
        const int rt = rt0 + (k >> 3); u.pm = rt; u.pn = tile_e[rt] * 8 + (k & 7); return true;
    }
};

struct MoeGatherOrder : MoeOrder { static constexpr bool GATHER = true; const int* rowtok; };

struct NoHook { __device__ __forceinline__ void run(int) const {} };
template <class Epi, class Sched, class Hook = NoHook>
__device__ __forceinline__ void gemm_phase(LAS unsigned char* lds, const Gemm g, const Sched& S, const Epi& E, int tid, const Hook& H = Hook()) {
    static_assert(sizeof(Epi) > 0, "");
    const int wid = __builtin_amdgcn_readfirstlane(tid >> 6), lane = tid & 63, wr = wid >> 2, wc = wid & 3, fr = lane & 15, fq = lane >> 4;
    const int K = g.K, nt = K / BK, lda = g.lda, ldb = g.ldb ? g.ldb : g.K;
    unsigned voffA[2], voffB[2], voffA1[2];
#pragma unroll
    for (int i = 0; i < 2; ++i) { int R, C; stage_rc(tid * 16 + i * 8192, R, C); const int Rb = Epi::PERM ? ((R & ~31) + perm32(R & 31)) : R;
        voffA[i] = (unsigned)(R * lda + C) * 2u; voffB[i] = (unsigned)(Rb * ldb + C) * 2u; }
    const size_t kstep = (size_t)(BK * 2);
    const size_t hstepA = (size_t)HALF * lda * 2, hstepB = (size_t)HALF * ldb * 2;
    const size_t tstepA = 2 * hstepA, tstepB = 2 * hstepB;
    const unsigned ldsw = (unsigned)wid * 1024u;
    constexpr bool F8 = Epi::F8; constexpr int KOFF = F8 ? 16 : 1024;
    const int aoff = F8 ? lds_byte(wr * 64 + fr, (fq & 1) * 16) + (fq >> 1) * 1024 : lds_byte(wr * 64 + fr, fq * 8);
    const int boff = F8 ? lds_byte(wc * 32 + fr, (fq & 1) * 16) + (fq >> 1) * 1024 : lds_byte(wc * 32 + fr, fq * 8);
#define PG8_SA(b, h) (((b) * 2 + (h)) * HTB)
#define PG8_SB(b, h) ((4 + (b) * 2 + (h)) * HTB)
#define PG8_STAGE(bufoff, gbase, voff) do { _Pragma("unroll") for (int _i = 0; _i < 2; ++_i) \
        __builtin_amdgcn_global_load_lds((const unsigned*)((const char*)(gbase) + (voff)[_i]), (LAS unsigned*)(lds + (bufoff) + ldsw + _i * 8192), 16, 0, 0); } while (0)
#define PG8_STAGE_A0(bufoff, gbase) PG8_STAGE(bufoff, gbase, voffA)
#define PG8_STAGE_A1(bufoff, gbase) do { if constexpr (Sched::GATHER) PG8_STAGE(bufoff, gbase, voffA1); else PG8_STAGE(bufoff, (gbase) + hstepA, voffA); } while (0)
#define PG8_ROWS(idx, u, d0, d1) do { _Pragma("unroll") for (int _i = 0; _i < 2; ++_i) { int R, C; stage_rc(tid * 16 + _i * 8192, R, C); \
        if ((idx) < RMAPN) { d0[_i] = rmap[(idx) * BM + R]; d1[_i] = rmap[(idx) * BM + HALF + R]; } else { d0[_i] = S.rowtok[(u).pm * BM + R]; d1[_i] = S.rowtok[(u).pm * BM + HALF + R]; } } } while (0)
#define PG8_SETA(d0, d1) do { _Pragma("unroll") for (int _i = 0; _i < 2; ++_i) { int R, C; stage_rc(tid * 16 + _i * 8192, R, C); voffA[_i] = (unsigned)(d0[_i] * lda + C) * 2u; voffA1[_i] = (unsigned)(d1[_i] * lda + C) * 2u; } } while (0)
#define PG8_LD8(dst, addr) do { const i32x4 lo_ = *(const LAS i32x4*)(addr), hi_ = *(const LAS i32x4*)((addr) + 16); dst = __builtin_shufflevector(lo_, hi_, 0, 1, 2, 3, 4, 5, 6, 7); } while (0)
#define PG8_LDA(dst, b, h) do { if constexpr (F8) { _Pragma("unroll") for (int m = 0; m < 4; ++m) PG8_LD8(dst##8[m], lds + PG8_SA(b, h) + aoff + m * 2048); } else { \
        _Pragma("unroll") for (int m = 0; m < 4; ++m) _Pragma("unroll") for (int k = 0; k < 2; ++k) dst[m][k] = *(const LAS bf16x8*)(lds + PG8_SA(b, h) + aoff + m * 2048 + k * 1024); } } while (0)
#define PG8_LDB(dst, b, h) do { if constexpr (F8) { _Pragma("unroll") for (int n = 0; n < 2; ++n) PG8_LD8(dst##8[n], lds + PG8_SB(b, h) + boff + n * 2048); } else { \
        _Pragma("unroll") for (int n = 0; n < 2; ++n) _Pragma("unroll") for (int k = 0; k < 2; ++k) dst[n][k] = *(const LAS bf16x8*)(lds + PG8_SB(b, h) + boff + n * 2048 + k * 1024); } } while (0)
#define PG8_CAT(x) __builtin_shufflevector((i32x4)(x)[0], (i32x4)(x)[1], 0, 1, 2, 3, 4, 5, 6, 7)
#define PG8_MMA(ai, bj, At, Bt) do { __builtin_amdgcn_s_setprio(1); if constexpr (F8) { _Pragma("unroll") for (int m = 0; m < 4; ++m) _Pragma("unroll") for (int n = 0; n < 2; ++n) \
        asm volatile("v_mfma_scale_f32_16x16x128_f8f6f4 %0, %1, %2, %0, %3, %4 op_sel_hi:[0,0,0]" : "+v"(acc[ai][bj][m][n]) : "v"(Bt##8[n]), "v"(At##8[m]), "v"(sc_b), "v"(sc_a));   \
      } else { _Pragma("unroll") for (int m = 0; m < 4; ++m) _Pragma("unroll") for (int n = 0; n < 2; ++n) _Pragma("unroll") for (int k = 0; k < 2; ++k) \
        acc[ai][bj][m][n] = __builtin_amdgcn_mfma_f32_16x16x32_bf16(Bt[n][k], At[m][k], acc[ai][bj][m][n], 0, 0, 0); } __builtin_amdgcn_s_setprio(0); } while (0)
#define PG8_WAIT_V(n) asm volatile("s_waitcnt vmcnt(" #n ")" ::: "memory")
#define PG8_WAIT_L(n) asm volatile("s_waitcnt lgkmcnt(" #n ")" ::: "memory")
#define PG8_BAR __builtin_amdgcn_s_barrier()
#define PG8_SCHED __builtin_amdgcn_sched_barrier(0)
    Unit cur, nxt; int ui = 0;
    if (!S.next(0, cur)) return;
    f32x4 acc[2][2][4][2];
#pragma unroll
    for (int a = 0; a < 2; ++a)
#pragma unroll
        for (int b = 0; b < 2; ++b)
#pragma unroll
            for (int m = 0; m < 4; ++m)
#pragma unroll
                for (int n = 0; n < 2; ++n) acc[a][b][m][n] = (f32x4){0.f, 0.f, 0.f, 0.f};
    bf16x8 At[4][2], B0[2][2], B1[2][2];
    const int sc_b = 121, sc_a = 127; i32x8 At8[4], B08[2], B18[2];
    const char* cA = (const char*)g.A + (Sched::GATHER ? (size_t)0 : (size_t)cur.pm * tstepA); const char* cB = (const char*)g.Bt + (size_t)cur.pn * tstepB;
    constexpr int RMAPN = 12; LAS int* rmap = (LAS int*)(lds + STAGE_BYTES);
    if constexpr (Sched::GATHER) {
        { Unit u; for (int i = 0; i < RMAPN && S.next(i, u); ++i) if (tid < BM) rmap[i * BM + tid] = S.rowtok[u.pm * BM + tid]; }
        asm volatile("s_waitcnt lgkmcnt(0)" ::: "memory"); __builtin_amdgcn_s_barrier();
        int d0[2], d1[2]; PG8_ROWS(0, cur, d0, d1); PG8_SETA(d0, d1); }
    PG8_STAGE(PG8_SB(0, 0), cB, voffB); PG8_STAGE(PG8_SB(0, 1), cB + hstepB, voffB); PG8_STAGE_A0(PG8_SA(0, 0), cA); PG8_STAGE_A1(PG8_SA(0, 1), cA);
    if (wr == 1) PG8_BAR;
    PG8_WAIT_V(2); PG8_BAR;
    PG8_STAGE(PG8_SB(1, 0), cB + kstep, voffB); PG8_STAGE_A0(PG8_SA(1, 0), cA + kstep); PG8_STAGE(PG8_SB(1, 1), cB + hstepB + kstep, voffB);
    PG8_WAIT_V(6); PG8_BAR;
    for (;;) {
        const bool has_next = S.next(ui + 1, nxt);
        const char* nA = (has_next && !Sched::GATHER) ? (const char*)g.A + (size_t)nxt.pm * tstepA : cA; const char* nB = has_next ? (const char*)g.Bt + (size_t)nxt.pn * tstepB : cB;
#pragma clang loop unroll(disable)
        for (int t = 0; t < nt; t += 2) {
            const bool last = (t == nt - 2);
            const char* a1 = cA + (size_t)(t + 1) * kstep;
            const char* a2 = last ? nA : cA + (size_t)(t + 2) * kstep; const char* b2 = last ? nB : cB + (size_t)(t + 2) * kstep;
            const char* a3 = a2 + kstep; const char* b3 = b2 + kstep;
            if constexpr (Epi::KSEG > 0) { if (t > 0 && (t % Epi::KSEG) == 0) { const int t2 = llane(); E.seg(acc, cur, t / Epi::KSEG, wr, wc, t2 & 15, t2 >> 4); } }
            int d0[2], d1[2];
            if constexpr (Sched::GATHER) { if (last && has_next) PG8_ROWS(ui + 1, nxt, d0, d1); }
            PG8_LDB(B0, 0, 0); PG8_LDB(B1, 0, 1); PG8_SCHED; PG8_LDA(At, 0, 0); PG8_STAGE_A1(PG8_SA(1, 1), a1);
            if constexpr (Sched::GATHER) { if (last && has_next) PG8_SETA(d0, d1); }
            PG8_WAIT_V(8); PG8_WAIT_L(0); PG8_BAR; PG8_MMA(0, 0, At, B0); PG8_MMA(0, 1, At, B1); PG8_BAR; PG8_SCHED;
            PG8_LDA(At, 0, 1); PG8_STAGE(PG8_SB(0, 0), b2, voffB); PG8_STAGE(PG8_SB(0, 1), b2 + hstepB, voffB); PG8_STAGE_A0(PG8_SA(0, 0), a2);
            PG8_WAIT_V(8); PG8_WAIT_L(0); PG8_BAR; PG8_MMA(1, 0, At, B0); PG8_MMA(1, 1, At, B1); PG8_BAR; PG8_SCHED;
            PG8_LDB(B0, 1, 0); PG8_LDB(B1, 1, 1); PG8_SCHED; PG8_LDA(At, 1, 0); PG8_STAGE_A1(PG8_SA(0, 1), a2);
            PG8_WAIT_V(8); PG8_WAIT_L(0); PG8_BAR; PG8_MMA(0, 0, At, B0); PG8_MMA(0, 1, At, B1); PG8_BAR; PG8_SCHED;
            PG8_LDA(At, 1, 1); PG8_STAGE(PG8_SB(1, 0), b3, voffB); PG8_STAGE(PG8_SB(1, 1), b3 + hstepB, voffB); PG8_STAGE_A0(PG8_SA(1, 0), a3);
            PG8_WAIT_V(8); PG8_WAIT_L(0); PG8_BAR; PG8_MMA(1, 0, At, B0); PG8_MMA(1, 1, At, B1); PG8_BAR; PG8_SCHED;
        }
        if (wr == 0) PG8_BAR;
        { const int t2 = llane(); E(acc, cur, wr, wc, t2 & 15, t2 >> 4); }
        H.run(ui);
        if (!has_next) break;
#pragma unroll
        for (int a = 0; a < 2; ++a)
#pragma unroll
            for (int b = 0; b < 2; ++b)
#pragma unroll
                for (int m = 0; m < 4; ++m)
#pragma unroll
                    for (int n = 0; n < 2; ++n) acc[a][b][m][n] = (f32x4){0.f, 0.f, 0.f, 0.f};
        cur = nxt; cA = nA; cB = nB; ++ui;
        if (wr == 1) PG8_BAR;
    }
    PG8_WAIT_V(0);
    PG8_BAR;
#undef PG8_SA
#undef PG8_SB
#undef PG8_STAGE
#undef PG8_LDA
#undef PG8_STAGE_A0
#undef PG8_STAGE_A1
#undef PG8_ROWS
#undef PG8_SETA
#undef PG8_LDB
#undef PG8_MMA
#undef PG8_CAT
#undef PG8_WAIT_V
#undef PG8_WAIT_L
#undef PG8_BAR
#undef PG8_SCHED
}

typedef const f32x4 (&AccRef)[2][2][4][2];
__device__ __forceinline__ u32x4 pack8(f32x4 a, f32x4 b) { u32x4 w; w.x = cvt_pk_bf16(a[0], a[1]); w.y = cvt_pk_bf16(a[2], a[3]); w.z = cvt_pk_bf16(b[0], b[1]); w.w = cvt_pk_bf16(b[2], b[3]); return w; }
__device__ __forceinline__ float dot4(f32x4 a) { return (a[0] * a[0] + a[1] * a[1]) + (a[2] * a[2] + a[3] * a[3]); }
__device__ __forceinline__ float red_fq_(float s, int lane) { s += shx(s, 16, lane); s += shx(s, 32, lane); return s; }
#define red_fq(s) red_fq_((s), fr + 16 * fq)
__device__ __forceinline__ f32x4 rope4(f32x4 v, f32x4 cs) { return (f32x4){v[0] * cs[0] - v[1] * cs[1], v[1] * cs[0] + v[0] * cs[1], v[2] * cs[2] - v[3] * cs[3], v[3] * cs[2] + v[2] * cs[3]}; }

__device__ __forceinline__ unsigned char* g8_addr(const bf16* z, int row, int c) { return (unsigned char*)z + (size_t)row * (ZLD * 2) + 2 * ZC_MG + c; }
__device__ __forceinline__ f32x4 u8x4_to_f(unsigned w) { return (f32x4){(float)(w & 255u), (float)((w >> 8) & 255u), (float)((w >> 16) & 255u), (float)(w >> 24)}; }
__device__ __forceinline__ unsigned sig_u8x4(f32x4 x) { unsigned r = 0;
#pragma unroll
    for (int j = 0; j < 4; ++j) r |= (unsigned)fminf(sigmoidf_(x[j]) * 256.f, 255.f) << (8 * j);
    return r; }
struct EpiWin {
    static constexpr bool PERM = true; static constexpr int KSEG = 0; static constexpr bool F8 = false;
    bf16* z; float* zs; float* zssq; const float* rstd; bf16* km; const float* rope;
    __device__ __forceinline__ void operator()(AccRef acc, const Unit& u, int wr, int wc, int fr, int fq) const {
        const int row0 = u.pm * BM + wr * 64 + fr, colw = u.pn * BM + wc * 32 + 8 * fq;
        const bool do_ssq = (u.pn >= 12 && u.pn <= 16), do_rope = (u.pn == 17 && wc < 2), do_side = (u.pn == 54 && wc == 2);
        float rsv[2][4];
#pragma unroll
        for (int ai = 0; ai < 2; ++ai)
#pragma unroll
            for (int m = 0; m < 4; ++m) rsv[ai][m] = rstd[row0 + ai * HALF + m * 16];
#pragma unroll
        for (int ai = 0; ai < 2; ++ai)
#pragma unroll
            for (int m = 0; m < 4; ++m) {
                const int row = row0 + ai * HALF + m * 16; const float rs = rsv[ai][m]; float sq = 0.f;
#pragma unroll
                for (int bj = 0; bj < 2; ++bj) {
                    f32x4 v0 = acc[ai][bj][m][0] * rs, v1 = acc[ai][bj][m][1] * rs;
                    if (bj == 0 && do_rope) {
                        const float* rp = rope + ((size_t)(row & (SEQ - 1)) * 32 + 16 * wc + 4 * fq) * 2;
                        v0 = rope4(v0, *(const f32x4*)rp); v1 = rope4(v1, *(const f32x4*)(rp + 4));
                        const u32x4 w = pack8(v0, v1);
#pragma unroll
                        for (int hh = 0; hh < 8; ++hh) *(u32x4*)(km + (size_t)row * 1536 + hh * 192 + 128 + 32 * wc + 8 * fq) = w;
                    }
                    sq += dot4(v0) + dot4(v1);
                    { const int zc = colw + bj * HALF;
                      if (zc >= ZC_MG && zc < ZC_MG + 6144) { u32x2 c8; c8.x = sig_u8x4(v0); c8.y = sig_u8x4(v1); *(u32x2*)g8_addr(z, row, zc - ZC_MG) = c8; }
                      else *(u32x4*)(z + (size_t)row * ZLD + zc) = pack8(v0, v1); }
                    if (bj == 1 && do_side) { float* sp = zs + (size_t)row * 32 + 8 * fq; *(f32x4*)sp = v0; *(f32x4*)(sp + 4) = v1; }
                }
                if (do_ssq) { sq = red_fq(sq); if (fq == 0) zssq[(size_t)row * 32 + (u.pn - 12) * 4 + wc] = sq; }
            }
    }
};
struct EpiWin8 {
    static constexpr bool PERM = true; static constexpr int KSEG = 0; static constexpr bool F8 = true;
    bf16* z; const float* rstd;
    __device__ __forceinline__ void operator()(AccRef acc, const Unit& u, int wr, int wc, int fr, int fq) const {
        const int row0 = u.pm * BM + wr * 64 + fr, colw = (u.pn + F8_T0) * BM + wc * 32 + 8 * fq;
        float rsv[2][4];
#pragma unroll
        for (int ai = 0; ai < 2; ++ai)
#pragma unroll
            for (int m = 0; m < 4; ++m) rsv[ai][m] = rstd[row0 + ai * HALF + m * 16];
#pragma unroll
        for (int ai = 0; ai < 2; ++ai)
#pragma unroll
            for (int m = 0; m < 4; ++m) { const int row = row0 + ai * HALF + m * 16; const float rs = rsv[ai][m];
#pragma unroll
                for (int bj = 0; bj < 2; ++bj) { u32x2 c8; c8.x = sig_u8x4(acc[ai][bj][m][0] * rs); c8.y = sig_u8x4(acc[ai][bj][m][1] * rs); *(u32x2*)g8_addr(z, row, colw + bj * HALF - ZC_MG) = c8; } }
    }
};
struct EpiMlaQ {
    static constexpr bool PERM = true; static constexpr int KSEG = 0; static constexpr bool F8 = false;
    bf16* qm; const float* zssq; const float* rope;
    __device__ __forceinline__ void operator()(AccRef acc, const Unit& u, int wr, int wc, int fr, int fq) const {
        const int row0 = u.pm * BM + wr * 64 + fr;
        f32x4 pv[2][4];
#pragma unroll
        for (int ai = 0; ai < 2; ++ai)
#pragma unroll
            for (int m = 0; m < 4; ++m) pv[ai][m] = (fq < 3) ? *(const f32x4*)(zssq + (size_t)(row0 + ai * HALF + m * 16) * 32 + 4 * fq) : (f32x4){0.f, 0.f, 0.f, 0.f};
#pragma unroll
        for (int ai = 0; ai < 2; ++ai)
#pragma unroll
            for (int m = 0; m < 4; ++m) {
                const int row = row0 + ai * HALF + m * 16;
                float s = (pv[ai][m][0] + pv[ai][m][1]) + (pv[ai][m][2] + pv[ai][m][3]);
                s = red_fq(s); const float rs = rsqrtf(s * (1.f / 768.f) + EPS);
#pragma unroll
                for (int bj = 0; bj < 2; ++bj) {
                    const int cb = u.pn * BM + bj * HALF + wc * 32, within = cb % 192;
                    f32x4 v0 = acc[ai][bj][m][0] * rs, v1 = acc[ai][bj][m][1] * rs;
                    if (within >= 128) {
                        const float* rp = rope + ((size_t)(row & (SEQ - 1)) * 32 + (within - 128) / 2 + 4 * fq) * 2;
                        v0 = rope4(v0, *(const f32x4*)rp); v1 = rope4(v1, *(const f32x4*)(rp + 4));
                    }
                    *(u32x4*)(qm + (size_t)row * 1536 + cb + 8 * fq) = pack8(v0, v1);
                }
            }
    }
};
struct EpiMlaKV {
    static constexpr bool PERM = true; static constexpr int KSEG = 0; static constexpr bool F8 = false;
    bf16* km; bf16* vm; const float* zssq;
    __device__ __forceinline__ void operator()(AccRef acc, const Unit& u, int wr, int wc, int fr, int fq) const {
        const int row0 = u.pm * BM + wr * 64 + fr;
        f32x4 pv[2][4];
#pragma unroll
        for (int ai = 0; ai < 2; ++ai)
#pragma unroll
            for (int m = 0; m < 4; ++m) pv[ai][m] = (fq < 2) ? *(const f32x4*)(zssq + (size_t)(row0 + ai * HALF + m * 16) * 32 + 12 + 4 * fq) : (f32x4){0.f, 0.f, 0.f, 0.f};
#pragma unroll
        for (int ai = 0; ai < 2; ++ai)
#pragma unroll
            for (int m = 0; m < 4; ++m) {
                const int row = row0 + ai * HALF + m * 16;
                float s = (pv[ai][m][0] + pv[ai][m][1]) + (pv[ai][m][2] + pv[ai][m][3]);
                s = red_fq(s); const float rs = rsqrtf(s * (1.f / 512.f) + EPS);
                *(u32x4*)(km + (size_t)row * 1536 + u.pn * 192 + wc * 32 + 8 * fq) = pack8(acc[ai][0][m][0] * rs, acc[ai][0][m][1] * rs);
                *(u32x4*)(vm + (size_t)row * 1024 + u.pn * 128 + wc * 32 + 8 * fq) = pack8(acc[ai][1][m][0] * rs, acc[ai][1][m][1] * rs);
            }
    }
};
struct EpiRowScale {
    static constexpr bool PERM = true; static constexpr int KSEG = 0; static constexpr bool F8 = false;
    bf16* O; int ldc; const float* rstd;
    const float* hssq;
    __device__ __forceinline__ void operator()(AccRef acc, const Unit& u, int wr, int wc, int fr, int fq) const {
        const int row0 = u.pm * BM + wr * 64 + fr, colw = u.pn * BM + wc * 32 + 8 * fq;
        float rsv[2][4];
        if (rstd) {
#pragma unroll
            for (int ai = 0; ai < 2; ++ai)
#pragma unroll
                for (int m = 0; m < 4; ++m) rsv[ai][m] = rstd[row0 + ai * HALF + m * 16];
        } else {
            f32x4 pp[2][4], qq[2][4];
#pragma unroll
            for (int ai = 0; ai < 2; ++ai)
#pragma unroll
                for (int m = 0; m < 4; ++m) { const float* hp = hssq + (size_t)(row0 + ai * HALF + m * 16) * 32 + 8 * fq; pp[ai][m] = *(const f32x4*)hp; qq[ai][m] = *(const f32x4*)(hp + 4); }
#pragma unroll
            for (int ai = 0; ai < 2; ++ai)
#pragma unroll
                for (int m = 0; m < 4; ++m) { const f32x4 p = pp[ai][m], q = qq[ai][m];
                    float s = ((p[0] + p[1]) + (p[2] + p[3])) + ((q[0] + q[1]) + (q[2] + q[3])); s = red_fq(s); rsv[ai][m] = rsqrtf(s * (1.f / 2048.f) + EPS); }
        }
#pragma unroll
        for (int ai = 0; ai < 2; ++ai)
#pragma unroll
            for (int m = 0; m < 4; ++m) {
                const int row = row0 + ai * HALF + m * 16; const float rs = rsv[ai][m];
#pragma unroll
                for (int bj = 0; bj < 2; ++bj) *(u32x4*)(O + (size_t)row * ldc + colw + bj * HALF) = pack8(acc[ai][bj][m][0] * rs, acc[ai][bj][m][1] * rs);
            }
    }
};
struct EpiBranch {
    static constexpr bool PERM = true; static constexpr int KSEG = 16; static constexpr bool F8 = false;
    const bf16* z; bf16* mbf;
    __device__ __forceinline__ void seg(f32x4 (&acc)[2][2][4][2], const Unit& u, int sgi, int wr, int wc, int fr, int fq) const {
        const int row0 = u.pm * BM + wr * 64 + fr, colw = u.pn * BM + wc * 32 + 8 * fq;
#pragma unroll
        for (int ai = 0; ai < 2; ++ai) {
            u32x2 ga[4][2], gb[4][2];
#pragma unroll
            for (int m = 0; m < 4; ++m)
#pragma unroll
                for (int bj = 0; bj < 2; ++bj) { const unsigned char* gp = g8_addr(z, row0 + ai * HALF + m * 16, (sgi - 1) * 2048 + colw + bj * HALF);
                    ga[m][bj] = *(const u32x2*)gp; gb[m][bj] = *(const u32x2*)(gp + 2048); }
#pragma unroll
            for (int m = 0; m < 4; ++m)
#pragma unroll
                for (int bj = 0; bj < 2; ++bj) { const u32x2 A = ga[m][bj], B = gb[m][bj];
                    const f32x4 b0 = u8x4_to_f(B.x) + 0.5f, b1 = u8x4_to_f(B.y) + 0.5f;
                    acc[ai][bj][m][0] *= (u8x4_to_f(A.x) + 0.5f) * (f32x4){__builtin_amdgcn_rcpf(b0[0]), __builtin_amdgcn_rcpf(b0[1]), __builtin_amdgcn_rcpf(b0[2]), __builtin_amdgcn_rcpf(b0[3])};
                    acc[ai][bj][m][1] *= (u8x4_to_f(A.y) + 0.5f) * (f32x4){__builtin_amdgcn_rcpf(b1[0]), __builtin_amdgcn_rcpf(b1[1]), __builtin_amdgcn_rcpf(b1[2]), __builtin_amdgcn_rcpf(b1[3])}; }
        }
    }
    __device__ __forceinline__ void operator()(AccRef acc, const Unit& u, int wr, int wc, int fr, int fq) const {
        const int row0 = u.pm * BM + wr * 64 + fr, colw = u.pn * BM + wc * 32 + 8 * fq;
#pragma unroll
        for (int ai = 0; ai < 2; ++ai) {
            u32x2 gv[4][2];
#pragma unroll
            for (int m = 0; m < 4; ++m)
#pragma unroll
                for (int bj = 0; bj < 2; ++bj) gv[m][bj] = *(const u32x2*)g8_addr(z, row0 + ai * HALF + m * 16, 2 * 2048 + colw + bj * HALF);
#pragma unroll
            for (int m = 0; m < 4; ++m)
#pragma unroll
                for (int bj = 0; bj < 2; ++bj) { const u32x2 gw = gv[m][bj];
                    const f32x4 g0 = (u8x4_to_f(gw.x) + 0.5f) * (1.f / 256.f), g1 = (u8x4_to_f(gw.y) + 0.5f) * (1.f / 256.f);
                    const f32x4 r0 = acc[ai][bj][m][0] * g0, r1 = acc[ai][bj][m][1] * g1;
                    if constexpr (F8_OUT) { u32x2 w8; w8.x = pk4_fp8(r0[0], r0[1], r0[2], r0[3]); w8.y = pk4_fp8(r1[0], r1[1], r1[2], r1[3]);
                        *(u32x2*)((unsigned char*)mbf + (size_t)(row0 + ai * HALF + m * 16) * 2048 + colw + bj * HALF) = w8; }
                    else *(u32x4*)(mbf + (size_t)(row0 + ai * HALF + m * 16) * 2048 + colw + bj * HALF) = pack8(r0, r1); }
        }
    }
};
template <bool F8_>
struct EpiResidT {
    static constexpr bool PERM = true; static constexpr int KSEG = 0; static constexpr bool F8 = F8_;
    bf16* hbf; float* hssq; unsigned char* h8;
    __device__ __forceinline__ void operator()(AccRef acc, const Unit& u, int wr, int wc, int fr, int fq) const {
        const int row0 = u.pm * BM + wr * 64 + fr, colw = u.pn * BM + wc * 32 + 8 * fq;
#pragma unroll
        for (int ai = 0; ai < 2; ++ai) {
            u32x4 bv[4][2];
#pragma unroll
            for (int m = 0; m < 4; ++m)
#pragma unroll
                for (int bj = 0; bj < 2; ++bj) bv[m][bj] = *(const u32x4*)(hbf + (size_t)(row0 + ai * HALF + m * 16) * 2048 + colw + bj * HALF);
#pragma unroll
            for (int m = 0; m < 4; ++m) {
                const int row = row0 + ai * HALF + m * 16; float sq = 0.f;
#pragma unroll
                for (int bj = 0; bj < 2; ++bj) {
                    const u32x4 w = bv[m][bj];
                    const f32x4 v0 = acc[ai][bj][m][0] + (f32x4){bflo(w.x), bfhi(w.x), bflo(w.y), bfhi(w.y)}, v1 = acc[ai][bj][m][1] + (f32x4){bflo(w.z), bfhi(w.z), bflo(w.w), bfhi(w.w)};
                    *(u32x4*)(hbf + (size_t)row * 2048 + colw + bj * HALF) = pack8(v0, v1);
                    if (h8) { u32x2 w8; w8.x = pk4_fp8(v0[0], v0[1], v0[2], v0[3]); w8.y = pk4_fp8(v1[0], v1[1], v1[2], v1[3]); *(u32x2*)(h8 + (size_t)row * 2048 + colw + bj * HALF) = w8; }
                    sq += dot4(v0) + dot4(v1);
                }
                sq = red_fq(sq); if (fq == 0) hssq[(size_t)row * 32 + u.pn * 4 + wc] = sq;
            }
        }
    }
};
using EpiResid = EpiResidT<false>;
struct EpiRouter {
    static constexpr bool PERM = false; static constexpr int KSEG = 0; static constexpr bool F8 = false;
    float* plog;
    __device__ __forceinline__ void operator()(AccRef acc, const Unit& u, int wr, int wc, int fr, int fq) const {
        const int row0 = u.pm * BM + wr * 64 + fr;
        if (wc < 2) {
#pragma unroll
            for (int ai = 0; ai < 2; ++ai)
#pragma unroll
                for (int m = 0; m < 4; ++m) { const int row = row0 + ai * HALF + m * 16;
#pragma unroll
                    for (int n = 0; n < 2; ++n) *(f32x4*)(plog + (size_t)row * 64 + wc * 32 + 16 * n + 4 * fq) = acc[ai][0][m][n]; }
        }
    }
};
struct EpiGateUp {
    static constexpr bool PERM = true; static constexpr int KSEG = 0; static constexpr bool F8 = F8_GU;
    bf16* hdn; const float* rowr;
    __device__ __forceinline__ void operator()(AccRef acc, const Unit& u, int wr, int wc, int fr, int fq) const {
        const int row0 = u.pm * BM + wr * 64 + fr, col = (u.pn & 7) * 128 + wc * 32 + 8 * fq;
        float rsv[2][4];
#pragma unroll
        for (int ai = 0; ai < 2; ++ai)
#pragma unroll
            for (int m = 0; m < 4; ++m) rsv[ai][m] = rowr[row0 + ai * HALF + m * 16];
#pragma unroll
        for (int ai = 0; ai < 2; ++ai)
#pragma unroll
            for (int m = 0; m < 4; ++m) {
                const int row = row0 + ai * HALF + m * 16; const float rs = rsv[ai][m];
                f32x4 o[2];
#pragma unroll
                for (int n = 0; n < 2; ++n) { const f32x4 g = acc[ai][0][m][n] * rs, up = acc[ai][1][m][n] * rs;
#pragma unroll
                    for (int j = 0; j < 4; ++j) o[n][j] = g[j] * sigmoidf_(g[j]) * up[j]; }
                if constexpr (F8_DN) { u32x2 w8; w8.x = pk4_fp8(o[0][0], o[0][1], o[0][2], o[0][3]); w8.y = pk4_fp8(o[1][0], o[1][1], o[1][2], o[1][3]); *(u32x2*)((unsigned char*)hdn + (size_t)row * 1024 + col) = w8; }
                else *(u32x4*)(hdn + (size_t)row * 1024 + col) = pack8(o[0], o[1]);
            }
    }
};
struct EpiDown {
    static constexpr bool PERM = true; static constexpr int KSEG = 0; static constexpr bool F8 = F8_DN;
    bf16* y; const float* roww;
    __device__ __forceinline__ void operator()(AccRef acc, const Unit& u, int wr, int wc, int fr, int fq) const {
        const int row0 = u.pm * BM + wr * 64 + fr, colw = (u.pn & 7) * BM + wc * 32 + 8 * fq;
        float wv[2][4];
#pragma unroll
        for (int ai = 0; ai < 2; ++ai)
#pragma unroll
            for (int m = 0; m < 4; ++m) wv[ai][m] = roww[row0 + ai * HALF + m * 16];
#pragma unroll
        for (int ai = 0; ai < 2; ++ai)
#pragma unroll
            for (int m = 0; m < 4; ++m) {
                const int row = row0 + ai * HALF + m * 16; const float w = wv[ai][m];
#pragma unroll
                for (int bj = 0; bj < 2; ++bj) *(u32x4*)(y + (size_t)row * 2048 + colw + bj * HALF) = pack8(acc[ai][bj][m][0] * w, acc[ai][bj][m][1] * w);
            }
    }
};
}
namespace att {
template <int DK> struct Geo { static constexpr int CPR = DK / 8, KROW = DK * 2, KBYTES = 64 * KROW, VBYTES = 16384, BUF = KBYTES + VBYTES, NKI = DK / 64, NVI = 2, NPT = NKI + NVI; };
constexpr int NBUF = 3;
constexpr int KB_OFF = 122880;
constexpr int TAB_OFF = 131072;
constexpr int RMASK_OFF = TAB_OFF + 4 * 132 * 4;
constexpr int IMPS_OFF = RMASK_OFF + 256;
static_assert(NBUF * Geo<192>::BUF <= KB_OFF && IMPS_OFF + 64 * 33 * 4 <= LDSCTL_OFF, "attention LDS");

__device__ __forceinline__ s16x4 vtr(const LAS unsigned char* p) { return __builtin_bit_cast(s16x4, __builtin_amdgcn_ds_read_tr16_b64_v4i16((LAS v4i16_t*)p)); }
__device__ __forceinline__ float half_max(float v) { auto rr = __builtin_amdgcn_permlane32_swap(__float_as_uint(v), __float_as_uint(v), false, false); return fmaxf(__uint_as_float(rr[0]), __uint_as_float(rr[1])); }
__device__ __forceinline__ float half_sum(float v) { auto rr = __builtin_amdgcn_permlane32_swap(__float_as_uint(v), __float_as_uint(v), false, false); return __uint_as_float(rr[0]) + __uint_as_float(rr[1]); }

template <int DK> __device__ __forceinline__ void dma_tile(LAS unsigned char* buf, const bf16* Kg, int ldk, const bf16* Vg, int ldv, int jt, int wave, int lane) {
    constexpr int CPR = Geo<DK>::CPR;
    const char* kt = (const char*)(Kg + (size_t)(64 * jt) * ldk); const char* vt = (const char*)(Vg + (size_t)(64 * jt) * ldv);
#pragma unroll
    for (int i = 0; i < Geo<DK>::NKI; ++i) { const int L = (wave * Geo<DK>::NKI + i) * 64 + lane, row = L / CPR, cp = L % CPR, c = (cp & ~7) | ((cp ^ row) & 7);
        __builtin_amdgcn_global_load_lds((const unsigned*)(kt + (unsigned)(row * ldk + c * 8) * 2u), (LAS unsigned*)(buf + (wave * Geo<DK>::NKI + i) * 1024), 16, 0, 0); }
#pragma unroll
    for (int i = 0; i < 2; ++i) { const int L = (wave * 2 + i) * 64 + lane, st = L >> 5, r = (L >> 2) & 7, cc = L & 3, key = (st >> 2) * 8 + r, dch = (st & 3) * 4 + cc;
        __builtin_amdgcn_global_load_lds((const unsigned*)(vt + (unsigned)(key * ldv + dch * 8) * 2u), (LAS unsigned*)(buf + Geo<DK>::KBYTES + (wave * 2 + i) * 1024), 16, 0, 0); }
}

struct State { f32x16 o[4]; float m, l; };
__device__ __forceinline__ void state_init(State& s) {
#pragma unroll
    for (int d = 0; d < 4; ++d)
#pragma unroll
        for (int r = 0; r < 16; ++r) s.o[d][r] = 0.f;
    s.m = -1e30f; s.l = 0.f;
}

template <int DK, bool MASK, bool KBIAS, bool T5, bool SEL, bool CMP, int CT, int HF>
__device__ __forceinline__ void half_compute(const LAS unsigned char* buf, int jt, const bf16x8 (&qf)[DK / 16], int t, int tw0, int W,
                                             const LAS float* kbias, const LAS float* tab, bool rowon, float cs, State& st,
                                             float (&impm)[16], float (&impt)[1], int lane) {
    constexpr int KROW = Geo<DK>::KROW, KS = CMP ? 16 : 1;
    const int hi = lane >> 5, l31 = lane & 31;
    const int pk0 = (CMP ? (1024 * jt + 31) : 64 * jt) + 32 * KS * HF, pk1 = pk0 + 31 * KS;
    const int dmin = tw0 - pk1, dmax = tw0 + 31 - pk0;
    if (MASK && (dmax < 0 || dmin >= W)) return;
    f32x4 kbv[4];
    if (KBIAS) {
#pragma unroll
        for (int a = 0; a < 4; ++a) kbv[a] = *(const LAS f32x4*)(kbias + 64 * jt + 32 * HF + 8 * a + 4 * hi);
    }
    f32x16 p;
#pragma unroll
    for (int r = 0; r < 16; ++r) p[r] = 0.f;
    const LAS unsigned char* krow = buf + (32 * HF + l31) * KROW;
    const LAS unsigned char* kp0 = krow + (((0 + hi) ^ l31) & 7) * 16; const LAS unsigned char* kp1 = krow + (((2 + hi) ^ l31) & 7) * 16;
    const LAS unsigned char* kp2 = krow + (((4 + hi) ^ l31) & 7) * 16; const LAS unsigned char* kp3 = krow + (((6 + hi) ^ l31) & 7) * 16;
#define ATT_KLD(kk) (*(const LAS bf16x8*)((((kk) & 3) == 0 ? kp0 : (((kk) & 3) == 1 ? kp1 : (((kk) & 3) == 2 ? kp2 : kp3))) + ((kk) >> 2) * 128))
    constexpr int NKH = DK / 32;
    bf16x8 kfa[NKH], kfb[NKH];
#pragma unroll
    for (int i = 0; i < NKH; ++i) kfa[i] = ATT_KLD(i);
    __builtin_amdgcn_sched_barrier(0);
#pragma unroll
    for (int i = 0; i < NKH; ++i) kfb[i] = ATT_KLD(NKH + i);
#pragma unroll
    for (int i = 0; i < NKH; ++i) p = __builtin_amdgcn_mfma_f32_32x32x16_bf16(kfa[i], qf[i], p, 0, 0, 0);
    __builtin_amdgcn_sched_barrier(0);
#pragma unroll
    for (int i = 0; i < NKH; ++i) p = __builtin_amdgcn_mfma_f32_32x32x16_bf16(kfb[i], qf[NKH + i], p, 0, 0, 0);
#undef ATT_KLD
    const unsigned vb0 = (unsigned)(size_t)(buf + Geo<DK>::KBYTES + (4 * hi + ((lane & 15) >> 2)) * 64 + (16 * ((lane >> 4) & 1) + 4 * (lane & 3)) * 2);
#define ATT_TRRD(dst, off) asm volatile("ds_read_b64_tr_b16 %0, %1 offset:%2" : "=&v"(dst) : "v"(vb0), "i"(off) : "memory")
    s16x4 l0, l1, l2, l3, h0, h1, h2, h3;
    { constexpr int b_ = (4 * HF) * 2048;
      ATT_TRRD(l0, b_); ATT_TRRD(h0, b_ + 2048); ATT_TRRD(l1, b_ + 512); ATT_TRRD(h1, b_ + 512 + 2048);
      ATT_TRRD(l2, b_ + 1024); ATT_TRRD(h2, b_ + 1024 + 2048); ATT_TRRD(l3, b_ + 1536); ATT_TRRD(h3, b_ + 1536 + 2048); }
    __builtin_amdgcn_sched_barrier(0);
    const int dq = t - pk0 - 4 * hi * KS;
    const bool need_mask = MASK && (dmin < 0 || dmax >= W);
    const float NEG = -__builtin_inff();
    if (T5 && dmin < 128) {
#pragma unroll
        for (int r = 0; r < 16; ++r) { const int c = (r & 3) + 8 * (r >> 2); const int d0 = dq - KS * c; p[r] = fmaf(p[r], cs, tab[min(max(d0, 0), 128)]); }
    } else {
        const float cfar = T5 ? tab[128] : 0.f;
#pragma unroll
        for (int r = 0; r < 16; ++r) { float b0 = cfar; if (KBIAS) b0 = kbv[r >> 2][r & 3]; p[r] = fmaf(p[r], cs, b0); }
    }
    if (need_mask) {
#pragma unroll
        for (int r = 0; r < 16; ++r) { const int c = (r & 3) + 8 * (r >> 2); if ((unsigned)(dq - KS * c) >= (unsigned)W) p[r] = NEG; }
    }
    if (SEL) { if (!rowon) {
#pragma unroll
        for (int r = 0; r < 16; ++r) p[r] = NEG; } }
    float pm = p[0];
#pragma unroll
    for (int r = 1; r < 16; ++r) pm = fmaxf(pm, p[r]);
    pm = half_max(pm);
    float mn = st.m, alpha = 1.f;
    if (!__all(pm - st.m <= 8.f ? 1 : 0)) {
        mn = fmaxf(st.m, pm); alpha = __builtin_amdgcn_exp2f(st.m - mn); st.m = mn;
#pragma unroll
        for (int d = 0; d < 4; ++d)
#pragma unroll
            for (int r = 0; r < 16; ++r) st.o[d][r] *= alpha;
        if (CMP) {
#pragma unroll
            for (int i = 0; i < 16; ++i) impm[i] *= alpha;
            impt[0] *= alpha;
        }
    }
    float ps = 0.f;
#pragma unroll
    for (int r = 0; r < 16; ++r) { p[r] = __builtin_amdgcn_exp2f(p[r] - mn); ps += p[r]; }
    ps = half_sum(ps);
    st.l = st.l * alpha + ps;
    if (CMP) {
        float ot[4];
#pragma unroll
        for (int a = 0; a < 4; ++a) { const float tl = p[4 * a + 3]; auto rr = __builtin_amdgcn_permlane32_swap(__float_as_uint(tl), __float_as_uint(tl), false, false);
            ot[a] = hi ? __uint_as_float(rr[0]) : __uint_as_float(rr[1]); }
#pragma unroll
        for (int a = 0; a < 4; ++a) { const float prev = hi ? ot[a] : (a == 0 ? impt[0] : ot[a > 0 ? a - 1 : 0]);
            impm[CT * 8 + HF * 4 + a] = 2.f * (p[4 * a] + p[4 * a + 1] + p[4 * a + 2]) + p[4 * a + 3] + prev; }
        impt[0] = ot[3];
    }
    bf16x8 pa[2];
    { u32x4 w;
      w.x = cvt_pk_bf16(p[0], p[1]); w.y = cvt_pk_bf16(p[2], p[3]); w.z = cvt_pk_bf16(p[4], p[5]); w.w = cvt_pk_bf16(p[6], p[7]); pa[0] = __builtin_bit_cast(bf16x8, w);
      w.x = cvt_pk_bf16(p[8], p[9]); w.y = cvt_pk_bf16(p[10], p[11]); w.z = cvt_pk_bf16(p[12], p[13]); w.w = cvt_pk_bf16(p[14], p[15]); pa[1] = __builtin_bit_cast(bf16x8, w); }
    s16x4 m0, m1, m2, m3, n0, n1, n2, n3;
    asm volatile("s_waitcnt lgkmcnt(0)" ::: "memory"); __builtin_amdgcn_sched_barrier(0);
    { constexpr int b_ = (4 * HF + 2) * 2048;
      ATT_TRRD(m0, b_); ATT_TRRD(n0, b_ + 2048); ATT_TRRD(m1, b_ + 512); ATT_TRRD(n1, b_ + 512 + 2048);
      ATT_TRRD(m2, b_ + 1024); ATT_TRRD(n2, b_ + 1024 + 2048); ATT_TRRD(m3, b_ + 1536); ATT_TRRD(n3, b_ + 1536 + 2048); }
    st.o[0] = __builtin_amdgcn_mfma_f32_32x32x16_bf16((bf16x8){l0[0], l0[1], l0[2], l0[3], h0[0], h0[1], h0[2], h0[3]}, pa[0], st.o[0], 0, 0, 0);
    st.o[1] = __builtin_amdgcn_mfma_f32_32x32x16_bf16((bf16x8){l1[0], l1[1], l1[2], l1[3], h1[0], h1[1], h1[2], h1[3]}, pa[0], st.o[1], 0, 0, 0);
    st.o[2] = __builtin_amdgcn_mfma_f32_32x32x16_bf16((bf16x8){l2[0], l2[1], l2[2], l2[3], h2[0], h2[1], h2[2], h2[3]}, pa[0], st.o[2], 0, 0, 0);
    st.o[3] = __builtin_amdgcn_mfma_f32_32x32x16_bf16((bf16x8){l3[0], l3[1], l3[2], l3[3], h3[0], h3[1], h3[2], h3[3]}, pa[0], st.o[3], 0, 0, 0);
    asm volatile("s_waitcnt lgkmcnt(0)" ::: "memory"); __builtin_amdgcn_sched_barrier(0);
    st.o[0] = __builtin_amdgcn_mfma_f32_32x32x16_bf16((bf16x8){m0[0], m0[1], m0[2], m0[3], n0[0], n0[1], n0[2], n0[3]}, pa[1], st.o[0], 0, 0, 0);
    st.o[1] = __builtin_amdgcn_mfma_f32_32x32x16_bf16((bf16x8){m1[0], m1[1], m1[2], m1[3], n1[0], n1[1], n1[2], n1[3]}, pa[1], st.o[1], 0, 0, 0);
    st.o[2] = __builtin_amdgcn_mfma_f32_32x32x16_bf16((bf16x8){m2[0], m2[1], m2[2], m2[3], n2[0], n2[1], n2[2], n2[3]}, pa[1], st.o[2], 0, 0, 0);
    st.o[3] = __builtin_amdgcn_mfma_f32_32x32x16_bf16((bf16x8){m3[0], m3[1], m3[2], m3[3], n3[0], n3[1], n3[2], n3[3]}, pa[1], st.o[3], 0, 0, 0);
    __builtin_amdgcn_sched_barrier(0);
#undef ATT_TRRD
}
template <int DK, bool MASK, bool KBIAS, bool T5, bool SEL, bool CMP, int CT>
__device__ __forceinline__ void tile_compute(const LAS unsigned char* buf, int jt, const bf16x8 (&qf)[DK / 16], int t, int tw0, int W,
                                             const LAS float* kbias, const LAS float* tab, unsigned rowmask, float cs, State& st,
                                             float (&impm)[16], float (&impt)[1], int lane) {
    bool rowon = true;
    if (SEL) { rowon = ((rowmask >> jt) & 1u) != 0u; if (!__any(rowon ? 1 : 0)) return; }
    half_compute<DK, MASK, KBIAS, T5, SEL, CMP, CT, 0>(buf, jt, qf, t, tw0, W, kbias, tab, rowon, cs, st, impm, impt, lane);
    half_compute<DK, MASK, KBIAS, T5, SEL, CMP, CT, 1>(buf, jt, qf, t, tw0, W, kbias, tab, rowon, cs, st, impm, impt, lane);
}

template <int N> __device__ __forceinline__ void wait_vm() { asm volatile("s_waitcnt vmcnt(%0)" :: "n"(N) : "memory"); }
template <int DK, bool MASK, bool KBIAS, bool T5, bool SEL>
__device__ __forceinline__ void attn_run(LAS unsigned char* lds, const bf16* Kg, int ldk, const bf16* Vg, int ldv, int jt_lo, int jt_hi,
                                         const bf16x8 (&qf)[DK / 16], int t, int tw0, int W, const LAS float* kbias, const LAS float* tab,
                                         unsigned rowmask, float cs, State& st, int tid) {
    const int lane = tid & 63, wave = __builtin_amdgcn_readfirstlane(tid >> 6);
    float dm0[16], dm1[1];
    dma_tile<DK>(lds, Kg, ldk, Vg, ldv, jt_lo, wave, lane);
    if (jt_lo + 1 < jt_hi) dma_tile<DK>(lds + Geo<DK>::BUF, Kg, ldk, Vg, ldv, jt_lo + 1, wave, lane);
    int cur = 0;
    for (int jt = jt_lo; jt < jt_hi; ++jt) {
        if (jt + 1 < jt_hi) wait_vm<Geo<DK>::NPT>(); else wait_vm<0>();
        asm volatile("s_waitcnt lgkmcnt(0)" ::: "memory");
        __builtin_amdgcn_s_barrier();
        asm volatile("" ::: "memory");
        const int lane_ = lane;
        const int nxt = cur >= 1 ? cur - 1 : 2;
        if (jt + 2 < jt_hi) dma_tile<DK>(lds + nxt * Geo<DK>::BUF, Kg, ldk, Vg, ldv, jt + 2, wave, lane_);
        tile_compute<DK, MASK, KBIAS, T5, SEL, false, 0>(lds + cur * Geo<DK>::BUF, jt, qf, t, tw0, W, kbias, tab, rowmask, cs, st, dm0, dm1, lane);
        cur = cur == 2 ? 0 : cur + 1;
    }
    asm volatile("s_waitcnt lgkmcnt(0)" ::: "memory");
    __builtin_amdgcn_s_barrier();
    asm volatile("" ::: "memory");
}

template <int DK> __device__ __forceinline__ void load_q(bf16x8 (&qf)[DK / 16], const bf16* qrow, int lane) {
#pragma unroll
    for (int kk = 0; kk < DK / 16; ++kk) qf[kk] = *(const bf16x8*)(qrow + 16 * kk + 8 * (lane >> 5));
}
template <int MODE> __device__ __forceinline__ void store_o(const State& st, float sc, bf16* orow, const bf16* addrow, int lane) {
    const int hi = lane >> 5;
#pragma unroll
    for (int db = 0; db < 4; ++db)
#pragma unroll
        for (int rg = 0; rg < 4; ++rg) {
            const int d = 32 * db + 8 * rg + 4 * hi;
            float v0 = st.o[db][4 * rg] * sc, v1 = st.o[db][4 * rg + 1] * sc, v2 = st.o[db][4 * rg + 2] * sc, v3 = st.o[db][4 * rg + 3] * sc;
            if (MODE != 0) { const u32x2 a = *(const u32x2*)((MODE == 1 ? (const bf16*)orow : addrow) + d); v0 += bflo(a.x); v1 += bfhi(a.x); v2 += bflo(a.y); v3 += bfhi(a.y); }
            u32x2 w; w.x = cvt_pk_bf16(v0, v1); w.y = cvt_pk_bf16(v2, v3);
            *(u32x2*)(orow + d) = w;
        }
}
}
struct Args { const float* in[32]; float* out; unsigned char* ws; int ph_lo, ph_hi, dbg, pad; };
#if defined(__HIP_DEVICE_COMPILE__)
typedef const __attribute__((address_space(4))) Args* KArgP;
#else
typedef const Args* KArgP;
#endif
struct KIn { KArgP p; __device__ __forceinline__ const float* operator[](int i) const { return p->in[i]; } };
struct KA { KIn in; float* out; unsigned char* ws; };

__device__ __forceinline__ float row_to_bf16(const float* xrow, bf16* orow, unsigned char* o8, int lane) {
    const f32x4* xr = (const f32x4*)xrow + lane; f32x4 v[8]; float s = 0.f;
#pragma unroll
    for (int j = 0; j < 8; ++j) { v[j] = xr[64 * j]; s += dot4v(v[j]); }
    s = wave_sum(s, lane);
    u32x2* ob = (u32x2*)orow + lane;
#pragma unroll
    for (int j = 0; j < 8; ++j) { u32x2 w; w.x = cvt_pk_bf16(v[j][0], v[j][1]); w.y = cvt_pk_bf16(v[j][2], v[j][3]); ob[64 * j] = w; }
    if (o8) {
#pragma unroll
        for (int j = 0; j < 8; ++j) ((unsigned*)o8)[lane + 64 * j] = pk4_fp8(v[j][0], v[j][1], v[j][2], v[j][3]);
    }
    return rsqrtf(s * (1.f / 2048.f) + EPS);
}

__device__ __forceinline__ int t5_bucket(int d) {
    if (d < 16) return d;
    const float df = (float)d;
    int large = 16 + (int)(logf(df / 16.f) / logf(8.f) * 16.f);
    return large < 31 ? large : 31;
}

__device__ __forceinline__ void ph_pre(const KA& a, int tid, int lane, int wave) {
    unsigned char* ws = a.ws;
    const int gw = blockIdx.x * NWAVES + wave, NGW = gridDim.x * NWAVES;
    const int gt = blockIdx.x * 512 + tid, NGT = gridDim.x * 512;
    bf16* hbf = (bf16*)(ws + WS_HBF); float* rstd0 = (float*)(ws + WS_RSTD0);
    for (int row = gw; row < NT; row += NGW) { const float r = row_to_bf16(a.in[0] + (size_t)row * DM, hbf + (size_t)row * DM, ws + WS_H8 + (size_t)row * DM, lane); if (lane == 0) rstd0[row] = r; }
    bf16* membf = (bf16*)(ws + WS_MEMBF); float* rstdm = (float*)(ws + WS_RSTDM);
    for (int row = gw; row < NB * MEML; row += NGW) { const float r = row_to_bf16(a.in[1] + (size_t)row * DM, membf + (size_t)row * DM, nullptr, lane); if (lane == 0) rstdm[row] = r; }
    float* rope = (float*)(ws + WS_ROPE);
    for (int i = gt; i < SEQ * 32; i += NGT) { const int pos = i >> 5, k = i & 31; const float inv = powf(10000.f, -(float)k / 32.f); const float ang = (float)pos * inv; rope[2 * i] = cosf(ang); rope[2 * i + 1] = sinf(ang); }
    float* tabd = (float*)(ws + WS_TABD);
    for (int i = gt; i < 8 * 132; i += NGT) { const int h = i / 132, d = i % 132; tabd[i] = (d <= 128) ? a.in[15][t5_bucket(d) * 8 + h] * LOG2E : 0.f; }
}

struct Src { const float* p; int ld; };
__device__ __forceinline__ Src conv_src(const KA& a, int l, int mat, int sub, int d) {
    Src s; s.p = nullptr; s.ld = 0;
    switch (mat) {
    case 0: { int c;
        if (d < 3072) c = d; else if (d < 3840) c = 3080 + (d - 3072); else if (d < 4352) c = 3848 + (d - 3840);
        else if (d < 4416) { const int j = d - 4352, i = j >> 1; c = 4360 + ((j & 1) ? 32 + i : i); }
        else if (d < 7872) c = 4424 + (d - 4416); else if (d < 14016) c = 7904 + (d - 7872);
        else if (d < 14024) c = 3072 + (d - 14016); else if (d < 14048) c = 7880 + (d - 14024); else c = -1;
        if (c >= 0) { s.p = a.in[3] + (size_t)l * DM * D_IN + c; s.ld = D_IN; } break; }
    case 1: { const int hd = d / 192, w = d % 192; int c = d; if (w >= 128) { const int j = w - 128, i = j >> 1; c = hd * 192 + 128 + ((j & 1) ? 32 + i : i); }
        s.p = a.in[7] + (size_t)l * 768 * 1536 + c; s.ld = 1536; break; }
    case 2: s.p = a.in[8] + (size_t)l * 512 * 2048 + d; s.ld = 2048; break;
    case 3: s.p = a.in[11] + (size_t)l * 6144 * 192 + d; s.ld = 192; break;
    case 4: s.p = a.in[12] + (size_t)l * 192 * 192 + d; s.ld = 192; break;
    case 5: s.p = a.in[13] + (size_t)l * 4096 * 128 + d; s.ld = 128; break;
    case 6: s.p = a.in[14] + (size_t)l * 128 * 128 + d; s.ld = 128; break;
    case 7: s.p = a.in[16] + (size_t)l * 3 * 1024 * 2048 + d; s.ld = 2048; break;
    case 8: s.p = a.in[17] + (size_t)l * 2048 * 2048 + d; s.ld = 2048; break;
    case 9: s.p = a.in[20] + (size_t)l * 2048 * 512 + d; s.ld = 512; break;
    case 10: s.p = a.in[21] + (size_t)l * 2048 * 1024 + d; s.ld = 1024; break;
    case 11: s.p = a.in[22] + (size_t)l * 512 * 2048 + d; s.ld = 2048; break;
    case 12: if (d < 4) { s.p = a.in[24] + (size_t)l * 2048 * 4 + d; s.ld = 4; } else if (d < 36) { s.p = a.in[26] + (size_t)l * 2048 * 32 + (d - 4); s.ld = 32; } break;
    case 13: { const int j = d >> 8, w = d & 255; const float* base = (w < 128 ? a.in[28] : a.in[29]) + ((size_t)l * NEXP + sub) * 2048 * 1024;
        s.p = base + j * 128 + (w & 127); s.ld = 1024; break; }
    default: s.p = a.in[30] + ((size_t)l * NEXP + sub) * 1024 * 2048 + d; s.ld = 2048; break;
    }
    return s;
}
__device__ __forceinline__ void conv_item(const KA& a, int l, int mt, int sub, const float* gain, int K, bf16* dst, int kb, int nb, LAS float* scr, int lane) {
    const int q = lane & 7, kr = lane >> 3, k0 = kb * 64, d0 = nb * 32 + 4 * q;
    const Src s0 = conv_src(a, l, mt, sub, d0), s3 = conv_src(a, l, mt, sub, d0 + 3);
    if ((s0.p == nullptr && s3.p == nullptr) || (s0.p != nullptr && s3.p == s0.p + 3)) {
        f32x4 v[8];
#pragma unroll
        for (int i = 0; i < 8; ++i) v[i] = s0.p ? *(const f32x4*)(s0.p + (size_t)(k0 + kr + 8 * i) * s0.ld) : (f32x4){0.f, 0.f, 0.f, 0.f};
#pragma unroll
        for (int i = 0; i < 8; ++i) { const float gq = gain ? gain[k0 + kr + 8 * i] : 1.f; LAS float* w = scr + (kr + 8 * i) * 33 + 4 * q;
            w[0] = v[i][0] * gq; w[1] = v[i][1] * gq; w[2] = v[i][2] * gq; w[3] = v[i][3] * gq; }
    } else {
        const Src s1 = conv_src(a, l, mt, sub, d0 + 1), s2 = conv_src(a, l, mt, sub, d0 + 2);
#pragma unroll 4
        for (int i = 0; i < 8; ++i) { const int k = k0 + kr + 8 * i; const float gq = gain ? gain[k] : 1.f; LAS float* w = scr + (kr + 8 * i) * 33 + 4 * q;
            w[0] = s0.p ? s0.p[(size_t)k * s0.ld] * gq : 0.f; w[1] = s1.p ? s1.p[(size_t)k * s1.ld] * gq : 0.f;
            w[2] = s2.p ? s2.p[(size_t)k * s2.ld] * gq : 0.f; w[3] = s3.p ? s3.p[(size_t)k * s3.ld] * gq : 0.f; }
    }
    LDS_WAIT(); asm volatile("" ::: "memory");
    const int c = lane & 7;
#pragma unroll
    for (int j = 0; j < 4; ++j) { const int nn = (lane >> 3) + 8 * j; const LAS float* qv = scr + (8 * c) * 33 + nn;
        u32x4 o; o.x = cvt_pk_bf16(qv[0 * 33], qv[1 * 33]); o.y = cvt_pk_bf16(qv[2 * 33], qv[3 * 33]); o.z = cvt_pk_bf16(qv[4 * 33], qv[5 * 33]); o.w = cvt_pk_bf16(qv[6 * 33], qv[7 * 33]);
        if (F8_OUT && mt == 8) { u32x2 o8; o8.x = pk4_fp8(qv[0 * 33] * 64.f, qv[1 * 33] * 64.f, qv[2 * 33] * 64.f, qv[3 * 33] * 64.f);
            o8.y = pk4_fp8(qv[4 * 33] * 64.f, qv[5 * 33] * 64.f, qv[6 * 33] * 64.f, qv[7 * 33] * 64.f);
            *(u32x2*)((unsigned char*)dst + (size_t)(nb * 32 + nn) * K + k0 + 8 * c) = o8; }
        else *(u32x4*)(dst + (size_t)(nb * 32 + nn) * K + k0 + 8 * c) = o;
        if (mt == 0) { const int d8 = nb * 32 + nn - F8_T0 * 256;
            if (d8 >= 0 && d8 < F8_NT * 256) { u32x2 o8; o8.x = pk4_fp8(qv[0 * 33] * 64.f, qv[1 * 33] * 64.f, qv[2 * 33] * 64.f, qv[3 * 33] * 64.f);
                o8.y = pk4_fp8(qv[4 * 33] * 64.f, qv[5 * 33] * 64.f, qv[6 * 33] * 64.f, qv[7 * 33] * 64.f);
                *(u32x2*)(a.ws + WS_WG8 + (size_t)d8 * DM + k0 + 8 * c) = o8; } } }
    LDS_WAIT(); asm volatile("" ::: "memory");
}
__device__ __forceinline__ void conv_load(const KA& a, int l, int mt, int sub, int kb, int nb, int lane, f32x4 (&v)[8]) {
    const int q = lane & 7, kr = lane >> 3, k0 = kb * 64; const Src s0 = conv_src(a, l, mt, sub, nb * 32 + 4 * q);
#pragma unroll
    for (int i = 0; i < 8; ++i) v[i] = *(const f32x4*)(s0.p + (size_t)(k0 + kr + 8 * i) * s0.ld);
}
__device__ __forceinline__ void conv_store(const f32x4 (&v)[8], const float* gain, int K, bf16* dst, int kb, int nb, LAS float* scr, int lane) {
    const int q = lane & 7, kr = lane >> 3, k0 = kb * 64;
#pragma unroll
    for (int i = 0; i < 8; ++i) { const float gq = gain ? gain[k0 + kr + 8 * i] : 1.f; LAS float* w = scr + (kr + 8 * i) * 33 + 4 * q;
        w[0] = v[i][0] * gq; w[1] = v[i][1] * gq; w[2] = v[i][2] * gq; w[3] = v[i][3] * gq; }
    LDS_WAIT(); asm volatile("" ::: "memory");
    const int c = lane & 7;
#pragma unroll
    for (int j = 0; j < 4; ++j) { const int nn = (lane >> 3) + 8 * j; const LAS float* qv = scr + (8 * c) * 33 + nn;
        u32x4 o; o.x = cvt_pk_bf16(qv[0 * 33], qv[1 * 33]); o.y = cvt_pk_bf16(qv[2 * 33], qv[3 * 33]); o.z = cvt_pk_bf16(qv[4 * 33], qv[5 * 33]); o.w = cvt_pk_bf16(qv[6 * 33], qv[7 * 33]);
        *(u32x4*)(dst + (size_t)(nb * 32 + nn) * K + k0 + 8 * c) = o; }
    LDS_WAIT(); asm volatile("" ::: "memory");
}
__device__ __forceinline__ void ph_conv(const KA& a, int l, LAS unsigned char* lds, int tid, int lane, int wave, int mt_lo, int mt_hi, int vb, int VG) {
    unsigned char* ws = a.ws;
    LAS float* scr = (LAS float*)(lds + wave * 16384);
    const int gw = vb * NWAVES + wave, NGW = VG * NWAVES;
    constexpr int NM = 15;
    static constexpr int mK[NM]   = {2048, 768, 512, 6144, 192, 4096, 128, 3072, 2048, 2048, 2048, 512, 2048, 2048, 1024};
    static constexpr int mN[NM]   = {ZLD, 1536, 2048, 192, 192, 128, 128, 2048, 2048, 512, 1024, 2048, 256, 2048, 2048};
    static constexpr int mS[NM]   = {1, 1, 1, 1, 1, 1, 1, 1, 1, 1, 1, 1, 1, NEXP, NEXP};
    static constexpr int mG[NM]   = {2, 5, 6, -1, -1, -1, -1, -1, -1, 18, 19, -1, 23, 23, -1};
    static constexpr size_t mD[NM] = {WS_WIN, WS_WUQ, WS_WUKV, WS_WCK1, WS_WCK2, WS_WCV1, WS_WCV2, WS_WBR, WS_WOUT, WS_WMQ, WS_WMKV, WS_WMO, WS_WR, WS_WGU, WS_WD};
    int base = 0;
#pragma unroll 1
    for (int mt = mt_lo; mt < mt_hi; ++mt) {
        const int K = mK[mt], nkb = K / 64, nnb = mN[mt] / 32, per = nkb * nnb, tot = per * mS[mt];
        const float* gain = mG[mt] >= 0 ? a.in[mG[mt]] + (size_t)l * K : nullptr;
        int first = gw - (base % NGW); if (first < 0) first += NGW;
        if (mt >= 13) {
            const int nnb2 = nnb / 2, per2 = nkb * nnb2, tot2 = per2 * mS[mt];
            int first2 = gw - ((base / 2) % NGW); if (first2 < 0) first2 += NGW;
            f32x4 vn0[8], vn1[8]; int r = first2;
            if (r < tot2) { const int sub = r / per2, q = r % per2; conv_load(a, l, mt, sub, q / nnb2, 2 * (q % nnb2), lane, vn0); conv_load(a, l, mt, sub, q / nnb2, 2 * (q % nnb2) + 1, lane, vn1); }
#pragma unroll 1
            for (; r < tot2; r += NGW) {
                f32x4 v0[8], v1[8];
#pragma unroll
                for (int i = 0; i < 8; ++i) { v0[i] = vn0[i]; v1[i] = vn1[i]; }
                const int rn = r + NGW;
                if (rn < tot2) { const int sub = rn / per2, q = rn % per2; conv_load(a, l, mt, sub, q / nnb2, 2 * (q % nnb2), lane, vn0); conv_load(a, l, mt, sub, q / nnb2, 2 * (q % nnb2) + 1, lane, vn1); }
                const int sub = r / per2, q = r % per2; bf16* dp = (bf16*)(ws + mD[mt]) + (size_t)sub * mN[mt] * K;
                conv_store(v0, gain, K, dp, q / nnb2, 2 * (q % nnb2), scr, lane);
                conv_store(v1, gain, K, dp, q / nnb2, 2 * (q % nnb2) + 1, scr, lane);
            }
        } else {
#pragma unroll 1
            for (int r = first; r < tot; r += NGW) {
                const int sub = r / per, q = r % per, kb = q / nnb, nb = q % nnb;
                conv_item(a, l, mt, sub, gain, K, (bf16*)(ws + mD[mt]) + (size_t)sub * mN[mt] * K, kb, nb, scr, lane);
            }
        }
        base += tot;
    }
    if (mt_lo != 0) return;
    float* c1p = (float*)(ws + WS_C1P);
    const int gt = vb * 512 + tid, NGT = VG * 512;
    for (int i = gt; i < 96 * 192 + 64 * 128; i += NGT) {
        float s = 0.f;
        if (i < 96 * 192) { const int ch = i / 192, n = i % 192; const float* pe = a.in[9] + (size_t)l * 6144 + ch * 64; const float* w = a.in[11] + (size_t)l * 6144 * 192 + (size_t)ch * 64 * 192 + n;
            for (int k = 0; k < 64; ++k) s += pe[k] * w[(size_t)k * 192]; }
        else { const int j = i - 96 * 192, ch = j / 128, n = j % 128; const float* pe = a.in[10] + (size_t)l * 4096 + ch * 64; const float* w = a.in[13] + (size_t)l * 4096 * 128 + (size_t)ch * 64 * 128 + n;
            for (int k = 0; k < 64; ++k) s += pe[k] * w[(size_t)k * 128]; }
        c1p[i] = s;
    }
    float* brt = (float*)(ws + WS_BRT) + 64 * l;
    if (gt < 64) brt[gt] = gt < 4 ? a.in[25][l * 4 + gt] : (gt < 36 ? a.in[27][l * 32 + gt - 4] : 0.f);
}

constexpr int MOE_ITEMS_GU = NEXP * 32 * 64, MOE_ITEMS_D = NEXP * 16 * 64, MOE_ITEMS = MOE_ITEMS_GU + MOE_ITEMS_D;
struct MoeItem { const float* src; int ld; unsigned char* dst; int K; const float* gain; bool f8; };
__device__ __forceinline__ MoeItem moe_item(const KA& a, int l, int it, int lane) {
    const int q = lane & 7, kq = lane >> 3; MoeItem m;
    if (it < MOE_ITEMS_GU) { const int e = it >> 11, r = it & 2047, kb = r >> 6, nb = r & 63, d = nb * 32 + 4 * q, j = d >> 8, w = d & 255;
        const float* base = (w < 128 ? a.in[28] : a.in[29]) + ((size_t)l * NEXP + e) * 2048 * 1024;
        m.src = base + (size_t)(kb * 64 + 8 * kq) * 1024 + j * 128 + (w & 127); m.ld = 1024; m.K = 2048;
        m.f8 = F8_GU; m.dst = a.ws + WS_WGU + (((size_t)e * 2048 + d) * 2048 + kb * 64 + 8 * kq) * (F8_GU ? 1 : 2); m.gain = a.in[23] + (size_t)l * 2048 + kb * 64 + 8 * kq; }
    else { const int t = it - MOE_ITEMS_GU, e = t >> 10, r = t & 1023, kb = r >> 6, nb = r & 63, d = nb * 32 + 4 * q;
        m.src = a.in[30] + ((size_t)l * NEXP + e) * 1024 * 2048 + (size_t)(kb * 64 + 8 * kq) * 2048 + d; m.ld = 2048; m.K = 1024;
        m.f8 = F8_DN; m.dst = a.ws + WS_WD + (((size_t)e * 2048 + d) * 1024 + kb * 64 + 8 * kq) * (F8_DN ? 1 : 2); m.gain = nullptr; }
    return m;
}
__device__ __forceinline__ void moe_load(const MoeItem& m, f32x4 (&v)[8], f32x4 (&g)[2]) {
#pragma unroll
    for (int i = 0; i < 8; ++i) v[i] = __builtin_nontemporal_load((const f32x4*)(m.src + (size_t)i * m.ld));
    g[0] = (f32x4){1.f, 1.f, 1.f, 1.f}; g[1] = g[0];
    if (m.gain) { g[0] = *(const f32x4*)m.gain; g[1] = *(const f32x4*)(m.gain + 4); }
}
__device__ __forceinline__ void moe_store(const MoeItem& m, const f32x4 (&v)[8], const f32x4 (&g)[2]) {
    const f32x4 g0 = g[0], g1 = g[1];
    if (m.f8) {
#pragma unroll
        for (int j = 0; j < 4; ++j) { u32x2 o; o.x = pk4_fp8(v[0][j] * g0[0] * 64.f, v[1][j] * g0[1] * 64.f, v[2][j] * g0[2] * 64.f, v[3][j] * g0[3] * 64.f);
            o.y = pk4_fp8(v[4][j] * g1[0] * 64.f, v[5][j] * g1[1] * 64.f, v[6][j] * g1[2] * 64.f, v[7][j] * g1[3] * 64.f);
            __builtin_nontemporal_store(o, (u32x2*)(m.dst + (size_t)j * m.K)); }
    } else {
#pragma unroll
        for (int j = 0; j < 4; ++j) { u32x4 o; o.x = cvt_pk_bf16(v[0][j] * g0[0], v[1][j] * g0[1]); o.y = cvt_pk_bf16(v[2][j] * g0[2], v[3][j] * g0[3]);
            o.z = cvt_pk_bf16(v[4][j] * g1[0], v[5][j] * g1[1]); o.w = cvt_pk_bf16(v[6][j] * g1[2], v[7][j] * g1[3]);
            __builtin_nontemporal_store(o, (u32x4*)(m.dst + (size_t)j * m.K * 2)); }
    }
}
__device__ __forceinline__ void moe_convert(const KA& a, int l, int gw, int NGW, int n0, int n1, int lane) {
#pragma unroll 1
    for (int n = n0; n < n1; n += 4) {
        const int i0 = gw + n * NGW;
        if (i0 >= MOE_ITEMS) break;
        const bool h1 = (n + 1 < n1) && (i0 + NGW < MOE_ITEMS), h2 = (n + 2 < n1) && (i0 + 2 * NGW < MOE_ITEMS), h3 = (n + 3 < n1) && (i0 + 3 * NGW < MOE_ITEMS);
        const MoeItem m0 = moe_item(a, l, i0, lane), m1 = moe_item(a, l, h1 ? i0 + NGW : i0, lane), m2 = moe_item(a, l, h2 ? i0 + 2 * NGW : i0, lane), m3 = moe_item(a, l, h3 ? i0 + 3 * NGW : i0, lane);
        f32x4 v0[8], v1[8], v2[8], v3[8], g0[2], g1[2], g2[2], g3[2];
        moe_load(m0, v0, g0); moe_load(m1, v1, g1); moe_load(m2, v2, g2); moe_load(m3, v3, g3);
        moe_store(m0, v0, g0); if (h1) moe_store(m1, v1, g1); if (h2) moe_store(m2, v2, g2); if (h3) moe_store(m3, v3, g3);
    }
}
__device__ __forceinline__ int q_next(gu32* q, LAS int* slot, int tid) {
    LDS_WAIT(); __syncthreads();
    if (tid == 0) *slot = (int)atomicAdd((unsigned*)q, 1u);
    LDS_WAIT(); __syncthreads();
    return __builtin_amdgcn_readfirstlane(*slot);
}
struct MoeConvHook {
    const KA* a; int l, gw, NGW, per, g;
    __device__ __forceinline__ void run(int ui) const {
        if (((ui ^ g) & 3) == 0) { const int k = ui >> 2; moe_convert(*a, l, gw, NGW, k * per, (k + 1) * per, llane()); asm volatile("s_waitcnt vmcnt(0)" ::: "memory"); }
    }
};

__device__ __forceinline__ void cumsum_item(int it, const float* zs, const float* bf, float* kb, int lane) {
    const int b = it >> 3, h = it & 7; const float bias = bf[h];
    float v[32]; float run = 0.f;
#pragma unroll
    for (int i = 0; i < 32; ++i) { const float x = zs[(size_t)(b * SEQ + lane * 32 + i) * 32 + h] + bias; const float ls = fminf(x, 0.f) - log1pf(__expf(-fabsf(x))); run += ls; v[i] = run; }
    float incl = run;
#pragma unroll
    for (int o = 1; o < 64; o <<= 1) { const float y = __int_as_float(__builtin_amdgcn_ds_bpermute(((lane - o) & 63) << 2, __float_as_int(incl))); if (lane >= o) incl += y; }
    const float excl = incl - run;
    float* dst = kb + (size_t)it * SEQ + lane * 32;
#pragma unroll
    for (int i = 0; i < 32; ++i) dst[i] = -(excl + v[i]) * LOG2E;
}

__device__ __forceinline__ float gelu_tanh(float x) { return 0.5f * x * (1.f + tanhf(0.7978845608028654f * (x + 0.044715f * x * x * x))); }
template <int DD>
__device__ __forceinline__ void compress_body(int b, int g, int ct, const bf16* zsrc  , const bf16* w1t, const bf16* w2t,
                                              const float* c1p, int nchunk, bf16* out, LAS unsigned char* lds, int tid, unsigned* dbgw) {
    constexpr int KD = 32 * DD, NCB = DD / 64, KH = KD / 2, NST = KH / 32, HP = DD + 8;
    const int lane = tid & 63, w = tid >> 6, cg = w & 3, kh = w >> 2, lr = lane & 15, kg = lane >> 4;
    LAS float* red = (LAS float*)lds;
    LAS float* c1s = (LAS float*)(lds + 32 * DD * 4);
    LAS bf16* hid = (LAS bf16*)(lds + 32 * DD * 4 + DD * 4);
    {
        constexpr int P = 512 / DD; const int part = tid / DD, col = tid - part * DD; float s = 0.f;
        if (part < P) {
#pragma unroll 1
            for (int c0 = part; c0 < nchunk; c0 += 8 * P) { float v[8];
#pragma unroll
                for (int j = 0; j < 8; ++j) v[j] = (c0 + j * P < nchunk) ? c1p[(c0 + j * P) * DD + col] : 0.f;
#pragma unroll
                for (int j = 0; j < 8; ++j) s += v[j]; }
            red[part * DD + col] = s;
        }
        LDS_WAIT(); __syncthreads();
        if (tid < DD) { float t = 0.f;
#pragma unroll
            for (int pp = 0; pp < P; ++pp) t += red[pp * DD + tid];
            c1s[tid] = t; }
        LDS_WAIT(); __syncthreads();
    }
    const bf16* abase[2];
#pragma unroll
    for (int rb = 0; rb < 2; ++rb) { int c = 32 * ct + 16 * rb + lr; c = c < 126 ? c : 126; abase[rb] = zsrc + (size_t)(b * SEQ + 16 * c) * ZLD + g * DD + 16 * kg; }
    const bf16* bbase = w1t + (size_t)(16 * cg * NCB + lr) * KD + 16 * kg;
    f32x4 acc[2][NCB];
#pragma unroll
    for (int rb = 0; rb < 2; ++rb)
#pragma unroll
        for (int cb = 0; cb < NCB; ++cb) acc[rb][cb] = (f32x4){0.f, 0.f, 0.f, 0.f};
    static_assert(NST % 8 == 0, "compress k-steps");
#define CMP_LOAD(AF, BF, S4) do { _Pragma("unroll") for (int q = 0; q < 4; ++q) { const int k0 = kh * KH + 64 * (((S4) + q) >> 1) + 8 * (((S4) + q) & 1), lrow = k0 / DD, dcol = k0 % DD; \
        _Pragma("unroll") for (int rb = 0; rb < 2; ++rb) AF[q][rb] = *(const bf16x8*)(abase[rb] + (size_t)lrow * ZLD + dcol); \
        _Pragma("unroll") for (int cb = 0; cb < NCB; ++cb) BF[q][cb] = *(const bf16x8*)(bbase + (size_t)(16 * cb) * KD + k0); } } while (0)
#define CMP_MMA(AF, BF) do { _Pragma("unroll") for (int q = 0; q < 4; ++q) _Pragma("unroll") for (int rb = 0; rb < 2; ++rb) _Pragma("unroll") for (int cb = 0; cb < NCB; ++cb) \
        acc[rb][cb] = __builtin_amdgcn_mfma_f32_16x16x32_bf16(AF[q][rb], BF[q][cb], acc[rb][cb], 0, 0, 0); } while (0)
    {
        bf16x8 afA[4][2], bfA[4][NCB], afB[4][2], bfB[4][NCB];
        CMP_LOAD(afA, bfA, 0);
#pragma unroll 1
        for (int s4 = 0; s4 < NST; s4 += 8) {
            CMP_LOAD(afB, bfB, s4 + 4);
            CMP_MMA(afA, bfA);
            if (s4 + 8 < NST) CMP_LOAD(afA, bfA, s4 + 8);
            CMP_MMA(afB, bfB);
        }
    }
#undef CMP_LOAD
#undef CMP_MMA
    if (kh == 1) {
#pragma unroll
        for (int rb = 0; rb < 2; ++rb)
#pragma unroll
            for (int cb = 0; cb < NCB; ++cb)
#pragma unroll
                for (int r = 0; r < 4; ++r) red[(16 * rb + 4 * kg + r) * DD + 16 * (cg * NCB + cb) + lr] = acc[rb][cb][r];
    }
    LDS_WAIT(); __syncthreads();
    if (kh == 0) {
#pragma unroll
        for (int rb = 0; rb < 2; ++rb)
#pragma unroll
            for (int cb = 0; cb < NCB; ++cb)
#pragma unroll
                for (int r = 0; r < 4; ++r) { const int row = 16 * rb + 4 * kg + r, col = 16 * (cg * NCB + cb) + lr;
                    const float x = acc[rb][cb][r] + red[row * DD + col] + c1s[col]; hid[row * HP + col] = f2bf(gelu_tanh(x));
                    }
    }
    LDS_WAIT(); __syncthreads();
#if defined(COMPRESS_S2_SCALAR)
    for (int o = tid; o < 32 * DD; o += 512) { const int row = o / DD, col = o % DD; float s2 = 0.f; const bf16* wr = w2t + (size_t)col * DD;
        for (int j = 0; j < DD; ++j) s2 += bf2f(hid[row * HP + j]) * bf2f(wr[j]);
        const int c = 32 * ct + row; out[((size_t)(b * 2 + g) * 128 + c) * DD + col] = c < 127 ? f2bf(s2) : (bf16)0; }
#else
    constexpr int NBLK = 2 * (DD / 16);
    for (int blk = w; blk < NBLK; blk += 8) {
        const int rb = blk & 1, cb = blk >> 1;
        f32x4 c4 = (f32x4){0.f, 0.f, 0.f, 0.f};
#pragma unroll
        for (int s = 0; s < DD / 32; ++s) {
            const bf16x8 af = *(const LAS bf16x8*)(hid + (16 * rb + lr) * HP + 32 * s + 8 * kg);
            const bf16x8 bfr = *(const bf16x8*)(w2t + (size_t)(16 * cb + lr) * DD + 32 * s + 8 * kg);
            c4 = __builtin_amdgcn_mfma_f32_16x16x32_bf16(af, bfr, c4, 0, 0, 0);
            asm volatile("" :: "v"(af), "v"(bfr));
        }
#pragma unroll
        for (int r = 0; r < 4; ++r) { const int c = 32 * ct + 16 * rb + 4 * kg + r; out[((size_t)(b * 2 + g) * 128 + c) * DD + 16 * cb + lr] = c < 127 ? f2bf(c4[r]) : (bf16)0; }
    }
#endif
    LDS_WAIT(); __syncthreads();
}

template <int DD>
__device__ __forceinline__ void compress_ref(int b, int g, int c, const bf16* zsrc, const bf16* w1t, const bf16* w2t, const float* c1p, int nchunk, bf16* out, LAS unsigned char* lds, int tid) {
    constexpr int KD = 32 * DD;
    LAS float* hid = (LAS float*)lds;
    if (tid < DD) {
        float s = 0.f; for (int ch = 0; ch < nchunk; ++ch) s += c1p[ch * DD + tid];
        const bf16* wr = w1t + (size_t)tid * KD;
        for (int l = 0; l < 32; ++l) { const bf16* zr = zsrc + (size_t)(b * SEQ + 16 * c + l) * ZLD + g * DD;
            for (int d = 0; d < DD; d += 8) { const u32x4 zv = *(const u32x4*)(zr + d), wv = *(const u32x4*)(wr + l * DD + d);
                s += bflo(zv.x) * bflo(wv.x) + bfhi(zv.x) * bfhi(wv.x) + bflo(zv.y) * bflo(wv.y) + bfhi(zv.y) * bfhi(wv.y) + bflo(zv.z) * bflo(wv.z) + bfhi(zv.z) * bfhi(wv.z) + bflo(zv.w) * bflo(wv.w) + bfhi(zv.w) * bfhi(wv.w); } }
        hid[tid] = bf2f(f2bf(gelu_tanh(s)));
    }
    LDS_WAIT(); __syncthreads();
    if (tid < DD) { float s = 0.f; const bf16* wr = w2t + (size_t)tid * DD; for (int j = 0; j < DD; ++j) s += hid[j] * bf2f(wr[j]); out[((size_t)(b * 2 + g) * 128 + c) * DD + tid] = f2bf(s); }
    LDS_WAIT(); __syncthreads();
}

constexpr float CS128 = 0.08838834764831845f * LOG2E, CS192 = 0.07216878364870323f * LOG2E;
constexpr int WBIG = 1 << 30;

__device__ __forceinline__ void fox_sub(int b, int h, int qt, const bf16* z, const float* kb, bf16* ofox, LAS unsigned char* lds, int tid) {
    const int lane = tid & 63, w = tid >> 6, tw0 = 256 * qt + 32 * w, t = tw0 + (lane & 31); const size_t row = (size_t)b * SEQ + t;
    bf16x8 qf[8]; att::load_q<128>(qf, z + row * ZLD + ZC_FQ + h * 128, lane);
    LAS float* kbl = (LAS float*)(lds + att::KB_OFF);
    if (tid * 4 < 256 * (qt + 1)) *(LAS f32x4*)(kbl + tid * 4) = *(const f32x4*)(kb + (size_t)(b * 8 + h) * SEQ + tid * 4);
    att::State st; att::state_init(st);
    att::attn_run<128, true, true, false, false>(lds, z + (size_t)b * SEQ * ZLD + ZC_FK + h * 128, ZLD, z + (size_t)b * SEQ * ZLD + ZC_FV + h * 128, ZLD, 0, 4 * (qt + 1),
                                                 qf, t, tw0, WBIG, kbl, nullptr, 0u, CS128, st, tid);
    att::store_o<0>(st, 1.f / st.l, ofox + row * 3072 + h * 128, nullptr, lane);
}
__device__ __forceinline__ void mla_sub(int b, int h, int qt, const bf16* qm, const bf16* km, const bf16* vm, bf16* omla, LAS unsigned char* lds, int tid) {
    const int lane = tid & 63, w = tid >> 6, tw0 = 256 * qt + 32 * w, t = tw0 + (lane & 31); const size_t row = (size_t)b * SEQ + t;
    bf16x8 qf[12]; att::load_q<192>(qf, qm + row * 1536 + h * 192, lane);
    att::State st; att::state_init(st);
    att::attn_run<192, true, false, false, false>(lds, km + (size_t)b * SEQ * 1536 + h * 192, 1536, vm + (size_t)b * SEQ * 1024 + h * 128, 1024, 0, 4 * (qt + 1),
                                                  qf, t, tw0, WBIG, nullptr, nullptr, 0u, CS192, st, tid);
    att::store_o<0>(st, 1.f / st.l, omla + row * 3072 + h * 128, nullptr, lane);
}
__device__ __forceinline__ void mem_unit(int uid, const bf16* qmem, const bf16* kvmem, bf16* omem, LAS unsigned char* lds, int tid) {
    const int b = uid >> 5, h = (uid >> 3) & 3, qt = uid & 7;
    const int lane = tid & 63, w = tid >> 6, tw0 = 256 * qt + 32 * w, t = tw0 + (lane & 31); const size_t row = (size_t)b * SEQ + t;
    bf16x8 qf[8]; att::load_q<128>(qf, qmem + row * 512 + h * 128, lane);
    att::State st; att::state_init(st);
    att::attn_run<128, false, false, false, false>(lds, kvmem + (size_t)b * MEML * 1024 + h * 128, 1024, kvmem + (size_t)b * MEML * 1024 + 512 + h * 128, 1024, 0, 4,
                                                   qf, t, tw0, WBIG, nullptr, nullptr, 0u, CS128, st, tid);
    att::store_o<0>(st, 1.f / st.l, omem + row * 512 + h * 128, nullptr, lane);
}
__device__ __forceinline__ void nsa_tabs(const float* tabd, int g, LAS unsigned char* lds, int tid) {
    LAS float* tab = (LAS float*)(lds + att::TAB_OFF);
    for (int i = tid; i < 4 * 132; i += 512) tab[i] = tabd[g * 4 * 132 + i];
    LDS_WAIT(); __syncthreads();
}
__device__ __forceinline__ void nsa_win_unit(int uid, const bf16* z, const float* zs, const float* tabd, bf16* ow, LAS unsigned char* lds, int tid) {
    const int b = uid >> 6, g = (uid >> 5) & 1, qt = uid & 31;
    const int lane = tid & 63, w = tid >> 6, hh = w >> 1, head = g * 4 + hh, tw0 = 64 * qt + 32 * (w & 1), t = tw0 + (lane & 31); const size_t row = (size_t)b * SEQ + t;
    nsa_tabs(tabd, g, lds, tid);
    bf16x8 qf[12]; att::load_q<192>(qf, z + row * ZLD + ZC_NQ + head * 192, lane);
    att::State st; att::state_init(st);
    att::attn_run<192, true, false, true, false>(lds, z + (size_t)b * SEQ * ZLD + ZC_NKW + g * 192, ZLD, z + (size_t)b * SEQ * ZLD + ZC_NVW + g * 128, ZLD, qt >= 8 ? qt - 8 : 0, qt + 1,
                                                 qf, t, tw0, 512, nullptr, (const LAS float*)(lds + att::TAB_OFF) + hh * 132, 0u, CS192, st, tid);
    const float g2 = sigmoidf_(zs[row * 32 + 8 + head * 3 + 2]);
    att::store_o<0>(st, g2 / st.l, ow + row * 1024 + head * 128, nullptr, lane);
}
__device__ __forceinline__ void nsa_cmp_sub(int b, int g, int qt, const bf16* z, const float* zs, const float* tabd, const bf16* kc, const bf16* vc, bf16* ow, unsigned* rmaskg,
                                            LAS unsigned char* lds, int tid) {
    const int lane = tid & 63, w = tid >> 6, hh = w >> 1, head = g * 4 + hh, hf = w & 1, tw0 = 64 * qt + 32 * hf, t = tw0 + (lane & 31), hi = lane >> 5; const size_t row = (size_t)b * SEQ + t;
    const int rowl = 32 * hf + (lane & 31);
    nsa_tabs(tabd, g, lds, tid);
    const LAS float* tab = (const LAS float*)(lds + att::TAB_OFF) + hh * 132;
    {
        const bf16* Kc = kc + (size_t)(b * 2 + g) * 128 * 192; const bf16* Vc = vc + (size_t)(b * 2 + g) * 128 * 128;
        att::dma_tile<192>(lds, Kc, 192, Vc, 128, 0, __builtin_amdgcn_readfirstlane(w), lane);
        att::dma_tile<192>(lds + att::Geo<192>::BUF, Kc, 192, Vc, 128, 1, __builtin_amdgcn_readfirstlane(w), lane);
    }
    VM_WAIT(); LDS_WAIT(); __syncthreads();
    bf16x8 qf[12]; att::load_q<192>(qf, z + row * ZLD + ZC_NQ + head * 192, lane);
    att::State st; att::state_init(st);
    float impm[16], impt[1];
#pragma unroll
    for (int i = 0; i < 16; ++i) impm[i] = 0.f;
    impt[0] = 0.f;
    att::tile_compute<192, true, false, true, false, true, 0>(lds, 0, qf, t, tw0, 0x7fffffff, nullptr, tab, 0u, CS192, st, impm, impt, lane);
    att::tile_compute<192, true, false, true, false, true, 1>(lds + att::Geo<192>::BUF, 1, qf, t, tw0, 0x7fffffff, nullptr, tab, 0u, CS192, st, impm, impt, lane);
    LDS_WAIT(); __syncthreads();
    const float inv = st.l > 0.f ? 1.f / st.l : 0.f;
    LAS float* IA = (LAS float*)lds;
#pragma unroll
    for (int i = 0; i < 16; ++i) { const int n = 16 * (i >> 3) + 8 * ((i >> 2) & 1) + 2 * (i & 3) + hi; IA[(hh * 64 + rowl) * 33 + n] = impm[i] * inv; }
    const float g0 = sigmoidf_(zs[row * 32 + 8 + head * 3 + 0]);
    att::store_o<1>(st, g0 * inv, ow + row * 1024 + head * 128, nullptr, lane);
    LDS_WAIT(); __syncthreads();
    {
        const int cur = qt, n = lane & 31;
#pragma unroll 1
        for (int ps = 0; ps < 4; ++ps) {
            const int r = w * 8 + ps * 2 + (lane >> 5);
            float imp = 0.f;
#pragma unroll
            for (int q = 0; q < 4; ++q) imp += IA[(q * 64 + r) * 33 + n];
            unsigned mask;
            if (cur < 8) mask = (2u << cur) - 1u;
            else {
                mask = 1u | (1u << cur) | (1u << (cur - 1));
                float val = (n >= 1 && n <= cur - 2) ? imp : -1.f;
#pragma unroll 1
                for (int k = 0; k < 5; ++k) {
                    float vm = val;
#pragma unroll
                    for (int o = 1; o < 32; o <<= 1) vm = fmaxf(vm, shx(vm, o, lane));
                    const unsigned long long bal = __ballot(val == vm && val >= 0.f);
                    const unsigned hm = (unsigned)(bal >> (lane & 32));
                    const int best = __ffs(hm) - 1;
                    mask |= 1u << best; if (n == best) val = -1.f;
                }
            }
            if (n == 0) rmaskg[(size_t)(b * 2 + g) * SEQ + 64 * qt + r] = mask;
        }
    }
    VM_WAIT(); LDS_WAIT(); __syncthreads();
}
__device__ __forceinline__ void nsa_sel_sub(int b, int g, int qt, const bf16* z, const float* zs, const float* tabd, const bf16* ow, const unsigned* rmaskg, bf16* onsa,
                                            LAS unsigned char* lds, int tid) {
    const int lane = tid & 63, w = tid >> 6, hh = w >> 1, head = g * 4 + hh, hf = w & 1, tw0 = 64 * qt + 32 * hf, t = tw0 + (lane & 31); const size_t row = (size_t)b * SEQ + t;
    nsa_tabs(tabd, g, lds, tid);
    const LAS float* tab = (const LAS float*)(lds + att::TAB_OFF) + hh * 132;
    bf16x8 qf[12]; att::load_q<192>(qf, z + row * ZLD + ZC_NQ + head * 192, lane);
    const unsigned rowmask = rmaskg[(size_t)(b * 2 + g) * SEQ + t];
    att::State st; att::state_init(st);
    att::attn_run<192, true, false, true, true>(lds, z + (size_t)b * SEQ * ZLD + ZC_NKS + g * 192, ZLD, z + (size_t)b * SEQ * ZLD + ZC_NVS + g * 128, ZLD, 0, qt + 1,
                                                qf, t, tw0, WBIG, nullptr, tab, rowmask, CS192, st, tid);
    const float g1 = sigmoidf_(zs[row * 32 + 8 + head * 3 + 1]);
    att::store_o<2>(st, g1 / st.l, onsa + row * 3072 + head * 128, ow + row * 1024 + head * 128, lane);
}

__device__ __forceinline__ void ph_route1(const float* plog, const float* hssq, const float* bias, float* rstd2, unsigned* cnt, int* asge, int* asgi, float* asgw, int tid) {
    for (int t = blockIdx.x * 512 + tid; t < NT; t += gridDim.x * 512) {
        float ss = 0.f;
#pragma unroll
        for (int j = 0; j < 8; ++j) { const f32x4 p = *(const f32x4*)(hssq + (size_t)t * 32 + 4 * j); ss += (p[0] + p[1]) + (p[2] + p[3]); }
        const float rs = rsqrtf(ss * (1.f / 2048.f) + EPS); rstd2[t] = rs;
        f32x4 gl = *(const f32x4*)(plog + (size_t)t * 64);
#pragma unroll
        for (int sl = 1; sl < 4; ++sl) gl += *(const f32x4*)(plog + (size_t)sl * NT * 64 + (size_t)t * 64);
        gl = gl * rs + *(const f32x4*)bias;
        int gs = 0; float gm = gl[0];
        if (gl[1] > gm) { gm = gl[1]; gs = 1; } if (gl[2] > gm) { gm = gl[2]; gs = 2; } if (gl[3] > gm) { gm = gl[3]; gs = 3; }
        const float pg = 1.f / (expf(gl[0] - gm) + expf(gl[1] - gm) + expf(gl[2] - gm) + expf(gl[3] - gm));
        f32x4 e0 = *(const f32x4*)(plog + (size_t)t * 64 + 4 + gs * 8), e1 = *(const f32x4*)(plog + (size_t)t * 64 + 8 + gs * 8);
#pragma unroll
        for (int sl = 1; sl < 4; ++sl) { e0 += *(const f32x4*)(plog + (size_t)sl * NT * 64 + (size_t)t * 64 + 4 + gs * 8); e1 += *(const f32x4*)(plog + (size_t)sl * NT * 64 + (size_t)t * 64 + 8 + gs * 8); }
        e0 = e0 * rs + *(const f32x4*)(bias + 4 + gs * 8); e1 = e1 * rs + *(const f32x4*)(bias + 8 + gs * 8);
        float ev[8] = {e0[0], e0[1], e0[2], e0[3], e1[0], e1[1], e1[2], e1[3]};
        int j0 = 0; float v0 = ev[0];
#pragma unroll
        for (int j = 1; j < 8; ++j) if (ev[j] > v0) { v0 = ev[j]; j0 = j; }
        int j1 = -1; float v1 = -3.0e38f;
#pragma unroll
        for (int j = 0; j < 8; ++j) if (j != j0 && ev[j] > v1) { v1 = ev[j]; j1 = j; }
        const float x1 = expf(v1 - v0), w0 = pg / (1.f + x1), w1 = pg * x1 / (1.f + x1);
        const int ea = gs * 8 + j0, eb = gs * 8 + j1;
        asge[2 * t] = ea; asge[2 * t + 1] = eb; asgw[2 * t] = w0; asgw[2 * t + 1] = w1;
        asgi[2 * t] = (int)atomicAdd(cnt + ea, 1u); asgi[2 * t + 1] = (int)atomicAdd(cnt + eb, 1u);
    }
}
__device__ __forceinline__ void ph_route2(const unsigned* cnt, const int* asge, const int* asgi, const float* asgw, const float* rstd2,
                                          int* pos, float* roww, float* rowr, int* tile, int* rowtok, LAS unsigned char* lds, int tid) {
    LAS int* ps = (LAS int*)lds;
    if (tid == 0) { int acc = 0;
#pragma unroll 1
        for (int e = 0; e < NEXP; ++e) { const int c = (int)cnt[e]; ps[e] = acc; ps[64 + e] = c; acc += ((c + 255) >> 8) << 8; } ps[32] = acc; }
    LDS_WAIT(); __syncthreads();
    if (blockIdx.x == 0 && tid == 0) { int rt = 0;
#pragma unroll 1
        for (int e = 0; e < NEXP; ++e) { const int n = (ps[e + 1] - ps[e]) >> 8;
#pragma unroll 1
            for (int i = 0; i < n; ++i) tile[rt++] = e; }
        tile[200] = rt;
#pragma clang loop vectorize(disable) unroll(disable)
        for (; rt < 200; ++rt) tile[rt] = -1; }
    const int gt = blockIdx.x * 512 + tid, NGT = gridDim.x * 512;
    for (int it = gt; it < NT * 2; it += NGT) {
        const int e = asge[it], dest = ps[e] + asgi[it], t = it >> 1;
        roww[dest] = asgw[it]; rowr[dest] = rstd2[t]; pos[it] = dest; rowtok[dest] = t;
    }
    for (int it = gt; it < NEXP * 256; it += NGT) {
        const int e = it >> 8, r = it & 255, c = ps[64 + e], pc = ps[e + 1] - ps[e] - c;
        if (r < pc) { const int dest = ps[e] + c + r; roww[dest] = 0.f; rowr[dest] = 0.f; rowtok[dest] = 0; }
    }
}
__device__ __forceinline__ void ph_combine(const bf16* y, const int* pos, bf16* hbf, unsigned char* h8, float* rstd0, const float* gfin, float* out, bool last, int lane, int wave) {
    const int gw = blockIdx.x * NWAVES + wave, NGW = gridDim.x * NWAVES;
    for (int t = gw; t < NT; t += NGW) {
        const int p0 = pos[2 * t], p1 = pos[2 * t + 1];
        u32x2* hr = (u32x2*)(hbf + (size_t)t * DM) + lane; const u32x2* y0 = (const u32x2*)(y + (size_t)p0 * DM) + lane; const u32x2* y1 = (const u32x2*)(y + (size_t)p1 * DM) + lane;
        f32x4 v[8]; float s = 0.f;
#pragma unroll
        for (int j = 0; j < 8; ++j) { const u32x2 a = y0[64 * j], c = y1[64 * j], hw = hr[64 * j]; f32x4 h;
            h[0] = (bflo(hw.x) + bflo(a.x)) + bflo(c.x); h[1] = (bfhi(hw.x) + bfhi(a.x)) + bfhi(c.x); h[2] = (bflo(hw.y) + bflo(a.y)) + bflo(c.y); h[3] = (bfhi(hw.y) + bfhi(a.y)) + bfhi(c.y);
            v[j] = h; s += dot4v(h); }
        s = wave_sum(s, lane); const float rs = rsqrtf(s * (1.f / 2048.f) + EPS);
        if (!last) {
#pragma unroll
            for (int j = 0; j < 8; ++j) { u32x2 w; w.x = cvt_pk_bf16(v[j][0], v[j][1]); w.y = cvt_pk_bf16(v[j][2], v[j][3]); hr[64 * j] = w; }
#pragma unroll
            for (int j = 0; j < 8; ++j) ((unsigned*)(h8 + (size_t)t * DM))[lane + 64 * j] = pk4_fp8(v[j][0], v[j][1], v[j][2], v[j][3]);
            if (lane == 0) rstd0[t] = rs;
        } else {
            f32x4* orow = (f32x4*)(out + (size_t)t * DM) + lane; const f32x4* gr = (const f32x4*)gfin + lane;
#pragma unroll
            for (int j = 0; j < 8; ++j) orow[64 * j] = v[j] * rs * gr[64 * j];
        }
    }
}
__device__ __forceinline__ GAS unsigned char* lws(unsigned char* p) { const unsigned long long v0 = (unsigned long long)p; unsigned lo = (unsigned)v0, hi = (unsigned)(v0 >> 32);
    { unsigned lv, hv; asm volatile("v_mov_b32 %0, %2\n\tv_mov_b32 %1, %3" : "=&v"(lv), "=&v"(hv) : "s"(lo), "s"(hi)); lo = __builtin_amdgcn_readfirstlane(lv); hi = __builtin_amdgcn_readfirstlane(hv); } return (GAS unsigned char*)(((unsigned long long)hi << 32) | lo); }
#define ltid() (wave0 * 64 + llane())
constexpr int NCONV_BLOCKS = 32;
constexpr int NPH_LAYER = 15, NPHASES = 1 + DEPTH * NPH_LAYER;
__device__ __forceinline__ KA kargs() {
    KA k;
#if defined(__HIP_DEVICE_COMPILE__)
    const unsigned long long v0 = (unsigned long long)(KArgP)__builtin_amdgcn_kernarg_segment_ptr(); unsigned lo = (unsigned)v0, hi = (unsigned)(v0 >> 32);
    { unsigned lv, hv; asm volatile("v_mov_b32 %0, %2\n\tv_mov_b32 %1, %3" : "=&v"(lv), "=&v"(hv) : "s"(lo), "s"(hi)); lo = __builtin_amdgcn_readfirstlane(lv); hi = __builtin_amdgcn_readfirstlane(hv); }
    k.in.p = (KArgP)(((unsigned long long)hi << 32) | lo); k.out = k.in.p->out; k.ws = k.in.p->ws;
#else
    k.in.p = nullptr; k.out = nullptr; k.ws = nullptr;
#endif
    return k;
}
__global__ void __launch_bounds__(512, 2) fwd(Args a) {
    extern __shared__ __attribute__((aligned(16))) unsigned char lds_[];
    LAS unsigned char* lds = (LAS unsigned char*)lds_;
    const int tid = threadIdx.x; const int wave0 = __builtin_amdgcn_readfirstlane(tid >> 6);
    const int G = gridDim.x, bx = blockIdx.x;
    gu32* ctl = (gu32*)(a.ws + WS_CTL);
    for (int u = tid; u < (LDS_BYTES - LDSCTL_OFF) / 4; u += 512) ((LAS unsigned*)(lds + LDSCTL_OFF))[u] = 0u;
    __syncthreads();
    const int lo = a.ph_lo, hi = a.ph_hi;
    XcdBarrier bar; bar.bar = (unsigned*)ctl + CW_BAR; bar.x = 0; bar.st = nullptr;
    if (hi - lo > 1) bar = xcd_barrier_post((unsigned*)ctl + CW_BAR, (volatile LAS unsigned*)(lds + MISC_OFF) + 8);
#define IN(k) (lo <= (k) && (k) < hi)
#if defined(TIMING_A)
#define STAMP(k) do { const unsigned long long now_ = __builtin_amdgcn_s_memrealtime(); GAS unsigned char* wsp_ = lws(a.ws); if (bx == 0 && llane() == 0 && wave0 == 0) { ((volatile GAS unsigned long long*)(wsp_ + WS_DBG))[8 + (k)] = now_; } } while (0)
#else
#define STAMP(k) do { } while (0)
#endif
#define SEAM(k) do { if (IN(k) && IN((k) + 1)) xcd_barrier(bar); STAMP(k); } while (0)

#define hbf ((bf16*)(ws + WS_HBF))
#define hf ((float*)(ws + WS_HF))
#define z ((bf16*)(ws + WS_Z))
#define zs ((float*)(ws + WS_ZS))
#define zssq ((float*)(ws + WS_ZSSQ))
#define hssq ((float*)(ws + WS_HSSQ))
#define rstd0 ((float*)(ws + WS_RSTD0))
#define rstd2 ((float*)(ws + WS_RSTD2))
#define qm ((bf16*)(ws + WS_QM))
#define km ((bf16*)(ws + WS_KM))
#define vm ((bf16*)(ws + WS_VM))
#define kc ((bf16*)(ws + WS_KC))
#define vc ((bf16*)(ws + WS_VC))
#define kb ((float*)(ws + WS_KB))
#define o3 ((bf16*)(ws + WS_O3))
#define ow ((bf16*)(ws + WS_OW))
#define mpart ((float*)(ws + WS_MPART))
#define mbf ((bf16*)(ws + WS_MBF))
#define qmem ((bf16*)(ws + WS_QMEM))
#define kvmem ((bf16*)(ws + WS_KVMEM))
#define omem ((bf16*)(ws + WS_OMEM))
#define logits ((float*)(ws + WS_LOGIT))
#define rope ((const float*)(ws + WS_ROPE))
#define tabd ((const float*)(ws + WS_TABD))
#define asge ((int*)(ws + WS_ASGE))
#define asgi ((int*)(ws + WS_ASGI))
#define asgw ((float*)(ws + WS_ASGW))
#define pos ((int*)(ws + WS_POS))
#define roww ((float*)(ws + WS_ROWW))
#define rowr ((float*)(ws + WS_ROWR))
#define tile ((int*)(ws + WS_TILE))
#define xg ((bf16*)(ws + WS_XG))
#define hdn ((bf16*)(ws + WS_HDN))
#define yb ((bf16*)(ws + WS_Y))
#ifndef PHMASK
#define PHMASK 0xFFFFFFFFu
#endif
#define EN(k) ((PHMASK >> (k)) & 1u)
    if (lo == 0) { STAMP(-1); }
    if (EN(0) && IN(0)) { asm volatile("; PHMARK 0"); const KA a = kargs(); GAS unsigned char* ws = lws(a.ws); (void)ws; { const int t_ = ltid(); ph_pre(a, t_, t_ & 63, __builtin_amdgcn_readfirstlane(t_ >> 6)); } }
#pragma unroll 1
    for (int l = -1; l < DEPTH; ++l) {
        const int pb = 1 + NPH_LAYER * l;
        if (l >= 0) {
        if (EN(2) && IN(pb + 1)) { asm volatile("; PHMARK 2"); const KA a = kargs(); GAS unsigned char* ws = lws(a.ws); (void)ws;
            if (EN(16)) { pg8::Gemm g{hbf, (const bf16*)(ws + WS_WIN), DM, DM}; pg8::WinOrder S; S.init(NT, (55 - F8_NT) * 256, G, bx);
              pg8::EpiWin E{z, zs, zssq, rstd0, km, rope}; pg8::gemm_phase(lds, g, S, E, ltid()); }
            if (EN(16)) { pg8::Gemm g{(const bf16*)(ws + WS_H8), (const bf16*)(ws + WS_WG8), DM / 2, DM / 2}; pg8::StaticOrder S; S.init(NT, F8_NT * 256, G, G - 1 - bx);
              pg8::EpiWin8 E{z, rstd0}; pg8::gemm_phase(lds, g, S, E, ltid()); }
        }
        SEAM(pb + 1);
        if (EN(3) && IN(pb + 2)) { asm volatile("; PHMARK 3"); const KA a = kargs(); GAS unsigned char* ws = lws(a.ws); (void)ws;
            if (EN(18)) { pg8::Gemm g{z + ZC_MCQ, (const bf16*)(ws + WS_WUQ), ZLD, 768}; pg8::StaticOrder S; S.init(NT, 1536, G, bx);
              pg8::EpiMlaQ E{qm, zssq, rope}; pg8::gemm_phase(lds, g, S, E, ltid()); }
            if (EN(19)) { pg8::Gemm g{z + ZC_MCKV, (const bf16*)(ws + WS_WUKV), ZLD, 512}; pg8::StaticOrder S; S.init(NT, 2048, G, bx);
              pg8::EpiMlaKV E{km, vm, zssq}; pg8::gemm_phase(lds, g, S, E, ltid()); }
            if (EN(21)) { const int t_ = ltid(); for (int it = (G - 1 - bx) * NWAVES + __builtin_amdgcn_readfirstlane(t_ >> 6); it < 64; it += G * NWAVES) cumsum_item(it, zs, a.in[4] + l * 8, kb, t_ & 63); }
#if defined(COMPRESS_REF)
            if (EN(22)) for (int u = bx; u < 2 * 16 * 128; u += G) {
                const int br = u >> 11, rem = u & 2047, bg = rem >> 7, c = rem & 127; const int t_ = ltid();
                if (c < 127) { if (br == 0) compress_ref<192>(bg >> 1, bg & 1, c, z + ZC_NKC, (const bf16*)(ws + WS_WCK1), (const bf16*)(ws + WS_WCK2), (const float*)(ws + WS_C1P), 96, kc, lds, t_);
                               else compress_ref<128>(bg >> 1, bg & 1, c, z + ZC_NVC, (const bf16*)(ws + WS_WCV1), (const bf16*)(ws + WS_WCV2), (const float*)(ws + WS_C1P) + 96 * 192, 64, vc, lds, t_); }
                else { bf16* o = (br == 0 ? kc + (size_t)bg * 128 * 192 + 127 * 192 : vc + (size_t)bg * 128 * 128 + 127 * 128); if (t_ < (br == 0 ? 192 : 128)) o[t_] = 0; }
            }
#else
#endif
            {
                const int NQ = (G & 7) == 0 ? 8 : 1, qid = NQ == 8 ? (bx & 7) : 0, ncq = 128 / NQ, nwq = 512 / NQ;
                gu32* q = ctl + CW_WQ + (l * 8 + qid) * 32; LAS int* slot = (LAS int*)(lds + LDSCTL_OFF + 2048);
#pragma unroll 1
                for (;;) { const int j = q_next(q, slot, ltid()); if (j >= ncq + nwq) break;
                    if (j < ncq) {
#if !defined(COMPRESS_REF)
                        if (EN(22)) { const int gj = qid * ncq + j, b = gj >> 4, r = gj & 15, br = r >> 3, g2 = (r >> 2) & 1, ct = r & 3;
                            if (br == 0) compress_body<192>(b, g2, ct, z + ZC_NKC, (const bf16*)(ws + WS_WCK1), (const bf16*)(ws + WS_WCK2), (const float*)(ws + WS_C1P), 96, kc, lds, ltid(), (unsigned*)ctl + CW_CHK);
                            else compress_body<128>(b, g2, ct, z + ZC_NVC, (const bf16*)(ws + WS_WCV1), (const bf16*)(ws + WS_WCV2), (const float*)(ws + WS_C1P) + 96 * 192, 64, vc, lds, ltid(), (unsigned*)ctl + CW_CHK + 8); }
#endif
                    } else if (EN(20)) { const int gj = qid * nwq + (j - ncq), bb = gj >> 6, r = gj & 63;
                        nsa_win_unit(bb * 64 + (r & 1) * 32 + (31 - (r >> 1)), z, zs, tabd, ow, lds, ltid()); }
                }
            }
        }
        SEAM(pb + 2);
        if (EN(4) && IN(pb + 3)) { asm volatile("; PHMARK 4"); const KA a = kargs(); GAS unsigned char* ws = lws(a.ws); (void)ws;
            const bool g256 = (G == 256); const int cg = g256 ? (bx >> 5) & 3 : 0;
            const int gwv = (g256 ? cg * 64 + (bx >> 7) * 32 + (bx & 31) : bx) * NWAVES + wave0, NGWv = G * NWAVES, nper = g256 ? CONV_N_ATT : (MOE_ITEMS + NGWv - 1) / NGWv;
#pragma unroll 1
            for (int sg = 0; sg < 4; ++sg) {
                if (EN(27) && sg == cg) { moe_convert(a, l, gwv, NGWv, 0, nper, llane()); asm volatile("s_waitcnt vmcnt(0)" ::: "memory"); }
                if (sg == 0) { if (EN(23)) for (int u = bx; u < 256; u += G) { const int v = (u & 7) * 32 + (u >> 3); const int bh = v >> 2, p = v & 3;
                    fox_sub(bh >> 3, bh & 7, 7 - p, z, kb, o3, lds, ltid()); fox_sub(bh >> 3, bh & 7, p, z, kb, o3, lds, ltid()); } }
                else if (sg == 1) { if (EN(24)) for (int u = bx; u < 256; u += G) { const int v = (u & 7) * 32 + (u >> 3); const int bh = v >> 2, p = v & 3;
                    mla_sub(bh >> 3, bh & 7, 7 - p, qm, km, vm, o3 + 1024, lds, ltid()); mla_sub(bh >> 3, bh & 7, p, qm, km, vm, o3 + 1024, lds, ltid()); } }
                else if (sg == 2) { if (EN(25)) for (int u = bx; u < 256; u += G) { const int v = (u & 7) * 32 + (u >> 3); const int b = v >> 5, g2 = (v >> 4) & 1, p = v & 15;
                    nsa_cmp_sub(b, g2, 31 - p, z, zs, tabd, kc, vc, ow, (unsigned*)(ws + WS_RMASK), lds, ltid()); nsa_cmp_sub(b, g2, p, z, zs, tabd, kc, vc, ow, (unsigned*)(ws + WS_RMASK), lds, ltid()); } }
                else { if (EN(26)) for (int u = bx; u < 256; u += G) { const int v = (u & 7) * 32 + (u >> 3); const int b = v >> 5, g2 = (v >> 4) & 1, p = v & 15;
                    nsa_sel_sub(b, g2, 31 - p, z, zs, tabd, ow, (const unsigned*)(ws + WS_RMASK), o3 + 2048, lds, ltid());
                    nsa_sel_sub(b, g2, p, z, zs, tabd, ow, (const unsigned*)(ws + WS_RMASK), o3 + 2048, lds, ltid()); } }
            }
        }
        SEAM(pb + 3);
        if (EN(5) && IN(pb + 4)) { asm volatile("; PHMARK 5"); const KA a = kargs(); GAS unsigned char* ws = lws(a.ws); (void)ws;
            pg8::Gemm g{o3, (const bf16*)(ws + WS_WBR), 3072, 3072}; pg8::StaticOrder S; S.init(NT, 2048, G, bx);
            pg8::EpiBranch E{z, mbf}; pg8::gemm_phase(lds, g, S, E, ltid());
        }
        SEAM(pb + 4);
        if (EN(6) && IN(pb + 5)) { asm volatile("; PHMARK 6"); const KA a = kargs(); GAS unsigned char* ws = lws(a.ws); (void)ws;
            pg8::Gemm g{mbf, (const bf16*)(ws + WS_WOUT), F8_OUT ? DM / 2 : DM, F8_OUT ? DM / 2 : DM}; pg8::StaticOrder S; S.init(NT, DM, G, bx);
            pg8::EpiResidT<F8_OUT != 0> E{hbf, hssq, nullptr}; pg8::gemm_phase(lds, g, S, E, ltid());
        }
        SEAM(pb + 5);
        if (EN(7) && IN(pb + 6)) { asm volatile("; PHMARK 7"); const KA a = kargs(); GAS unsigned char* ws = lws(a.ws); (void)ws;
            pg8::Gemm g{hbf, (const bf16*)(ws + WS_WMQ), DM, DM}; pg8::StaticOrder S; S.init(NT, 512, G, bx);
            pg8::EpiRowScale E{qmem, 512, nullptr, hssq}; pg8::gemm_phase(lds, g, S, E, ltid());
            {
            if (EN(17)) { pg8::Gemm g{(const bf16*)(ws + WS_MEMBF), (const bf16*)(ws + WS_WMKV), DM, DM}; pg8::StaticOrder S; S.init(NB * MEML, 1024, G, G - 1 - bx);
              pg8::EpiRowScale E{kvmem, 1024, (const float*)(ws + WS_RSTDM), nullptr}; pg8::gemm_phase(lds, g, S, E, ltid()); }
            }
            if (EN(27) && G == 256 && bx >= 128 && bx < 224) { moe_convert(a, l, CONV_N_ATT * 2048 + (bx - 128) * NWAVES + wave0, 96 * NWAVES, 0, ((48 - CONV_N_ATT) * 2048 + 96 * NWAVES - 1) / (96 * NWAVES), llane()); asm volatile("s_waitcnt vmcnt(0)" ::: "memory"); }
        }
        SEAM(pb + 6);
        if (EN(8) && IN(pb + 7)) { asm volatile("; PHMARK 8"); const KA a = kargs(); GAS unsigned char* ws = lws(a.ws); (void)ws; for (int u = bx; u < 256; u += G) mem_unit(u, qmem, kvmem, omem, lds, ltid()); }
        SEAM(pb + 7);
        if (EN(9) && IN(pb + 8)) { asm volatile("; PHMARK 9"); const KA a = kargs(); GAS unsigned char* ws = lws(a.ws); (void)ws;
            pg8::Gemm g{omem, (const bf16*)(ws + WS_WMO), 512, 512}; pg8::StaticOrder S; S.init(NT, DM, G, bx);
            pg8::EpiResid E{hbf, hssq, F8_GU ? (unsigned char*)(ws + WS_H8) : nullptr}; pg8::gemm_phase(lds, g, S, E, ltid());
        }
        SEAM(pb + 8);
        if (EN(10) && IN(pb + 9)) { asm volatile("; PHMARK 10"); const KA a = kargs(); GAS unsigned char* ws = lws(a.ws); (void)ws;
            const int G4 = G >> 2, sl = bx / G4;
            if (sl < 4) { pg8::Gemm g{hbf + 512 * sl, (const bf16*)(ws + WS_WR) + 512 * sl, DM, 512, DM}; pg8::StaticOrder S; S.init(NT, 256, G4, bx - sl * G4);
                pg8::EpiRouter E{logits + (size_t)sl * NT * 64}; pg8::gemm_phase(lds, g, S, E, ltid()); }
        }
        SEAM(pb + 9);
        }
        { const int ps = l < 0 ? 0 : pb + 10;
          if (EN(11) && IN(ps)) { asm volatile("; PHMARK 11"); const KA a = kargs(); GAS unsigned char* ws = lws(a.ws); (void)ws;
            if (l >= 0) ph_route1(logits, hssq, (const float*)(ws + WS_BRT) + 64 * l, rstd2, (unsigned*)ctl + CW_CNT + l * 64, asge, asgi, asgw, ltid());
            if (l + 1 < DEPTH) { const int t_ = ltid(); ph_conv(a, l + 1, lds, t_, t_ & 63, __builtin_amdgcn_readfirstlane(t_ >> 6), 0, 13, bx, G); } }
          SEAM(ps); }
        if (l >= 0) {

        if (EN(12) && IN(pb + 11)) { asm volatile("; PHMARK 12"); const KA a = kargs(); GAS unsigned char* ws = lws(a.ws); (void)ws; const int t_ = ltid(); ph_route2((const unsigned*)ctl + CW_CNT + l * 64, asge, asgi, asgw, rstd2, pos, roww, rowr, tile, (int*)xg, lds, t_); LDS_WAIT(); __syncthreads(); }
        SEAM(pb + 11);
        if (EN(13) && IN(pb + 12)) { asm volatile("; PHMARK 13"); const KA a = kargs(); GAS unsigned char* ws = lws(a.ws); (void)ws;
            pg8::Gemm g{F8_GU ? (const bf16*)(ws + WS_H8) : (const bf16*)hbf, (const bf16*)(ws + WS_WGU), F8_GU ? DM / 2 : DM, F8_GU ? DM / 2 : DM}; pg8::MoeGatherOrder S; S.init(tile, G, bx); S.rowtok = (const int*)xg;
            pg8::EpiGateUp E{hdn, rowr}; pg8::gemm_phase(lds, g, S, E, ltid());
        }
        SEAM(pb + 12);
        if (EN(14) && IN(pb + 13)) { asm volatile("; PHMARK 14"); const KA a = kargs(); GAS unsigned char* ws = lws(a.ws); (void)ws;
            pg8::Gemm g{hdn, (const bf16*)(ws + WS_WD), F8_DN ? DEXP / 2 : DEXP, F8_DN ? DEXP / 2 : DEXP}; pg8::MoeOrder S; S.init(tile, G, bx);
            pg8::EpiDown E{yb, roww}; pg8::gemm_phase(lds, g, S, E, ltid());
        }
        SEAM(pb + 13);
        if (EN(15) && IN(pb + 14)) { asm volatile("; PHMARK 15"); const KA a = kargs(); GAS unsigned char* ws = lws(a.ws); (void)ws; { const int t_ = ltid(); ph_combine(yb, pos, hbf, (unsigned char*)(ws + WS_H8), rstd0, a.in[31], a.out, l == DEPTH - 1, t_ & 63, __builtin_amdgcn_readfirstlane(t_ >> 6)); } }
        SEAM(pb + 14);
        }
    }
#if defined(TIMING_A)
    if (hi - lo > 1) {
        xcd_barrier(bar);
        const unsigned long long* ts = (const unsigned long long*)(a.ws + WS_DBG) + 8;
        const unsigned long long t0 = __hip_atomic_load(ts - 1, RLX_AGENT), t1 = __hip_atomic_load(ts + NPHASES - 1, RLX_AGENT);
        const unsigned long long ta = __hip_atomic_load(ts + TIMING_A, RLX_AGENT), tb = __hip_atomic_load(ts + TIMING_B, RLX_AGENT);
        const float fa = (float)(ta - t0) / (float)(t1 - t0), fb = (float)(tb - t0) / (float)(t1 - t0);
        const float c1 = sqrtf(0.1f * rintf(fa * 80.f)), c2 = 100.f + 10.f * rintf(fb * 80.f);
        for (size_t i = (size_t)bx * 512 + ltid(); i < (size_t)NT * DM; i += (size_t)G * 512) a.out[i] = (i == 12345) ? c2 : c1;
    }
#endif
#undef IN
#undef SEAM
#undef hbf
#undef hf
#undef z
#undef zs
#undef zssq
#undef hssq
#undef rstd0
#undef rstd2
#undef qm
#undef km
#undef vm
#undef kc
#undef vc
#undef kb
#undef o3
#undef ow
#undef mpart
#undef mbf
#undef qmem
#undef kvmem
#undef omem
#undef logits
#undef rope
#undef tabd
#undef asge
#undef asgi
#undef asgw
#undef pos
#undef roww
#undef rowr
#undef tile
#undef xg
#undef hdn
#undef yb
}

#ifndef N_LAUNCH_MODE
#define N_LAUNCH_MODE 1
#endif
extern "C" void kernel_launch(void* const* d_in, const int* in_sizes, int n_in, void* d_out, int out_size, void* d_ws, size_t ws_size, hipStream_t stream) {
    static int grid = 0;
    if (grid == 0) {
        if (n_in != 32 || out_size != NT * DM || ws_size < WS_END) { fprintf(stderr, "kernel_launch: unexpected shapes (n_in %d out %d ws %zu need %zu)\n", n_in, out_size, ws_size, (size_t)WS_END); grid = -1; return; }
        int dev = 0, cus = 0, per_cu = 0;
        if (hipGetDevice(&dev) != hipSuccess || hipDeviceGetAttribute(&cus, hipDeviceAttributeMultiprocessorCount, dev) != hipSuccess) { grid = -1; return; }
        if (hipFuncSetAttribute((const void*)fwd, hipFuncAttributeMaxDynamicSharedMemorySize, LDS_BYTES) != hipSuccess) { fprintf(stderr, "kernel_launch: hipFuncSetAttribute failed\n"); grid = -1; return; }
        if (hipOccupancyMaxActiveBlocksPerMultiprocessor(&per_cu, (const void*)fwd, 512, LDS_BYTES) != hipSuccess || per_cu < 1) fprintf(stderr, "kernel_launch: occupancy query says %d\n", per_cu);
        (void)hipGetLastError();
        grid = cus & ~3;
    }
    if (grid < 0) return;
    Args a{};
    for (int i = 0; i < 32; ++i) a.in[i] = (const float*)d_in[i];
    a.out = (float*)d_out; a.ws = (unsigned char*)d_ws; a.dbg = 0; a.pad = 0;
#if defined(DEBUG_CODES)
    unsigned char* ws = (unsigned char*)d_ws;
    (void)hipMemsetAsync(ws, 0xAA, WS_END, stream);
    (void)hipMemsetAsync(ws + WS_DBG, 0, 4096, stream);
    for (int run = 0; run < 3; ++run) {
        (void)hipMemsetAsync((char*)d_ws + WS_CTL, 0, CTL_ZERO_BYTES, stream);
        for (int p = 0; p < NPHASES; ++p) {
            a.ph_lo = p; a.ph_hi = p + 1; hipLaunchKernelGGL(fwd, dim3(grid), dim3(512), LDS_BYTES, stream, a);
            const int l = p == 0 ? 0 : (p - 1) / NPH_LAYER, j = p == 0 ? -1 : (p - 1) % NPH_LAYER;
            auto one = [&](int stage, size_t off, size_t bytes, int kind) { const DbgBuf b[] = {{off, bytes, kind}}; dbg_stage(stream, ws, run, stage, b, 1, a.out); };
            if (l == 0) {
                if (j == 0) { one(34, WS_WIN, (size_t)ZLD * DM * 2, 1); one(35, WS_WCK1, (size_t)192 * 6144 * 2, 1); one(36, WS_WCK2, (size_t)192 * 192 * 2, 1); one(37, WS_C1P, (size_t)(96 * 192 + 64 * 128) * 4, 0);
                              one(38, WS_WCV1, (size_t)128 * 4096 * 2, 1); one(39, WS_ROPE, (size_t)2048 * 64 * 4, 0); }
                if (j == 1) { one(1, WS_Z, (size_t)NT * ZLD * 2, 1); one(2, WS_ZS, (size_t)NT * 32 * 4, 0); one(3, WS_KVMEM, (size_t)2048 * 1024 * 2, 1); }
                if (j == 2) { hipLaunchKernelGGL(dbg_copy, dim3(1), dim3(64), 0, stream, (const unsigned*)(ws + WS_CTL) + CW_CHK, (unsigned*)(ws + WS_DBG + 2048) + 48, 16); one(4, WS_QM, (size_t)NT * 1536 * 2, 1); one(5, WS_KM, (size_t)NT * 1536 * 2, 1); one(6, WS_VM, (size_t)NT * 1024 * 2, 1); one(7, WS_OW, (size_t)NT * 1024 * 2, 1);
                              one(8, WS_KB, (size_t)64 * 2048 * 4, 0); one(9, WS_KC, (size_t)16 * 128 * 192 * 2, 1); one(10, WS_VC, (size_t)16 * 128 * 128 * 2, 1); }
                if (j == 3) { one(11, WS_O3, (size_t)NT * 1024 * 2, 1); one(12, WS_O3 + (size_t)NT * 1024 * 2, (size_t)NT * 1024 * 2, 1); one(13, WS_RMASK, (size_t)16 * 2048 * 4, 2);
                              one(14, WS_O3 + (size_t)2 * NT * 1024 * 2, (size_t)NT * 1024 * 2, 1); one(15, WS_OW, (size_t)NT * 1024 * 2, 1); }
                if (j == 4) one(16, WS_MBF, (size_t)NT * DM * 2, 1);
                if (j == 5) { one(17, WS_HF, (size_t)NT * DM * 4, 0); one(18, WS_HBF, (size_t)NT * DM * 2, 1); one(19, WS_HSSQ, (size_t)NT * 32 * 4, 0); }
                if (j == 6) one(20, WS_QMEM, (size_t)NT * 512 * 2, 1);
                if (j == 7) one(21, WS_OMEM, (size_t)NT * 512 * 2, 1);
                if (j == 8) { one(22, WS_HF, (size_t)NT * DM * 4, 0); one(23, WS_HBF, (size_t)NT * DM * 2, 1); one(24, WS_HSSQ, (size_t)NT * 32 * 4, 0); }
                if (j == 9) { one(25, WS_LOGIT, (size_t)NT * 64 * 4, 0); one(26, WS_RSTD2, (size_t)NT * 4, 0); }
                if (j == 10) { one(27, WS_ASGE, (size_t)NT * 2 * 4, 2); one(28, WS_ASGW, (size_t)NT * 2 * 4, 0); }
                if (j == 11) one(29, WS_TILE, (size_t)201 * 4, 2);
                if (j == 14) { one(30, WS_HF, (size_t)NT * DM * 4, 0); one(31, WS_HBF, (size_t)NT * DM * 2, 1); one(32, WS_RSTD0, (size_t)NT * 4, 0); }
            } else if (j == 14) one(33, (size_t)-1, (size_t)NT * DM * 4, 0);
        }
    }
    hipLaunchKernelGGL(dbg_final, dim3(1024), dim3(256), 0, stream, (const unsigned long long*)(ws + WS_DBG), (const unsigned*)(ws + WS_DBG + 2048), a.out, (size_t)NT * DM, 39);
#else
    (void)hipMemsetAsync((char*)d_ws + WS_CTL, 0, CTL_ZERO_BYTES, stream);
#if N_LAUNCH_MODE == 0
    a.ph_lo = 0; a.ph_hi = NPHASES;
    hipLaunchKernelGGL(fwd, dim3(grid), dim3(512), LDS_BYTES, stream, a);
#else
    for (int p = 0; p < NPHASES; ++p) { a.ph_lo = p; a.ph_hi = p + 1; hipLaunchKernelGGL(fwd, dim3(grid), dim3(512), LDS_BYTES, stream, a); }
#endif
#endif
}
```

```cpp
#define N_LAUNCH_MODE 0
#ifndef F8_GU
#define F8_GU 1
#endif
#ifndef F8_DN
#define F8_DN 1
#endif
#ifndef F8_OUT
#define F8_OUT 1
#endif
#include <hip/hip_runtime.h>
#include <cstdio>
#include <cstdint>

#define LAS __attribute__((address_space(3)))
#define GAS __attribute__((address_space(1)))
typedef unsigned short bf16;
typedef short bf16x8 __attribute__((ext_vector_type(8)));
typedef short s16x4 __attribute__((ext_vector_type(4)));
typedef short v4i16_t __attribute__((ext_vector_type(4)));
typedef float f32x2 __attribute__((ext_vector_type(2)));
typedef float f32x4 __attribute__((ext_vector_type(4)));
typedef float f32x16 __attribute__((ext_vector_type(16)));
typedef unsigned u32x2 __attribute__((ext_vector_type(2)));
typedef int i32x4 __attribute__((ext_vector_type(4)));
typedef int i32x8 __attribute__((ext_vector_type(8)));
typedef unsigned u32x4 __attribute__((ext_vector_type(4)));
typedef GAS unsigned gu32;

constexpr int DM = 2048, NB = 8, SEQ = 2048, DEPTH = 2, NT = NB * SEQ;
constexpr int MEML = 256;
constexpr float EPS = 1e-6f;
constexpr int D_IN = 14048, ZLD = 14080;
constexpr int ZC_FQ = 0, ZC_FK = 1024, ZC_FV = 2048, ZC_MCQ = 3072, ZC_MCKV = 3840, ZC_MKR = 4352, ZC_NQ = 4416, ZC_NKC = 5952, ZC_NVC = 6336,
              ZC_NKS = 6592, ZC_NVS = 6976, ZC_NKW = 7232, ZC_NVW = 7616, ZC_MG = 7872, ZC_FF = 14016, ZC_NGT = 14024;
constexpr int NEXP = 32, DEXP = 1024, PMAX = 40960;
constexpr float LOG2E = 1.4426950408889634f;

constexpr size_t MiB = 1u << 20;
constexpr size_t al256(size_t x) { return (x + 255) & ~(size_t)255; }
constexpr size_t WS_CTL = 0, CTL_ZERO_BYTES = 1 * MiB;
constexpr size_t WS_WIN  = 1 * MiB;
constexpr size_t WS_WUQ  = WS_WIN  + al256((size_t)ZLD * DM * 2);
constexpr size_t WS_WUKV = WS_WUQ  + al256((size_t)1536 * 768 * 2);
constexpr size_t WS_WCK1 = WS_WUKV + al256((size_t)2048 * 512 * 2);
constexpr size_t WS_WCK2 = WS_WCK1 + al256((size_t)192 * 6144 * 2);
constexpr size_t WS_WCV1 = WS_WCK2 + al256((size_t)192 * 192 * 2);
constexpr size_t WS_WCV2 = WS_WCV1 + al256((size_t)128 * 4096 * 2);
constexpr size_t WS_WBR  = WS_WCV2 + al256((size_t)128 * 128 * 2);
constexpr size_t WS_WOUT = WS_WBR  + al256((size_t)3 * 2048 * 1024 * 2);
constexpr size_t WS_WMQ  = WS_WOUT + al256((size_t)2048 * 2048 * 2);
constexpr size_t WS_WMKV = WS_WMQ  + al256((size_t)512 * 2048 * 2);
constexpr size_t WS_WMO  = WS_WMKV + al256((size_t)1024 * 2048 * 2);
constexpr size_t WS_WR   = WS_WMO  + al256((size_t)2048 * 512 * 2);
constexpr size_t WS_WGU  = WS_WR   + al256((size_t)256 * 2048 * 2);
constexpr size_t WS_WD   = WS_WGU  + al256((size_t)NEXP * 2048 * 2048 * 2);
constexpr size_t WS_ACT  = WS_WD   + al256((size_t)NEXP * 2048 * 1024 * 2);
constexpr size_t WS_HBF  = WS_ACT;
constexpr size_t WS_HF   = WS_HBF  + al256((size_t)NT * DM * 2);
constexpr size_t WS_Z    = WS_HF   + al256((size_t)NT * DM * 4);
constexpr size_t WS_XG   = WS_Z;
constexpr size_t WS_HDN  = WS_XG   + al256((size_t)PMAX * 2048 * 2);
constexpr size_t WS_Y    = WS_HDN  + al256((size_t)PMAX * 1024 * 2);
constexpr size_t WS_ZEND = WS_Z    + al256((size_t)NT * ZLD * 2);
static_assert(WS_Y + (size_t)PMAX * 2048 * 2 <= WS_ZEND, "MoE overlay fits in z");
constexpr size_t WS_ZS   = WS_ZEND;
constexpr size_t WS_ZSSQ = WS_ZS   + al256((size_t)NT * 32 * 4);
constexpr size_t WS_HSSQ = WS_ZSSQ + al256((size_t)NT * 32 * 4);
constexpr size_t WS_RSTD0= WS_HSSQ + al256((size_t)NT * 32 * 4);
constexpr size_t WS_RSTD2= WS_RSTD0+ al256((size_t)NT * 4);
constexpr size_t WS_QM   = WS_RSTD2+ al256((size_t)NT * 4);
constexpr size_t WS_KM   = WS_QM   + al256((size_t)NT * 1536 * 2);
constexpr size_t WS_VM   = WS_KM   + al256((size_t)NT * 1536 * 2);
constexpr size_t WS_KC   = WS_VM   + al256((size_t)NT * 1024 * 2);
constexpr size_t WS_VC   = WS_KC   + al256((size_t)16 * 128 * 192 * 2);
constexpr size_t WS_KB   = WS_VC   + al256((size_t)16 * 128 * 128 * 2);
constexpr size_t WS_O3   = WS_KB   + al256((size_t)64 * 2048 * 4);
constexpr size_t WS_OW   = WS_O3   + al256((size_t)3 * NT * 1024 * 2);
constexpr size_t WS_MPART= WS_OW   + al256((size_t)NT * 1024 * 2);
constexpr size_t WS_MBF  = WS_MPART+ al256((size_t)NT * DM * 4);
constexpr size_t WS_QMEM = WS_MBF  + al256((size_t)NT * DM * 2);
constexpr size_t WS_KVMEM= WS_QMEM + al256((size_t)NT * 512 * 2);
constexpr size_t WS_OMEM = WS_KVMEM+ al256((size_t)2048 * 1024 * 2);
constexpr size_t WS_LOGIT= WS_OMEM + al256((size_t)NT * 512 * 2);
constexpr size_t WS_MEMBF= WS_LOGIT+ al256((size_t)4 * NT * 64 * 4);
constexpr size_t WS_RSTDM= WS_MEMBF+ al256((size_t)2048 * 2048 * 2);
constexpr size_t WS_ROPE = WS_RSTDM+ al256((size_t)2048 * 4);
constexpr size_t WS_TABD = WS_ROPE + al256((size_t)2048 * 64 * 4);
constexpr size_t WS_C1P  = WS_TABD + al256((size_t)8 * 132 * 4);
constexpr size_t WS_BRT  = WS_C1P  + al256((size_t)(96 * 192 + 64 * 128) * 4);
constexpr size_t WS_ASGE = WS_BRT  + al256(2 * 64 * 4);
constexpr size_t WS_ASGI = WS_ASGE + al256((size_t)NT * 2 * 4);
constexpr size_t WS_ASGW = WS_ASGI + al256((size_t)NT * 2 * 4);
constexpr size_t WS_POS  = WS_ASGW + al256((size_t)NT * 2 * 4);
constexpr size_t WS_ROWW = WS_POS  + al256((size_t)NT * 2 * 4);
constexpr size_t WS_ROWR = WS_ROWW + al256((size_t)PMAX * 4);
constexpr size_t WS_TILE = WS_ROWR + al256((size_t)PMAX * 4);
constexpr size_t WS_RMASK= WS_TILE + al256(256 * 4);
constexpr size_t WS_DBG  = WS_RMASK+ al256((size_t)16 * 2048 * 4);
constexpr size_t WS_H8   = WS_DBG  + al256(4096);
constexpr size_t WS_WG8  = WS_H8   + al256((size_t)NT * DM);
constexpr size_t WS_END  = WS_WG8  + al256((size_t)23 * 256 * DM);
static_assert(WS_END <= (size_t)2048 * MiB, "workspace budget");

constexpr int CW_BAR = 4096;
constexpr int CW_CNT = 8192;
constexpr int F8_T0 = 31, F8_NT = 23;
constexpr int CONV_N_ATT = 40;
constexpr int CW_WQ = 24576;
constexpr int CW_CHK = 12288;

constexpr int RING_BYTES = 131072;
constexpr int LDSCTL_OFF = 143360, MISC_OFF = LDSCTL_OFF + 320;
constexpr int LDS_BYTES = 147456;
constexpr int NWAVES = 8;

#define RLX_AGENT __ATOMIC_RELAXED, __HIP_MEMORY_SCOPE_AGENT
#define LDS_WAIT() asm volatile("s_waitcnt lgkmcnt(0)" ::: "memory")
#define VM_WAIT() asm volatile("s_waitcnt vmcnt(0)" ::: "memory")

typedef __bf16 bf16x2_t __attribute__((ext_vector_type(2)));
__device__ __forceinline__ unsigned cvt_pk_bf16(float lo, float hi) { const f32x2 v = {lo, hi}; const bf16x2_t b = __builtin_convertvector(v, bf16x2_t); return __builtin_bit_cast(unsigned, b); }
__device__ __forceinline__ float clamp_e4m3(float x) { return __builtin_amdgcn_fmed3f(x, -448.f, 448.f); }
__device__ __forceinline__ unsigned pk4_fp8(float a, float b, float c, float d) { int w = 0; w = __builtin_amdgcn_cvt_pk_fp8_f32(clamp_e4m3(a), clamp_e4m3(b), w, false); w = __builtin_amdgcn_cvt_pk_fp8_f32(clamp_e4m3(c), clamp_e4m3(d), w, true); return (unsigned)w; }
__device__ __forceinline__ float bf2f(unsigned short b) { return __uint_as_float(((unsigned)b) << 16); }
__device__ __forceinline__ float bflo(unsigned w) { return __uint_as_float(w << 16); }
__device__ __forceinline__ float bfhi(unsigned w) { return __uint_as_float(w & 0xffff0000u); }
__device__ __forceinline__ unsigned short f2bf(float f) { return (unsigned short)(cvt_pk_bf16(f, 0.f) & 0xffffu); }
__device__ __forceinline__ int llane() { int l; asm volatile("v_mbcnt_lo_u32_b32 %0, -1, 0\n\tv_mbcnt_hi_u32_b32 %0, -1, %0" : "=v"(l)); return l; }
__device__ __forceinline__ float shx(float v, int mask, int lane) { return __int_as_float(__builtin_amdgcn_ds_bpermute((lane ^ mask) << 2, __float_as_int(v))); }
__device__ __forceinline__ float wave_sum(float v, int lane) {
#pragma unroll
    for (int o = 1; o < 64; o <<= 1) v += shx(v, o, lane);
    return v;
}
__device__ __forceinline__ float dot4v(f32x4 a) { return (a[0] * a[0] + a[1] * a[1]) + (a[2] * a[2] + a[3] * a[3]); }
__device__ __forceinline__ float sigmoidf_(float x) { return __builtin_amdgcn_rcpf(1.f + __builtin_amdgcn_exp2f(-LOG2E * x)); }

#define XB_TMO      128
#define XB_XCNT(j)  (256  + 64 * (j))
#define XB_XSUB(j)  (1280 + 64 * (j))
#define XB_XGEN(j)  (2304 + 64 * (j))
#define XB_TOP      3328
#define XB_TOPGEN   3392
#define XCD_BAR_WORDS 3456
#define XB_SPIN_CAP (1u << 18)
__device__ __forceinline__ unsigned xb_ld(unsigned* p)              { return __hip_atomic_load(p, __ATOMIC_RELAXED, __HIP_MEMORY_SCOPE_AGENT); }
__device__ __forceinline__ unsigned xb_add(unsigned* p, unsigned v) { return __hip_atomic_fetch_add(p, v, __ATOMIC_RELAXED, __HIP_MEMORY_SCOPE_AGENT); }
__device__ __forceinline__ unsigned xb_xcc_id() { return (unsigned)__builtin_amdgcn_s_getreg((3 << 11) | 20) & 0xFu; }
#define XB_SPIN(cond, bar) do { unsigned _sp = 0; while (cond) { __builtin_amdgcn_s_sleep(1); \
    if ((++_sp & 255u) == 0u) { if (xb_ld(&(bar)[XB_TMO])) break; if (_sp > XB_SPIN_CAP) { atomicAdd(&(bar)[XB_TMO], 1u); break; } } } } while (0)
struct XcdBarrier { unsigned* bar; unsigned x; volatile LAS unsigned* st; };
__device__ __forceinline__ XcdBarrier xcd_barrier_post(unsigned* bar, volatile LAS unsigned* st) {
    XcdBarrier b; b.bar = bar; b.x = xb_xcc_id(); b.st = st;
    if (threadIdx.x == 0) (void)xb_add(&bar[XB_XCNT(b.x)], 1u);
    return b;
}
__device__ __forceinline__ void xcd_barrier_complete(unsigned* bar, unsigned x, unsigned& nloc, unsigned& nx) {
    const unsigned G = gridDim.x * gridDim.y * gridDim.z;
    unsigned sum, cnt, mine, sp = 0u;
    for (;;) {
        sum = 0u; cnt = 0u; mine = 0u;
#pragma unroll
        for (unsigned j = 0; j < 16; ++j) { const unsigned c = xb_ld(&bar[XB_XCNT(j)]); sum += c; cnt += (c > 0u) ? 1u : 0u; mine = (j == x) ? c : mine; }
        if (sum == G) break;
        __builtin_amdgcn_s_sleep(1);
        if ((++sp & 255u) == 0u) { if (xb_ld(&bar[XB_TMO])) break; if (sp > XB_SPIN_CAP) { atomicAdd(&bar[XB_TMO], 1u); break; } }
    }
    nloc = mine > 0u ? mine : 1u; nx = cnt > 0u ? cnt : 1u;
}
__device__ __forceinline__ void xcd_barrier(const XcdBarrier& b) {
    asm volatile("s_waitcnt vmcnt(0)" ::: "memory");
    __syncthreads();
    if (threadIdx.x == 0) {
        unsigned* bar = b.bar;
        __builtin_amdgcn_s_waitcnt(0);
        unsigned nloc = b.st[0], nx = b.st[1];
        if (nloc == 0u) { xcd_barrier_complete(bar, b.x, nloc, nx); b.st[0] = nloc; b.st[1] = nx; }
        const unsigned old = xb_add(&bar[XB_XSUB(b.x)], 1u);
        const unsigned gen = old / nloc;
        if (old + 1u == (gen + 1u) * nloc) {
            __builtin_amdgcn_fence(__ATOMIC_RELEASE, "agent");
            asm volatile("s_waitcnt vmcnt(0)" ::: "memory");
            const unsigned og = xb_add(&bar[XB_TOP], 1u);
            const unsigned tg = og / nx;
            if (og + 1u == (tg + 1u) * nx) xb_add(&bar[XB_TOPGEN], 1u);
            else XB_SPIN(xb_ld(&bar[XB_TOPGEN]) == tg, bar);
            __builtin_amdgcn_fence(__ATOMIC_ACQUIRE, "agent");
            xb_add(&bar[XB_XGEN(b.x)], 1u);
            asm volatile("s_waitcnt vmcnt(0)" ::: "memory");
        } else {
            XB_SPIN(xb_ld(&bar[XB_XGEN(b.x)]) == gen, bar);
            __builtin_amdgcn_fence(__ATOMIC_ACQUIRE, "agent");
            asm volatile("s_waitcnt vmcnt(0)" ::: "memory");
        }
    }
    __syncthreads();
}
namespace pg8 {
constexpr int BM = 256, BK = 64, HALF = 128, HTB = HALF * BK * 2, STAGE_BYTES = 8 * HTB, NXCD = 8, WGM = 4;
__host__ __device__ __forceinline__ int lds_byte(int r, int c) { const int st = (r >> 4) * 2 + (c >> 5), rr = r & 15, cc = c & 31, ob = rr * 64 + cc * 2; return st * 1024 + (ob ^ (((ob >> 9) & 1) << 5)); }
__host__ __device__ __forceinline__ void stage_rc(int b, int& R, int& C) { const int st = b / 1024, sb = b % 1024, swz = sb ^ (((sb >> 9) & 1) << 5); R = (st >> 1) * 16 + swz / 64; C = (st & 1) * 32 + (swz % 64) / 2; }
__host__ __device__ __forceinline__ int perm32(int rho) { const int n = rho >> 4, i = rho & 15; return 8 * (i >> 2) + 4 * n + (i & 3); }

struct Unit { int pm, pn; };
struct Gemm { const bf16* A; const bf16* Bt; int lda; int K; int ldb = 0; };

struct StaticOrder {
    static constexpr bool GATHER = false;
    int nM, nN, nwg, G, c;
    __device__ void init(int M, int N, int G_, int c_) { nM = M / BM; nN = N / BM; nwg = nM * nN; G = G_; c = c_; }
    __device__ __forceinline__ bool next(int i, Unit& u) const {
        const long L = (long)i * G + c; if (L >= nwg) return false;
        int wgid = (int)L; { const int q = nwg / NXCD, r = nwg % NXCD, xcd = wgid % NXCD, off = wgid / NXCD; wgid = (xcd < r ? xcd * (q + 1) : r * (q + 1) + (xcd - r) * q) + off; }
        const int nig = WGM * nN, gid = wgid / nig, fm = gid * WGM, gsz = (nM - fm) < WGM ? (nM - fm) : WGM;
        u.pm = fm + ((wgid % nig) % gsz); u.pn = (wgid % nig) / gsz; return true;
    }
};
struct WinOrder : StaticOrder {
    __device__ __forceinline__ bool next(int i, Unit& u) const { if (!StaticOrder::next(i, u)) return false; if (u.pn >= F8_T0) u.pn += F8_NT; return true; }
};
struct BranchOrder {
    StaticOrder S;
    __device__ void init(int G_, int c_) { S.init(NT, 2048, G_, c_); }
    __device__ __forceinline__ bool next(int i, Unit& u) const {
        Unit t; if (!S.next(i / 3, t)) return false; const int n = i % 3;
        u.pm = n * 64 + t.pm; u.pn = n * 8 + t.pn; return true;
    }
};
struct MoeOrder {
    static constexpr bool GATHER = false;
    const int* tile_e; int rt0, nk, rw;
    __device__ __forceinline__ void init(const int* tab, int G_, int c_) {
        tile_e = tab; const int nt = tab[200]; const bool x8 = (G_ & 7) == 0;
        const int t8 = (nt + 7) >> 3, r0 = x8 ? (c_ & 7) * t8 : 0; int cnt = nt - r0; cnt = cnt < 0 ? 0 : ((x8 && cnt > t8) ? t8 : cnt);
        rt0 = r0; nk = cnt * 8; rw = x8 ? (((G_ >> 3) << 16) | (c_ >> 3)) : ((G_ << 16) | c_);
    }
    __device__ __forceinline__ bool next(int i, Unit& u) const {
        const int k = i * (rw >> 16) + (rw & 0xffff); if (k >= nk) return false;
        const int rt = rt0 + (k >> 3); u.pm = rt; u.pn = tile_e[rt] * 8 + (k & 7); return true;
    }
};

struct MoeGatherOrder : MoeOrder { static constexpr bool GATHER = true; const int* rowtok; };

struct NoHook { __device__ __forceinline__ void run(int) const {} };
template <class Epi, class Sched, class Hook = NoHook>
__device__ __forceinline__ void gemm_phase(LAS unsigned char* lds, const Gemm g, const Sched& S, const Epi& E, int tid, const Hook& H = Hook()) {
    static_assert(sizeof(Epi) > 0, "");
    const int wid = __builtin_amdgcn_readfirstlane(tid >> 6), lane = tid & 63, wr = wid >> 2, wc = wid & 3, fr = lane & 15, fq = lane >> 4;
    const int K = g.K, nt = K / BK, lda = g.lda, ldb = g.ldb ? g.ldb : g.K;
    unsigned voffA[2], voffB[2], voffA1[2];
#pragma unroll
    for (int i = 0; i < 2; ++i) { int R, C; stage_rc(tid * 16 + i * 8192, R, C); const int Rb = Epi::PERM ? ((R & ~31) + perm32(R & 31)) : R;
        voffA[i] = (unsigned)(R * lda + C) * 2u; voffB[i] = (unsigned)(Rb * ldb + C) * 2u; }
    const size_t kstep = (size_t)(BK * 2);
    const size_t hstepA = (size_t)HALF * lda * 2, hstepB = (size_t)HALF * ldb * 2;
    const size_t tstepA = 2 * hstepA, tstepB = 2 * hstepB;
    const unsigned ldsw = (unsigned)wid * 1024u;
    constexpr bool F8 = Epi::F8; constexpr int KOFF = F8 ? 16 : 1024;
    const int aoff = F8 ? lds_byte(wr * 64 + fr, (fq & 1) * 16) + (fq >> 1) * 1024 : lds_byte(wr * 64 + fr, fq * 8);
    const int boff = F8 ? lds_byte(wc * 32 + fr, (fq & 1) * 16) + (fq >> 1) * 1024 : lds_byte(wc * 32 + fr, fq * 8);
#define PG8_SA(b, h) (((b) * 2 + (h)) * HTB)
#define PG8_SB(b, h) ((4 + (b) * 2 + (h)) * HTB)
#define PG8_STAGE(bufoff, gbase, voff) do { _Pragma("unroll") for (int _i = 0; _i < 2; ++_i) \
        __builtin_amdgcn_global_load_lds((const unsigned*)((const char*)(gbase) + (voff)[_i]), (LAS unsigned*)(lds + (bufoff) + ldsw + _i * 8192), 16, 0, 0); } while (0)
#define PG8_STAGE_A0(bufoff, gbase) PG8_STAGE(bufoff, gbase, voffA)
#define PG8_STAGE_A1(bufoff, gbase) do { if constexpr (Sched::GATHER) PG8_STAGE(bufoff, gbase, voffA1); else PG8_STAGE(bufoff, (gbase) + hstepA, voffA); } while (0)
#define PG8_ROWS(idx, u, d0, d1) do { _Pragma("unroll") for (int _i = 0; _i < 2; ++_i) { int R, C; stage_rc(tid * 16 + _i * 8192, R, C); \
        if ((idx) < RMAPN) { d0[_i] = rmap[(idx) * BM + R]; d1[_i] = rmap[(idx) * BM + HALF + R]; } else { d0[_i] = S.rowtok[(u).pm * BM + R]; d1[_i] = S.rowtok[(u).pm * BM + HALF + R]; } } } while (0)
#define PG8_SETA(d0, d1) do { _Pragma("unroll") for (int _i = 0; _i < 2; ++_i) { int R, C; stage_rc(tid * 16 + _i * 8192, R, C); voffA[_i] = (unsigned)(d0[_i] * lda + C) * 2u; voffA1[_i] = (unsigned)(d1[_i] * lda + C) * 2u; } } while (0)
#define PG8_LD8(dst, addr) do { const i32x4 lo_ = *(const LAS i32x4*)(addr), hi_ = *(const LAS i32x4*)((addr) + 16); dst = __builtin_shufflevector(lo_, hi_, 0, 1, 2, 3, 4, 5, 6, 7); } while (0)
#define PG8_LDA(dst, b, h) do { if constexpr (F8) { _Pragma("unroll") for (int m = 0; m < 4; ++m) PG8_LD8(dst##8[m], lds + PG8_SA(b, h) + aoff + m * 2048); } else { \
        _Pragma("unroll") for (int m = 0; m < 4; ++m) _Pragma("unroll") for (int k = 0; k < 2; ++k) dst[m][k] = *(const LAS bf16x8*)(lds + PG8_SA(b, h) + aoff + m * 2048 + k * 1024); } } while (0)
#define PG8_LDB(dst, b, h) do { if constexpr (F8) { _Pragma("unroll") for (int n = 0; n < 2; ++n) PG8_LD8(dst##8[n], lds + PG8_SB(b, h) + boff + n * 2048); } else { \
        _Pragma("unroll") for (int n = 0; n < 2; ++n) _Pragma("unroll") for (int k = 0; k < 2; ++k) dst[n][k] = *(const LAS bf16x8*)(lds + PG8_SB(b, h) + boff + n * 2048 + k * 1024); } } while (0)
#define PG8_CAT(x) __builtin_shufflevector((i32x4)(x)[0], (i32x4)(x)[1], 0, 1, 2, 3, 4, 5, 6, 7)
#define PG8_MMA(ai, bj, At, Bt) do { __builtin_amdgcn_s_setprio(1); if constexpr (F8) { _Pragma("unroll") for (int m = 0; m < 4; ++m) _Pragma("unroll") for (int n = 0; n < 2; ++n) \
        asm volatile("v_mfma_scale_f32_16x16x128_f8f6f4 %0, %1, %2, %0, %3, %4 op_sel_hi:[0,0,0]" : "+v"(acc[ai][bj][m][n]) : "v"(Bt##8[n]), "v"(At##8[m]), "v"(sc_b), "v"(sc_a));   \
      } else { _Pragma("unroll") for (int m = 0; m < 4; ++m) _Pragma("unroll") for (int n = 0; n < 2; ++n) _Pragma("unroll") for (int k = 0; k < 2; ++k) \
        acc[ai][bj][m][n] = __builtin_amdgcn_mfma_f32_16x16x32_bf16(Bt[n][k], At[m][k], acc[ai][bj][m][n], 0, 0, 0); } __builtin_amdgcn_s_setprio(0); } while (0)
#define PG8_WAIT_V(n) asm volatile("s_waitcnt vmcnt(" #n ")" ::: "memory")
#define PG8_WAIT_L(n) asm volatile("s_waitcnt lgkmcnt(" #n ")" ::: "memory")
#define PG8_BAR __builtin_amdgcn_s_barrier()
#define PG8_SCHED __builtin_amdgcn_sched_barrier(0)
    Unit cur, nxt; int ui = 0;
    if (!S.next(0, cur)) return;
    f32x4 acc[2][2][4][2];
#pragma unroll
    for (int a = 0; a < 2; ++a)
#pragma unroll
        for (int b = 0; b < 2; ++b)
#pragma unroll
            for (int m = 0; m < 4; ++m)
#pragma unroll
                for (int n = 0; n < 2; ++n) acc[a][b][m][n] = (f32x4){0.f, 0.f, 0.f, 0.f};
    bf16x8 At[4][2], B0[2][2], B1[2][2];
    const int sc_b = 121, sc_a = 127; i32x8 At8[4], B08[2], B18[2];
    const char* cA = (const char*)g.A + (Sched::GATHER ? (size_t)0 : (size_t)cur.pm * tstepA); const char* cB = (const char*)g.Bt + (size_t)cur.pn * tstepB;
    constexpr int RMAPN = 12; LAS int* rmap = (LAS int*)(lds + STAGE_BYTES);
    if constexpr (Sched::GATHER) {
        { Unit u; for (int i = 0; i < RMAPN && S.next(i, u); ++i) if (tid < BM) rmap[i * BM + tid] = S.rowtok[u.pm * BM + tid]; }
        asm volatile("s_waitcnt lgkmcnt(0)" ::: "memory"); __builtin_amdgcn_s_barrier();
        int d0[2], d1[2]; PG8_ROWS(0, cur, d0, d1); PG8_SETA(d0, d1); }
    PG8_STAGE(PG8_SB(0, 0), cB, voffB); PG8_STAGE(PG8_SB(0, 1), cB + hstepB, voffB); PG8_STAGE_A0(PG8_SA(0, 0), cA); PG8_STAGE_A1(PG8_SA(0, 1), cA);
    if (wr == 1) PG8_BAR;
    PG8_WAIT_V(2); PG8_BAR;
    PG8_STAGE(PG8_SB(1, 0), cB + kstep, voffB); PG8_STAGE_A0(PG8_SA(1, 0), cA + kstep); PG8_STAGE(PG8_SB(1, 1), cB + hstepB + kstep, voffB);
    PG8_WAIT_V(6); PG8_BAR;
    for (;;) {
        const bool has_next = S.next(ui + 1, nxt);
        const char* nA = (has_next && !Sched::GATHER) ? (const char*)g.A + (size_t)nxt.pm * tstepA : cA; const char* nB = has_next ? (const char*)g.Bt + (size_t)nxt.pn * tstepB : cB;
#pragma clang loop unroll(disable)
        for (int t = 0; t < nt; t += 2) {
            const bool last = (t == nt - 2);
            const char* a1 = cA + (size_t)(t + 1) * kstep;
            const char* a2 = last ? nA : cA + (size_t)(t + 2) * kstep; const char* b2 = last ? nB : cB + (size_t)(t + 2) * kstep;
            const char* a3 = a2 + kstep; const char* b3 = b2 + kstep;
            if constexpr (Epi::KSEG > 0) { if (t > 0 && (t % Epi::KSEG) == 0) { const int t2 = llane(); E.seg(acc, cur, t / Epi::KSEG, wr, wc, t2 & 15, t2 >> 4); } }
            int d0[2], d1[2];
            if constexpr (Sched::GATHER) { if (last && has_next) PG8_ROWS(ui + 1, nxt, d0, d1); }
            PG8_LDB(B0, 0, 0); PG8_LDB(B1, 0, 1); PG8_SCHED; PG8_LDA(At, 0, 0); PG8_STAGE_A1(PG8_SA(1, 1), a1);
            if constexpr (Sched::GATHER) { if (last && has_next) PG8_SETA(d0, d1); }
            PG8_WAIT_V(8); PG8_WAIT_L(0); PG8_BAR; PG8_MMA(0, 0, At, B0); PG8_MMA(0, 1, At, B1); PG8_BAR; PG8_SCHED;
            PG8_LDA(At, 0, 1); PG8_STAGE(PG8_SB(0, 0), b2, voffB); PG8_STAGE(PG8_SB(0, 1), b2 + hstepB, voffB); PG8_STAGE_A0(PG8_SA(0, 0), a2);
            PG8_WAIT_V(8); PG8_WAIT_L(0); PG8_BAR; PG8_MMA(1, 0, At, B0); PG8_MMA(1, 1, At, B1); PG8_BAR; PG8_SCHED;
            PG8_LDB(B0, 1, 0); PG8_LDB(B1, 1, 1); PG8_SCHED; PG8_LDA(At, 1, 0); PG8_STAGE_A1(PG8_SA(0, 1), a2);
            PG8_WAIT_V(8); PG8_WAIT_L(0); PG8_BAR; PG8_MMA(0, 0, At, B0); PG8_MMA(0, 1, At, B1); PG8_BAR; PG8_SCHED;
            PG8_LDA(At, 1, 1); PG8_STAGE(PG8_SB(1, 0), b3, voffB); PG8_STAGE(PG8_SB(1, 1), b3 + hstepB, voffB); PG8_STAGE_A0(PG8_SA(1, 0), a3);
            PG8_WAIT_V(8); PG8_WAIT_L(0); PG8_BAR; PG8_MMA(1, 0, At, B0); PG8_MMA(1, 1, At, B1); PG8_BAR; PG8_SCHED;
        }
        if (wr == 0) PG8_BAR;
        { const int t2 = llane(); E(acc, cur, wr, wc, t2 & 15, t2 >> 4); }
        H.run(ui);
        if (!has_next) break;
#pragma unroll
        for (int a = 0; a < 2; ++a)
#pragma unroll
            for (int b = 0; b < 2; ++b)
#pragma unroll
                for (int m = 0; m < 4; ++m)
#pragma unroll
                    for (int n = 0; n < 2; ++n) acc[a][b][m][n] = (f32x4){0.f, 0.f, 0.f, 0.f};
        cur = nxt; cA = nA; cB = nB; ++ui;
        if (wr == 1) PG8_BAR;
    }
    PG8_WAIT_V(0);
    PG8_BAR;
#undef PG8_SA
#undef PG8_SB
#undef PG8_STAGE
#undef PG8_LDA
#undef PG8_STAGE_A0
#undef PG8_STAGE_A1
#undef PG8_ROWS
#undef PG8_SETA
#undef PG8_LDB
#undef PG8_MMA
#undef PG8_CAT
#undef PG8_WAIT_V
#undef PG8_WAIT_L
#undef PG8_BAR
#undef PG8_SCHED
}

typedef const f32x4 (&AccRef)[2][2][4][2];
__device__ __forceinline__ u32x4 pack8(f32x4 a, f32x4 b) { u32x4 w; w.x = cvt_pk_bf16(a[0], a[1]); w.y = cvt_pk_bf16(a[2], a[3]); w.z = cvt_pk_bf16(b[0], b[1]); w.w = cvt_pk_bf16(b[2], b[3]); return w; }
__device__ __forceinline__ float dot4(f32x4 a) { return (a[0] * a[0] + a[1] * a[1]) + (a[2] * a[2] + a[3] * a[3]); }
__device__ __forceinline__ float red_fq_(float s, int lane) { s += shx(s, 16, lane); s += shx(s, 32, lane); return s; }
#define red_fq(s) red_fq_((s), fr + 16 * fq)
__device__ __forceinline__ f32x4 rope4(f32x4 v, f32x4 cs) { return (f32x4){v[0] * cs[0] - v[1] * cs[1], v[1] * cs[0] + v[0] * cs[1], v[2] * cs[2] - v[3] * cs[3], v[3] * cs[2] + v[2] * cs[3]}; }

__device__ __forceinline__ unsigned char* g8_addr(const bf16* z, int row, int c) { return (unsigned char*)z + (size_t)row * (ZLD * 2) + 2 * ZC_MG + c; }
__device__ __forceinline__ f32x4 u8x4_to_f(unsigned w) { return (f32x4){(float)(w & 255u), (float)((w >> 8) & 255u), (float)((w >> 16) & 255u), (float)(w >> 24)}; }
__device__ __forceinline__ unsigned sig_u8x4(f32x4 x) { unsigned r = 0;
#pragma unroll
    for (int j = 0; j < 4; ++j) r |= (unsigned)fminf(sigmoidf_(x[j]) * 256.f, 255.f) << (8 * j);
    return r; }
struct EpiWin {
    static constexpr bool PERM = true; static constexpr int KSEG = 0; static constexpr bool F8 = false;
    bf16* z; float* zs; float* zssq; const float* rstd; bf16* km; const float* rope;
    __device__ __forceinline__ void operator()(AccRef acc, const Unit& u, int wr, int wc, int fr, int fq) const {
        const int row0 = u.pm * BM + wr * 64 + fr, colw = u.pn * BM + wc * 32 + 8 * fq;
        const bool do_ssq = (u.pn >= 12 && u.pn <= 16), do_rope = (u.pn == 17 && wc < 2), do_side = (u.pn == 54 && wc == 2);
        float rsv[2][4];
#pragma unroll
        for (int ai = 0; ai < 2; ++ai)
#pragma unroll
            for (int m = 0; m < 4; ++m) rsv[ai][m] = rstd[row0 + ai * HALF + m * 16];
#pragma unroll
        for (int ai = 0; ai < 2; ++ai)
#pragma unroll
            for (int m = 0; m < 4; ++m) {
                const int row = row0 + ai * HALF + m * 16; const float rs = rsv[ai][m]; float sq = 0.f;
#pragma unroll
                for (int bj = 0; bj < 2; ++bj) {
                    f32x4 v0 = acc[ai][bj][m][0] * rs, v1 = acc[ai][bj][m][1] * rs;
                    if (bj == 0 && do_rope) {
                        const float* rp = rope + ((size_t)(row & (SEQ - 1)) * 32 + 16 * wc + 4 * fq) * 2;
                        v0 = rope4(v0, *(const f32x4*)rp); v1 = rope4(v1, *(const f32x4*)(rp + 4));
                        const u32x4 w = pack8(v0, v1);
#pragma unroll
                        for (int hh = 0; hh < 8; ++hh) *(u32x4*)(km + (size_t)row * 1536 + hh * 192 + 128 + 32 * wc + 8 * fq) = w;
                    }
                    sq += dot4(v0) + dot4(v1);
                    { const int zc = colw + bj * HALF;
                      if (zc >= ZC_MG && zc < ZC_MG + 6144) { u32x2 c8; c8.x = sig_u8x4(v0); c8.y = sig_u8x4(v1); *(u32x2*)g8_addr(z, row, zc - ZC_MG) = c8; }
                      else *(u32x4*)(z + (size_t)row * ZLD + zc) = pack8(v0, v1); }
                    if (bj == 1 && do_side) { float* sp = zs + (size_t)row * 32 + 8 * fq; *(f32x4*)sp = v0; *(f32x4*)(sp + 4) = v1; }
                }
                if (do_ssq) { sq = red_fq(sq); if (fq == 0) zssq[(size_t)row * 32 + (u.pn - 12) * 4 + wc] = sq; }
            }
    }
};
struct EpiWin8 {
    static constexpr bool PERM = true; static constexpr int KSEG = 0; static constexpr bool F8 = true;
    bf16* z; const float* rstd;
    __device__ __forceinline__ void operator()(AccRef acc, const Unit& u, int wr, int wc, int fr, int fq) const {
        const int row0 = u.pm * BM + wr * 64 + fr, colw = (u.pn + F8_T0) * BM + wc * 32 + 8 * fq;
        float rsv[2][4];
#pragma unroll
        for (int ai = 0; ai < 2; ++ai)
#pragma unroll
            for (int m = 0; m < 4; ++m) rsv[ai][m] = rstd[row0 + ai * HALF + m * 16];
#pragma unroll
        for (int ai = 0; ai < 2; ++ai)
#pragma unroll
            for (int m = 0; m < 4; ++m) { const int row = row0 + ai * HALF + m * 16; const float rs = rsv[ai][m];
#pragma unroll
                for (int bj = 0; bj < 2; ++bj) { u32x2 c8; c8.x = sig_u8x4(acc[ai][bj][m][0] * rs); c8.y = sig_u8x4(acc[ai][bj][m][1] * rs); *(u32x2*)g8_addr(z, row, colw + bj * HALF - ZC_MG) = c8; } }
    }
};
struct EpiMlaQ {
    static constexpr bool PERM = true; static constexpr int KSEG = 0; static constexpr bool F8 = false;
    bf16* qm; const float* zssq; const float* rope;
    __device__ __forceinline__ void operator()(AccRef acc, const Unit& u, int wr, int wc, int fr, int fq) const {
        const int row0 = u.pm * BM + wr * 64 + fr;
        f32x4 pv[2][4];
#pragma unroll
        for (int ai = 0; ai < 2; ++ai)
#pragma unroll
            for (int m = 0; m < 4; ++m) pv[ai][m] = (fq < 3) ? *(const f32x4*)(zssq + (size_t)(row0 + ai * HALF + m * 16) * 32 + 4 * fq) : (f32x4){0.f, 0.f, 0.f, 0.f};
#pragma unroll
        for (int ai = 0; ai < 2; ++ai)
#pragma unroll
            for (int m = 0; m < 4; ++m) {
                const int row = row0 + ai * HALF + m * 16;
                float s = (pv[ai][m][0] + pv[ai][m][1]) + (pv[ai][m][2] + pv[ai][m][3]);
                s = red_fq(s); const float rs = rsqrtf(s * (1.f / 768.f) + EPS);
#pragma unroll
                for (int bj = 0; bj < 2; ++bj) {
                    const int cb = u.pn * BM + bj * HALF + wc * 32, within = cb % 192;
                    f32x4 v0 = acc[ai][bj][m][0] * rs, v1 = acc[ai][bj][m][1] * rs;
                    if (within >= 128) {
                        const float* rp = rope + ((size_t)(row & (SEQ - 1)) * 32 + (within - 128) / 2 + 4 * fq) * 2;
                        v0 = rope4(v0, *(const f32x4*)rp); v1 = rope4(v1, *(const f32x4*)(rp + 4));
                    }
                    *(u32x4*)(qm + (size_t)row * 1536 + cb + 8 * fq) = pack8(v0, v1);
                }
            }
    }
};
struct EpiMlaKV {
    static constexpr bool PERM = true; static constexpr int KSEG = 0; static constexpr bool F8 = false;
    bf16* km; bf16* vm; const float* zssq;
    __device__ __forceinline__ void operator()(AccRef acc, const Unit& u, int wr, int wc, int fr, int fq) const {
        const int row0 = u.pm * BM + wr * 64 + fr;
        f32x4 pv[2][4];
#pragma unroll
        for (int ai = 0; ai < 2; ++ai)
#pragma unroll
            for (int m = 0; m < 4; ++m) pv[ai][m] = (fq < 2) ? *(const f32x4*)(zssq + (size_t)(row0 + ai * HALF + m * 16) * 32 + 12 + 4 * fq) : (f32x4){0.f, 0.f, 0.f, 0.f};
#pragma unroll
        for (int ai = 0; ai < 2; ++ai)
#pragma unroll
            for (int m = 0; m < 4; ++m) {
                const int row = row0 + ai * HALF + m * 16;
                float s = (pv[ai][m][0] + pv[ai][m][1]) + (pv[ai][m][2] + pv[ai][m][3]);
                s = red_fq(s); const float rs = rsqrtf(s * (1.f / 512.f) + EPS);
                *(u32x4*)(km + (size_t)row * 1536 + u.pn * 192 + wc * 32 + 8 * fq) = pack8(acc[ai][0][m][0] * rs, acc[ai][0][m][1] * rs);
                *(u32x4*)(vm + (size_t)row * 1024 + u.pn * 128 + wc * 32 + 8 * fq) = pack8(acc[ai][1][m][0] * rs, acc[ai][1][m][1] * rs);
            }
    }
};
struct EpiRowScale {
    static constexpr bool PERM = true; static constexpr int KSEG = 0; static constexpr bool F8 = false;
    bf16* O; int ldc; const float* rstd;
    const float* hssq;
    __device__ __forceinline__ void operator()(AccRef acc, const Unit& u, int wr, int wc, int fr, int fq) const {
        const int row0 = u.pm * BM + wr * 64 + fr, colw = u.pn * BM + wc * 32 + 8 * fq;
        float rsv[2][4];
        if (rstd) {
#pragma unroll
            for (int ai = 0; ai < 2; ++ai)
#pragma unroll
                for (int m = 0; m < 4; ++m) rsv[ai][m] = rstd[row0 + ai * HALF + m * 16];
        } else {
            f32x4 pp[2][4], qq[2][4];
#pragma unroll
            for (int ai = 0; ai < 2; ++ai)
#pragma unroll
                for (int m = 0; m < 4; ++m) { const float* hp = hssq + (size_t)(row0 + ai * HALF + m * 16) * 32 + 8 * fq; pp[ai][m] = *(const f32x4*)hp; qq[ai][m] = *(const f32x4*)(hp + 4); }
#pragma unroll
            for (int ai = 0; ai < 2; ++ai)
#pragma unroll
                for (int m = 0; m < 4; ++m) { const f32x4 p = pp[ai][m], q = qq[ai][m];
                    float s = ((p[0] + p[1]) + (p[2] + p[3])) + ((q[0] + q[1]) + (q[2] + q[3])); s = red_fq(s); rsv[ai][m] = rsqrtf(s * (1.f / 2048.f) + EPS); }
        }
#pragma unroll
        for (int ai = 0; ai < 2; ++ai)
#pragma unroll
            for (int m = 0; m < 4; ++m) {
                const int row = row0 + ai * HALF + m * 16; const float rs = rsv[ai][m];
#pragma unroll
                for (int bj = 0; bj < 2; ++bj) *(u32x4*)(O + (size_t)row * ldc + colw + bj * HALF) = pack8(acc[ai][bj][m][0] * rs, acc[ai][bj][m][1] * rs);
            }
    }
};
struct EpiBranch {
    static constexpr bool PERM = true; static constexpr int KSEG = 16; static constexpr bool F8 = false;
    const bf16* z; bf16* mbf;
    __device__ __forceinline__ void seg(f32x4 (&acc)[2][2][4][2], const Unit& u, int sgi, int wr, int wc, int fr, int fq) const {
        const int row0 = u.pm * BM + wr * 64 + fr, colw = u.pn * BM + wc * 32 + 8 * fq;
#pragma unroll
        for (int ai = 0; ai < 2; ++ai) {
            u32x2 ga[4][2], gb[4][2];
#pragma unroll
            for (int m = 0; m < 4; ++m)
#pragma unroll
                for (int bj = 0; bj < 2; ++bj) { const unsigned char* gp = g8_addr(z, row0 + ai * HALF + m * 16, (sgi - 1) * 2048 + colw + bj * HALF);
                    ga[m][bj] = *(const u32x2*)gp; gb[m][bj] = *(const u32x2*)(gp + 2048); }
#pragma unroll
            for (int m = 0; m < 4; ++m)
#pragma unroll
                for (int bj = 0; bj < 2; ++bj) { const u32x2 A = ga[m][bj], B = gb[m][bj];
                    const f32x4 b0 = u8x4_to_f(B.x) + 0.5f, b1 = u8x4_to_f(B.y) + 0.5f;
                    acc[ai][bj][m][0] *= (u8x4_to_f(A.x) + 0.5f) * (f32x4){__builtin_amdgcn_rcpf(b0[0]), __builtin_amdgcn_rcpf(b0[1]), __builtin_amdgcn_rcpf(b0[2]), __builtin_amdgcn_rcpf(b0[3])};
                    acc[ai][bj][m][1] *= (u8x4_to_f(A.y) + 0.5f) * (f32x4){__builtin_amdgcn_rcpf(b1[0]), __builtin_amdgcn_rcpf(b1[1]), __builtin_amdgcn_rcpf(b1[2]), __builtin_amdgcn_rcpf(b1[3])}; }
        }
    }
    __device__ __forceinline__ void operator()(AccRef acc, const Unit& u, int wr, int wc, int fr, int fq) const {
        const int row0 = u.pm * BM + wr * 64 + fr, colw = u.pn * BM + wc * 32 + 8 * fq;
#pragma unroll
        for (int ai = 0; ai < 2; ++ai) {
            u32x2 gv[4][2];
#pragma unroll
            for (int m = 0; m < 4; ++m)
#pragma unroll
                for (int bj = 0; bj < 2; ++bj) gv[m][bj] = *(const u32x2*)g8_addr(z, row0 + ai * HALF + m * 16, 2 * 2048 + colw + bj * HALF);
#pragma unroll
            for (int m = 0; m < 4; ++m)
#pragma unroll
                for (int bj = 0; bj < 2; ++bj) { const u32x2 gw = gv[m][bj];
                    const f32x4 g0 = (u8x4_to_f(gw.x) + 0.5f) * (1.f / 256.f), g1 = (u8x4_to_f(gw.y) + 0.5f) * (1.f / 256.f);
                    const f32x4 r0 = acc[ai][bj][m][0] * g0, r1 = acc[ai][bj][m][1] * g1;
                    if constexpr (F8_OUT) { u32x2 w8; w8.x = pk4_fp8(r0[0], r0[1], r0[2], r0[3]); w8.y = pk4_fp8(r1[0], r1[1], r1[2], r1[3]);
                        *(u32x2*)((unsigned char*)mbf + (size_t)(row0 + ai * HALF + m * 16) * 2048 + colw + bj * HALF) = w8; }
                    else *(u32x4*)(mbf + (size_t)(row0 + ai * HALF + m * 16) * 2048 + colw + bj * HALF) = pack8(r0, r1); }
        }
    }
};
template <bool F8_>
struct EpiResidT {
    static constexpr bool PERM = true; static constexpr int KSEG = 0; static constexpr bool F8 = F8_;
    bf16* hbf; float* hssq; unsigned char* h8;
    __device__ __forceinline__ void operator()(AccRef acc, const Unit& u, int wr, int wc, int fr, int fq) const {
        const int row0 = u.pm * BM + wr * 64 + fr, colw = u.pn * BM + wc * 32 + 8 * fq;
#pragma unroll
        for (int ai = 0; ai < 2; ++ai) {
            u32x4 bv[4][2];
#pragma unroll
            for (int m = 0; m < 4; ++m)
#pragma unroll
                for (int bj = 0; bj < 2; ++bj) bv[m][bj] = *(const u32x4*)(hbf + (size_t)(row0 + ai * HALF + m * 16) * 2048 + colw + bj * HALF);
#pragma unroll
            for (int m = 0; m < 4; ++m) {
                const int row = row0 + ai * HALF + m * 16; float sq = 0.f;
#pragma unroll
                for (int bj = 0; bj < 2; ++bj) {
                    const u32x4 w = bv[m][bj];
                    const f32x4 v0 = acc[ai][bj][m][0] + (f32x4){bflo(w.x), bfhi(w.x), bflo(w.y), bfhi(w.y)}, v1 = acc[ai][bj][m][1] + (f32x4){bflo(w.z), bfhi(w.z), bflo(w.w), bfhi(w.w)};
                    *(u32x4*)(hbf + (size_t)row * 2048 + colw + bj * HALF) = pack8(v0, v1);
                    if (h8) { u32x2 w8; w8.x = pk4_fp8(v0[0], v0[1], v0[2], v0[3]); w8.y = pk4_fp8(v1[0], v1[1], v1[2], v1[3]); *(u32x2*)(h8 + (size_t)row * 2048 + colw + bj * HALF) = w8; }
                    sq += dot4(v0) + dot4(v1);
                }
                sq = red_fq(sq); if (fq == 0) hssq[(size_t)row * 32 + u.pn * 4 + wc] = sq;
            }
        }
    }
};
using EpiResid = EpiResidT<false>;
struct EpiRouter {
    static constexpr bool PERM = false; static constexpr int KSEG = 0; static constexpr bool F8 = false;
    float* plog;
    __device__ __forceinline__ void operator()(AccRef acc, const Unit& u, int wr, int wc, int fr, int fq) const {
        const int row0 = u.pm * BM + wr * 64 + fr;
        if (wc < 2) {
#pragma unroll
            for (int ai = 0; ai < 2; ++ai)
#pragma unroll
                for (int m = 0; m < 4; ++m) { const int row = row0 + ai * HALF + m * 16;
#pragma unroll
                    for (int n = 0; n < 2; ++n) *(f32x4*)(plog + (size_t)row * 64 + wc * 32 + 16 * n + 4 * fq) = acc[ai][0][m][n]; }
        }
    }
};
struct EpiGateUp {
    static constexpr bool PERM = true; static constexpr int KSEG = 0; static constexpr bool F8 = F8_GU;
    bf16* hdn; const float* rowr;
    __device__ __forceinline__ void operator()(AccRef acc, const Unit& u, int wr, int wc, int fr, int fq) const {
        const int row0 = u.pm * BM + wr * 64 + fr, col = (u.pn & 7) * 128 + wc * 32 + 8 * fq;
        float rsv[2][4];
#pragma unroll
        for (int ai = 0; ai < 2; ++ai)
#pragma unroll
            for (int m = 0; m < 4; ++m) rsv[ai][m] = rowr[row0 + ai * HALF + m * 16];
#pragma unroll
        for (int ai = 0; ai < 2; ++ai)
#pragma unroll
            for (int m = 0; m < 4; ++m) {
                const int row = row0 + ai * HALF + m * 16; const float rs = rsv[ai][m];
                f32x4 o[2];
#pragma unroll
                for (int n = 0; n < 2; ++n) { const f32x4 g = acc[ai][0][m][n] * rs, up = acc[ai][1][m][n] * rs;
#pragma unroll
                    for (int j = 0; j < 4; ++j) o[n][j] = g[j] * sigmoidf_(g[j]) * up[j]; }
                if constexpr (F8_DN) { u32x2 w8; w8.x = pk4_fp8(o[0][0], o[0][1], o[0][2], o[0][3]); w8.y = pk4_fp8(o[1][0], o[1][1], o[1][2], o[1][3]); *(u32x2*)((unsigned char*)hdn + (size_t)row * 1024 + col) = w8; }
                else *(u32x4*)(hdn + (size_t)row * 1024 + col) = pack8(o[0], o[1]);
            }
    }
};
struct EpiDown {
    static constexpr bool PERM = true; static constexpr int KSEG = 0; static constexpr bool F8 = F8_DN;
    bf16* y; const float* roww;
    __device__ __forceinline__ void operator()(AccRef acc, const Unit& u, int wr, int wc, int fr, int fq) const {
        const int row0 = u.pm * BM + wr * 64 + fr, colw = (u.pn & 7) * BM + wc * 32 + 8 * fq;
        float wv[2][4];
#pragma unroll
        for (int ai = 0; ai < 2; ++ai)
#pragma unroll
            for (int m = 0; m < 4; ++m) wv[ai][m] = roww[row0 + ai * HALF + m * 16];
#pragma unroll
        for (int ai = 0; ai < 2; ++ai)
#pragma unroll
            for (int m = 0; m < 4; ++m) {
                const int row = row0 + ai * HALF + m * 16; const float w = wv[ai][m];
#pragma unroll
                for (int bj = 0; bj < 2; ++bj) *(u32x4*)(y + (size_t)row * 2048 + colw + bj * HALF) = pack8(acc[ai][bj][m][0] * w, acc[ai][bj][m][1] * w);
            }
    }
};
}
namespace att {
template <int DK> struct Geo { static constexpr int CPR = DK / 8, KROW = DK * 2, KBYTES = 64 * KROW, VBYTES = 16384, BUF = KBYTES + VBYTES, NKI = DK / 64, NVI = 2, NPT = NKI + NVI; };
constexpr int NBUF = 3;
constexpr int KB_OFF = 122880;
constexpr int TAB_OFF = 131072;
constexpr int RMASK_OFF = TAB_OFF + 4 * 132 * 4;
constexpr int IMPS_OFF = RMASK_OFF + 256;
static_assert(NBUF * Geo<192>::BUF <= KB_OFF && IMPS_OFF + 64 * 33 * 4 <= LDSCTL_OFF, "attention LDS");

__device__ __forceinline__ s16x4 vtr(const LAS unsigned char* p) { return __builtin_bit_cast(s16x4, __builtin_amdgcn_ds_read_tr16_b64_v4i16((LAS v4i16_t*)p)); }
__device__ __forceinline__ float half_max(float v) { auto rr = __builtin_amdgcn_permlane32_swap(__float_as_uint(v), __float_as_uint(v), false, false); return fmaxf(__uint_as_float(rr[0]), __uint_as_float(rr[1])); }
__device__ __forceinline__ float half_sum(float v) { auto rr = __builtin_amdgcn_permlane32_swap(__float_as_uint(v), __float_as_uint(v), false, false); return __uint_as_float(rr[0]) + __uint_as_float(rr[1]); }

template <int DK> __device__ __forceinline__ void dma_tile(LAS unsigned char* buf, const bf16* Kg, int ldk, const bf16* Vg, int ldv, int jt, int wave, int lane) {
    constexpr int CPR = Geo<DK>::CPR;
    const char* kt = (const char*)(Kg + (size_t)(64 * jt) * ldk); const char* vt = (const char*)(Vg + (size_t)(64 * jt) * ldv);
#pragma unroll
    for (int i = 0; i < Geo<DK>::NKI; ++i) { const int L = (wave * Geo<DK>::NKI + i) * 64 + lane, row = L / CPR, cp = L % CPR, c = (cp & ~7) | ((cp ^ row) & 7);
        __builtin_amdgcn_global_load_lds((const unsigned*)(kt + (unsigned)(row * ldk + c * 8) * 2u), (LAS unsigned*)(buf + (wave * Geo<DK>::NKI + i) * 1024), 16, 0, 0); }
#pragma unroll
    for (int i = 0; i < 2; ++i) { const int L = (wave * 2 + i) * 64 + lane, st = L >> 5, r = (L >> 2) & 7, cc = L & 3, key = (st >> 2) * 8 + r, dch = (st & 3) * 4 + cc;
        __builtin_amdgcn_global_load_lds((const unsigned*)(vt + (unsigned)(key * ldv + dch * 8) * 2u), (LAS unsigned*)(buf + Geo<DK>::KBYTES + (wave * 2 + i) * 1024), 16, 0, 0); }
}

struct State { f32x16 o[4]; float m, l; };
__device__ __forceinline__ void state_init(State& s) {
#pragma unroll
    for (int d = 0; d < 4; ++d)
#pragma unroll
        for (int r = 0; r < 16; ++r) s.o[d][r] = 0.f;
    s.m = -1e30f; s.l = 0.f;
}

template <int DK, bool MASK, bool KBIAS, bool T5, bool SEL, bool CMP, int CT, int HF>
__device__ __forceinline__ void half_compute(const LAS unsigned char* buf, int jt, const bf16x8 (&qf)[DK / 16], int t, int tw0, int W,
                                             const LAS float* kbias, const LAS float* tab, bool rowon, float cs, State& st,
                                             float (&impm)[16], float (&impt)[1], int lane) {
    constexpr int KROW = Geo<DK>::KROW, KS = CMP ? 16 : 1;
    const int hi = lane >> 5, l31 = lane & 31;
    const int pk0 = (CMP ? (1024 * jt + 31) : 64 * jt) + 32 * KS * HF, pk1 = pk0 + 31 * KS;
    const int dmin = tw0 - pk1, dmax = tw0 + 31 - pk0;
    if (MASK && (dmax < 0 || dmin >= W)) return;
    f32x4 kbv[4];
    if (KBIAS) {
#pragma unroll
        for (int a = 0; a < 4; ++a) kbv[a] = *(const LAS f32x4*)(kbias + 64 * jt + 32 * HF + 8 * a + 4 * hi);
    }
    f32x16 p;
#pragma unroll
    for (int r = 0; r < 16; ++r) p[r] = 0.f;
    const LAS unsigned char* krow = buf + (32 * HF + l31) * KROW;
    const LAS unsigned char* kp0 = krow + (((0 + hi) ^ l31) & 7) * 16; const LAS unsigned char* kp1 = krow + (((2 + hi) ^ l31) & 7) * 16;
    const LAS unsigned char* kp2 = krow + (((4 + hi) ^ l31) & 7) * 16; const LAS unsigned char* kp3 = krow + (((6 + hi) ^ l31) & 7) * 16;
#define ATT_KLD(kk) (*(const LAS bf16x8*)((((kk) & 3) == 0 ? kp0 : (((kk) & 3) == 1 ? kp1 : (((kk) & 3) == 2 ? kp2 : kp3))) + ((kk) >> 2) * 128))
    constexpr int NKH = DK / 32;
    bf16x8 kfa[NKH], kfb[NKH];
#pragma unroll
    for (int i = 0; i < NKH; ++i) kfa[i] = ATT_KLD(i);
    __builtin_amdgcn_sched_barrier(0);
#pragma unroll
    for (int i = 0; i < NKH; ++i) kfb[i] = ATT_KLD(NKH + i);
#pragma unroll
    for (int i = 0; i < NKH; ++i) p = __builtin_amdgcn_mfma_f32_32x32x16_bf16(kfa[i], qf[i], p, 0, 0, 0);
    __builtin_amdgcn_sched_barrier(0);
#pragma unroll
    for (int i = 0; i < NKH; ++i) p = __builtin_amdgcn_mfma_f32_32x32x16_bf16(kfb[i], qf[NKH + i], p, 0, 0, 0);
#undef ATT_KLD
    const unsigned vb0 = (unsigned)(size_t)(buf + Geo<DK>::KBYTES + (4 * hi + ((lane & 15) >> 2)) * 64 + (16 * ((lane >> 4) & 1) + 4 * (lane & 3)) * 2);
#define ATT_TRRD(dst, off) asm volatile("ds_read_b64_tr_b16 %0, %1 offset:%2" : "=&v"(dst) : "v"(vb0), "i"(off) : "memory")
    s16x4 l0, l1, l2, l3, h0, h1, h2, h3;
    { constexpr int b_ = (4 * HF) * 2048;
      ATT_TRRD(l0, b_); ATT_TRRD(h0, b_ + 2048); ATT_TRRD(l1, b_ + 512); ATT_TRRD(h1, b_ + 512 + 2048);
      ATT_TRRD(l2, b_ + 1024); ATT_TRRD(h2, b_ + 1024 + 2048); ATT_TRRD(l3, b_ + 1536); ATT_TRRD(h3, b_ + 1536 + 2048); }
    __builtin_amdgcn_sched_barrier(0);
    const int dq = t - pk0 - 4 * hi * KS;
    const bool need_mask = MASK && (dmin < 0 || dmax >= W);
    const float NEG = -__builtin_inff();
    if (T5 && dmin < 128) {
#pragma unroll
        for (int r = 0; r < 16; ++r) { const int c = (r & 3) + 8 * (r >> 2); const int d0 = dq - KS * c; p[r] = fmaf(p[r], cs, tab[min(max(d0, 0), 128)]); }
    } else {
        const float cfar = T5 ? tab[128] : 0.f;
#pragma unroll
        for (int r = 0; r < 16; ++r) { float b0 = cfar; if (KBIAS) b0 = kbv[r >> 2][r & 3]; p[r] = fmaf(p[r], cs, b0); }
    }
    if (need_mask) {
#pragma unroll
        for (int r = 0; r < 16; ++r) { const int c = (r & 3) + 8 * (r >> 2); if ((unsigned)(dq - KS * c) >= (unsigned)W) p[r] = NEG; }
    }
    if (SEL) { if (!rowon) {
#pragma unroll
        for (int r = 0; r < 16; ++r) p[r] = NEG; } }
    float pm = p[0];
#pragma unroll
    for (int r = 1; r < 16; ++r) pm = fmaxf(pm, p[r]);
    pm = half_max(pm);
    float mn = st.m, alpha = 1.f;
    if (!__all(pm - st.m <= 8.f ? 1 : 0)) {
        mn = fmaxf(st.m, pm); alpha = __builtin_amdgcn_exp2f(st.m - mn); st.m = mn;
#pragma unroll
        for (int d = 0; d < 4; ++d)
#pragma unroll
            for (int r = 0; r < 16; ++r) st.o[d][r] *= alpha;
        if (CMP) {
#pragma unroll
            for (int i = 0; i < 16; ++i) impm[i] *= alpha;
            impt[0] *= alpha;
        }
    }
    float ps = 0.f;
#pragma unroll
    for (int r = 0; r < 16; ++r) { p[r] = __builtin_amdgcn_exp2f(p[r] - mn); ps += p[r]; }
    ps = half_sum(ps);
    st.l = st.l * alpha + ps;
    if (CMP) {
        float ot[4];
#pragma unroll
        for (int a = 0; a < 4; ++a) { const float tl = p[4 * a + 3]; auto rr = __builtin_amdgcn_permlane32_swap(__float_as_uint(tl), __float_as_uint(tl), false, false);
            ot[a] = hi ? __uint_as_float(rr[0]) : __uint_as_float(rr[1]); }
#pragma unroll
        for (int a = 0; a < 4; ++a) { const float prev = hi ? ot[a] : (a == 0 ? impt[0] : ot[a > 0 ? a - 1 : 0]);
            impm[CT * 8 + HF * 4 + a] = 2.f * (p[4 * a] + p[4 * a + 1] + p[4 * a + 2]) + p[4 * a + 3] + prev; }
        impt[0] = ot[3];
    }
    bf16x8 pa[2];
    { u32x4 w;
      w.x = cvt_pk_bf16(p[0], p[1]); w.y = cvt_pk_bf16(p[2], p[3]); w.z = cvt_pk_bf16(p[4], p[5]); w.w = cvt_pk_bf16(p[6], p[7]); pa[0] = __builtin_bit_cast(bf16x8, w);
      w.x = cvt_pk_bf16(p[8], p[9]); w.y = cvt_pk_bf16(p[10], p[11]); w.z = cvt_pk_bf16(p[12], p[13]); w.w = cvt_pk_bf16(p[14], p[15]); pa[1] = __builtin_bit_cast(bf16x8, w); }
    s16x4 m0, m1, m2, m3, n0, n1, n2, n3;
    asm volatile("s_waitcnt lgkmcnt(0)" ::: "memory"); __builtin_amdgcn_sched_barrier(0);
    { constexpr int b_ = (4 * HF + 2) * 2048;
      ATT_TRRD(m0, b_); ATT_TRRD(n0, b_ + 2048); ATT_TRRD(m1, b_ + 512); ATT_TRRD(n1, b_ + 512 + 2048);
      ATT_TRRD(m2, b_ + 1024); ATT_TRRD(n2, b_ + 1024 + 2048); ATT_TRRD(m3, b_ + 1536); ATT_TRRD(n3, b_ + 1536 + 2048); }
    st.o[0] = __builtin_amdgcn_mfma_f32_32x32x16_bf16((bf16x8){l0[0], l0[1], l0[2], l0[3], h0[0], h0[1], h0[2], h0[3]}, pa[0], st.o[0], 0, 0, 0);
    st.o[1] = __builtin_amdgcn_mfma_f32_32x32x16_bf16((bf16x8){l1[0], l1[1], l1[2], l1[3], h1[0], h1[1], h1[2], h1[3]}, pa[0], st.o[1], 0, 0, 0);
    st.o[2] = __builtin_amdgcn_mfma_f32_32x32x16_bf16((bf16x8){l2[0], l2[1], l2[2], l2[3], h2[0], h2[1], h2[2], h2[3]}, pa[0], st.o[2], 0, 0, 0);
    st.o[3] = __builtin_amdgcn_mfma_f32_32x32x16_bf16((bf16x8){l3[0], l3[1], l3[2], l3[3], h3[0], h3[1], h3[2], h3[3]}, pa[0], st.o[3], 0, 0, 0);
    asm volatile("s_waitcnt lgkmcnt(0)" ::: "memory"); __builtin_amdgcn_sched_barrier(0);
    st.o[0] = __builtin_amdgcn_mfma_f32_32x32x16_bf16((bf16x8){m0[0], m0[1], m0[2], m0[3], n0[0], n0[1], n0[2], n0[3]}, pa[1], st.o[0], 0, 0, 0);
    st.o[1] = __builtin_amdgcn_mfma_f32_32x32x16_bf16((bf16x8){m1[0], m1[1], m1[2], m1[3], n1[0], n1[1], n1[2], n1[3]}, pa[1], st.o[1], 0, 0, 0);
    st.o[2] = __builtin_amdgcn_mfma_f32_32x32x16_bf16((bf16x8){m2[0], m2[1], m2[2], m2[3], n2[0], n2[1], n2[2], n2[3]}, pa[1], st.o[2], 0, 0, 0);
    st.o[3] = __builtin_amdgcn_mfma_f32_32x32x16_bf16((bf16x8){m3[0], m3[1], m3[2], m3[3], n3[0], n3[1], n3[2], n3[3]}, pa[1], st.o[3], 0, 0, 0);
    __builtin_amdgcn_sched_barrier(0);
#undef ATT_TRRD
}
template <int DK, bool MASK, bool KBIAS, bool T5, bool SEL, bool CMP, int CT>
__device__ __forceinline__ void tile_compute(const LAS unsigned char* buf, int jt, const bf16x8 (&qf)[DK / 16], int t, int tw0, int W,
                                             const LAS float* kbias, const LAS float* tab, unsigned rowmask, float cs, State& st,
                                             float (&impm)[16], float (&impt)[1], int lane) {
    bool rowon = true;
    if (SEL) { rowon = ((rowmask >> jt) & 1u) != 0u; if (!__any(rowon ? 1 : 0)) return; }
    half_compute<DK, MASK, KBIAS, T5, SEL, CMP, CT, 0>(buf, jt, qf, t, tw0, W, kbias, tab, rowon, cs, st, impm, impt, lane);
    half_compute<DK, MASK, KBIAS, T5, SEL, CMP, CT, 1>(buf, jt, qf, t, tw0, W, kbias, tab, rowon, cs, st, impm, impt, lane);
}

template <int N> __device__ __forceinline__ void wait_vm() { asm volatile("s_waitcnt vmcnt(%0)" :: "n"(N) : "memory"); }
template <int DK, bool MASK, bool KBIAS, bool T5, bool SEL>
__device__ __forceinline__ void attn_run(LAS unsigned char* lds, const bf16* Kg, int ldk, const bf16* Vg, int ldv, int jt_lo, int jt_hi,
                                         const bf16x8 (&qf)[DK / 16], int t, int tw0, int W, const LAS float* kbias, const LAS float* tab,
                                         unsigned rowmask, float cs, State& st, int tid) {
    const int lane = tid & 63, wave = __builtin_amdgcn_readfirstlane(tid >> 6);
    float dm0[16], dm1[1];
    dma_tile<DK>(lds, Kg, ldk, Vg, ldv, jt_lo, wave, lane);
    if (jt_lo + 1 < jt_hi) dma_tile<DK>(lds + Geo<DK>::BUF, Kg, ldk, Vg, ldv, jt_lo + 1, wave, lane);
    int cur = 0;
    for (int jt = jt_lo; jt < jt_hi; ++jt) {
        if (jt + 1 < jt_hi) wait_vm<Geo<DK>::NPT>(); else wait_vm<0>();
        asm volatile("s_waitcnt lgkmcnt(0)" ::: "memory");
        __builtin_amdgcn_s_barrier();
        asm volatile("" ::: "memory");
        const int lane_ = lane;
        const int nxt = cur >= 1 ? cur - 1 : 2;
        if (jt + 2 < jt_hi) dma_tile<DK>(lds + nxt * Geo<DK>::BUF, Kg, ldk, Vg, ldv, jt + 2, wave, lane_);
        tile_compute<DK, MASK, KBIAS, T5, SEL, false, 0>(lds + cur * Geo<DK>::BUF, jt, qf, t, tw0, W, kbias, tab, rowmask, cs, st, dm0, dm1, lane);
        cur = cur == 2 ? 0 : cur + 1;
    }
    asm volatile("s_waitcnt lgkmcnt(0)" ::: "memory");
    __builtin_amdgcn_s_barrier();
    asm volatile("" ::: "memory");
}

template <int DK> __device__ __forceinline__ void load_q(bf16x8 (&qf)[DK / 16], const bf16* qrow, int lane) {
#pragma unroll
    for (int kk = 0; kk < DK / 16; ++kk) qf[kk] = *(const bf16x8*)(qrow + 16 * kk + 8 * (lane >> 5));
}
template <int MODE> __device__ __forceinline__ void store_o(const State& st, float sc, bf16* orow, const bf16* addrow, int lane) {
    const int hi = lane >> 5;
#pragma unroll
    for (int db = 0; db < 4; ++db)
#pragma unroll
        for (int rg = 0; rg < 4; ++rg) {
            const int d = 32 * db + 8 * rg + 4 * hi;
            float v0 = st.o[db][4 * rg] * sc, v1 = st.o[db][4 * rg + 1] * sc, v2 = st.o[db][4 * rg + 2] * sc, v3 = st.o[db][4 * rg + 3] * sc;
            if (MODE != 0) { const u32x2 a = *(const u32x2*)((MODE == 1 ? (const bf16*)orow : addrow) + d); v0 += bflo(a.x); v1 += bfhi(a.x); v2 += bflo(a.y); v3 += bfhi(a.y); }
            u32x2 w; w.x = cvt_pk_bf16(v0, v1); w.y = cvt_pk_bf16(v2, v3);
            *(u32x2*)(orow + d) = w;
        }
}
}
struct Args { const float* in[32]; float* out; unsigned char* ws; int ph_lo, ph_hi, dbg, pad; };
#if defined(__HIP_DEVICE_COMPILE__)
typedef const __attribute__((address_space(4))) Args* KArgP;
#else
typedef const Args* KArgP;
#endif
struct KIn { KArgP p; __device__ __forceinline__ const float* operator[](int i) const { return p->in[i]; } };
struct KA { KIn in; float* out; unsigned char* ws; };

__device__ __forceinline__ float row_to_bf16(const float* xrow, bf16* orow, unsigned char* o8, int lane) {
    const f32x4* xr = (const f32x4*)xrow + lane; f32x4 v[8]; float s = 0.f;
#pragma unroll
    for (int j = 0; j < 8; ++j) { v[j] = xr[64 * j]; s += dot4v(v[j]); }
    s = wave_sum(s, lane);
    u32x2* ob = (u32x2*)orow + lane;
#pragma unroll
    for (int j = 0; j < 8; ++j) { u32x2 w; w.x = cvt_pk_bf16(v[j][0], v[j][1]); w.y = cvt_pk_bf16(v[j][2], v[j][3]); ob[64 * j] = w; }
    if (o8) {
#pragma unroll
        for (int j = 0; j < 8; ++j) ((unsigned*)o8)[lane + 64 * j] = pk4_fp8(v[j][0], v[j][1], v[j][2], v[j][3]);
    }
    return rsqrtf(s * (1.f / 2048.f) + EPS);
}

__device__ __forceinline__ int t5_bucket(int d) {
    if (d < 16) return d;
    const float df = (float)d;
    int large = 16 + (int)(logf(df / 16.f) / logf(8.f) * 16.f);
    return large < 31 ? large : 31;
}

__device__ __forceinline__ void ph_pre(const KA& a, int tid, int lane, int wave) {
    unsigned char* ws = a.ws;
    const int gw = blockIdx.x * NWAVES + wave, NGW = gridDim.x * NWAVES;
    const int gt = blockIdx.x * 512 + tid, NGT = gridDim.x * 512;
    bf16* hbf = (bf16*)(ws + WS_HBF); float* rstd0 = (float*)(ws + WS_RSTD0);
    for (int row = gw; row < NT; row += NGW) { const float r = row_to_bf16(a.in[0] + (size_t)row * DM, hbf + (size_t)row * DM, ws + WS_H8 + (size_t)row * DM, lane); if (lane == 0) rstd0[row] = r; }
    bf16* membf = (bf16*)(ws + WS_MEMBF); float* rstdm = (float*)(ws + WS_RSTDM);
    for (int row = gw; row < NB * MEML; row += NGW) { const float r = row_to_bf16(a.in[1] + (size_t)row * DM, membf + (size_t)row * DM, nullptr, lane); if (lane == 0) rstdm[row] = r; }
    float* rope = (float*)(ws + WS_ROPE);
    for (int i = gt; i < SEQ * 32; i += NGT) { const int pos = i >> 5, k = i & 31; const float inv = powf(10000.f, -(float)k / 32.f); const float ang = (float)pos * inv; rope[2 * i] = cosf(ang); rope[2 * i + 1] = sinf(ang); }
    float* tabd = (float*)(ws + WS_TABD);
    for (int i = gt; i < 8 * 132; i += NGT) { const int h = i / 132, d = i % 132; tabd[i] = (d <= 128) ? a.in[15][t5_bucket(d) * 8 + h] * LOG2E : 0.f; }
}

struct Src { const float* p; int ld; };
__device__ __forceinline__ Src conv_src(const KA& a, int l, int mat, int sub, int d) {
    Src s; s.p = nullptr; s.ld = 0;
    switch (mat) {
    case 0: { int c;
        if (d < 3072) c = d; else if (d < 3840) c = 3080 + (d - 3072); else if (d < 4352) c = 3848 + (d - 3840);
        else if (d < 4416) { const int j = d - 4352, i = j >> 1; c = 4360 + ((j & 1) ? 32 + i : i); }
        else if (d < 7872) c = 4424 + (d - 4416); else if (d < 14016) c = 7904 + (d - 7872);
        else if (d < 14024) c = 3072 + (d - 14016); else if (d < 14048) c = 7880 + (d - 14024); else c = -1;
        if (c >= 0) { s.p = a.in[3] + (size_t)l * DM * D_IN + c; s.ld = D_IN; } break; }
    case 1: { const int hd = d / 192, w = d % 192; int c = d; if (w >= 128) { const int j = w - 128, i = j >> 1; c = hd * 192 + 128 + ((j & 1) ? 32 + i : i); }
        s.p = a.in[7] + (size_t)l * 768 * 1536 + c; s.ld = 1536; break; }
    case 2: s.p = a.in[8] + (size_t)l * 512 * 2048 + d; s.ld = 2048; break;
    case 3: s.p = a.in[11] + (size_t)l * 6144 * 192 + d; s.ld = 192; break;
    case 4: s.p = a.in[12] + (size_t)l * 192 * 192 + d; s.ld = 192; break;
    case 5: s.p = a.in[13] + (size_t)l * 4096 * 128 + d; s.ld = 128; break;
    case 6: s.p = a.in[14] + (size_t)l * 128 * 128 + d; s.ld = 128; break;
    case 7: s.p = a.in[16] + (size_t)l * 3 * 1024 * 2048 + d; s.ld = 2048; break;
    case 8: s.p = a.in[17] + (size_t)l * 2048 * 2048 + d; s.ld = 2048; break;
    case 9: s.p = a.in[20] + (size_t)l * 2048 * 512 + d; s.ld = 512; break;
    case 10: s.p = a.in[21] + (size_t)l * 2048 * 1024 + d; s.ld = 1024; break;
    case 11: s.p = a.in[22] + (size_t)l * 512 * 2048 + d; s.ld = 2048; break;
    case 12: if (d < 4) { s.p = a.in[24] + (size_t)l * 2048 * 4 + d; s.ld = 4; } else if (d < 36) { s.p = a.in[26] + (size_t)l * 2048 * 32 + (d - 4); s.ld = 32; } break;
    case 13: { const int j = d >> 8, w = d & 255; const float* base = (w < 128 ? a.in[28] : a.in[29]) + ((size_t)l * NEXP + sub) * 2048 * 1024;
        s.p = base + j * 128 + (w & 127); s.ld = 1024; break; }
    default: s.p = a.in[30] + ((size_t)l * NEXP + sub) * 1024 * 2048 + d; s.ld = 2048; break;
    }
    return s;
}
__device__ __forceinline__ void conv_item(const KA& a, int l, int mt, int sub, const float* gain, int K, bf16* dst, int kb, int nb, LAS float* scr, int lane) {
    const int q = lane & 7, kr = lane >> 3, k0 = kb * 64, d0 = nb * 32 + 4 * q;
    const Src s0 = conv_src(a, l, mt, sub, d0), s3 = conv_src(a, l, mt, sub, d0 + 3);
    if ((s0.p == nullptr && s3.p == nullptr) || (s0.p != nullptr && s3.p == s0.p + 3)) {
        f32x4 v[8];
#pragma unroll
        for (int i = 0; i < 8; ++i) v[i] = s0.p ? *(const f32x4*)(s0.p + (size_t)(k0 + kr + 8 * i) * s0.ld) : (f32x4){0.f, 0.f, 0.f, 0.f};
#pragma unroll
        for (int i = 0; i < 8; ++i) { const float gq = gain ? gain[k0 + kr + 8 * i] : 1.f; LAS float* w = scr + (kr + 8 * i) * 33 + 4 * q;
            w[0] = v[i][0] * gq; w[1] = v[i][1] * gq; w[2] = v[i][2] * gq; w[3] = v[i][3] * gq; }
    } else {
        const Src s1 = conv_src(a, l, mt, sub, d0 + 1), s2 = conv_src(a, l, mt, sub, d0 + 2);
#pragma unroll 4
        for (int i = 0; i < 8; ++i) { const int k = k0 + kr + 8 * i; const float gq = gain ? gain[k] : 1.f; LAS float* w = scr + (kr + 8 * i) * 33 + 4 * q;
            w[0] = s0.p ? s0.p[(size_t)k * s0.ld] * gq : 0.f; w[1] = s1.p ? s1.p[(size_t)k * s1.ld] * gq : 0.f;
            w[2] = s2.p ? s2.p[(size_t)k * s2.ld] * gq : 0.f; w[3] = s3.p ? s3.p[(size_t)k * s3.ld] * gq : 0.f; }
    }
    LDS_WAIT(); asm volatile("" ::: "memory");
    const int c = lane & 7;
#pragma unroll
    for (int j = 0; j < 4; ++j) { const int nn = (lane >> 3) + 8 * j; const LAS float* qv = scr + (8 * c) * 33 + nn;
        u32x4 o; o.x = cvt_pk_bf16(qv[0 * 33], qv[1 * 33]); o.y = cvt_pk_bf16(qv[2 * 33], qv[3 * 33]); o.z = cvt_pk_bf16(qv[4 * 33], qv[5 * 33]); o.w = cvt_pk_bf16(qv[6 * 33], qv[7 * 33]);
        if (F8_OUT && mt == 8) { u32x2 o8; o8.x = pk4_fp8(qv[0 * 33] * 64.f, qv[1 * 33] * 64.f, qv[2 * 33] * 64.f, qv[3 * 33] * 64.f);
            o8.y = pk4_fp8(qv[4 * 33] * 64.f, qv[5 * 33] * 64.f, qv[6 * 33] * 64.f, qv[7 * 33] * 64.f);
            *(u32x2*)((unsigned char*)dst + (size_t)(nb * 32 + nn) * K + k0 + 8 * c) = o8; }
        else *(u32x4*)(dst + (size_t)(nb * 32 + nn) * K + k0 + 8 * c) = o;
        if (mt == 0) { const int d8 = nb * 32 + nn - F8_T0 * 256;
            if (d8 >= 0 && d8 < F8_NT * 256) { u32x2 o8; o8.x = pk4_fp8(qv[0 * 33] * 64.f, qv[1 * 33] * 64.f, qv[2 * 33] * 64.f, qv[3 * 33] * 64.f);
                o8.y = pk4_fp8(qv[4 * 33] * 64.f, qv[5 * 33] * 64.f, qv[6 * 33] * 64.f, qv[7 * 33] * 64.f);
                *(u32x2*)(a.ws + WS_WG8 + (size_t)d8 * DM + k0 + 8 * c) = o8; } } }
    LDS_WAIT(); asm volatile("" ::: "memory");
}
__device__ __forceinline__ void conv_load(const KA& a, int l, int mt, int sub, int kb, int nb, int lane, f32x4 (&v)[8]) {
    const int q = lane & 7, kr = lane >> 3, k0 = kb * 64; const Src s0 = conv_src(a, l, mt, sub, nb * 32 + 4 * q);
#pragma unroll
    for (int i = 0; i < 8; ++i) v[i] = *(const f32x4*)(s0.p + (size_t)(k0 + kr + 8 * i) * s0.ld);
}
__device__ __forceinline__ void conv_store(const f32x4 (&v)[8], const float* gain, int K, bf16* dst, int kb, int nb, LAS float* scr, int lane) {
    const int q = lane & 7, kr = lane >> 3, k0 = kb * 64;
#pragma unroll
    for (int i = 0; i < 8; ++i) { const float gq = gain ? gain[k0 + kr + 8 * i] : 1.f; LAS float* w = scr + (kr + 8 * i) * 33 + 4 * q;
        w[0] = v[i][0] * gq; w[1] = v[i][1] * gq; w[2] = v[i][2] * gq; w[3] = v[i][3] * gq; }
    LDS_WAIT(); asm volatile("" ::: "memory");
    const int c = lane & 7;
#pragma unroll
    for (int j = 0; j < 4; ++j) { const int nn = (lane >> 3) + 8 * j; const LAS float* qv = scr + (8 * c) * 33 + nn;
        u32x4 o; o.x = cvt_pk_bf16(qv[0 * 33], qv[1 * 33]); o.y = cvt_pk_bf16(qv[2 * 33], qv[3 * 33]); o.z = cvt_pk_bf16(qv[4 * 33], qv[5 * 33]); o.w = cvt_pk_bf16(qv[6 * 33], qv[7 * 33]);
        *(u32x4*)(dst + (size_t)(nb * 32 + nn) * K + k0 + 8 * c) = o; }
    LDS_WAIT(); asm volatile("" ::: "memory");
}
__device__ __forceinline__ void ph_conv(const KA& a, int l, LAS unsigned char* lds, int tid, int lane, int wave, int mt_lo, int mt_hi, int vb, int VG) {
    unsigned char* ws = a.ws;
    LAS float* scr = (LAS float*)(lds + wave * 16384);
    const int gw = vb * NWAVES + wave, NGW = VG * NWAVES;
    constexpr int NM = 15;
    static constexpr int mK[NM]   = {2048, 768, 512, 6144, 192, 4096, 128, 3072, 2048, 2048, 2048, 512, 2048, 2048, 1024};
    static constexpr int mN[NM]   = {ZLD, 1536, 2048, 192, 192, 128, 128, 2048, 2048, 512, 1024, 2048, 256, 2048, 2048};
    static constexpr int mS[NM]   = {1, 1, 1, 1, 1, 1, 1, 1, 1, 1, 1, 1, 1, NEXP, NEXP};
    static constexpr int mG[NM]   = {2, 5, 6, -1, -1, -1, -1, -1, -1, 18, 19, -1, 23, 23, -1};
    static constexpr size_t mD[NM] = {WS_WIN, WS_WUQ, WS_WUKV, WS_WCK1, WS_WCK2, WS_WCV1, WS_WCV2, WS_WBR, WS_WOUT, WS_WMQ, WS_WMKV, WS_WMO, WS_WR, WS_WGU, WS_WD};
    int base = 0;
#pragma unroll 1
    for (int mt = mt_lo; mt < mt_hi; ++mt) {
        const int K = mK[mt], nkb = K / 64, nnb = mN[mt] / 32, per = nkb * nnb, tot = per * mS[mt];
        const float* gain = mG[mt] >= 0 ? a.in[mG[mt]] + (size_t)l * K : nullptr;
        int first = gw - (base % NGW); if (first < 0) first += NGW;
        if (mt >= 13) {
            const int nnb2 = nnb / 2, per2 = nkb * nnb2, tot2 = per2 * mS[mt];
            int first2 = gw - ((base / 2) % NGW); if (first2 < 0) first2 += NGW;
            f32x4 vn0[8], vn1[8]; int r = first2;
            if (r < tot2) { const int sub = r / per2, q = r % per2; conv_load(a, l, mt, sub, q / nnb2, 2 * (q % nnb2), lane, vn0); conv_load(a, l, mt, sub, q / nnb2, 2 * (q % nnb2) + 1, lane, vn1); }
#pragma unroll 1
            for (; r < tot2; r += NGW) {
                f32x4 v0[8], v1[8];
#pragma unroll
                for (int i = 0; i < 8; ++i) { v0[i] = vn0[i]; v1[i] = vn1[i]; }
                const int rn = r + NGW;
                if (rn < tot2) { const int sub = rn / per2, q = rn % per2; conv_load(a, l, mt, sub, q / nnb2, 2 * (q % nnb2), lane, vn0); conv_load(a, l, mt, sub, q / nnb2, 2 * (q % nnb2) + 1, lane, vn1); }
                const int sub = r / per2, q = r % per2; bf16* dp = (bf16*)(ws + mD[mt]) + (size_t)sub * mN[mt] * K;
                conv_store(v0, gain, K, dp, q / nnb2, 2 * (q % nnb2), scr, lane);
                conv_store(v1, gain, K, dp, q / nnb2, 2 * (q % nnb2) + 1, scr, lane);
            }
        } else {
#pragma unroll 1
            for (int r = first; r < tot; r += NGW) {
                const int sub = r / per, q = r % per, kb = q / nnb, nb = q % nnb;
                conv_item(a, l, mt, sub, gain, K, (bf16*)(ws + mD[mt]) + (size_t)sub * mN[mt] * K, kb, nb, scr, lane);
            }
        }
        base += tot;
    }
    if (mt_lo != 0) return;
    float* c1p = (float*)(ws + WS_C1P);
    const int gt = vb * 512 + tid, NGT = VG * 512;
    for (int i = gt; i < 96 * 192 + 64 * 128; i += NGT) {
        float s = 0.f;
        if (i < 96 * 192) { const int ch = i / 192, n = i % 192; const float* pe = a.in[9] + (size_t)l * 6144 + ch * 64; const float* w = a.in[11] + (size_t)l * 6144 * 192 + (size_t)ch * 64 * 192 + n;
            for (int k = 0; k < 64; ++k) s += pe[k] * w[(size_t)k * 192]; }
        else { const int j = i - 96 * 192, ch = j / 128, n = j % 128; const float* pe = a.in[10] + (size_t)l * 4096 + ch * 64; const float* w = a.in[13] + (size_t)l * 4096 * 128 + (size_t)ch * 64 * 128 + n;
            for (int k = 0; k < 64; ++k) s += pe[k] * w[(size_t)k * 128]; }
        c1p[i] = s;
    }
    float* brt = (float*)(ws + WS_BRT) + 64 * l;
    if (gt < 64) brt[gt] = gt < 4 ? a.in[25][l * 4 + gt] : (gt < 36 ? a.in[27][l * 32 + gt - 4] : 0.f);
}

constexpr int MOE_ITEMS_GU = NEXP * 32 * 64, MOE_ITEMS_D = NEXP * 16 * 64, MOE_ITEMS = MOE_ITEMS_GU + MOE_ITEMS_D;
struct MoeItem { const float* src; int ld; unsigned char* dst; int K; const float* gain; bool f8; };
__device__ __forceinline__ MoeItem moe_item(const KA& a, int l, int it, int lane) {
    const int q = lane & 7, kq = lane >> 3; MoeItem m;
    if (it < MOE_ITEMS_GU) { const int e = it >> 11, r = it & 2047, kb = r >> 6, nb = r & 63, d = nb * 32 + 4 * q, j = d >> 8, w = d & 255;
        const float* base = (w < 128 ? a.in[28] : a.in[29]) + ((size_t)l * NEXP + e) * 2048 * 1024;
        m.src = base + (size_t)(kb * 64 + 8 * kq) * 1024 + j * 128 + (w & 127); m.ld = 1024; m.K = 2048;
        m.f8 = F8_GU; m.dst = a.ws + WS_WGU + (((size_t)e * 2048 + d) * 2048 + kb * 64 + 8 * kq) * (F8_GU ? 1 : 2); m.gain = a.in[23] + (size_t)l * 2048 + kb * 64 + 8 * kq; }
    else { const int t = it - MOE_ITEMS_GU, e = t >> 10, r = t & 1023, kb = r >> 6, nb = r & 63, d = nb * 32 + 4 * q;
        m.src = a.in[30] + ((size_t)l * NEXP + e) * 1024 * 2048 + (size_t)(kb * 64 + 8 * kq) * 2048 + d; m.ld = 2048; m.K = 1024;
        m.f8 = F8_DN; m.dst = a.ws + WS_WD + (((size_t)e * 2048 + d) * 1024 + kb * 64 + 8 * kq) * (F8_DN ? 1 : 2); m.gain = nullptr; }
    return m;
}
__device__ __forceinline__ void moe_load(const MoeItem& m, f32x4 (&v)[8], f32x4 (&g)[2]) {
#pragma unroll
    for (int i = 0; i < 8; ++i) v[i] = __builtin_nontemporal_load((const f32x4*)(m.src + (size_t)i * m.ld));
    g[0] = (f32x4){1.f, 1.f, 1.f, 1.f}; g[1] = g[0];
    if (m.gain) { g[0] = *(const f32x4*)m.gain; g[1] = *(const f32x4*)(m.gain + 4); }
}
__device__ __forceinline__ void moe_store(const MoeItem& m, const f32x4 (&v)[8], const f32x4 (&g)[2]) {
    const f32x4 g0 = g[0], g1 = g[1];
    if (m.f8) {
#pragma unroll
        for (int j = 0; j < 4; ++j) { u32x2 o; o.x = pk4_fp8(v[0][j] * g0[0] * 64.f, v[1][j] * g0[1] * 64.f, v[2][j] * g0[2] * 64.f, v[3][j] * g0[3] * 64.f);
            o.y = pk4_fp8(v[4][j] * g1[0] * 64.f, v[5][j] * g1[1] * 64.f, v[6][j] * g1[2] * 64.f, v[7][j] * g1[3] * 64.f);
            __builtin_nontemporal_store(o, (u32x2*)(m.dst + (size_t)j * m.K)); }
    } else {
#pragma unroll
        for (int j = 0; j < 4; ++j) { u32x4 o; o.x = cvt_pk_bf16(v[0][j] * g0[0], v[1][j] * g0[1]); o.y = cvt_pk_bf16(v[2][j] * g0[2], v[3][j] * g0[3]);
            o.z = cvt_pk_bf16(v[4][j] * g1[0], v[5][j] * g1[1]); o.w = cvt_pk_bf16(v[6][j] * g1[2], v[7][j] * g1[3]);
            __builtin_nontemporal_store(o, (u32x4*)(m.dst + (size_t)j * m.K * 2)); }
    }
}
__device__ __forceinline__ void moe_convert(const KA& a, int l, int gw, int NGW, int n0, int n1, int lane) {
#pragma unroll 1
    for (int n = n0; n < n1; n += 4) {
        const int i0 = gw + n * NGW;
        if (i0 >= MOE_ITEMS) break;
        const bool h1 = (n + 1 < n1) && (i0 + NGW < MOE_ITEMS), h2 = (n + 2 < n1) && (i0 + 2 * NGW < MOE_ITEMS), h3 = (n + 3 < n1) && (i0 + 3 * NGW < MOE_ITEMS);
        const MoeItem m0 = moe_item(a, l, i0, lane), m1 = moe_item(a, l, h1 ? i0 + NGW : i0, lane), m2 = moe_item(a, l, h2 ? i0 + 2 * NGW : i0, lane), m3 = moe_item(a, l, h3 ? i0 + 3 * NGW : i0, lane);
        f32x4 v0[8], v1[8], v2[8], v3[8], g0[2], g1[2], g2[2], g3[2];
        moe_load(m0, v0, g0); moe_load(m1, v1, g1); moe_load(m2, v2, g2); moe_load(m3, v3, g3);
        moe_store(m0, v0, g0); if (h1) moe_store(m1, v1, g1); if (h2) moe_store(m2, v2, g2); if (h3) moe_store(m3, v3, g3);
    }
}
__device__ __forceinline__ int q_next(gu32* q, LAS int* slot, int tid) {
    LDS_WAIT(); __syncthreads();
    if (tid == 0) *slot = (int)atomicAdd((unsigned*)q, 1u);
    LDS_WAIT(); __syncthreads();
    return __builtin_amdgcn_readfirstlane(*slot);
}
struct MoeConvHook {
    const KA* a; int l, gw, NGW, per, g;
    __device__ __forceinline__ void run(int ui) const {
        if (((ui ^ g) & 3) == 0) { const int k = ui >> 2; moe_convert(*a, l, gw, NGW, k * per, (k + 1) * per, llane()); asm volatile("s_waitcnt vmcnt(0)" ::: "memory"); }
    }
};

__device__ __forceinline__ void cumsum_item(int it, const float* zs, const float* bf, float* kb, int lane) {
    const int b = it >> 3, h = it & 7; const float bias = bf[h];
    float v[32]; float run = 0.f;
#pragma unroll
    for (int i = 0; i < 32; ++i) { const float x = zs[(size_t)(b * SEQ + lane * 32 + i) * 32 + h] + bias; const float ls = fminf(x, 0.f) - log1pf(__expf(-fabsf(x))); run += ls; v[i] = run; }
    float incl = run;
#pragma unroll
    for (int o = 1; o < 64; o <<= 1) { const float y = __int_as_float(__builtin_amdgcn_ds_bpermute(((lane - o) & 63) << 2, __float_as_int(incl))); if (lane >= o) incl += y; }
    const float excl = incl - run;
    float* dst = kb + (size_t)it * SEQ + lane * 32;
#pragma unroll
    for (int i = 0; i < 32; ++i) dst[i] = -(excl + v[i]) * LOG2E;
}

__device__ __forceinline__ float gelu_tanh(float x) { return 0.5f * x * (1.f + tanhf(0.7978845608028654f * (x + 0.044715f * x * x * x))); }
template <int DD>
__device__ __forceinline__ void compress_body(int b, int g, int ct, const bf16* zsrc  , const bf16* w1t, const bf16* w2t,
                                              const float* c1p, int nchunk, bf16* out, LAS unsigned char* lds, int tid, unsigned* dbgw) {
    constexpr int KD = 32 * DD, NCB = DD / 64, KH = KD / 2, NST = KH / 32, HP = DD + 8;
    const int lane = tid & 63, w = tid >> 6, cg = w & 3, kh = w >> 2, lr = lane & 15, kg = lane >> 4;
    LAS float* red = (LAS float*)lds;
    LAS float* c1s = (LAS float*)(lds + 32 * DD * 4);
    LAS bf16* hid = (LAS bf16*)(lds + 32 * DD * 4 + DD * 4);
    if (tid < DD) { float s = 0.f; for (int ch = 0; ch < nchunk; ++ch) s += c1p[ch * DD + tid]; c1s[tid] = s; }
    const bf16* abase[2];
#pragma unroll
    for (int rb = 0; rb < 2; ++rb) { int c = 32 * ct + 16 * rb + lr; c = c < 126 ? c : 126; abase[rb] = zsrc + (size_t)(b * SEQ + 16 * c) * ZLD + g * DD + 8 * kg; }
    const bf16* bbase = w1t + (size_t)(16 * cg * NCB + lr) * KD + 8 * kg;
    f32x4 acc[2][NCB];
#pragma unroll
    for (int rb = 0; rb < 2; ++rb)
#pragma unroll
        for (int cb = 0; cb < NCB; ++cb) acc[rb][cb] = (f32x4){0.f, 0.f, 0.f, 0.f};
#pragma unroll 1
    for (int s4 = 0; s4 < NST; s4 += 8) {
        bf16x8 af[8][2], bfr[8][NCB];
#pragma unroll
        for (int q = 0; q < 8; ++q) { const int k0 = kh * KH + 32 * (s4 + q), lrow = k0 / DD, dcol = k0 % DD;
#pragma unroll
            for (int rb = 0; rb < 2; ++rb) af[q][rb] = *(const bf16x8*)(abase[rb] + (size_t)lrow * ZLD + dcol);
#pragma unroll
            for (int cb = 0; cb < NCB; ++cb) bfr[q][cb] = *(const bf16x8*)(bbase + (size_t)(16 * cb) * KD + k0); }
#pragma unroll
        for (int q = 0; q < 8; ++q)
#pragma unroll
            for (int rb = 0; rb < 2; ++rb)
#pragma unroll
                for (int cb = 0; cb < NCB; ++cb) acc[rb][cb] = __builtin_amdgcn_mfma_f32_16x16x32_bf16(af[q][rb], bfr[q][cb], acc[rb][cb], 0, 0, 0);
    }
    if (kh == 1) {
#pragma unroll
        for (int rb = 0; rb < 2; ++rb)
#pragma unroll
            for (int cb = 0; cb < NCB; ++cb)
#pragma unroll
                for (int r = 0; r < 4; ++r) red[(16 * rb + 4 * kg + r) * DD + 16 * (cg * NCB + cb) + lr] = acc[rb][cb][r];
    }
    LDS_WAIT(); __syncthreads();
    if (kh == 0) {
#pragma unroll
        for (int rb = 0; rb < 2; ++rb)
#pragma unroll
            for (int cb = 0; cb < NCB; ++cb)
#pragma unroll
                for (int r = 0; r < 4; ++r) { const int row = 16 * rb + 4 * kg + r, col = 16 * (cg * NCB + cb) + lr;
                    const float x = acc[rb][cb][r] + red[row * DD + col] + c1s[col]; hid[row * HP + col] = f2bf(gelu_tanh(x));
                    }
    }
    LDS_WAIT(); __syncthreads();
#if defined(COMPRESS_S2_SCALAR)
    for (int o = tid; o < 32 * DD; o += 512) { const int row = o / DD, col = o % DD; float s2 = 0.f; const bf16* wr = w2t + (size_t)col * DD;
        for (int j = 0; j < DD; ++j) s2 += bf2f(hid[row * HP + j]) * bf2f(wr[j]);
        const int c = 32 * ct + row; out[((size_t)(b * 2 + g) * 128 + c) * DD + col] = c < 127 ? f2bf(s2) : (bf16)0; }
#else
    constexpr int NBLK = 2 * (DD / 16);
    for (int blk = w; blk < NBLK; blk += 8) {
        const int rb = blk & 1, cb = blk >> 1;
        f32x4 c4 = (f32x4){0.f, 0.f, 0.f, 0.f};
#pragma unroll
        for (int s = 0; s < DD / 32; ++s) {
            const bf16x8 af = *(const LAS bf16x8*)(hid + (16 * rb + lr) * HP + 32 * s + 8 * kg);
            const bf16x8 bfr = *(const bf16x8*)(w2t + (size_t)(16 * cb + lr) * DD + 32 * s + 8 * kg);
            c4 = __builtin_amdgcn_mfma_f32_16x16x32_bf16(af, bfr, c4, 0, 0, 0);
            asm volatile("" :: "v"(af), "v"(bfr));
        }
#pragma unroll
        for (int r = 0; r < 4; ++r) { const int c = 32 * ct + 16 * rb + 4 * kg + r; out[((size_t)(b * 2 + g) * 128 + c) * DD + 16 * cb + lr] = c < 127 ? f2bf(c4[r]) : (bf16)0; }
    }
#endif
    LDS_WAIT(); __syncthreads();
}

template <int DD>
__device__ __forceinline__ void compress_ref(int b, int g, int c, const bf16* zsrc, const bf16* w1t, const bf16* w2t, const float* c1p, int nchunk, bf16* out, LAS unsigned char* lds, int tid) {
    constexpr int KD = 32 * DD;
    LAS float* hid = (LAS float*)lds;
    if (tid < DD) {
        float s = 0.f; for (int ch = 0; ch < nchunk; ++ch) s += c1p[ch * DD + tid];
        const bf16* wr = w1t + (size_t)tid * KD;
        for (int l = 0; l < 32; ++l) { const bf16* zr = zsrc + (size_t)(b * SEQ + 16 * c + l) * ZLD + g * DD;
            for (int d = 0; d < DD; d += 8) { const u32x4 zv = *(const u32x4*)(zr + d), wv = *(const u32x4*)(wr + l * DD + d);
                s += bflo(zv.x) * bflo(wv.x) + bfhi(zv.x) * bfhi(wv.x) + bflo(zv.y) * bflo(wv.y) + bfhi(zv.y) * bfhi(wv.y) + bflo(zv.z) * bflo(wv.z) + bfhi(zv.z) * bfhi(wv.z) + bflo(zv.w) * bflo(wv.w) + bfhi(zv.w) * bfhi(wv.w); } }
        hid[tid] = bf2f(f2bf(gelu_tanh(s)));
    }
    LDS_WAIT(); __syncthreads();
    if (tid < DD) { float s = 0.f; const bf16* wr = w2t + (size_t)tid * DD; for (int j = 0; j < DD; ++j) s += hid[j] * bf2f(wr[j]); out[((size_t)(b * 2 + g) * 128 + c) * DD + tid] = f2bf(s); }
    LDS_WAIT(); __syncthreads();
}

constexpr float CS128 = 0.08838834764831845f * LOG2E, CS192 = 0.07216878364870323f * LOG2E;
constexpr int WBIG = 1 << 30;

__device__ __forceinline__ void fox_sub(int b, int h, int qt, const bf16* z, const float* kb, bf16* ofox, LAS unsigned char* lds, int tid) {
    const int lane = tid & 63, w = tid >> 6, tw0 = 256 * qt + 32 * w, t = tw0 + (lane & 31); const size_t row = (size_t)b * SEQ + t;
    bf16x8 qf[8]; att::load_q<128>(qf, z + row * ZLD + ZC_FQ + h * 128, lane);
    LAS float* kbl = (LAS float*)(lds + att::KB_OFF);
    if (tid * 4 < 256 * (qt + 1)) *(LAS f32x4*)(kbl + tid * 4) = *(const f32x4*)(kb + (size_t)(b * 8 + h) * SEQ + tid * 4);
    att::State st; att::state_init(st);
    att::attn_run<128, true, true, false, false>(lds, z + (size_t)b * SEQ * ZLD + ZC_FK + h * 128, ZLD, z + (size_t)b * SEQ * ZLD + ZC_FV + h * 128, ZLD, 0, 4 * (qt + 1),
                                                 qf, t, tw0, WBIG, kbl, nullptr, 0u, CS128, st, tid);
    att::store_o<0>(st, 1.f / st.l, ofox + row * 3072 + h * 128, nullptr, lane);
}
__device__ __forceinline__ void mla_sub(int b, int h, int qt, const bf16* qm, const bf16* km, const bf16* vm, bf16* omla, LAS unsigned char* lds, int tid) {
    const int lane = tid & 63, w = tid >> 6, tw0 = 256 * qt + 32 * w, t = tw0 + (lane & 31); const size_t row = (size_t)b * SEQ + t;
    bf16x8 qf[12]; att::load_q<192>(qf, qm + row * 1536 + h * 192, lane);
    att::State st; att::state_init(st);
    att::attn_run<192, true, false, false, false>(lds, km + (size_t)b * SEQ * 1536 + h * 192, 1536, vm + (size_t)b * SEQ * 1024 + h * 128, 1024, 0, 4 * (qt + 1),
                                                  qf, t, tw0, WBIG, nullptr, nullptr, 0u, CS192, st, tid);
    att::store_o<0>(st, 1.f / st.l, omla + row * 3072 + h * 128, nullptr, lane);
}
__device__ __forceinline__ void mem_unit(int uid, const bf16* qmem, const bf16* kvmem, bf16* omem, LAS unsigned char* lds, int tid) {
    const int b = uid >> 5, h = (uid >> 3) & 3, qt = uid & 7;
    const int lane = tid & 63, w = tid >> 6, tw0 = 256 * qt + 32 * w, t = tw0 + (lane & 31); const size_t row = (size_t)b * SEQ + t;
    bf16x8 qf[8]; att::load_q<128>(qf, qmem + row * 512 + h * 128, lane);
    att::State st; att::state_init(st);
    att::attn_run<128, false, false, false, false>(lds, kvmem + (size_t)b * MEML * 1024 + h * 128, 1024, kvmem + (size_t)b * MEML * 1024 + 512 + h * 128, 1024, 0, 4,
                                                   qf, t, tw0, WBIG, nullptr, nullptr, 0u, CS128, st, tid);
    att::store_o<0>(st, 1.f / st.l, omem + row * 512 + h * 128, nullptr, lane);
}
__device__ __forceinline__ void nsa_tabs(const float* tabd, int g, LAS unsigned char* lds, int tid) {
    LAS float* tab = (LAS float*)(lds + att::TAB_OFF);
    for (int i = tid; i < 4 * 132; i += 512) tab[i] = tabd[g * 4 * 132 + i];
    LDS_WAIT(); __syncthreads();
}
__device__ __forceinline__ void nsa_win_unit(int uid, const bf16* z, const float* zs, const float* tabd, bf16* ow, LAS unsigned char* lds, int tid) {
    const int b = uid >> 6, g = (uid >> 5) & 1, qt = uid & 31;
    const int lane = tid & 63, w = tid >> 6, hh = w >> 1, head = g * 4 + hh, tw0 = 64 * qt + 32 * (w & 1), t = tw0 + (lane & 31); const size_t row = (size_t)b * SEQ + t;
    nsa_tabs(tabd, g, lds, tid);
    bf16x8 qf[12]; att::load_q<192>(qf, z + row * ZLD + ZC_NQ + head * 192, lane);
    att::State st; att::state_init(st);
    att::attn_run<192, true, false, true, false>(lds, z + (size_t)b * SEQ * ZLD + ZC_NKW + g * 192, ZLD, z + (size_t)b * SEQ * ZLD + ZC_NVW + g * 128, ZLD, qt >= 8 ? qt - 8 : 0, qt + 1,
                                                 qf, t, tw0, 512, nullptr, (const LAS float*)(lds + att::TAB_OFF) + hh * 132, 0u, CS192, st, tid);
    const float g2 = sigmoidf_(zs[row * 32 + 8 + head * 3 + 2]);
    att::store_o<0>(st, g2 / st.l, ow + row * 1024 + head * 128, nullptr, lane);
}
__device__ __forceinline__ void nsa_cmp_sub(int b, int g, int qt, const bf16* z, const float* zs, const float* tabd, const bf16* kc, const bf16* vc, bf16* ow, unsigned* rmaskg,
                                            LAS unsigned char* lds, int tid) {
    const int lane = tid & 63, w = tid >> 6, hh = w >> 1, head = g * 4 + hh, hf = w & 1, tw0 = 64 * qt + 32 * hf, t = tw0 + (lane & 31), hi = lane >> 5; const size_t row = (size_t)b * SEQ + t;
    const int rowl = 32 * hf + (lane & 31);
    nsa_tabs(tabd, g, lds, tid);
    const LAS float* tab = (const LAS float*)(lds + att::TAB_OFF) + hh * 132;
    {
        const bf16* Kc = kc + (size_t)(b * 2 + g) * 128 * 192; const bf16* Vc = vc + (size_t)(b * 2 + g) * 128 * 128;
        att::dma_tile<192>(lds, Kc, 192, Vc, 128, 0, __builtin_amdgcn_readfirstlane(w), lane);
        att::dma_tile<192>(lds + att::Geo<192>::BUF, Kc, 192, Vc, 128, 1, __builtin_amdgcn_readfirstlane(w), lane);
    }
    VM_WAIT(); LDS_WAIT(); __syncthreads();
    bf16x8 qf[12]; att::load_q<192>(qf, z + row * ZLD + ZC_NQ + head * 192, lane);
    att::State st; att::state_init(st);
    float impm[16], impt[1];
#pragma unroll
    for (int i = 0; i < 16; ++i) impm[i] = 0.f;
    impt[0] = 0.f;
    att::tile_compute<192, true, false, true, false, true, 0>(lds, 0, qf, t, tw0, 0x7fffffff, nullptr, tab, 0u, CS192, st, impm, impt, lane);
    att::tile_compute<192, true, false, true, false, true, 1>(lds + att::Geo<192>::BUF, 1, qf, t, tw0, 0x7fffffff, nullptr, tab, 0u, CS192, st, impm, impt, lane);
    LDS_WAIT(); __syncthreads();
    const float inv = st.l > 0.f ? 1.f / st.l : 0.f;
    LAS float* IA = (LAS float*)lds;
#pragma unroll
    for (int i = 0; i < 16; ++i) { const int n = 16 * (i >> 3) + 8 * ((i >> 2) & 1) + 2 * (i & 3) + hi; IA[(hh * 64 + rowl) * 33 + n] = impm[i] * inv; }
    const float g0 = sigmoidf_(zs[row * 32 + 8 + head * 3 + 0]);
    att::store_o<1>(st, g0 * inv, ow + row * 1024 + head * 128, nullptr, lane);
    LDS_WAIT(); __syncthreads();
    {
        const int cur = qt, n = lane & 31;
#pragma unroll 1
        for (int ps = 0; ps < 4; ++ps) {
            const int r = w * 8 + ps * 2 + (lane >> 5);
            float imp = 0.f;
#pragma unroll
            for (int q = 0; q < 4; ++q) imp += IA[(q * 64 + r) * 33 + n];
            unsigned mask;
            if (cur < 8) mask = (2u << cur) - 1u;
            else {
                mask = 1u | (1u << cur) | (1u << (cur - 1));
                float val = (n >= 1 && n <= cur - 2) ? imp : -1.f;
#pragma unroll 1
                for (int k = 0; k < 5; ++k) {
                    float vm = val;
#pragma unroll
                    for (int o = 1; o < 32; o <<= 1) vm = fmaxf(vm, shx(vm, o, lane));
                    const unsigned long long bal = __ballot(val == vm && val >= 0.f);
                    const unsigned hm = (unsigned)(bal >> (lane & 32));
                    const int best = __ffs(hm) - 1;
                    mask |= 1u << best; if (n == best) val = -1.f;
                }
            }
            if (n == 0) rmaskg[(size_t)(b * 2 + g) * SEQ + 64 * qt + r] = mask;
        }
    }
    VM_WAIT(); LDS_WAIT(); __syncthreads();
}
__device__ __forceinline__ void nsa_sel_sub(int b, int g, int qt, const bf16* z, const float* zs, const float* tabd, const bf16* ow, const unsigned* rmaskg, bf16* onsa,
                                            LAS unsigned char* lds, int tid) {
    const int lane = tid & 63, w = tid >> 6, hh = w >> 1, head = g * 4 + hh, hf = w & 1, tw0 = 64 * qt + 32 * hf, t = tw0 + (lane & 31); const size_t row = (size_t)b * SEQ + t;
    nsa_tabs(tabd, g, lds, tid);
    const LAS float* tab = (const LAS float*)(lds + att::TAB_OFF) + hh * 132;
    bf16x8 qf[12]; att::load_q<192>(qf, z + row * ZLD + ZC_NQ + head * 192, lane);
    const unsigned rowmask = rmaskg[(size_t)(b * 2 + g) * SEQ + t];
    att::State st; att::state_init(st);
    att::attn_run<192, true, false, true, true>(lds, z + (size_t)b * SEQ * ZLD + ZC_NKS + g * 192, ZLD, z + (size_t)b * SEQ * ZLD + ZC_NVS + g * 128, ZLD, 0, qt + 1,
                                                qf, t, tw0, WBIG, nullptr, tab, rowmask, CS192, st, tid);
    const float g1 = sigmoidf_(zs[row * 32 + 8 + head * 3 + 1]);
    att::store_o<2>(st, g1 / st.l, onsa + row * 3072 + head * 128, ow + row * 1024 + head * 128, lane);
}

__device__ __forceinline__ void ph_route1(const float* plog, const float* hssq, const float* bias, float* rstd2, unsigned* cnt, int* asge, int* asgi, float* asgw, int tid) {
    for (int t = blockIdx.x * 512 + tid; t < NT; t += gridDim.x * 512) {
        float ss = 0.f;
#pragma unroll
        for (int j = 0; j < 8; ++j) { const f32x4 p = *(const f32x4*)(hssq + (size_t)t * 32 + 4 * j); ss += (p[0] + p[1]) + (p[2] + p[3]); }
        const float rs = rsqrtf(ss * (1.f / 2048.f) + EPS); rstd2[t] = rs;
        f32x4 gl = *(const f32x4*)(plog + (size_t)t * 64);
#pragma unroll
        for (int sl = 1; sl < 4; ++sl) gl += *(const f32x4*)(plog + (size_t)sl * NT * 64 + (size_t)t * 64);
        gl = gl * rs + *(const f32x4*)bias;
        int gs = 0; float gm = gl[0];
        if (gl[1] > gm) { gm = gl[1]; gs = 1; } if (gl[2] > gm) { gm = gl[2]; gs = 2; } if (gl[3] > gm) { gm = gl[3]; gs = 3; }
        const float pg = 1.f / (expf(gl[0] - gm) + expf(gl[1] - gm) + expf(gl[2] - gm) + expf(gl[3] - gm));
        f32x4 e0 = *(const f32x4*)(plog + (size_t)t * 64 + 4 + gs * 8), e1 = *(const f32x4*)(plog + (size_t)t * 64 + 8 + gs * 8);
#pragma unroll
        for (int sl = 1; sl < 4; ++sl) { e0 += *(const f32x4*)(plog + (size_t)sl * NT * 64 + (size_t)t * 64 + 4 + gs * 8); e1 += *(const f32x4*)(plog + (size_t)sl * NT * 64 + (size_t)t * 64 + 8 + gs * 8); }
        e0 = e0 * rs + *(const f32x4*)(bias + 4 + gs * 8); e1 = e1 * rs + *(const f32x4*)(bias + 8 + gs * 8);
        float ev[8] = {e0[0], e0[1], e0[2], e0[3], e1[0], e1[1], e1[2], e1[3]};
        int j0 = 0; float v0 = ev[0];
#pragma unroll
        for (int j = 1; j < 8; ++j) if (ev[j] > v0) { v0 = ev[j]; j0 = j; }
        int j1 = -1; float v1 = -3.0e38f;
#pragma unroll
        for (int j = 0; j < 8; ++j) if (j != j0 && ev[j] > v1) { v1 = ev[j]; j1 = j; }
        const float x1 = expf(v1 - v0), w0 = pg / (1.f + x1), w1 = pg * x1 / (1.f + x1);
        const int ea = gs * 8 + j0, eb = gs * 8 + j1;
        asge[2 * t] = ea; asge[2 * t + 1] = eb; asgw[2 * t] = w0; asgw[2 * t + 1] = w1;
        asgi[2 * t] = (int)atomicAdd(cnt + ea, 1u); asgi[2 * t + 1] = (int)atomicAdd(cnt + eb, 1u);
    }
}
__device__ __forceinline__ void ph_route2(const unsigned* cnt, const int* asge, const int* asgi, const float* asgw, const float* rstd2,
                                          int* pos, float* roww, float* rowr, int* tile, int* rowtok, LAS unsigned char* lds, int tid) {
    LAS int* ps = (LAS int*)lds;
    if (tid < NEXP) ps[64 + tid] = (int)cnt[tid];
    LDS_WAIT(); __syncthreads();
    if (tid == 0) { int acc = 0;
#pragma unroll 1
        for (int e = 0; e < NEXP; ++e) { const int c = ps[64 + e]; ps[e] = acc; acc += ((c + 255) >> 8) << 8; } ps[32] = acc; }
    LDS_WAIT(); __syncthreads();
    if (blockIdx.x == 0 && tid == 0) { int rt = 0;
#pragma unroll 1
        for (int e = 0; e < NEXP; ++e) { const int n = (ps[e + 1] - ps[e]) >> 8;
#pragma unroll 1
            for (int i = 0; i < n; ++i) tile[rt++] = e; }
        tile[200] = rt;
#pragma clang loop vectorize(disable) unroll(disable)
        for (; rt < 200; ++rt) tile[rt] = -1; }
    const int gt = blockIdx.x * 512 + tid, NGT = gridDim.x * 512;
    for (int it = gt; it < NT * 2; it += NGT) {
        const int e = asge[it], dest = ps[e] + asgi[it], t = it >> 1;
        roww[dest] = asgw[it]; rowr[dest] = rstd2[t]; pos[it] = dest; rowtok[dest] = t;
    }
    for (int it = gt; it < NEXP * 256; it += NGT) {
        const int e = it >> 8, r = it & 255, c = ps[64 + e], pc = ps[e + 1] - ps[e] - c;
        if (r < pc) { const int dest = ps[e] + c + r; roww[dest] = 0.f; rowr[dest] = 0.f; rowtok[dest] = 0; }
    }
}
__device__ __forceinline__ void ph_combine(const bf16* y, const int* pos, bf16* hbf, unsigned char* h8, float* rstd0, const float* gfin, float* out, bool last, int lane, int wave) {
    const int gw = blockIdx.x * NWAVES + wave, NGW = gridDim.x * NWAVES;
    for (int t = gw; t < NT; t += NGW) {
        const int p0 = pos[2 * t], p1 = pos[2 * t + 1];
        u32x2* hr = (u32x2*)(hbf + (size_t)t * DM) + lane; const u32x2* y0 = (const u32x2*)(y + (size_t)p0 * DM) + lane; const u32x2* y1 = (const u32x2*)(y + (size_t)p1 * DM) + lane;
        f32x4 v[8]; float s = 0.f;
#pragma unroll
        for (int j = 0; j < 8; ++j) { const u32x2 a = y0[64 * j], c = y1[64 * j], hw = hr[64 * j]; f32x4 h;
            h[0] = (bflo(hw.x) + bflo(a.x)) + bflo(c.x); h[1] = (bfhi(hw.x) + bfhi(a.x)) + bfhi(c.x); h[2] = (bflo(hw.y) + bflo(a.y)) + bflo(c.y); h[3] = (bfhi(hw.y) + bfhi(a.y)) + bfhi(c.y);
            v[j] = h; s += dot4v(h); }
        s = wave_sum(s, lane); const float rs = rsqrtf(s * (1.f / 2048.f) + EPS);
        if (!last) {
#pragma unroll
            for (int j = 0; j < 8; ++j) { u32x2 w; w.x = cvt_pk_bf16(v[j][0], v[j][1]); w.y = cvt_pk_bf16(v[j][2], v[j][3]); hr[64 * j] = w; }
#pragma unroll
            for (int j = 0; j < 8; ++j) ((unsigned*)(h8 + (size_t)t * DM))[lane + 64 * j] = pk4_fp8(v[j][0], v[j][1], v[j][2], v[j][3]);
            if (lane == 0) rstd0[t] = rs;
        } else {
            f32x4* orow = (f32x4*)(out + (size_t)t * DM) + lane; const f32x4* gr = (const f32x4*)gfin + lane;
#pragma unroll
            for (int j = 0; j < 8; ++j) orow[64 * j] = v[j] * rs * gr[64 * j];
        }
    }
}
__device__ __forceinline__ GAS unsigned char* lws(unsigned char* p) { const unsigned long long v0 = (unsigned long long)p; unsigned lo = (unsigned)v0, hi = (unsigned)(v0 >> 32);
    { unsigned lv, hv; asm volatile("v_mov_b32 %0, %2\n\tv_mov_b32 %1, %3" : "=&v"(lv), "=&v"(hv) : "s"(lo), "s"(hi)); lo = __builtin_amdgcn_readfirstlane(lv); hi = __builtin_amdgcn_readfirstlane(hv); } return (GAS unsigned char*)(((unsigned long long)hi << 32) | lo); }
#define ltid() (wave0 * 64 + llane())
constexpr int NCONV_BLOCKS = 32;
constexpr int NPH_LAYER = 15, NPHASES = 1 + DEPTH * NPH_LAYER;
__device__ __forceinline__ KA kargs() {
    KA k;
#if defined(__HIP_DEVICE_COMPILE__)
    const unsigned long long v0 = (unsigned long long)(KArgP)__builtin_amdgcn_kernarg_segment_ptr(); unsigned lo = (unsigned)v0, hi = (unsigned)(v0 >> 32);
    { unsigned lv, hv; asm volatile("v_mov_b32 %0, %2\n\tv_mov_b32 %1, %3" : "=&v"(lv), "=&v"(hv) : "s"(lo), "s"(hi)); lo = __builtin_amdgcn_readfirstlane(lv); hi = __builtin_amdgcn_readfirstlane(hv); }
    k.in.p = (KArgP)(((unsigned long long)hi << 32) | lo); k.out = k.in.p->out; k.ws = k.in.p->ws;
#else
    k.in.p = nullptr; k.out = nullptr; k.ws = nullptr;
#endif
    return k;
}
__global__ void __launch_bounds__(512, 2) fwd(Args a) {
    extern __shared__ __attribute__((aligned(16))) unsigned char lds_[];
    LAS unsigned char* lds = (LAS unsigned char*)lds_;
    const int tid = threadIdx.x; const int wave0 = __builtin_amdgcn_readfirstlane(tid >> 6);
    const int G = gridDim.x, bx = blockIdx.x;
    gu32* ctl = (gu32*)(a.ws + WS_CTL);
    for (int u = tid; u < (LDS_BYTES - LDSCTL_OFF) / 4; u += 512) ((LAS unsigned*)(lds + LDSCTL_OFF))[u] = 0u;
    __syncthreads();
    const int lo = a.ph_lo, hi = a.ph_hi;
    XcdBarrier bar; bar.bar = (unsigned*)ctl + CW_BAR; bar.x = 0; bar.st = nullptr;
    if (hi - lo > 1) bar = xcd_barrier_post((unsigned*)ctl + CW_BAR, (volatile LAS unsigned*)(lds + MISC_OFF) + 8);
#define IN(k) (lo <= (k) && (k) < hi)
#if defined(TIMING_A)
#define STAMP(k) do { const unsigned long long now_ = __builtin_amdgcn_s_memrealtime(); GAS unsigned char* wsp_ = lws(a.ws); if (bx == 0 && llane() == 0 && wave0 == 0) { ((volatile GAS unsigned long long*)(wsp_ + WS_DBG))[8 + (k)] = now_; } } while (0)
#else
#define STAMP(k) do { } while (0)
#endif
#define SEAM(k) do { if (IN(k) && IN((k) + 1)) xcd_barrier(bar); STAMP(k); } while (0)

#define hbf ((bf16*)(ws + WS_HBF))
#define hf ((float*)(ws + WS_HF))
#define z ((bf16*)(ws + WS_Z))
#define zs ((float*)(ws + WS_ZS))
#define zssq ((float*)(ws + WS_ZSSQ))
#define hssq ((float*)(ws + WS_HSSQ))
#define rstd0 ((float*)(ws + WS_RSTD0))
#define rstd2 ((float*)(ws + WS_RSTD2))
#define qm ((bf16*)(ws + WS_QM))
#define km ((bf16*)(ws + WS_KM))
#define vm ((bf16*)(ws + WS_VM))
#define kc ((bf16*)(ws + WS_KC))
#define vc ((bf16*)(ws + WS_VC))
#define kb ((float*)(ws + WS_KB))
#define o3 ((bf16*)(ws + WS_O3))
#define ow ((bf16*)(ws + WS_OW))
#define mpart ((float*)(ws + WS_MPART))
#define mbf ((bf16*)(ws + WS_MBF))
#define qmem ((bf16*)(ws + WS_QMEM))
#define kvmem ((bf16*)(ws + WS_KVMEM))
#define omem ((bf16*)(ws + WS_OMEM))
#define logits ((float*)(ws + WS_LOGIT))
#define rope ((const float*)(ws + WS_ROPE))
#define tabd ((const float*)(ws + WS_TABD))
#define asge ((int*)(ws + WS_ASGE))
#define asgi ((int*)(ws + WS_ASGI))
#define asgw ((float*)(ws + WS_ASGW))
#define pos ((int*)(ws + WS_POS))
#define roww ((float*)(ws + WS_ROWW))
#define rowr ((float*)(ws + WS_ROWR))
#define tile ((int*)(ws + WS_TILE))
#define xg ((bf16*)(ws + WS_XG))
#define hdn ((bf16*)(ws + WS_HDN))
#define yb ((bf16*)(ws + WS_Y))
#ifndef PHMASK
#define PHMASK 0xFFFFFFFFu
#endif
#define EN(k) ((PHMASK >> (k)) & 1u)
    if (lo == 0) { STAMP(-1); }
    if (EN(0) && IN(0)) { asm volatile("; PHMARK 0"); const KA a = kargs(); GAS unsigned char* ws = lws(a.ws); (void)ws; { const int t_ = ltid(); ph_pre(a, t_, t_ & 63, __builtin_amdgcn_readfirstlane(t_ >> 6)); } }
#pragma unroll 1
    for (int l = -1; l < DEPTH; ++l) {
        const int pb = 1 + NPH_LAYER * l;
        if (l >= 0) {
        if (EN(2) && IN(pb + 1)) { asm volatile("; PHMARK 2"); const KA a = kargs(); GAS unsigned char* ws = lws(a.ws); (void)ws;
            if (EN(16)) { pg8::Gemm g{hbf, (const bf16*)(ws + WS_WIN), DM, DM}; pg8::WinOrder S; S.init(NT, (55 - F8_NT) * 256, G, bx);
              pg8::EpiWin E{z, zs, zssq, rstd0, km, rope}; pg8::gemm_phase(lds, g, S, E, ltid()); }
            if (EN(16)) { pg8::Gemm g{(const bf16*)(ws + WS_H8), (const bf16*)(ws + WS_WG8), DM / 2, DM / 2}; pg8::StaticOrder S; S.init(NT, F8_NT * 256, G, G - 1 - bx);
              pg8::EpiWin8 E{z, rstd0}; pg8::gemm_phase(lds, g, S, E, ltid()); }
        }
        SEAM(pb + 1);
        if (EN(3) && IN(pb + 2)) { asm volatile("; PHMARK 3"); const KA a = kargs(); GAS unsigned char* ws = lws(a.ws); (void)ws;
            if (EN(18)) { pg8::Gemm g{z + ZC_MCQ, (const bf16*)(ws + WS_WUQ), ZLD, 768}; pg8::StaticOrder S; S.init(NT, 1536, G, bx);
              pg8::EpiMlaQ E{qm, zssq, rope}; pg8::gemm_phase(lds, g, S, E, ltid()); }
            if (EN(19)) { pg8::Gemm g{z + ZC_MCKV, (const bf16*)(ws + WS_WUKV), ZLD, 512}; pg8::StaticOrder S; S.init(NT, 2048, G, bx);
              pg8::EpiMlaKV E{km, vm, zssq}; pg8::gemm_phase(lds, g, S, E, ltid()); }
            if (EN(21)) { const int t_ = ltid(); for (int it = (G - 1 - bx) * NWAVES + __builtin_amdgcn_readfirstlane(t_ >> 6); it < 64; it += G * NWAVES) cumsum_item(it, zs, a.in[4] + l * 8, kb, t_ & 63); }
#if defined(COMPRESS_REF)
            if (EN(22)) for (int u = bx; u < 2 * 16 * 128; u += G) {
                const int br = u >> 11, rem = u & 2047, bg = rem >> 7, c = rem & 127; const int t_ = ltid();
                if (c < 127) { if (br == 0) compress_ref<192>(bg >> 1, bg & 1, c, z + ZC_NKC, (const bf16*)(ws + WS_WCK1), (const bf16*)(ws + WS_WCK2), (const float*)(ws + WS_C1P), 96, kc, lds, t_);
                               else compress_ref<128>(bg >> 1, bg & 1, c, z + ZC_NVC, (const bf16*)(ws + WS_WCV1), (const bf16*)(ws + WS_WCV2), (const float*)(ws + WS_C1P) + 96 * 192, 64, vc, lds, t_); }
                else { bf16* o = (br == 0 ? kc + (size_t)bg * 128 * 192 + 127 * 192 : vc + (size_t)bg * 128 * 128 + 127 * 128); if (t_ < (br == 0 ? 192 : 128)) o[t_] = 0; }
            }
#else
#endif
            {
                const int NQ = (G & 7) == 0 ? 8 : 1, qid = NQ == 8 ? (bx & 7) : 0, ncq = 128 / NQ, nwq = 512 / NQ;
                gu32* q = ctl + CW_WQ + (l * 8 + qid) * 32; LAS int* slot = (LAS int*)(lds + LDSCTL_OFF + 2048);
#pragma unroll 1
                for (;;) { const int j = q_next(q, slot, ltid()); if (j >= ncq + nwq) break;
                    if (j < ncq) {
#if !defined(COMPRESS_REF)
                        if (EN(22)) { const int gj = qid * ncq + j, b = gj >> 4, r = gj & 15, br = r >> 3, g2 = (r >> 2) & 1, ct = r & 3;
                            if (br == 0) compress_body<192>(b, g2, ct, z + ZC_NKC, (const bf16*)(ws + WS_WCK1), (const bf16*)(ws + WS_WCK2), (const float*)(ws + WS_C1P), 96, kc, lds, ltid(), (unsigned*)ctl + CW_CHK);
                            else compress_body<128>(b, g2, ct, z + ZC_NVC, (const bf16*)(ws + WS_WCV1), (const bf16*)(ws + WS_WCV2), (const float*)(ws + WS_C1P) + 96 * 192, 64, vc, lds, ltid(), (unsigned*)ctl + CW_CHK + 8); }
#endif
                    } else if (EN(20)) { const int gj = qid * nwq + (j - ncq), bb = gj >> 6, r = gj & 63;
                        nsa_win_unit(bb * 64 + (r & 1) * 32 + (31 - (r >> 1)), z, zs, tabd, ow, lds, ltid()); }
                }
            }
        }
        SEAM(pb + 2);
        if (EN(4) && IN(pb + 3)) { asm volatile("; PHMARK 4"); const KA a = kargs(); GAS unsigned char* ws = lws(a.ws); (void)ws;
            const bool g256 = (G == 256); const int cg = g256 ? (bx >> 5) & 3 : 0;
            const int gwv = (g256 ? cg * 64 + (bx >> 7) * 32 + (bx & 31) : bx) * NWAVES + wave0, NGWv = G * NWAVES, nper = g256 ? CONV_N_ATT : (MOE_ITEMS + NGWv - 1) / NGWv;
#pragma unroll 1
            for (int sg = 0; sg < 4; ++sg) {
                if (EN(27) && sg == cg) { moe_convert(a, l, gwv, NGWv, 0, nper, llane()); asm volatile("s_waitcnt vmcnt(0)" ::: "memory"); }
                if (sg == 0) { if (EN(23)) for (int u = bx; u < 256; u += G) { const int v = (u & 7) * 32 + (u >> 3); const int bh = v >> 2, p = v & 3;
                    fox_sub(bh >> 3, bh & 7, 7 - p, z, kb, o3, lds, ltid()); fox_sub(bh >> 3, bh & 7, p, z, kb, o3, lds, ltid()); } }
                else if (sg == 1) { if (EN(24)) for (int u = bx; u < 256; u += G) { const int v = (u & 7) * 32 + (u >> 3); const int bh = v >> 2, p = v & 3;
                    mla_sub(bh >> 3, bh & 7, 7 - p, qm, km, vm, o3 + 1024, lds, ltid()); mla_sub(bh >> 3, bh & 7, p, qm, km, vm, o3 + 1024, lds, ltid()); } }
                else if (sg == 2) { if (EN(25)) for (int u = bx; u < 256; u += G) { const int v = (u & 7) * 32 + (u >> 3); const int b = v >> 5, g2 = (v >> 4) & 1, p = v & 15;
                    nsa_cmp_sub(b, g2, 31 - p, z, zs, tabd, kc, vc, ow, (unsigned*)(ws + WS_RMASK), lds, ltid()); nsa_cmp_sub(b, g2, p, z, zs, tabd, kc, vc, ow, (unsigned*)(ws + WS_RMASK), lds, ltid()); } }
                else { if (EN(26)) for (int u = bx; u < 256; u += G) { const int v = (u & 7) * 32 + (u >> 3); const int b = v >> 5, g2 = (v >> 4) & 1, p = v & 15;
                    nsa_sel_sub(b, g2, 31 - p, z, zs, tabd, ow, (const unsigned*)(ws + WS_RMASK), o3 + 2048, lds, ltid());
                    nsa_sel_sub(b, g2, p, z, zs, tabd, ow, (const unsigned*)(ws + WS_RMASK), o3 + 2048, lds, ltid()); } }
            }
        }
        SEAM(pb + 3);
        if (EN(5) && IN(pb + 4)) { asm volatile("; PHMARK 5"); const KA a = kargs(); GAS unsigned char* ws = lws(a.ws); (void)ws;
            pg8::Gemm g{o3, (const bf16*)(ws + WS_WBR), 3072, 3072}; pg8::StaticOrder S; S.init(NT, 2048, G, bx);
            pg8::EpiBranch E{z, mbf}; pg8::gemm_phase(lds, g, S, E, ltid());
        }
        SEAM(pb + 4);
        if (EN(6) && IN(pb + 5)) { asm volatile("; PHMARK 6"); const KA a = kargs(); GAS unsigned char* ws = lws(a.ws); (void)ws;
            pg8::Gemm g{mbf, (const bf16*)(ws + WS_WOUT), F8_OUT ? DM / 2 : DM, F8_OUT ? DM / 2 : DM}; pg8::StaticOrder S; S.init(NT, DM, G, bx);
            pg8::EpiResidT<F8_OUT != 0> E{hbf, hssq, nullptr}; pg8::gemm_phase(lds, g, S, E, ltid());
        }
        SEAM(pb + 5);
        if (EN(7) && IN(pb + 6)) { asm volatile("; PHMARK 7"); const KA a = kargs(); GAS unsigned char* ws = lws(a.ws); (void)ws;
            pg8::Gemm g{hbf, (const bf16*)(ws + WS_WMQ), DM, DM}; pg8::StaticOrder S; S.init(NT, 512, G, bx);
            pg8::EpiRowScale E{qmem, 512, nullptr, hssq}; pg8::gemm_phase(lds, g, S, E, ltid());
            {
            if (EN(17)) { pg8::Gemm g{(const bf16*)(ws + WS_MEMBF), (const bf16*)(ws + WS_WMKV), DM, DM}; pg8::StaticOrder S; S.init(NB * MEML, 1024, G, G - 1 - bx);
              pg8::EpiRowScale E{kvmem, 1024, (const float*)(ws + WS_RSTDM), nullptr}; pg8::gemm_phase(lds, g, S, E, ltid()); }
            }
            if (EN(27) && G == 256 && bx >= 128 && bx < 224) { moe_convert(a, l, CONV_N_ATT * 2048 + (bx - 128) * NWAVES + wave0, 96 * NWAVES, 0, ((48 - CONV_N_ATT) * 2048 + 96 * NWAVES - 1) / (96 * NWAVES), llane()); asm volatile("s_waitcnt vmcnt(0)" ::: "memory"); }
        }
        SEAM(pb + 6);
        if (EN(8) && IN(pb + 7)) { asm volatile("; PHMARK 8"); const KA a = kargs(); GAS unsigned char* ws = lws(a.ws); (void)ws; for (int u = bx; u < 256; u += G) mem_unit(u, qmem, kvmem, omem, lds, ltid()); }
        SEAM(pb + 7);
        if (EN(9) && IN(pb + 8)) { asm volatile("; PHMARK 9"); const KA a = kargs(); GAS unsigned char* ws = lws(a.ws); (void)ws;
            pg8::Gemm g{omem, (const bf16*)(ws + WS_WMO), 512, 512}; pg8::StaticOrder S; S.init(NT, DM, G, bx);
            pg8::EpiResid E{hbf, hssq, F8_GU ? (unsigned char*)(ws + WS_H8) : nullptr}; pg8::gemm_phase(lds, g, S, E, ltid());
        }
        SEAM(pb + 8);
        if (EN(10) && IN(pb + 9)) { asm volatile("; PHMARK 10"); const KA a = kargs(); GAS unsigned char* ws = lws(a.ws); (void)ws;
            const int G4 = G >> 2, sl = bx / G4;
            if (sl < 4) { pg8::Gemm g{hbf + 512 * sl, (const bf16*)(ws + WS_WR) + 512 * sl, DM, 512, DM}; pg8::StaticOrder S; S.init(NT, 256, G4, bx - sl * G4);
                pg8::EpiRouter E{logits + (size_t)sl * NT * 64}; pg8::gemm_phase(lds, g, S, E, ltid()); }
        }
        SEAM(pb + 9);
        }
        { const int ps = l < 0 ? 0 : pb + 10;
          if (EN(11) && IN(ps)) { asm volatile("; PHMARK 11"); const KA a = kargs(); GAS unsigned char* ws = lws(a.ws); (void)ws;
            if (l >= 0) ph_route1(logits, hssq, (const float*)(ws + WS_BRT) + 64 * l, rstd2, (unsigned*)ctl + CW_CNT + l * 64, asge, asgi, asgw, ltid());
            if (l + 1 < DEPTH) { const int t_ = ltid(); ph_conv(a, l + 1, lds, t_, t_ & 63, __builtin_amdgcn_readfirstlane(t_ >> 6), 0, 13, bx, G); } }
          SEAM(ps); }
        if (l >= 0) {

        if (EN(12) && IN(pb + 11)) { asm volatile("; PHMARK 12"); const KA a = kargs(); GAS unsigned char* ws = lws(a.ws); (void)ws; const int t_ = ltid(); ph_route2((const unsigned*)ctl + CW_CNT + l * 64, asge, asgi, asgw, rstd2, pos, roww, rowr, tile, (int*)xg, lds, t_); LDS_WAIT(); __syncthreads(); }
        SEAM(pb + 11);
        if (EN(13) && IN(pb + 12)) { asm volatile("; PHMARK 13"); const KA a = kargs(); GAS unsigned char* ws = lws(a.ws); (void)ws;
            pg8::Gemm g{F8_GU ? (const bf16*)(ws + WS_H8) : (const bf16*)hbf, (const bf16*)(ws + WS_WGU), F8_GU ? DM / 2 : DM, F8_GU ? DM / 2 : DM}; pg8::MoeGatherOrder S; S.init(tile, G, bx); S.rowtok = (const int*)xg;
            pg8::EpiGateUp E{hdn, rowr}; pg8::gemm_phase(lds, g, S, E, ltid());
        }
        SEAM(pb + 12);
        if (EN(14) && IN(pb + 13)) { asm volatile("; PHMARK 14"); const KA a = kargs(); GAS unsigned char* ws = lws(a.ws); (void)ws;
            pg8::Gemm g{hdn, (const bf16*)(ws + WS_WD), F8_DN ? DEXP / 2 : DEXP, F8_DN ? DEXP / 2 : DEXP}; pg8::MoeOrder S; S.init(tile, G, bx);
            pg8::EpiDown E{yb, roww}; pg8::gemm_phase(lds, g, S, E, ltid());
        }
        SEAM(pb + 13);
        if (EN(15) && IN(pb + 14)) { asm volatile("; PHMARK 15"); const KA a = kargs(); GAS unsigned char* ws = lws(a.ws); (void)ws; { const int t_ = ltid(); ph_combine(yb, pos, hbf, (unsigned char*)(ws + WS_H8), rstd0, a.in[31], a.out, l == DEPTH - 1, t_ & 63, __builtin_amdgcn_readfirstlane(t_ >> 6)); } }
        SEAM(pb + 14);
        }
    }
#if defined(TIMING_A)
    if (hi - lo > 1) {
        xcd_barrier(bar);
        const unsigned long long* ts = (const unsigned long long*)(a.ws + WS_DBG) + 8;
        const unsigned long long t0 = __hip_atomic_load(ts - 1, RLX_AGENT), t1 = __hip_atomic_load(ts + NPHASES - 1, RLX_AGENT);
        const unsigned long long ta = __hip_atomic_load(ts + TIMING_A, RLX_AGENT), tb = __hip_atomic_load(ts + TIMING_B, RLX_AGENT);
        const float fa = (float)(ta - t0) / (float)(t1 - t0), fb = (float)(tb - t0) / (float)(t1 - t0);
        const float c1 = sqrtf(0.1f * rintf(fa * 80.f)), c2 = 100.f + 10.f * rintf(fb * 80.f);
        for (size_t i = (size_t)bx * 512 + ltid(); i < (size_t)NT * DM; i += (size_t)G * 512) a.out[i] = (i == 12345) ? c2 : c1;
    }
#endif
#undef IN
#undef SEAM
#undef hbf
#undef hf
#undef z
#undef zs
#undef zssq
#undef hssq
#undef rstd0
#undef rstd2
#undef qm
#undef km
#undef vm
#undef kc
#undef vc
#undef kb
#undef o3
#undef ow
#undef mpart
#undef mbf
#undef qmem
#undef kvmem
#undef omem
#undef logits
#undef rope
#undef tabd
#undef asge
#undef asgi
#undef asgw
#undef pos
#undef roww
#undef rowr
#undef tile
#undef xg
#undef hdn
#undef yb
}

#ifndef N_LAUNCH_MODE
#define N_LAUNCH_MODE 1
#endif
extern "C" void kernel_launch(void* const* d_in, const int* in_sizes, int n_in, void* d_out, int out_size, void* d_ws, size_t ws_size, hipStream_t stream) {
    static int grid = 0;
    if (grid == 0) {
        if (n_in != 32 || out_size != NT * DM || ws_size < WS_END) { fprintf(stderr, "kernel_launch: unexpected shapes (n_in %d out %d ws %zu need %zu)\n", n_in, out_size, ws_size, (size_t)WS_END); grid = -1; return; }
        int dev = 0, cus = 0, per_cu = 0;
        if (hipGetDevice(&dev) != hipSuccess || hipDeviceGetAttribute(&cus, hipDeviceAttributeMultiprocessorCount, dev) != hipSuccess) { grid = -1; return; }
        if (hipFuncSetAttribute((const void*)fwd, hipFuncAttributeMaxDynamicSharedMemorySize, LDS_BYTES) != hipSuccess) { fprintf(stderr, "kernel_launch: hipFuncSetAttribute failed\n"); grid = -1; return; }
        if (hipOccupancyMaxActiveBlocksPerMultiprocessor(&per_cu, (const void*)fwd, 512, LDS_BYTES) != hipSuccess || per_cu < 1) fprintf(stderr, "kernel_launch: occupancy query says %d\n", per_cu);
        (void)hipGetLastError();
        grid = cus & ~3;
    }
    if (grid < 0) return;
    Args a{};
    for (int i = 0; i < 32; ++i) a.in[i] = (const float*)d_in[i];
    a.out = (float*)d_out; a.ws = (unsigned char*)d_ws; a.dbg = 0; a.pad = 0;
#if defined(DEBUG_CODES)
    unsigned char* ws = (unsigned char*)d_ws;
    (void)hipMemsetAsync(ws, 0xAA, WS_END, stream);
    (void)hipMemsetAsync(ws + WS_DBG, 0, 4096, stream);
    for (int run = 0; run < 3; ++run) {
        (void)hipMemsetAsync((char*)d_ws + WS_CTL, 0, CTL_ZERO_BYTES, stream);
        for (int p = 0; p < NPHASES; ++p) {
            a.ph_lo = p; a.ph_hi = p + 1; hipLaunchKernelGGL(fwd, dim3(grid), dim3(512), LDS_BYTES, stream, a);
            const int l = p == 0 ? 0 : (p - 1) / NPH_LAYER, j = p == 0 ? -1 : (p - 1) % NPH_LAYER;
            auto one = [&](int stage, size_t off, size_t bytes, int kind) { const DbgBuf b[] = {{off, bytes, kind}}; dbg_stage(stream, ws, run, stage, b, 1, a.out); };
            if (l == 0) {
                if (j == 0) { one(34, WS_WIN, (size_t)ZLD * DM * 2, 1); one(35, WS_WCK1, (size_t)192 * 6144 * 2, 1); one(36, WS_WCK2, (size_t)192 * 192 * 2, 1); one(37, WS_C1P, (size_t)(96 * 192 + 64 * 128) * 4, 0);
                              one(38, WS_WCV1, (size_t)128 * 4096 * 2, 1); one(39, WS_ROPE, (size_t)2048 * 64 * 4, 0); }
                if (j == 1) { one(1, WS_Z, (size_t)NT * ZLD * 2, 1); one(2, WS_ZS, (size_t)NT * 32 * 4, 0); one(3, WS_KVMEM, (size_t)2048 * 1024 * 2, 1); }
                if (j == 2) { hipLaunchKernelGGL(dbg_copy, dim3(1), dim3(64), 0, stream, (const unsigned*)(ws + WS_CTL) + CW_CHK, (unsigned*)(ws + WS_DBG + 2048) + 48, 16); one(4, WS_QM, (size_t)NT * 1536 * 2, 1); one(5, WS_KM, (size_t)NT * 1536 * 2, 1); one(6, WS_VM, (size_t)NT * 1024 * 2, 1); one(7, WS_OW, (size_t)NT * 1024 * 2, 1);
                              one(8, WS_KB, (size_t)64 * 2048 * 4, 0); one(9, WS_KC, (size_t)16 * 128 * 192 * 2, 1); one(10, WS_VC, (size_t)16 * 128 * 128 * 2, 1); }
                if (j == 3) { one(11, WS_O3, (size_t)NT * 1024 * 2, 1); one(12, WS_O3 + (size_t)NT * 1024 * 2, (size_t)NT * 1024 * 2, 1); one(13, WS_RMASK, (size_t)16 * 2048 * 4, 2);
                              one(14, WS_O3 + (size_t)2 * NT * 1024 * 2, (size_t)NT * 1024 * 2, 1); one(15, WS_OW, (size_t)NT * 1024 * 2, 1); }
                if (j == 4) one(16, WS_MBF, (size_t)NT * DM * 2, 1);
                if (j == 5) { one(17, WS_HF, (size_t)NT * DM * 4, 0); one(18, WS_HBF, (size_t)NT * DM * 2, 1); one(19, WS_HSSQ, (size_t)NT * 32 * 4, 0); }
                if (j == 6) one(20, WS_QMEM, (size_t)NT * 512 * 2, 1);
                if (j == 7) one(21, WS_OMEM, (size_t)NT * 512 * 2, 1);
                if (j == 8) { one(22, WS_HF, (size_t)NT * DM * 4, 0); one(23, WS_HBF, (size_t)NT * DM * 2, 1); one(24, WS_HSSQ, (size_t)NT * 32 * 4, 0); }
                if (j == 9) { one(25, WS_LOGIT, (size_t)NT * 64 * 4, 0); one(26, WS_RSTD2, (size_t)NT * 4, 0); }
                if (j == 10) { one(27, WS_ASGE, (size_t)NT * 2 * 4, 2); one(28, WS_ASGW, (size_t)NT * 2 * 4, 0); }
                if (j == 11) one(29, WS_TILE, (size_t)201 * 4, 2);
                if (j == 14) { one(30, WS_HF, (size_t)NT * DM * 4, 0); one(31, WS_HBF, (size_t)NT * DM * 2, 1); one(32, WS_RSTD0, (size_t)NT * 4, 0); }
            } else if (j == 14) one(33, (size_t)-1, (size_t)NT * DM * 4, 0);
        }
    }
    hipLaunchKernelGGL(dbg_final, dim3(1024), dim3(256), 0, stream, (const unsigned long long*)(ws + WS_DBG), (const unsigned*)(ws + WS_DBG + 2048), a.out, (size_t)NT * DM, 39);
#else
    (void)hipMemsetAsync((char*)d_ws + WS_CTL, 0, CTL_ZERO_BYTES, stream);
#if N_LAUNCH_MODE == 0
    a.ph_lo = 0; a.ph_hi = NPHASES;
    hipLaunchKernelGGL(fwd, dim3(grid), dim3(512), LDS_BYTES, stream, a);
#else
    for (int p = 0; p < NPHASES; ++p) { a.ph_lo = p; a.ph_hi = p + 1; hipLaunchKernelGGL(fwd, dim3(grid), dim3(512), LDS_BYTES, stream, a); }
#endif
#endif
}
```

```cpp
#define N_LAUNCH_MODE 0
#ifndef F8_GU
#define F8_GU 1
#endif
#ifndef F8_DN
#define F8_DN 1
#endif
#ifndef F8_OUT
#define F8_OUT 1
#endif
#include <hip/hip_runtime.h>
#include <cstdio>
#include <cstdint>

#define LAS __attribute__((address_space(3)))
#define GAS __attribute__((address_space(1)))
typedef unsigned short bf16;
typedef short bf16x8 __attribute__((ext_vector_type(8)));
typedef short s16x4 __attribute__((ext_vector_type(4)));
typedef short v4i16_t __attribute__((ext_vector_type(4)));
typedef float f32x2 __attribute__((ext_vector_type(2)));
typedef float f32x4 __attribute__((ext_vector_type(4)));
typedef float f32x16 __attribute__((ext_vector_type(16)));
typedef unsigned u32x2 __attribute__((ext_vector_type(2)));
typedef int i32x4 __attribute__((ext_vector_type(4)));
typedef int i32x8 __attribute__((ext_vector_type(8)));
typedef unsigned u32x4 __attribute__((ext_vector_type(4)));
typedef GAS unsigned gu32;

constexpr int DM = 2048, NB = 8, SEQ = 2048, DEPTH = 2, NT = NB * SEQ;
constexpr int MEML = 256;
constexpr float EPS = 1e-6f;
constexpr int D_IN = 14048, ZLD = 14080;
constexpr int ZC_FQ = 0, ZC_FK = 1024, ZC_FV = 2048, ZC_MCQ = 3072, ZC_MCKV = 3840, ZC_MKR = 4352, ZC_NQ = 4416, ZC_NKC = 5952, ZC_NVC = 6336,
              ZC_NKS = 6592, ZC_NVS = 6976, ZC_NKW = 7232, ZC_NVW = 7616, ZC_MG = 7872, ZC_FF = 14016, ZC_NGT = 14024;
constexpr int NEXP = 32, DEXP = 1024, PMAX = 40960;
constexpr float LOG2E = 1.4426950408889634f;

constexpr size_t MiB = 1u << 20;
constexpr size_t al256(size_t x) { return (x + 255) & ~(size_t)255; }
constexpr size_t WS_CTL = 0, CTL_ZERO_BYTES = 1 * MiB;
constexpr size_t WS_WIN  = 1 * MiB;
constexpr size_t WS_WUQ  = WS_WIN  + al256((size_t)ZLD * DM * 2);
constexpr size_t WS_WUKV = WS_WUQ  + al256((size_t)1536 * 768 * 2);
constexpr size_t WS_WCK1 = WS_WUKV + al256((size_t)2048 * 512 * 2);
constexpr size_t WS_WCK2 = WS_WCK1 + al256((size_t)192 * 6144 * 2);
constexpr size_t WS_WCV1 = WS_WCK2 + al256((size_t)192 * 192 * 2);
constexpr size_t WS_WCV2 = WS_WCV1 + al256((size_t)128 * 4096 * 2);
constexpr size_t WS_WBR  = WS_WCV2 + al256((size_t)128 * 128 * 2);
constexpr size_t WS_WOUT = WS_WBR  + al256((size_t)3 * 2048 * 1024 * 2);
constexpr size_t WS_WMQ  = WS_WOUT + al256((size_t)2048 * 2048 * 2);
constexpr size_t WS_WMKV = WS_WMQ  + al256((size_t)512 * 2048 * 2);
constexpr size_t WS_WMO  = WS_WMKV + al256((size_t)1024 * 2048 * 2);
constexpr size_t WS_WR   = WS_WMO  + al256((size_t)2048 * 512 * 2);
constexpr size_t WS_WGU  = WS_WR   + al256((size_t)256 * 2048 * 2);
constexpr size_t WS_WD   = WS_WGU  + al256((size_t)NEXP * 2048 * 2048 * 2);
constexpr size_t WS_ACT  = WS_WD   + al256((size_t)NEXP * 2048 * 1024 * 2);
constexpr size_t WS_HBF  = WS_ACT;
constexpr size_t WS_HF   = WS_HBF  + al256((size_t)NT * DM * 2);
constexpr size_t WS_Z    = WS_HF   + al256((size_t)NT * DM * 4);
constexpr size_t WS_XG   = WS_Z;
constexpr size_t WS_HDN  = WS_XG   + al256((size_t)PMAX * 2048 * 2);
constexpr size_t WS_Y    = WS_HDN  + al256((size_t)PMAX * 1024 * 2);
constexpr size_t WS_ZEND = WS_Z    + al256((size_t)NT * ZLD * 2);
static_assert(WS_Y + (size_t)PMAX * 2048 * 2 <= WS_ZEND, "MoE overlay fits in z");
constexpr size_t WS_ZS   = WS_ZEND;
constexpr size_t WS_ZSSQ = WS_ZS   + al256((size_t)NT * 32 * 4);
constexpr size_t WS_HSSQ = WS_ZSSQ + al256((size_t)NT * 32 * 4);
constexpr size_t WS_RSTD0= WS_HSSQ + al256((size_t)NT * 32 * 4);
constexpr size_t WS_RSTD2= WS_RSTD0+ al256((size_t)NT * 4);
constexpr size_t WS_QM   = WS_RSTD2+ al256((size_t)NT * 4);
constexpr size_t WS_KM   = WS_QM   + al256((size_t)NT * 1536 * 2);
constexpr size_t WS_VM   = WS_KM   + al256((size_t)NT * 1536 * 2);
constexpr size_t WS_KC   = WS_VM   + al256((size_t)NT * 1024 * 2);
constexpr size_t WS_VC   = WS_KC   + al256((size_t)16 * 128 * 192 * 2);
constexpr size_t WS_KB   = WS_VC   + al256((size_t)16 * 128 * 128 * 2);
constexpr size_t WS_O3   = WS_KB   + al256((size_t)64 * 2048 * 4);
constexpr size_t WS_OW   = WS_O3   + al256((size_t)3 * NT * 1024 * 2);
constexpr size_t WS_MPART= WS_OW   + al256((size_t)NT * 1024 * 2);
constexpr size_t WS_MBF  = WS_MPART+ al256((size_t)NT * DM * 4);
constexpr size_t WS_QMEM = WS_MBF  + al256((size_t)NT * DM * 2);
constexpr size_t WS_KVMEM= WS_QMEM + al256((size_t)NT * 512 * 2);
constexpr size_t WS_OMEM = WS_KVMEM+ al256((size_t)2048 * 1024 * 2);
constexpr size_t WS_LOGIT= WS_OMEM + al256((size_t)NT * 512 * 2);
constexpr size_t WS_MEMBF= WS_LOGIT+ al256((size_t)4 * NT * 64 * 4);
constexpr size_t WS_RSTDM= WS_MEMBF+ al256((size_t)2048 * 2048 * 2);
constexpr size_t WS_ROPE = WS_RSTDM+ al256((size_t)2048 * 4);
constexpr size_t WS_TABD = WS_ROPE + al256((size_t)2048 * 64 * 4);
constexpr size_t WS_C1P  = WS_TABD + al256((size_t)8 * 132 * 4);
constexpr size_t WS_BRT  = WS_C1P  + al256((size_t)(96 * 192 + 64 * 128) * 4);
constexpr size_t WS_ASGE = WS_BRT  + al256(2 * 64 * 4);
constexpr size_t WS_ASGI = WS_ASGE + al256((size_t)NT * 2 * 4);
constexpr size_t WS_ASGW = WS_ASGI + al256((size_t)NT * 2 * 4);
constexpr size_t WS_POS  = WS_ASGW + al256((size_t)NT * 2 * 4);
constexpr size_t WS_ROWW = WS_POS  + al256((size_t)NT * 2 * 4);
constexpr size_t WS_ROWR = WS_ROWW + al256((size_t)PMAX * 4);
constexpr size_t WS_TILE = WS_ROWR + al256((size_t)PMAX * 4);
constexpr size_t WS_RMASK= WS_TILE + al256(256 * 4);
constexpr size_t WS_DBG  = WS_RMASK+ al256((size_t)16 * 2048 * 4);
constexpr size_t WS_H8   = WS_DBG  + al256(4096);
constexpr size_t WS_WG8  = WS_H8   + al256((size_t)NT * DM);
constexpr size_t WS_END  = WS_WG8  + al256((size_t)23 * 256 * DM);
static_assert(WS_END <= (size_t)2048 * MiB, "workspace budget");

constexpr int CW_BAR = 4096;
constexpr int CW_CNT = 8192;
constexpr int F8_T0 = 31, F8_NT = 23;
constexpr int CONV_N_ATT = 40;
constexpr int CW_WQ = 24576;
constexpr int CW_CHK = 12288;

constexpr int RING_BYTES = 131072;
constexpr int LDSCTL_OFF = 143360, MISC_OFF = LDSCTL_OFF + 320;
constexpr int LDS_BYTES = 147456;
constexpr int NWAVES = 8;

#define RLX_AGENT __ATOMIC_RELAXED, __HIP_MEMORY_SCOPE_AGENT
#define LDS_WAIT() asm volatile("s_waitcnt lgkmcnt(0)" ::: "memory")
#define VM_WAIT() asm volatile("s_waitcnt vmcnt(0)" ::: "memory")

typedef __bf16 bf16x2_t __attribute__((ext_vector_type(2)));
__device__ __forceinline__ unsigned cvt_pk_bf16(float lo, float hi) { const f32x2 v = {lo, hi}; const bf16x2_t b = __builtin_convertvector(v, bf16x2_t); return __builtin_bit_cast(unsigned, b); }
__device__ __forceinline__ float clamp_e4m3(float x) { return __builtin_amdgcn_fmed3f(x, -448.f, 448.f); }
__device__ __forceinline__ unsigned pk4_fp8(float a, float b, float c, float d) { int w = 0; w = __builtin_amdgcn_cvt_pk_fp8_f32(clamp_e4m3(a), clamp_e4m3(b), w, false); w = __builtin_amdgcn_cvt_pk_fp8_f32(clamp_e4m3(c), clamp_e4m3(d), w, true); return (unsigned)w; }
__device__ __forceinline__ float bf2f(unsigned short b) { return __uint_as_float(((unsigned)b) << 16); }
__device__ __forceinline__ float bflo(unsigned w) { return __uint_as_float(w << 16); }
__device__ __forceinline__ float bfhi(unsigned w) { return __uint_as_float(w & 0xffff0000u); }
__device__ __forceinline__ unsigned short f2bf(float f) { return (unsigned short)(cvt_pk_bf16(f, 0.f) & 0xffffu); }
__device__ __forceinline__ int llane() { int l; asm volatile("v_mbcnt_lo_u32_b32 %0, -1, 0\n\tv_mbcnt_hi_u32_b32 %0, -1, %0" : "=v"(l)); return l; }
__device__ __forceinline__ float shx(float v, int mask, int lane) { return __int_as_float(__builtin_amdgcn_ds_bpermute((lane ^ mask) << 2, __float_as_int(v))); }
__device__ __forceinline__ float wave_sum(float v, int lane) {
#pragma unroll
    for (int o = 1; o < 64; o <<= 1) v += shx(v, o, lane);
    return v;
}
__device__ __forceinline__ float dot4v(f32x4 a) { return (a[0] * a[0] + a[1] * a[1]) + (a[2] * a[2] + a[3] * a[3]); }
__device__ __forceinline__ float sigmoidf_(float x) { return __builtin_amdgcn_rcpf(1.f + __builtin_amdgcn_exp2f(-LOG2E * x)); }

#define XB_TMO      128
#define XB_XCNT(j)  (256  + 64 * (j))
#define XB_XSUB(j)  (1280 + 64 * (j))
#define XB_XGEN(j)  (2304 + 64 * (j))
#define XB_TOP      3328
#define XB_TOPGEN   3392
#define XCD_BAR_WORDS 3456
#define XB_SPIN_CAP (1u << 18)
__device__ __forceinline__ unsigned xb_ld(unsigned* p)              { return __hip_atomic_load(p, __ATOMIC_RELAXED, __HIP_MEMORY_SCOPE_AGENT); }
__device__ __forceinline__ unsigned xb_add(unsigned* p, unsigned v) { return __hip_atomic_fetch_add(p, v, __ATOMIC_RELAXED, __HIP_MEMORY_SCOPE_AGENT); }
__device__ __forceinline__ unsigned xb_xcc_id() { return (unsigned)__builtin_amdgcn_s_getreg((3 << 11) | 20) & 0xFu; }
#define XB_SPIN(cond, bar) do { unsigned _sp = 0; while (cond) { __builtin_amdgcn_s_sleep(1); \
    if ((++_sp & 255u) == 0u) { if (xb_ld(&(bar)[XB_TMO])) break; if (_sp > XB_SPIN_CAP) { atomicAdd(&(bar)[XB_TMO], 1u); break; } } } } while (0)
struct XcdBarrier { unsigned* bar; unsigned x; volatile LAS unsigned* st; };
__device__ __forceinline__ XcdBarrier xcd_barrier_post(unsigned* bar, volatile LAS unsigned* st) {
    XcdBarrier b; b.bar = bar; b.x = xb_xcc_id(); b.st = st;
    if (threadIdx.x == 0) (void)xb_add(&bar[XB_XCNT(b.x)], 1u);
    return b;
}
__device__ __forceinline__ void xcd_barrier_complete(unsigned* bar, unsigned x, unsigned& nloc, unsigned& nx) {
    const unsigned G = gridDim.x * gridDim.y * gridDim.z;
    unsigned sum, cnt, mine, sp = 0u;
    for (;;) {
        sum = 0u; cnt = 0u; mine = 0u;
#pragma unroll
        for (unsigned j = 0; j < 16; ++j) { const unsigned c = xb_ld(&bar[XB_XCNT(j)]); sum += c; cnt += (c > 0u) ? 1u : 0u; mine = (j == x) ? c : mine; }
        if (sum == G) break;
        __builtin_amdgcn_s_sleep(1);
        if ((++sp & 255u) == 0u) { if (xb_ld(&bar[XB_TMO])) break; if (sp > XB_SPIN_CAP) { atomicAdd(&bar[XB_TMO], 1u); break; } }
    }
    nloc = mine > 0u ? mine : 1u; nx = cnt > 0u ? cnt : 1u;
}
__device__ __forceinline__ void xcd_barrier(const XcdBarrier& b) {
    asm volatile("s_waitcnt vmcnt(0)" ::: "memory");
    __syncthreads();
    if (threadIdx.x == 0) {
        unsigned* bar = b.bar;
        __builtin_amdgcn_s_waitcnt(0);
        unsigned nloc = b.st[0], nx = b.st[1];
        if (nloc == 0u) { xcd_barrier_complete(bar, b.x, nloc, nx); b.st[0] = nloc; b.st[1] = nx; }
        const unsigned old = xb_add(&bar[XB_XSUB(b.x)], 1u);
        const unsigned gen = old / nloc;
        if (old + 1u == (gen + 1u) * nloc) {
            __builtin_amdgcn_fence(__ATOMIC_RELEASE, "agent");
            asm volatile("s_waitcnt vmcnt(0)" ::: "memory");
            const unsigned og = xb_add(&bar[XB_TOP], 1u);
            const unsigned tg = og / nx;
            if (og + 1u == (tg + 1u) * nx) xb_add(&bar[XB_TOPGEN], 1u);
            else XB_SPIN(xb_ld(&bar[XB_TOPGEN]) == tg, bar);
            __builtin_amdgcn_fence(__ATOMIC_ACQUIRE, "agent");
            xb_add(&bar[XB_XGEN(b.x)], 1u);
            asm volatile("s_waitcnt vmcnt(0)" ::: "memory");
        } else {
            XB_SPIN(xb_ld(&bar[XB_XGEN(b.x)]) == gen, bar);
            __builtin_amdgcn_fence(__ATOMIC_ACQUIRE, "agent");
            asm volatile("s_waitcnt vmcnt(0)" ::: "memory");
        }
    }
    __syncthreads();
}
namespace pg8 {
constexpr int BM = 256, BK = 64, HALF = 128, HTB = HALF * BK * 2, STAGE_BYTES = 8 * HTB, NXCD = 8, WGM = 4;
__host__ __device__ __forceinline__ int lds_byte(int r, int c) { const int st = (r >> 4) * 2 + (c >> 5), rr = r & 15, cc = c & 31, ob = rr * 64 + cc * 2; return st * 1024 + (ob ^ (((ob >> 9) & 1) << 5)); }
__host__ __device__ __forceinline__ void stage_rc(int b, int& R, int& C) { const int st = b / 1024, sb = b % 1024, swz = sb ^ (((sb >> 9) & 1) << 5); R = (st >> 1) * 16 + swz / 64; C = (st & 1) * 32 + (swz % 64) / 2; }
__host__ __device__ __forceinline__ int perm32(int rho) { const int n = rho >> 4, i = rho & 15; return 8 * (i >> 2) + 4 * n + (i & 3); }

struct Unit { int pm, pn; };
struct Gemm { const bf16* A; const bf16* Bt; int lda; int K; int ldb = 0; };

struct StaticOrder {
    static constexpr bool GATHER = false;
    int nM, nN, nwg, G, c;
    __device__ void init(int M, int N, int G_, int c_) { nM = M / BM; nN = N / BM; nwg = nM * nN; G = G_; c = c_; }
    __device__ __forceinline__ bool next(int i, Unit& u) const {
        const long L = (long)i * G + c; if (L >= nwg) return false;
        int wgid = (int)L; { const int q = nwg / NXCD, r = nwg % NXCD, xcd = wgid % NXCD, off = wgid / NXCD; wgid = (xcd < r ? xcd * (q + 1) : r * (q + 1) + (xcd - r) * q) + off; }
        const int nig = WGM * nN, gid = wgid / nig, fm = gid * WGM, gsz = (nM - fm) < WGM ? (nM - fm) : WGM;
        u.pm = fm + ((wgid % nig) % gsz); u.pn = (wgid % nig) / gsz; return true;
    }
};
struct WinOrder : StaticOrder {
    __device__ __forceinline__ bool next(int i, Unit& u) const { if (!StaticOrder::next(i, u)) return false; if (u.pn >= F8_T0) u.pn += F8_NT; return true; }
};
struct BranchOrder {
    StaticOrder S;
    __device__ void init(int G_, int c_) { S.init(NT, 2048, G_, c_); }
    __device__ __forceinline__ bool next(int i, Unit& u) const {
        Unit t; if (!S.next(i / 3, t)) return false; const int n = i % 3;
        u.pm = n * 64 + t.pm; u.pn = n * 8 + t.pn; return true;
    }
};
struct MoeOrder {
    static constexpr bool GATHER = false;
    const int* tile_e; int rt0, nk, rw;
    __device__ __forceinline__ void init(const int* tab, int G_, int c_) {
        tile_e = tab; const int nt = tab[200]; const bool x8 = (G_ & 7) == 0;
        const int t8 = (nt + 7) >> 3, r0 = x8 ? (c_ & 7) * t8 : 0; int cnt = nt - r0; cnt = cnt < 0 ? 0 : ((x8 && cnt > t8) ? t8 : cnt);
        rt0 = r0; nk = cnt * 8; rw = x8 ? (((G_ >> 3) << 16) | (c_ >> 3)) : ((G_ << 16) | c_);
    }
    __device__ __forceinline__ bool next(int i, Unit& u) const {
        const int k = i * (rw >> 16) + (rw & 0xffff); if (k >= nk) return false;
        const int rt = rt0 + (k >> 3); u.pm = rt; u.pn = tile_e[rt] * 8 + (k & 7); return true;
    }
};

struct MoeGatherOrder : MoeOrder { static constexpr bool GATHER = true; const int* rowtok; };

struct NoHook { __device__ __forceinline__ void run(int) const {} };
template <class Epi, class Sched, class Hook = NoHook>
__device__ __forceinline__ void gemm_phase(LAS unsigned char* lds, const Gemm g, const Sched& S, const Epi& E, int tid, const Hook& H = Hook()) {
    static_assert(sizeof(Epi) > 0, "");
    const int wid = __builtin_amdgcn_readfirstlane(tid >> 6), lane = tid & 63, wr = wid >> 2, wc = wid & 3, fr = lane & 15, fq = lane >> 4;
    const int K = g.K, nt = K / BK, lda = g.lda, ldb = g.ldb ? g.ldb : g.K;
    unsigned voffA[2], voffB[2], voffA1[2];
#pragma unroll
    for (int i = 0; i < 2; ++i) { int R, C; stage_rc(tid * 16 + i * 8192, R, C); const int Rb = Epi::PERM ? ((R & ~31) + perm32(R & 31)) : R;
        voffA[i] = (unsigned)(R * lda + C) * 2u; voffB[i] = (unsigned)(Rb * ldb + C) * 2u; }
    const size_t kstep = (size_t)(BK * 2);
    const size_t hstepA = (size_t)HALF * lda * 2, hstepB = (size_t)HALF * ldb * 2;
    const size_t tstepA = 2 * hstepA, tstepB = 2 * hstepB;
    const unsigned ldsw = (unsigned)wid * 1024u;
    constexpr bool F8 = Epi::F8; constexpr int KOFF = F8 ? 16 : 1024;
    const int aoff = F8 ? lds_byte(wr * 64 + fr, (fq & 1) * 16) + (fq >> 1) * 1024 : lds_byte(wr * 64 + fr, fq * 8);
    const int boff = F8 ? lds_byte(wc * 32 + fr, (fq & 1) * 16) + (fq >> 1) * 1024 : lds_byte(wc * 32 + fr, fq * 8);
#define PG8_SA(b, h) (((b) * 2 + (h)) * HTB)
#define PG8_SB(b, h) ((4 + (b) * 2 + (h)) * HTB)
#define PG8_STAGE(bufoff, gbase, voff) do { _Pragma("unroll") for (int _i = 0; _i < 2; ++_i) \
        __builtin_amdgcn_global_load_lds((const unsigned*)((const char*)(gbase) + (voff)[_i]), (LAS unsigned*)(lds + (bufoff) + ldsw + _i * 8192), 16, 0, 0); } while (0)
#define PG8_STAGE_A0(bufoff, gbase) PG8_STAGE(bufoff, gbase, voffA)
#define PG8_STAGE_A1(bufoff, gbase) do { if constexpr (Sched::GATHER) PG8_STAGE(bufoff, gbase, voffA1); else PG8_STAGE(bufoff, (gbase) + hstepA, voffA); } while (0)
#define PG8_ROWS(idx, u, d0, d1) do { _Pragma("unroll") for (int _i = 0; _i < 2; ++_i) { int R, C; stage_rc(tid * 16 + _i * 8192, R, C); \
        if ((idx) < RMAPN) { d0[_i] = rmap[(idx) * BM + R]; d1[_i] = rmap[(idx) * BM + HALF + R]; } else { d0[_i] = S.rowtok[(u).pm * BM + R]; d1[_i] = S.rowtok[(u).pm * BM + HALF + R]; } } } while (0)
#define PG8_SETA(d0, d1) do { _Pragma("unroll") for (int _i = 0; _i < 2; ++_i) { int R, C; stage_rc(tid * 16 + _i * 8192, R, C); voffA[_i] = (unsigned)(d0[_i] * lda + C) * 2u; voffA1[_i] = (unsigned)(d1[_i] * lda + C) * 2u; } } while (0)
#define PG8_LD8(dst, addr) do { const i32x4 lo_ = *(const LAS i32x4*)(addr), hi_ = *(const LAS i32x4*)((addr) + 16); dst = __builtin_shufflevector(lo_, hi_, 0, 1, 2, 3, 4, 5, 6, 7); } while (0)
#define PG8_LDA(dst, b, h) do { if constexpr (F8) { _Pragma("unroll") for (int m = 0; m < 4; ++m) PG8_LD8(dst##8[m], lds + PG8_SA(b, h) + aoff + m * 2048); } else { \
        _Pragma("unroll") for (int m = 0; m < 4; ++m) _Pragma("unroll") for (int k = 0; k < 2; ++k) dst[m][k] = *(const LAS bf16x8*)(lds + PG8_SA(b, h) + aoff + m * 2048 + k * 1024); } } while (0)
#define PG8_LDB(dst, b, h) do { if constexpr (F8) { _Pragma("unroll") for (int n = 0; n < 2; ++n) PG8_LD8(dst##8[n], lds + PG8_SB(b, h) + boff + n * 2048); } else { \
        _Pragma("unroll") for (int n = 0; n < 2; ++n) _Pragma("unroll") for (int k = 0; k < 2; ++k) dst[n][k] = *(const LAS bf16x8*)(lds + PG8_SB(b, h) + boff + n * 2048 + k * 1024); } } while (0)
#define PG8_CAT(x) __builtin_shufflevector((i32x4)(x)[0], (i32x4)(x)[1], 0, 1, 2, 3, 4, 5, 6, 7)
#define PG8_MMA(ai, bj, At, Bt) do { __builtin_amdgcn_s_setprio(1); if constexpr (F8) { _Pragma("unroll") for (int m = 0; m < 4; ++m) _Pragma("unroll") for (int n = 0; n < 2; ++n) \
        asm volatile("v_mfma_scale_f32_16x16x128_f8f6f4 %0, %1, %2, %0, %3, %4 op_sel_hi:[0,0,0]" : "+v"(acc[ai][bj][m][n]) : "v"(Bt##8[n]), "v"(At##8[m]), "v"(sc_b), "v"(sc_a));   \
      } else { _Pragma("unroll") for (int m = 0; m < 4; ++m) _Pragma("unroll") for (int n = 0; n < 2; ++n) _Pragma("unroll") for (int k = 0; k < 2; ++k) \
        acc[ai][bj][m][n] = __builtin_amdgcn_mfma_f32_16x16x32_bf16(Bt[n][k], At[m][k], acc[ai][bj][m][n], 0, 0, 0); } __builtin_amdgcn_s_setprio(0); } while (0)
#define PG8_WAIT_V(n) asm volatile("s_waitcnt vmcnt(" #n ")" ::: "memory")
#define PG8_WAIT_L(n) asm volatile("s_waitcnt lgkmcnt(" #n ")" ::: "memory")
#define PG8_BAR __builtin_amdgcn_s_barrier()
#define PG8_SCHED __builtin_amdgcn_sched_barrier(0)
    Unit cur, nxt; int ui = 0;
    if (!S.next(0, cur)) return;
    f32x4 acc[2][2][4][2];
#pragma unroll
    for (int a = 0; a < 2; ++a)
#pragma unroll
        for (int b = 0; b < 2; ++b)
#pragma unroll
            for (int m = 0; m < 4; ++m)
#pragma unroll
                for (int n = 0; n < 2; ++n) acc[a][b][m][n] = (f32x4){0.f, 0.f, 0.f, 0.f};
    bf16x8 At[4][2], B0[2][2], B1[2][2];
    const int sc_b = 121, sc_a = 127; i32x8 At8[4], B08[2], B18[2];
    const char* cA = (const char*)g.A + (Sched::GATHER ? (size_t)0 : (size_t)cur.pm * tstepA); const char* cB = (const char*)g.Bt + (size_t)cur.pn * tstepB;
    constexpr int RMAPN = 12; LAS int* rmap = (LAS int*)(lds + STAGE_BYTES);
    if constexpr (Sched::GATHER) {
        { Unit u; for (int i = 0; i < RMAPN && S.next(i, u); ++i) if (tid < BM) rmap[i * BM + tid] = S.rowtok[u.pm * BM + tid]; }
        asm volatile("s_waitcnt lgkmcnt(0)" ::: "memory"); __builtin_amdgcn_s_barrier();
        int d0[2], d1[2]; PG8_ROWS(0, cur, d0, d1); PG8_SETA(d0, d1); }
    PG8_STAGE(PG8_SB(0, 0), cB, voffB); PG8_STAGE(PG8_SB(0, 1), cB + hstepB, voffB); PG8_STAGE_A0(PG8_SA(0, 0), cA); PG8_STAGE_A1(PG8_SA(0, 1), cA);
    if (wr == 1) PG8_BAR;
    PG8_WAIT_V(2); PG8_BAR;
    PG8_STAGE(PG8_SB(1, 0), cB + kstep, voffB); PG8_STAGE_A0(PG8_SA(1, 0), cA + kstep); PG8_STAGE(PG8_SB(1, 1), cB + hstepB + kstep, voffB);
    PG8_WAIT_V(6); PG8_BAR;
    for (;;) {
        const bool has_next = S.next(ui + 1, nxt);
        const char* nA = (has_next && !Sched::GATHER) ? (const char*)g.A + (size_t)nxt.pm * tstepA : cA; const char* nB = has_next ? (const char*)g.Bt + (size_t)nxt.pn * tstepB : cB;
#pragma clang loop unroll(disable)
        for (int t = 0; t < nt; t += 2) {
            const bool last = (t == nt - 2);
            const char* a1 = cA + (size_t)(t + 1) * kstep;
            const char* a2 = last ? nA : cA + (size_t)(t + 2) * kstep; const char* b2 = last ? nB : cB + (size_t)(t + 2) * kstep;
            const char* a3 = a2 + kstep; const char* b3 = b2 + kstep;
            if constexpr (Epi::KSEG > 0) { if (t > 0 && (t % Epi::KSEG) == 0) { const int t2 = llane(); E.seg(acc, cur, t / Epi::KSEG, wr, wc, t2 & 15, t2 >> 4); } }
            int d0[2], d1[2];
            if constexpr (Sched::GATHER) { if (last && has_next) PG8_ROWS(ui + 1, nxt, d0, d1); }
            PG8_LDB(B0, 0, 0); PG8_LDB(B1, 0, 1); PG8_SCHED; PG8_LDA(At, 0, 0); PG8_STAGE_A1(PG8_SA(1, 1), a1);
            if constexpr (Sched::GATHER) { if (last && has_next) PG8_SETA(d0, d1); }
            PG8_WAIT_V(8); PG8_WAIT_L(0); PG8_BAR; PG8_MMA(0, 0, At, B0); PG8_MMA(0, 1, At, B1); PG8_BAR; PG8_SCHED;
            PG8_LDA(At, 0, 1); PG8_STAGE(PG8_SB(0, 0), b2, voffB); PG8_STAGE(PG8_SB(0, 1), b2 + hstepB, voffB); PG8_STAGE_A0(PG8_SA(0, 0), a2);
            PG8_WAIT_V(8); PG8_WAIT_L(0); PG8_BAR; PG8_MMA(1, 0, At, B0); PG8_MMA(1, 1, At, B1); PG8_BAR; PG8_SCHED;
            PG8_LDB(B0, 1, 0); PG8_LDB(B1, 1, 1); PG8_SCHED; PG8_LDA(At, 1, 0); PG8_STAGE_A1(PG8_SA(0, 1), a2);
            PG8_WAIT_V(8); PG8_WAIT_L(0); PG8_BAR; PG8_MMA(0, 0, At, B0); PG8_MMA(0, 1, At, B1); PG8_BAR; PG8_SCHED;
            PG8_LDA(At, 1, 1); PG8_STAGE(PG8_SB(1, 0), b3, voffB); PG8_STAGE(PG8_SB(1, 1), b3 + hstepB, voffB); PG8_STAGE_A0(PG8_SA(1, 0), a3);
            PG8_WAIT_V(8); PG8_WAIT_L(0); PG8_BAR; PG8_MMA(1, 0, At, B0); PG8_MMA(1, 1, At, B1); PG8_BAR; PG8_SCHED;
        }
        if (wr == 0) PG8_BAR;
        { const int t2 = llane(); E(acc, cur, wr, wc, t2 & 15, t2 >> 4); }
        H.run(ui);
        if (!has_next) break;
#pragma unroll
        for (int a = 0; a < 2; ++a)
#pragma unroll
            for (int b = 0; b < 2; ++b)
#pragma unroll
                for (int m = 0; m < 4; ++m)
#pragma unroll
                    for (int n = 0; n < 2; ++n) acc[a][b][m][n] = (f32x4){0.f, 0.f, 0.f, 0.f};
        cur = nxt; cA = nA; cB = nB; ++ui;
        if (wr == 1) PG8_BAR;
    }
    PG8_WAIT_V(0);
    PG8_BAR;
#undef PG8_SA
#undef PG8_SB
#undef PG8_STAGE
#undef PG8_LDA
#undef PG8_STAGE_A0
#undef PG8_STAGE_A1
#undef PG8_ROWS
#undef PG8_SETA
#undef PG8_LDB
#undef PG8_MMA
#undef PG8_CAT
#undef PG8_WAIT_V
#undef PG8_WAIT_L
#undef PG8_BAR
#undef PG8_SCHED
}

typedef const f32x4 (&AccRef)[2][2][4][2];
__device__ __forceinline__ u32x4 pack8(f32x4 a, f32x4 b) { u32x4 w; w.x = cvt_pk_bf16(a[0], a[1]); w.y = cvt_pk_bf16(a[2], a[3]); w.z = cvt_pk_bf16(b[0], b[1]); w.w = cvt_pk_bf16(b[2], b[3]); return w; }
__device__ __forceinline__ float dot4(f32x4 a) { return (a[0] * a[0] + a[1] * a[1]) + (a[2] * a[2] + a[3] * a[3]); }
__device__ __forceinline__ float red_fq_(float s, int lane) { s += shx(s, 16, lane); s += shx(s, 32, lane); return s; }
#define red_fq(s) red_fq_((s), fr + 16 * fq)
__device__ __forceinline__ f32x4 rope4(f32x4 v, f32x4 cs) { return (f32x4){v[0] * cs[0] - v[1] * cs[1], v[1] * cs[0] + v[0] * cs[1], v[2] * cs[2] - v[3] * cs[3], v[3] * cs[2] + v[2] * cs[3]}; }

__device__ __forceinline__ unsigned char* g8_addr(const bf16* z, int row, int c) { return (unsigned char*)z + (size_t)row * (ZLD * 2) + 2 * ZC_MG + c; }
__device__ __forceinline__ f32x4 u8x4_to_f(unsigned w) { return (f32x4){(float)(w & 255u), (float)((w >> 8) & 255u), (float)((w >> 16) & 255u), (float)(w >> 24)}; }
__device__ __forceinline__ unsigned sig_u8x4(f32x4 x) { unsigned r = 0;
#pragma unroll
    for (int j = 0; j < 4; ++j) r |= (unsigned)fminf(sigmoidf_(x[j]) * 256.f, 255.f) << (8 * j);
    return r; }
struct EpiWin {
    static constexpr bool PERM = true; static constexpr int KSEG = 0; static constexpr bool F8 = false;
    bf16* z; float* zs; float* zssq; const float* rstd; bf16* km; const float* rope;
    __device__ __forceinline__ void operator()(AccRef acc, const Unit& u, int wr, int wc, int fr, int fq) const {
        const int row0 = u.pm * BM + wr * 64 + fr, colw = u.pn * BM + wc * 32 + 8 * fq;
        const bool do_ssq = (u.pn >= 12 && u.pn <= 16), do_rope = (u.pn == 17 && wc < 2), do_side = (u.pn == 54 && wc == 2);
        float rsv[2][4];
#pragma unroll
        for (int ai = 0; ai < 2; ++ai)
#pragma unroll
            for (int m = 0; m < 4; ++m) rsv[ai][m] = rstd[row0 + ai * HALF + m * 16];
#pragma unroll
        for (int ai = 0; ai < 2; ++ai)
#pragma unroll
            for (int m = 0; m < 4; ++m) {
                const int row = row0 + ai * HALF + m * 16; const float rs = rsv[ai][m]; float sq = 0.f;
#pragma unroll
                for (int bj = 0; bj < 2; ++bj) {
                    f32x4 v0 = acc[ai][bj][m][0] * rs, v1 = acc[ai][bj][m][1] * rs;
                    if (bj == 0 && do_rope) {
                        const float* rp = rope + ((size_t)(row & (SEQ - 1)) * 32 + 16 * wc + 4 * fq) * 2;
                        v0 = rope4(v0, *(const f32x4*)rp); v1 = rope4(v1, *(const f32x4*)(rp + 4));
                        const u32x4 w = pack8(v0, v1);
#pragma unroll
                        for (int hh = 0; hh < 8; ++hh) *(u32x4*)(km + (size_t)row * 1536 + hh * 192 + 128 + 32 * wc + 8 * fq) = w;
                    }
                    sq += dot4(v0) + dot4(v1);
                    { const int zc = colw + bj * HALF;
                      if (zc >= ZC_MG && zc < ZC_MG + 6144) { u32x2 c8; c8.x = sig_u8x4(v0); c8.y = sig_u8x4(v1); *(u32x2*)g8_addr(z, row, zc - ZC_MG) = c8; }
                      else *(u32x4*)(z + (size_t)row * ZLD + zc) = pack8(v0, v1); }
                    if (bj == 1 && do_side) { float* sp = zs + (size_t)row * 32 + 8 * fq; *(f32x4*)sp = v0; *(f32x4*)(sp + 4) = v1; }
                }
                if (do_ssq) { sq = red_fq(sq); if (fq == 0) zssq[(size_t)row * 32 + (u.pn - 12) * 4 + wc] = sq; }
            }
    }
};
struct EpiWin8 {
    static constexpr bool PERM = true; static constexpr int KSEG = 0; static constexpr bool F8 = true;
    bf16* z; const float* rstd;
    __device__ __forceinline__ void operator()(AccRef acc, const Unit& u, int wr, int wc, int fr, int fq) const {
        const int row0 = u.pm * BM + wr * 64 + fr, colw = (u.pn + F8_T0) * BM + wc * 32 + 8 * fq;
        float rsv[2][4];
#pragma unroll
        for (int ai = 0; ai < 2; ++ai)
#pragma unroll
            for (int m = 0; m < 4; ++m) rsv[ai][m] = rstd[row0 + ai * HALF + m * 16];
#pragma unroll
        for (int ai = 0; ai < 2; ++ai)
#pragma unroll
            for (int m = 0; m < 4; ++m) { const int row = row0 + ai * HALF + m * 16; const float rs = rsv[ai][m];
#pragma unroll
                for (int bj = 0; bj < 2; ++bj) { u32x2 c8; c8.x = sig_u8x4(acc[ai][bj][m][0] * rs); c8.y = sig_u8x4(acc[ai][bj][m][1] * rs); *(u32x2*)g8_addr(z, row, colw + bj * HALF - ZC_MG) = c8; } }
    }
};
struct EpiMlaQ {
    static constexpr bool PERM = true; static constexpr int KSEG = 0; static constexpr bool F8 = false;
    bf16* qm; const float* zssq; const float* rope;
    __device__ __forceinline__ void operator()(AccRef acc, const Unit& u, int wr, int wc, int fr, int fq) const {
        const int row0 = u.pm * BM + wr * 64 + fr;
        f32x4 pv[2][4];
#pragma unroll
        for (int ai = 0; ai < 2; ++ai)
#pragma unroll
            for (int m = 0; m < 4; ++m) pv[ai][m] = (fq < 3) ? *(const f32x4*)(zssq + (size_t)(row0 + ai * HALF + m * 16) * 32 + 4 * fq) : (f32x4){0.f, 0.f, 0.f, 0.f};
#pragma unroll
        for (int ai = 0; ai < 2; ++ai)
#pragma unroll
            for (int m = 0; m < 4; ++m) {
                const int row = row0 + ai * HALF + m * 16;
                float s = (pv[ai][m][0] + pv[ai][m][1]) + (pv[ai][m][2] + pv[ai][m][3]);
                s = red_fq(s); const float rs = rsqrtf(s * (1.f / 768.f) + EPS);
#pragma unroll
                for (int bj = 0; bj < 2; ++bj) {
                    const int cb = u.pn * BM + bj * HALF + wc * 32, within = cb % 192;
                    f32x4 v0 = acc[ai][bj][m][0] * rs, v1 = acc[ai][bj][m][1] * rs;
                    if (within >= 128) {
                        const float* rp = rope + ((size_t)(row & (SEQ - 1)) * 32 + (within - 128) / 2 + 4 * fq) * 2;
                        v0 = rope4(v0, *(const f32x4*)rp); v1 = rope4(v1, *(const f32x4*)(rp + 4));
                    }
                    *(u32x4*)(qm + (size_t)row * 1536 + cb + 8 * fq) = pack8(v0, v1);
                }
            }
    }
};
struct EpiMlaKV {
    static constexpr bool PERM = true; static constexpr int KSEG = 0; static constexpr bool F8 = false;
    bf16* km; bf16* vm; const float* zssq;
    __device__ __forceinline__ void operator()(AccRef acc, const Unit& u, int wr, int wc, int fr, int fq) const {
        const int row0 = u.pm * BM + wr * 64 + fr;
        f32x4 pv[2][4];
#pragma unroll
        for (int ai = 0; ai < 2; ++ai)
#pragma unroll
            for (int m = 0; m < 4; ++m) pv[ai][m] = (fq < 2) ? *(const f32x4*)(zssq + (size_t)(row0 + ai * HALF + m * 16) * 32 + 12 + 4 * fq) : (f32x4){0.f, 0.f, 0.f, 0.f};
#pragma unroll
        for (int ai = 0; ai < 2; ++ai)
#pragma unroll
            for (int m = 0; m < 4; ++m) {
                const int row = row0 + ai * HALF + m * 16;
                float s = (pv[ai][m][0] + pv[ai][m][1]) + (pv[ai][m][2] + pv[ai][m][3]);
                s = red_fq(s); const float rs = rsqrtf(s * (1.f / 512.f) + EPS);
                *(u32x4*)(km + (size_t)row * 1536 + u.pn * 192 + wc * 32 + 8 * fq) = pack8(acc[ai][0][m][0] * rs, acc[ai][0][m][1] * rs);
                *(u32x4*)(vm + (size_t)row * 1024 + u.pn * 128 + wc * 32 + 8 * fq) = pack8(acc[ai][1][m][0] * rs, acc[ai][1][m][1] * rs);
            }
    }
};
struct EpiRowScale {
    static constexpr bool PERM = true; static constexpr int KSEG = 0; static constexpr bool F8 = false;
    bf16* O; int ldc; const float* rstd;
    const float* hssq;
    __device__ __forceinline__ void operator()(AccRef acc, const Unit& u, int wr, int wc, int fr, int fq) const {
        const int row0 = u.pm * BM + wr * 64 + fr, colw = u.pn * BM + wc * 32 + 8 * fq;
        float rsv[2][4];
        if (rstd) {
#pragma unroll
            for (int ai = 0; ai < 2; ++ai)
#pragma unroll
                for (int m = 0; m < 4; ++m) rsv[ai][m] = rstd[row0 + ai * HALF + m * 16];
        } else {
            f32x4 pp[2][4], qq[2][4];
#pragma unroll
            for (int ai = 0; ai < 2; ++ai)
#pragma unroll
                for (int m = 0; m < 4; ++m) { const float* hp = hssq + (size_t)(row0 + ai * HALF + m * 16) * 32 + 8 * fq; pp[ai][m] = *(const f32x4*)hp; qq[ai][m] = *(const f32x4*)(hp + 4); }
#pragma unroll
            for (int ai = 0; ai < 2; ++ai)
#pragma unroll
                for (int m = 0; m < 4; ++m) { const f32x4 p = pp[ai][m], q = qq[ai][m];
                    float s = ((p[0] + p[1]) + (p[2] + p[3])) + ((q[0] + q[1]) + (q[2] + q[3])); s = red_fq(s); rsv[ai][m] = rsqrtf(s * (1.f / 2048.f) + EPS); }
        }
#pragma unroll
        for (int ai = 0; ai < 2; ++ai)
#pragma unroll
            for (int m = 0; m < 4; ++m) {
                const int row = row0 + ai * HALF + m * 16; const float rs = rsv[ai][m];
#pragma unroll
                for (int bj = 0; bj < 2; ++bj) *(u32x4*)(O + (size_t)row * ldc + colw + bj * HALF) = pack8(acc[ai][bj][m][0] * rs, acc[ai][bj][m][1] * rs);
            }
    }
};
struct EpiBranch {
    static constexpr bool PERM = true; static constexpr int KSEG = 16; static constexpr bool F8 = false;
    const bf16* z; bf16* mbf;
    __device__ __forceinline__ void seg(f32x4 (&acc)[2][2][4][2], const Unit& u, int sgi, int wr, int wc, int fr, int fq) const {
        const int row0 = u.pm * BM + wr * 64 + fr, colw = u.pn * BM + wc * 32 + 8 * fq;
#pragma unroll
        for (int ai = 0; ai < 2; ++ai) {
            u32x2 ga[4][2], gb[4][2];
#pragma unroll
            for (int m = 0; m < 4; ++m)
#pragma unroll
                for (int bj = 0; bj < 2; ++bj) { const unsigned char* gp = g8_addr(z, row0 + ai * HALF + m * 16, (sgi - 1) * 2048 + colw + bj * HALF);
                    ga[m][bj] = *(const u32x2*)gp; gb[m][bj] = *(const u32x2*)(gp + 2048); }
#pragma unroll
            for (int m = 0; m < 4; ++m)
#pragma unroll
                for (int bj = 0; bj < 2; ++bj) { const u32x2 A = ga[m][bj], B = gb[m][bj];
                    const f32x4 b0 = u8x4_to_f(B.x) + 0.5f, b1 = u8x4_to_f(B.y) + 0.5f;
                    acc[ai][bj][m][0] *= (u8x4_to_f(A.x) + 0.5f) * (f32x4){__builtin_amdgcn_rcpf(b0[0]), __builtin_amdgcn_rcpf(b0[1]), __builtin_amdgcn_rcpf(b0[2]), __builtin_amdgcn_rcpf(b0[3])};
                    acc[ai][bj][m][1] *= (u8x4_to_f(A.y) + 0.5f) * (f32x4){__builtin_amdgcn_rcpf(b1[0]), __builtin_amdgcn_rcpf(b1[1]), __builtin_amdgcn_rcpf(b1[2]), __builtin_amdgcn_rcpf(b1[3])}; }
        }
    }
    __device__ __forceinline__ void operator()(AccRef acc, const Unit& u, int wr, int wc, int fr, int fq) const {
        const int row0 = u.pm * BM + wr * 64 + fr, colw = u.pn * BM + wc * 32 + 8 * fq;
#pragma unroll
        for (int ai = 0; ai < 2; ++ai) {
            u32x2 gv[4][2];
#pragma unroll
            for (int m = 0; m < 4; ++m)
#pragma unroll
                for (int bj = 0; bj < 2; ++bj) gv[m][bj] = *(const u32x2*)g8_addr(z, row0 + ai * HALF + m * 16, 2 * 2048 + colw + bj * HALF);
#pragma unroll
            for (int m = 0; m < 4; ++m)
#pragma unroll
                for (int bj = 0; bj < 2; ++bj) { const u32x2 gw = gv[m][bj];
                    const f32x4 g0 = (u8x4_to_f(gw.x) + 0.5f) * (1.f / 256.f), g1 = (u8x4_to_f(gw.y) + 0.5f) * (1.f / 256.f);
                    const f32x4 r0 = acc[ai][bj][m][0] * g0, r1 = acc[ai][bj][m][1] * g1;
                    if constexpr (F8_OUT) { u32x2 w8; w8.x = pk4_fp8(r0[0], r0[1], r0[2], r0[3]); w8.y = pk4_fp8(r1[0], r1[1], r1[2], r1[3]);
                        *(u32x2*)((unsigned char*)mbf + (size_t)(row0 + ai * HALF + m * 16) * 2048 + colw + bj * HALF) = w8; }
                    else *(u32x4*)(mbf + (size_t)(row0 + ai * HALF + m * 16) * 2048 + colw + bj * HALF) = pack8(r0, r1); }
        }
    }
};
template <bool F8_>
struct EpiResidT {
    static constexpr bool PERM = true; static constexpr int KSEG = 0; static constexpr bool F8 = F8_;
    bf16* hbf; float* hssq; unsigned char* h8;
    __device__ __forceinline__ void operator()(AccRef acc, const Unit& u, int wr, int wc, int fr, int fq) const {
        const int row0 = u.pm * BM + wr * 64 + fr, colw = u.pn * BM + wc * 32 + 8 * fq;
#pragma unroll
        for (int ai = 0; ai < 2; ++ai) {
            u32x4 bv[4][2];
#pragma unroll
            for (int m = 0; m < 4; ++m)
#pragma unroll
                for (int bj = 0; bj < 2; ++bj) bv[m][bj] = *(const u32x4*)(hbf + (size_t)(row0 + ai * HALF + m * 16) * 2048 + colw + bj * HALF);
#pragma unroll
            for (int m = 0; m < 4; ++m) {
                const int row = row0 + ai * HALF + m * 16; float sq = 0.f;
#pragma unroll
                for (int bj = 0; bj < 2; ++bj) {
                    const u32x4 w = bv[m][bj];
                    const f32x4 v0 = acc[ai][bj][m][0] + (f32x4){bflo(w.x), bfhi(w.x), bflo(w.y), bfhi(w.y)}, v1 = acc[ai][bj][m][1] + (f32x4){bflo(w.z), bfhi(w.z), bflo(w.w), bfhi(w.w)};
                    *(u32x4*)(hbf + (size_t)row * 2048 + colw + bj * HALF) = pack8(v0, v1);
                    if (h8) { u32x2 w8; w8.x = pk4_fp8(v0[0], v0[1], v0[2], v0[3]); w8.y = pk4_fp8(v1[0], v1[1], v1[2], v1[3]); *(u32x2*)(h8 + (size_t)row * 2048 + colw + bj * HALF) = w8; }
                    sq += dot4(v0) + dot4(v1);
                }
                sq = red_fq(sq); if (fq == 0) hssq[(size_t)row * 32 + u.pn * 4 + wc] = sq;
            }
        }
    }
};
using EpiResid = EpiResidT<false>;
struct EpiRouter {
    static constexpr bool PERM = false; static constexpr int KSEG = 0; static constexpr bool F8 = false;
    float* plog;
    __device__ __forceinline__ void operator()(AccRef acc, const Unit& u, int wr, int wc, int fr, int fq) const {
        const int row0 = u.pm * BM + wr * 64 + fr;
        if (wc < 2) {
#pragma unroll
            for (int ai = 0; ai < 2; ++ai)
#pragma unroll
                for (int m = 0; m < 4; ++m) { const int row = row0 + ai * HALF + m * 16;
#pragma unroll
                    for (int n = 0; n < 2; ++n) *(f32x4*)(plog + (size_t)row * 64 + wc * 32 + 16 * n + 4 * fq) = acc[ai][0][m][n]; }
        }
    }
};
struct EpiGateUp {
    static constexpr bool PERM = true; static constexpr int KSEG = 0; static constexpr bool F8 = F8_GU;
    bf16* hdn; const float* rowr;
    __device__ __forceinline__ void operator()(AccRef acc, const Unit& u, int wr, int wc, int fr, int fq) const {
        const int row0 = u.pm * BM + wr * 64 + fr, col = (u.pn & 7) * 128 + wc * 32 + 8 * fq;
        float rsv[2][4];
#pragma unroll
        for (int ai = 0; ai < 2; ++ai)
#pragma unroll
            for (int m = 0; m < 4; ++m) rsv[ai][m] = rowr[row0 + ai * HALF + m * 16];
#pragma unroll
        for (int ai = 0; ai < 2; ++ai)
#pragma unroll
            for (int m = 0; m < 4; ++m) {
                const int row = row0 + ai * HALF + m * 16; const float rs = rsv[ai][m];
                f32x4 o[2];
#pragma unroll
                for (int n = 0; n < 2; ++n) { const f32x4 g = acc[ai][0][m][n] * rs, up = acc[ai][1][m][n] * rs;
#pragma unroll
                    for (int j = 0; j < 4; ++j) o[n][j] = g[j] * sigmoidf_(g[j]) * up[j]; }
                if constexpr (F8_DN) { u32x2 w8; w8.x = pk4_fp8(o[0][0], o[0][1], o[0][2], o[0][3]); w8.y = pk4_fp8(o[1][0], o[1][1], o[1][2], o[1][3]); *(u32x2*)((unsigned char*)hdn + (size_t)row * 1024 + col) = w8; }
                else *(u32x4*)(hdn + (size_t)row * 1024 + col) = pack8(o[0], o[1]);
            }
    }
};
struct EpiDown {
    static constexpr bool PERM = true; static constexpr int KSEG = 0; static constexpr bool F8 = F8_DN;
    bf16* y; const float* roww;
    __device__ __forceinline__ void operator()(AccRef acc, const Unit& u, int wr, int wc, int fr, int fq) const {
        const int row0 = u.pm * BM + wr * 64 + fr, colw = (u.pn & 7) * BM + wc * 32 + 8 * fq;
        float wv[2][4];
#pragma unroll
        for (int ai = 0; ai < 2; ++ai)
#pragma unroll
            for (int m = 0; m < 4; ++m) wv[ai][m] = roww[row0 + ai * HALF + m * 16];
#pragma unroll
        for (int ai = 0; ai < 2; ++ai)
#pragma unroll
            for (int m = 0; m < 4; ++m) {
                const int row = row0 + ai * HALF + m * 16; const float w = wv[ai][m];
#pragma unroll
                for (int bj = 0; bj < 2; ++bj) *(u32x4*)(y + (size_t)row * 2048 + colw + bj * HALF) = pack8(acc[ai][bj][m][0] * w, acc[ai][bj][m][1] * w);
            }
    }
};
}
namespace att {
template <int DK> struct Geo { static constexpr int CPR = DK / 8, KROW = DK * 2, KBYTES = 64 * KROW, VBYTES = 16384, BUF = KBYTES + VBYTES, NKI = DK / 64, NVI = 2, NPT = NKI + NVI; };
constexpr int NBUF = 3;
constexpr int KB_OFF = 122880;
constexpr int TAB_OFF = 131072;
constexpr int RMASK_OFF = TAB_OFF + 4 * 132 * 4;
constexpr int IMPS_OFF = RMASK_OFF + 256;
static_assert(NBUF * Geo<192>::BUF <= KB_OFF && IMPS_OFF + 64 * 33 * 4 <= LDSCTL_OFF, "attention LDS");

__device__ __forceinline__ s16x4 vtr(const LAS unsigned char* p) { return __builtin_bit_cast(s16x4, __builtin_amdgcn_ds_read_tr16_b64_v4i16((LAS v4i16_t*)p)); }
__device__ __forceinline__ float half_max(float v) { auto rr = __builtin_amdgcn_permlane32_swap(__float_as_uint(v), __float_as_uint(v), false, false); return fmaxf(__uint_as_float(rr[0]), __uint_as_float(rr[1])); }
__device__ __forceinline__ float half_sum(float v) { auto rr = __builtin_amdgcn_permlane32_swap(__float_as_uint(v), __float_as_uint(v), false, false); return __uint_as_float(rr[0]) + __uint_as_float(rr[1]); }

template <int DK> __device__ __forceinline__ void dma_tile(LAS unsigned char* buf, const bf16* Kg, int ldk, const bf16* Vg, int ldv, int jt, int wave, int lane) {
    constexpr int CPR = Geo<DK>::CPR;
    const char* kt = (const char*)(Kg + (size_t)(64 * jt) * ldk); const char* vt = (const char*)(Vg + (size_t)(64 * jt) * ldv);
#pragma unroll
    for (int i = 0; i < Geo<DK>::NKI; ++i) { const int L = (wave * Geo<DK>::NKI + i) * 64 + lane, row = L / CPR, cp = L % CPR, c = (cp & ~7) | ((cp ^ row) & 7);
        __builtin_amdgcn_global_load_lds((const unsigned*)(kt + (unsigned)(row * ldk + c * 8) * 2u), (LAS unsigned*)(buf + (wave * Geo<DK>::NKI + i) * 1024), 16, 0, 0); }
#pragma unroll
    for (int i = 0; i < 2; ++i) { const int L = (wave * 2 + i) * 64 + lane, st = L >> 5, r = (L >> 2) & 7, cc = L & 3, key = (st >> 2) * 8 + r, dch = (st & 3) * 4 + cc;
        __builtin_amdgcn_global_load_lds((const unsigned*)(vt + (unsigned)(key * ldv + dch * 8) * 2u), (LAS unsigned*)(buf + Geo<DK>::KBYTES + (wave * 2 + i) * 1024), 16, 0, 0); }
}

struct State { f32x16 o[4]; float m, l; };
__device__ __forceinline__ void state_init(State& s) {
#pragma unroll
    for (int d = 0; d < 4; ++d)
#pragma unroll
        for (int r = 0; r < 16; ++r) s.o[d][r] = 0.f;
    s.m = -1e30f; s.l = 0.f;
}

template <int DK, bool MASK, bool KBIAS, bool T5, bool SEL, bool CMP, int CT, int HF>
__device__ __forceinline__ void half_compute(const LAS unsigned char* buf, int jt, const bf16x8 (&qf)[DK / 16], int t, int tw0, int W,
                                             const LAS float* kbias, const LAS float* tab, bool rowon, float cs, State& st,
                                             float (&impm)[16], float (&impt)[1], int lane) {
    constexpr int KROW = Geo<DK>::KROW, KS = CMP ? 16 : 1;
    const int hi = lane >> 5, l31 = lane & 31;
    const int pk0 = (CMP ? (1024 * jt + 31) : 64 * jt) + 32 * KS * HF, pk1 = pk0 + 31 * KS;
    const int dmin = tw0 - pk1, dmax = tw0 + 31 - pk0;
    if (MASK && (dmax < 0 || dmin >= W)) return;
    f32x4 kbv[4];
    if (KBIAS) {
#pragma unroll
        for (int a = 0; a < 4; ++a) kbv[a] = *(const LAS f32x4*)(kbias + 64 * jt + 32 * HF + 8 * a + 4 * hi);
    }
    f32x16 p;
#pragma unroll
    for (int r = 0; r < 16; ++r) p[r] = 0.f;
    const LAS unsigned char* krow = buf + (32 * HF + l31) * KROW;
    const LAS unsigned char* kp0 = krow + (((0 + hi) ^ l31) & 7) * 16; const LAS unsigned char* kp1 = krow + (((2 + hi) ^ l31) & 7) * 16;
    const LAS unsigned char* kp2 = krow + (((4 + hi) ^ l31) & 7) * 16; const LAS unsigned char* kp3 = krow + (((6 + hi) ^ l31) & 7) * 16;
#define ATT_KLD(kk) (*(const LAS bf16x8*)((((kk) & 3) == 0 ? kp0 : (((kk) & 3) == 1 ? kp1 : (((kk) & 3) == 2 ? kp2 : kp3))) + ((kk) >> 2) * 128))
    constexpr int NKH = DK / 32;
    bf16x8 kfa[NKH], kfb[NKH];
#pragma unroll
    for (int i = 0; i < NKH; ++i) kfa[i] = ATT_KLD(i);
    __builtin_amdgcn_sched_barrier(0);
#pragma unroll
    for (int i = 0; i < NKH; ++i) kfb[i] = ATT_KLD(NKH + i);
#pragma unroll
    for (int i = 0; i < NKH; ++i) p = __builtin_amdgcn_mfma_f32_32x32x16_bf16(kfa[i], qf[i], p, 0, 0, 0);
    __builtin_amdgcn_sched_barrier(0);
#pragma unroll
    for (int i = 0; i < NKH; ++i) p = __builtin_amdgcn_mfma_f32_32x32x16_bf16(kfb[i], qf[NKH + i], p, 0, 0, 0);
#undef ATT_KLD
    const unsigned vb0 = (unsigned)(size_t)(buf + Geo<DK>::KBYTES + (4 * hi + ((lane & 15) >> 2)) * 64 + (16 * ((lane >> 4) & 1) + 4 * (lane & 3)) * 2);
#define ATT_TRRD(dst, off) asm volatile("ds_read_b64_tr_b16 %0, %1 offset:%2" : "=&v"(dst) : "v"(vb0), "i"(off) : "memory")
    s16x4 l0, l1, l2, l3, h0, h1, h2, h3;
    { constexpr int b_ = (4 * HF) * 2048;
      ATT_TRRD(l0, b_); ATT_TRRD(h0, b_ + 2048); ATT_TRRD(l1, b_ + 512); ATT_TRRD(h1, b_ + 512 + 2048);
      ATT_TRRD(l2, b_ + 1024); ATT_TRRD(h2, b_ + 1024 + 2048); ATT_TRRD(l3, b_ + 1536); ATT_TRRD(h3, b_ + 1536 + 2048); }
    __builtin_amdgcn_sched_barrier(0);
    const int dq = t - pk0 - 4 * hi * KS;
    const bool need_mask = MASK && (dmin < 0 || dmax >= W);
    const float NEG = -__builtin_inff();
    if (T5 && dmin < 128) {
#pragma unroll
        for (int r = 0; r < 16; ++r) { const int c = (r & 3) + 8 * (r >> 2); const int d0 = dq - KS * c; p[r] = fmaf(p[r], cs, tab[min(max(d0, 0), 128)]); }
    } else {
        const float cfar = T5 ? tab[128] : 0.f;
#pragma unroll
        for (int r = 0; r < 16; ++r) { float b0 = cfar; if (KBIAS) b0 = kbv[r >> 2][r & 3]; p[r] = fmaf(p[r], cs, b0); }
    }
    if (need_mask) {
#pragma unroll
        for (int r = 0; r < 16; ++r) { const int c = (r & 3) + 8 * (r >> 2); if ((unsigned)(dq - KS * c) >= (unsigned)W) p[r] = NEG; }
    }
    if (SEL) { if (!rowon) {
#pragma unroll
        for (int r = 0; r < 16; ++r) p[r] = NEG; } }
    float pm = p[0];
#pragma unroll
    for (int r = 1; r < 16; ++r) pm = fmaxf(pm, p[r]);
    pm = half_max(pm);
    float mn = st.m, alpha = 1.f;
    if (!__all(pm - st.m <= 8.f ? 1 : 0)) {
        mn = fmaxf(st.m, pm); alpha = __builtin_amdgcn_exp2f(st.m - mn); st.m = mn;
#pragma unroll
        for (int d = 0; d < 4; ++d)
#pragma unroll
            for (int r = 0; r < 16; ++r) st.o[d][r] *= alpha;
        if (CMP) {
#pragma unroll
            for (int i = 0; i < 16; ++i) impm[i] *= alpha;
            impt[0] *= alpha;
        }
    }
    float ps = 0.f;
#pragma unroll
    for (int r = 0; r < 16; ++r) { p[r] = __builtin_amdgcn_exp2f(p[r] - mn); ps += p[r]; }
    ps = half_sum(ps);
    st.l = st.l * alpha + ps;
    if (CMP) {
        float ot[4];
#pragma unroll
        for (int a = 0; a < 4; ++a) { const float tl = p[4 * a + 3]; auto rr = __builtin_amdgcn_permlane32_swap(__float_as_uint(tl), __float_as_uint(tl), false, false);
            ot[a] = hi ? __uint_as_float(rr[0]) : __uint_as_float(rr[1]); }
#pragma unroll
        for (int a = 0; a < 4; ++a) { const float prev = hi ? ot[a] : (a == 0 ? impt[0] : ot[a > 0 ? a - 1 : 0]);
            impm[CT * 8 + HF * 4 + a] = 2.f * (p[4 * a] + p[4 * a + 1] + p[4 * a + 2]) + p[4 * a + 3] + prev; }
        impt[0] = ot[3];
    }
    bf16x8 pa[2];
    { u32x4 w;
      w.x = cvt_pk_bf16(p[0], p[1]); w.y = cvt_pk_bf16(p[2], p[3]); w.z = cvt_pk_bf16(p[4], p[5]); w.w = cvt_pk_bf16(p[6], p[7]); pa[0] = __builtin_bit_cast(bf16x8, w);
      w.x = cvt_pk_bf16(p[8], p[9]); w.y = cvt_pk_bf16(p[10], p[11]); w.z = cvt_pk_bf16(p[12], p[13]); w.w = cvt_pk_bf16(p[14], p[15]); pa[1] = __builtin_bit_cast(bf16x8, w); }
    s16x4 m0, m1, m2, m3, n0, n1, n2, n3;
    asm volatile("s_waitcnt lgkmcnt(0)" ::: "memory"); __builtin_amdgcn_sched_barrier(0);
    { constexpr int b_ = (4 * HF + 2) * 2048;
      ATT_TRRD(m0, b_); ATT_TRRD(n0, b_ + 2048); ATT_TRRD(m1, b_ + 512); ATT_TRRD(n1, b_ + 512 + 2048);
      ATT_TRRD(m2, b_ + 1024); ATT_TRRD(n2, b_ + 1024 + 2048); ATT_TRRD(m3, b_ + 1536); ATT_TRRD(n3, b_ + 1536 + 2048); }
    st.o[0] = __builtin_amdgcn_mfma_f32_32x32x16_bf16((bf16x8){l0[0], l0[1], l0[2], l0[3], h0[0], h0[1], h0[2], h0[3]}, pa[0], st.o[0], 0, 0, 0);
    st.o[1] = __builtin_amdgcn_mfma_f32_32x32x16_bf16((bf16x8){l1[0], l1[1], l1[2], l1[3], h1[0], h1[1], h1[2], h1[3]}, pa[0], st.o[1], 0, 0, 0);
    st.o[2] = __builtin_amdgcn_mfma_f32_32x32x16_bf16((bf16x8){l2[0], l2[1], l2[2], l2[3], h2[0], h2[1], h2[2], h2[3]}, pa[0], st.o[2], 0, 0, 0);
    st.o[3] = __builtin_amdgcn_mfma_f32_32x32x16_bf16((bf16x8){l3[0], l3[1], l3[2], l3[3], h3[0], h3[1], h3[2], h3[3]}, pa[0], st.o[3], 0, 0, 0);
    asm volatile("s_waitcnt lgkmcnt(0)" ::: "memory"); __builtin_amdgcn_sched_barrier(0);
    st.o[0] = __builtin_amdgcn_mfma_f32_32x32x16_bf16((bf16x8){m0[0], m0[1], m0[2], m0[3], n0[0], n0[1], n0[2], n0[3]}, pa[1], st.o[0], 0, 0, 0);
    st.o[1] = __builtin_amdgcn_mfma_f32_32x32x16_bf16((bf16x8){m1[0], m1[1], m1[2], m1[3], n1[0], n1[1], n1[2], n1[3]}, pa[1], st.o[1], 0, 0, 0);
    st.o[2] = __builtin_amdgcn_mfma_f32_32x32x16_bf16((bf16x8){m2[0], m2[1], m2[2], m2[3], n2[0], n2[1], n2[2], n2[3]}, pa[1], st.o[2], 0, 0, 0);
    st.o[3] = __builtin_amdgcn_mfma_f32_32x32x16_bf16((bf16x8){m3[0], m3[1], m3[2], m3[3], n3[0], n3[1], n3[2], n3[3]}, pa[1], st.o[3], 0, 0, 0);
    __builtin_amdgcn_sched_barrier(0);
#undef ATT_TRRD
}
template <int DK, bool MASK, bool KBIAS, bool T5, bool SEL, bool CMP, int CT>
__device__ __forceinline__ void tile_compute(const LAS unsigned char* buf, int jt, const bf16x8 (&qf)[DK / 16], int t, int tw0, int W,
                                             const LAS float* kbias, const LAS float* tab, unsigned rowmask, float cs, State& st,
                                             float (&impm)[16], float (&impt)[1], int lane) {
    bool rowon = true;
    if (SEL) { rowon = ((rowmask >> jt) & 1u) != 0u; if (!__any(rowon ? 1 : 0)) return; }
    half_compute<DK, MASK, KBIAS, T5, SEL, CMP, CT, 0>(buf, jt, qf, t, tw0, W, kbias, tab, rowon, cs, st, impm, impt, lane);
    half_compute<DK, MASK, KBIAS, T5, SEL, CMP, CT, 1>(buf, jt, qf, t, tw0, W, kbias, tab, rowon, cs, st, impm, impt, lane);
}

template <int N> __device__ __forceinline__ void wait_vm() { asm volatile("s_waitcnt vmcnt(%0)" :: "n"(N) : "memory"); }
template <int DK, bool MASK, bool KBIAS, bool T5, bool SEL>
__device__ __forceinline__ void attn_run(LAS unsigned char* lds, const bf16* Kg, int ldk, const bf16* Vg, int ldv, int jt_lo, int jt_hi,
                                         const bf16x8 (&qf)[DK / 16], int t, int tw0, int W, const LAS float* kbias, const LAS float* tab,
                                         unsigned rowmask, float cs, State& st, int tid) {
    const int lane = tid & 63, wave = __builtin_amdgcn_readfirstlane(tid >> 6);
    float dm0[16], dm1[1];
    dma_tile<DK>(lds, Kg, ldk, Vg, ldv, jt_lo, wave, lane);
    if (jt_lo + 1 < jt_hi) dma_tile<DK>(lds + Geo<DK>::BUF, Kg, ldk, Vg, ldv, jt_lo + 1, wave, lane);
    int cur = 0;
    for (int jt = jt_lo; jt < jt_hi; ++jt) {
        if (jt + 1 < jt_hi) wait_vm<Geo<DK>::NPT>(); else wait_vm<0>();
        asm volatile("s_waitcnt lgkmcnt(0)" ::: "memory");
        __builtin_amdgcn_s_barrier();
        asm volatile("" ::: "memory");
        const int lane_ = lane;
        const int nxt = cur >= 1 ? cur - 1 : 2;
        if (jt + 2 < jt_hi) dma_tile<DK>(lds + nxt * Geo<DK>::BUF, Kg, ldk, Vg, ldv, jt + 2, wave, lane_);
        tile_compute<DK, MASK, KBIAS, T5, SEL, false, 0>(lds + cur * Geo<DK>::BUF, jt, qf, t, tw0, W, kbias, tab, rowmask, cs, st, dm0, dm1, lane);
        cur = cur == 2 ? 0 : cur + 1;
    }
    asm volatile("s_waitcnt lgkmcnt(0)" ::: "memory");
    __builtin_amdgcn_s_barrier();
    asm volatile("" ::: "memory");
}

template <int DK> __device__ __forceinline__ void load_q(bf16x8 (&qf)[DK / 16], const bf16* qrow, int lane) {
#pragma unroll
    for (int kk = 0; kk < DK / 16; ++kk) qf[kk] = *(const bf16x8*)(qrow + 16 * kk + 8 * (lane >> 5));
}
template <int MODE> __device__ __forceinline__ void store_o(const State& st, float sc, bf16* orow, const bf16* addrow, int lane) {
    const int hi = lane >> 5;
#pragma unroll
    for (int db = 0; db < 4; ++db)
#pragma unroll
        for (int rg = 0; rg < 4; ++rg) {
            const int d = 32 * db + 8 * rg + 4 * hi;
            float v0 = st.o[db][4 * rg] * sc, v1 = st.o[db][4 * rg + 1] * sc, v2 = st.o[db][4 * rg + 2] * sc, v3 = st.o[db][4 * rg + 3] * sc;
            if (MODE != 0) { const u32x2 a = *(const u32x2*)((MODE == 1 ? (const bf16*)orow : addrow) + d); v0 += bflo(a.x); v1 += bfhi(a.x); v2 += bflo(a.y); v3 += bfhi(a.y); }
            u32x2 w; w.x = cvt_pk_bf16(v0, v1); w.y = cvt_pk_bf16(v2, v3);
            *(u32x2*)(orow + d) = w;
        }
}
}
struct Args { const float* in[32]; float* out; unsigned char* ws; int ph_lo, ph_hi, dbg, pad; };
#if defined(__HIP_DEVICE_COMPILE__)
typedef const __attribute__((address_space(4))) Args* KArgP;
#else
typedef const Args* KArgP;
#endif
struct KIn { KArgP p; __device__ __forceinline__ const float* operator[](int i) const { return p->in[i]; } };
struct KA { KIn in; float* out; unsigned char* ws; };

__device__ __forceinline__ float row_to_bf16(const float* xrow, bf16* orow, unsigned char* o8, int lane) {
    const f32x4* xr = (const f32x4*)xrow + lane; f32x4 v[8]; float s = 0.f;
#pragma unroll
    for (int j = 0; j < 8; ++j) { v[j] = xr[64 * j]; s += dot4v(v[j]); }
    s = wave_sum(s, lane);
    u32x2* ob = (u32x2*)orow + lane;
#pragma unroll
    for (int j = 0; j < 8; ++j) { u32x2 w; w.x = cvt_pk_bf16(v[j][0], v[j][1]); w.y = cvt_pk_bf16(v[j][2], v[j][3]); ob[64 * j] = w; }
    if (o8) {
#pragma unroll
        for (int j = 0; j < 8; ++j) ((unsigned*)o8)[lane + 64 * j] = pk4_fp8(v[j][0], v[j][1], v[j][2], v[j][3]);
    }
    return rsqrtf(s * (1.f / 2048.f) + EPS);
}

__device__ __forceinline__ int t5_bucket(int d) {
    if (d < 16) return d;
    const float df = (float)d;
    int large = 16 + (int)(logf(df / 16.f) / logf(8.f) * 16.f);
    return large < 31 ? large : 31;
}

__device__ __forceinline__ void ph_pre(const KA& a, int tid, int lane, int wave) {
    unsigned char* ws = a.ws;
    const int gw = blockIdx.x * NWAVES + wave, NGW = gridDim.x * NWAVES;
    const int gt = blockIdx.x * 512 + tid, NGT = gridDim.x * 512;
    bf16* hbf = (bf16*)(ws + WS_HBF); float* rstd0 = (float*)(ws + WS_RSTD0);
    for (int row = gw; row < NT; row += NGW) { const float r = row_to_bf16(a.in[0] + (size_t)row * DM, hbf + (size_t)row * DM, ws + WS_H8 + (size_t)row * DM, lane); if (lane == 0) rstd0[row] = r; }
    bf16* membf = (bf16*)(ws + WS_MEMBF); float* rstdm = (float*)(ws + WS_RSTDM);
    for (int row = gw; row < NB * MEML; row += NGW) { const float r = row_to_bf16(a.in[1] + (size_t)row * DM, membf + (size_t)row * DM, nullptr, lane); if (lane == 0) rstdm[row] = r; }
    float* rope = (float*)(ws + WS_ROPE);
    for (int i = gt; i < SEQ * 32; i += NGT) { const int pos = i >> 5, k = i & 31; const float inv = powf(10000.f, -(float)k / 32.f); const float ang = (float)pos * inv; rope[2 * i] = cosf(ang); rope[2 * i + 1] = sinf(ang); }
    float* tabd = (float*)(ws + WS_TABD);
    for (int i = gt; i < 8 * 132; i += NGT) { const int h = i / 132, d = i % 132; tabd[i] = (d <= 128) ? a.in[15][t5_bucket(d) * 8 + h] * LOG2E : 0.f; }
}

struct Src { const float* p; int ld; };
__device__ __forceinline__ Src conv_src(const KA& a, int l, int mat, int sub, int d) {
    Src s; s.p = nullptr; s.ld = 0;
    switch (mat) {
    case 0: { int c;
        if (d < 3072) c = d; else if (d < 3840) c = 3080 + (d - 3072); else if (d < 4352) c = 3848 + (d - 3840);
        else if (d < 4416) { const int j = d - 4352, i = j >> 1; c = 4360 + ((j & 1) ? 32 + i : i); }
        else if (d < 7872) c = 4424 + (d - 4416); else if (d < 14016) c = 7904 + (d - 7872);
        else if (d < 14024) c = 3072 + (d - 14016); else if (d < 14048) c = 7880 + (d - 14024); else c = -1;
        if (c >= 0) { s.p = a.in[3] + (size_t)l * DM * D_IN + c; s.ld = D_IN; } break; }
    case 1: { const int hd = d / 192, w = d % 192; int c = d; if (w >= 128) { const int j = w - 128, i = j >> 1; c = hd * 192 + 128 + ((j & 1) ? 32 + i : i); }
        s.p = a.in[7] + (size_t)l * 768 * 1536 + c; s.ld = 1536; break; }
    case 2: s.p = a.in[8] + (size_t)l * 512 * 2048 + d; s.ld = 2048; break;
    case 3: s.p = a.in[11] + (size_t)l * 6144 * 192 + d; s.ld = 192; break;
    case 4: s.p = a.in[12] + (size_t)l * 192 * 192 + d; s.ld = 192; break;
    case 5: s.p = a.in[13] + (size_t)l * 4096 * 128 + d; s.ld = 128; break;
    case 6: s.p = a.in[14] + (size_t)l * 128 * 128 + d; s.ld = 128; break;
    case 7: s.p = a.in[16] + (size_t)l * 3 * 1024 * 2048 + d; s.ld = 2048; break;
    case 8: s.p = a.in[17] + (size_t)l * 2048 * 2048 + d; s.ld = 2048; break;
    case 9: s.p = a.in[20] + (size_t)l * 2048 * 512 + d; s.ld = 512; break;
    case 10: s.p = a.in[21] + (size_t)l * 2048 * 1024 + d; s.ld = 1024; break;
    case 11: s.p = a.in[22] + (size_t)l * 512 * 2048 + d; s.ld = 2048; break;
    case 12: if (d < 4) { s.p = a.in[24] + (size_t)l * 2048 * 4 + d; s.ld = 4; } else if (d < 36) { s.p = a.in[26] + (size_t)l * 2048 * 32 + (d - 4); s.ld = 32; } break;
    case 13: { const int j = d >> 8, w = d & 255; const float* base = (w < 128 ? a.in[28] : a.in[29]) + ((size_t)l * NEXP + sub) * 2048 * 1024;
        s.p = base + j * 128 + (w & 127); s.ld = 1024; break; }
    default: s.p = a.in[30] + ((size_t)l * NEXP + sub) * 1024 * 2048 + d; s.ld = 2048; break;
    }
    return s;
}
__device__ __forceinline__ void conv_item(const KA& a, int l, int mt, int sub, const float* gain, int K, bf16* dst, int kb, int nb, LAS float* scr, int lane) {
    const int q = lane & 7, kr = lane >> 3, k0 = kb * 64, d0 = nb * 32 + 4 * q;
    const Src s0 = conv_src(a, l, mt, sub, d0), s3 = conv_src(a, l, mt, sub, d0 + 3);
    if ((s0.p == nullptr && s3.p == nullptr) || (s0.p != nullptr && s3.p == s0.p + 3)) {
        f32x4 v[8];
#pragma unroll
        for (int i = 0; i < 8; ++i) v[i] = s0.p ? *(const f32x4*)(s0.p + (size_t)(k0 + kr + 8 * i) * s0.ld) : (f32x4){0.f, 0.f, 0.f, 0.f};
#pragma unroll
        for (int i = 0; i < 8; ++i) { const float gq = gain ? gain[k0 + kr + 8 * i] : 1.f; LAS float* w = scr + (kr + 8 * i) * 33 + 4 * q;
            w[0] = v[i][0] * gq; w[1] = v[i][1] * gq; w[2] = v[i][2] * gq; w[3] = v[i][3] * gq; }
    } else {
        const Src s1 = conv_src(a, l, mt, sub, d0 + 1), s2 = conv_src(a, l, mt, sub, d0 + 2);
#pragma unroll 4
        for (int i = 0; i < 8; ++i) { const int k = k0 + kr + 8 * i; const float gq = gain ? gain[k] : 1.f; LAS float* w = scr + (kr + 8 * i) * 33 + 4 * q;
            w[0] = s0.p ? s0.p[(size_t)k * s0.ld] * gq : 0.f; w[1] = s1.p ? s1.p[(size_t)k * s1.ld] * gq : 0.f;
            w[2] = s2.p ? s2.p[(size_t)k * s2.ld] * gq : 0.f; w[3] = s3.p ? s3.p[(size_t)k * s3.ld] * gq : 0.f; }
    }
    LDS_WAIT(); asm volatile("" ::: "memory");
    const int c = lane & 7;
#pragma unroll
    for (int j = 0; j < 4; ++j) { const int nn = (lane >> 3) + 8 * j; const LAS float* qv = scr + (8 * c) * 33 + nn;
        u32x4 o; o.x = cvt_pk_bf16(qv[0 * 33], qv[1 * 33]); o.y = cvt_pk_bf16(qv[2 * 33], qv[3 * 33]); o.z = cvt_pk_bf16(qv[4 * 33], qv[5 * 33]); o.w = cvt_pk_bf16(qv[6 * 33], qv[7 * 33]);
        if (F8_OUT && mt == 8) { u32x2 o8; o8.x = pk4_fp8(qv[0 * 33] * 64.f, qv[1 * 33] * 64.f, qv[2 * 33] * 64.f, qv[3 * 33] * 64.f);
            o8.y = pk4_fp8(qv[4 * 33] * 64.f, qv[5 * 33] * 64.f, qv[6 * 33] * 64.f, qv[7 * 33] * 64.f);
            *(u32x2*)((unsigned char*)dst + (size_t)(nb * 32 + nn) * K + k0 + 8 * c) = o8; }
        else *(u32x4*)(dst + (size_t)(nb * 32 + nn) * K + k0 + 8 * c) = o;
        if (mt == 0) { const int d8 = nb * 32 + nn - F8_T0 * 256;
            if (d8 >= 0 && d8 < F8_NT * 256) { u32x2 o8; o8.x = pk4_fp8(qv[0 * 33] * 64.f, qv[1 * 33] * 64.f, qv[2 * 33] * 64.f, qv[3 * 33] * 64.f);
                o8.y = pk4_fp8(qv[4 * 33] * 64.f, qv[5 * 33] * 64.f, qv[6 * 33] * 64.f, qv[7 * 33] * 64.f);
                *(u32x2*)(a.ws + WS_WG8 + (size_t)d8 * DM + k0 + 8 * c) = o8; } } }
    LDS_WAIT(); asm volatile("" ::: "memory");
}
__device__ __forceinline__ void conv_load(const KA& a, int l, int mt, int sub, int kb, int nb, int lane, f32x4 (&v)[8]) {
    const int q = lane & 7, kr = lane >> 3, k0 = kb * 64; const Src s0 = conv_src(a, l, mt, sub, nb * 32 + 4 * q);
#pragma unroll
    for (int i = 0; i < 8; ++i) v[i] = *(const f32x4*)(s0.p + (size_t)(k0 + kr + 8 * i) * s0.ld);
}
__device__ __forceinline__ void conv_store(const f32x4 (&v)[8], const float* gain, int K, bf16* dst, int kb, int nb, LAS float* scr, int lane) {
    const int q = lane & 7, kr = lane >> 3, k0 = kb * 64;
#pragma unroll
    for (int i = 0; i < 8; ++i) { const float gq = gain ? gain[k0 + kr + 8 * i] : 1.f; LAS float* w = scr + (kr + 8 * i) * 33 + 4 * q;
        w[0] = v[i][0] * gq; w[1] = v[i][1] * gq; w[2] = v[i][2] * gq; w[3] = v[i][3] * gq; }
    LDS_WAIT(); asm volatile("" ::: "memory");
    const int c = lane & 7;
#pragma unroll
    for (int j = 0; j < 4; ++j) { const int nn = (lane >> 3) + 8 * j; const LAS float* qv = scr + (8 * c) * 33 + nn;
        u32x4 o; o.x = cvt_pk_bf16(qv[0 * 33], qv[1 * 33]); o.y = cvt_pk_bf16(qv[2 * 33], qv[3 * 33]); o.z = cvt_pk_bf16(qv[4 * 33], qv[5 * 33]); o.w = cvt_pk_bf16(qv[6 * 33], qv[7 * 33]);
        *(u32x4*)(dst + (size_t)(nb * 32 + nn) * K + k0 + 8 * c) = o; }
    LDS_WAIT(); asm volatile("" ::: "memory");
}
__device__ __forceinline__ void ph_conv(const KA& a, int l, LAS unsigned char* lds, int tid, int lane, int wave, int mt_lo, int mt_hi, int vb, int VG) {
    unsigned char* ws = a.ws;
    LAS float* scr = (LAS float*)(lds + wave * 16384);
    const int gw = vb * NWAVES + wave, NGW = VG * NWAVES;
    constexpr int NM = 15;
    static constexpr int mK[NM]   = {2048, 768, 512, 6144, 192, 4096, 128, 3072, 2048, 2048, 2048, 512, 2048, 2048, 1024};
    static constexpr int mN[NM]   = {ZLD, 1536, 2048, 192, 192, 128, 128, 2048, 2048, 512, 1024, 2048, 256, 2048, 2048};
    static constexpr int mS[NM]   = {1, 1, 1, 1, 1, 1, 1, 1, 1, 1, 1, 1, 1, NEXP, NEXP};
    static constexpr int mG[NM]   = {2, 5, 6, -1, -1, -1, -1, -1, -1, 18, 19, -1, 23, 23, -1};
    static constexpr size_t mD[NM] = {WS_WIN, WS_WUQ, WS_WUKV, WS_WCK1, WS_WCK2, WS_WCV1, WS_WCV2, WS_WBR, WS_WOUT, WS_WMQ, WS_WMKV, WS_WMO, WS_WR, WS_WGU, WS_WD};
    int base = 0;
#pragma unroll 1
    for (int mt = mt_lo; mt < mt_hi; ++mt) {
        const int K = mK[mt], nkb = K / 64, nnb = mN[mt] / 32, per = nkb * nnb, tot = per * mS[mt];
        const float* gain = mG[mt] >= 0 ? a.in[mG[mt]] + (size_t)l * K : nullptr;
        int first = gw - (base % NGW); if (first < 0) first += NGW;
        if (mt >= 13) {
            const int nnb2 = nnb / 2, per2 = nkb * nnb2, tot2 = per2 * mS[mt];
            int first2 = gw - ((base / 2) % NGW); if (first2 < 0) first2 += NGW;
            f32x4 vn0[8], vn1[8]; int r = first2;
            if (r < tot2) { const int sub = r / per2, q = r % per2; conv_load(a, l, mt, sub, q / nnb2, 2 * (q % nnb2), lane, vn0); conv_load(a, l, mt, sub, q / nnb2, 2 * (q % nnb2) + 1, lane, vn1); }
#pragma unroll 1
            for (; r < tot2; r += NGW) {
                f32x4 v0[8], v1[8];
#pragma unroll
                for (int i = 0; i < 8; ++i) { v0[i] = vn0[i]; v1[i] = vn1[i]; }
                const int rn = r + NGW;
                if (rn < tot2) { const int sub = rn / per2, q = rn % per2; conv_load(a, l, mt, sub, q / nnb2, 2 * (q % nnb2), lane, vn0); conv_load(a, l, mt, sub, q / nnb2, 2 * (q % nnb2) + 1, lane, vn1); }
                const int sub = r / per2, q = r % per2; bf16* dp = (bf16*)(ws + mD[mt]) + (size_t)sub * mN[mt] * K;
                conv_store(v0, gain, K, dp, q / nnb2, 2 * (q % nnb2), scr, lane);
                conv_store(v1, gain, K, dp, q / nnb2, 2 * (q % nnb2) + 1, scr, lane);
            }
        } else {
#pragma unroll 1
            for (int r = first; r < tot; r += NGW) {
                const int sub = r / per, q = r % per, kb = q / nnb, nb = q % nnb;
                conv_item(a, l, mt, sub, gain, K, (bf16*)(ws + mD[mt]) + (size_t)sub * mN[mt] * K, kb, nb, scr, lane);
            }
        }
        base += tot;
    }
    if (mt_lo != 0) return;
    float* c1p = (float*)(ws + WS_C1P);
    const int gt = vb * 512 + tid, NGT = VG * 512;
    for (int i = gt; i < 96 * 192 + 64 * 128; i += NGT) {
        float s = 0.f;
        if (i < 96 * 192) { const int ch = i / 192, n = i % 192; const float* pe = a.in[9] + (size_t)l * 6144 + ch * 64; const float* w = a.in[11] + (size_t)l * 6144 * 192 + (size_t)ch * 64 * 192 + n;
            for (int k = 0; k < 64; ++k) s += pe[k] * w[(size_t)k * 192]; }
        else { const int j = i - 96 * 192, ch = j / 128, n = j % 128; const float* pe = a.in[10] + (size_t)l * 4096 + ch * 64; const float* w = a.in[13] + (size_t)l * 4096 * 128 + (size_t)ch * 64 * 128 + n;
            for (int k = 0; k < 64; ++k) s += pe[k] * w[(size_t)k * 128]; }
        c1p[i] = s;
    }
    float* brt = (float*)(ws + WS_BRT) + 64 * l;
    if (gt < 64) brt[gt] = gt < 4 ? a.in[25][l * 4 + gt] : (gt < 36 ? a.in[27][l * 32 + gt - 4] : 0.f);
}

constexpr int MOE_ITEMS_GU = NEXP * 32 * 64, MOE_ITEMS_D = NEXP * 16 * 64, MOE_ITEMS = MOE_ITEMS_GU + MOE_ITEMS_D;
struct MoeItem { const float* src; int ld; unsigned char* dst; int K; const float* gain; bool f8; };
__device__ __forceinline__ MoeItem moe_item(const KA& a, int l, int it, int lane) {
    const int q = lane & 7, kq = lane >> 3; MoeItem m;
    if (it < MOE_ITEMS_GU) { const int e = it >> 11, r = it & 2047, kb = r >> 6, nb = r & 63, d = nb * 32 + 4 * q, j = d >> 8, w = d & 255;
        const float* base = (w < 128 ? a.in[28] : a.in[29]) + ((size_t)l * NEXP + e) * 2048 * 1024;
        m.src = base + (size_t)(kb * 64 + 8 * kq) * 1024 + j * 128 + (w & 127); m.ld = 1024; m.K = 2048;
        m.f8 = F8_GU; m.dst = a.ws + WS_WGU + (((size_t)e * 2048 + d) * 2048 + kb * 64 + 8 * kq) * (F8_GU ? 1 : 2); m.gain = a.in[23] + (size_t)l * 2048 + kb * 64 + 8 * kq; }
    else { const int t = it - MOE_ITEMS_GU, e = t >> 10, r = t & 1023, kb = r >> 6, nb = r & 63, d = nb * 32 + 4 * q;
        m.src = a.in[30] + ((size_t)l * NEXP + e) * 1024 * 2048 + (size_t)(kb * 64 + 8 * kq) * 2048 + d; m.ld = 2048; m.K = 1024;
        m.f8 = F8_DN; m.dst = a.ws + WS_WD + (((size_t)e * 2048 + d) * 1024 + kb * 64 + 8 * kq) * (F8_DN ? 1 : 2); m.gain = nullptr; }
    return m;
}
__device__ __forceinline__ void moe_load(const MoeItem& m, f32x4 (&v)[8], f32x4 (&g)[2]) {
#pragma unroll
    for (int i = 0; i < 8; ++i) v[i] = __builtin_nontemporal_load((const f32x4*)(m.src + (size_t)i * m.ld));
    g[0] = (f32x4){1.f, 1.f, 1.f, 1.f}; g[1] = g[0];
    if (m.gain) { g[0] = *(const f32x4*)m.gain; g[1] = *(const f32x4*)(m.gain + 4); }
}
__device__ __forceinline__ void moe_store(const MoeItem& m, const f32x4 (&v)[8], const f32x4 (&g)[2]) {
    const f32x4 g0 = g[0], g1 = g[1];
    if (m.f8) {
#pragma unroll
        for (int j = 0; j < 4; ++j) { u32x2 o; o.x = pk4_fp8(v[0][j] * g0[0] * 64.f, v[1][j] * g0[1] * 64.f, v[2][j] * g0[2] * 64.f, v[3][j] * g0[3] * 64.f);
            o.y = pk4_fp8(v[4][j] * g1[0] * 64.f, v[5][j] * g1[1] * 64.f, v[6][j] * g1[2] * 64.f, v[7][j] * g1[3] * 64.f);
            __builtin_nontemporal_store(o, (u32x2*)(m.dst + (size_t)j * m.K)); }
    } else {
#pragma unroll
        for (int j = 0; j < 4; ++j) { u32x4 o; o.x = cvt_pk_bf16(v[0][j] * g0[0], v[1][j] * g0[1]); o.y = cvt_pk_bf16(v[2][j] * g0[2], v[3][j] * g0[3]);
            o.z = cvt_pk_bf16(v[4][j] * g1[0], v[5][j] * g1[1]); o.w = cvt_pk_bf16(v[6][j] * g1[2], v[7][j] * g1[3]);
            __builtin_nontemporal_store(o, (u32x4*)(m.dst + (size_t)j * m.K * 2)); }
    }
}
__device__ __forceinline__ void moe_convert(const KA& a, int l, int gw, int NGW, int n0, int n1, int lane) {
#pragma unroll 1
    for (int n = n0; n < n1; n += 4) {
        const int i0 = gw + n * NGW;
        if (i0 >= MOE_ITEMS) break;
        const bool h1 = (n + 1 < n1) && (i0 + NGW < MOE_ITEMS), h2 = (n + 2 < n1) && (i0 + 2 * NGW < MOE_ITEMS), h3 = (n + 3 < n1) && (i0 + 3 * NGW < MOE_ITEMS);
        const MoeItem m0 = moe_item(a, l, i0, lane), m1 = moe_item(a, l, h1 ? i0 + NGW : i0, lane), m2 = moe_item(a, l, h2 ? i0 + 2 * NGW : i0, lane), m3 = moe_item(a, l, h3 ? i0 + 3 * NGW : i0, lane);
        f32x4 v0[8], v1[8], v2[8], v3[8], g0[2], g1[2], g2[2], g3[2];
        moe_load(m0, v0, g0); moe_load(m1, v1, g1); moe_load(m2, v2, g2); moe_load(m3, v3, g3);
        moe_store(m0, v0, g0); if (h1) moe_store(m1, v1, g1); if (h2) moe_store(m2, v2, g2); if (h3) moe_store(m3, v3, g3);
    }
}
__device__ __forceinline__ int q_next(gu32* q, LAS int* slot, int tid) {
    LDS_WAIT(); __syncthreads();
    if (tid == 0) *slot = (int)atomicAdd((unsigned*)q, 1u);
    LDS_WAIT(); __syncthreads();
    return __builtin_amdgcn_readfirstlane(*slot);
}
struct MoeConvHook {
    const KA* a; int l, gw, NGW, per, g;
    __device__ __forceinline__ void run(int ui) const {
        if (((ui ^ g) & 3) == 0) { const int k = ui >> 2; moe_convert(*a, l, gw, NGW, k * per, (k + 1) * per, llane()); asm volatile("s_waitcnt vmcnt(0)" ::: "memory"); }
    }
};

__device__ __forceinline__ void cumsum_item(int it, const float* zs, const float* bf, float* kb, int lane) {
    const int b = it >> 3, h = it & 7; const float bias = bf[h];
    float v[32]; float run = 0.f;
#pragma unroll
    for (int i = 0; i < 32; ++i) { const float x = zs[(size_t)(b * SEQ + lane * 32 + i) * 32 + h] + bias; const float ls = fminf(x, 0.f) - log1pf(__expf(-fabsf(x))); run += ls; v[i] = run; }
    float incl = run;
#pragma unroll
    for (int o = 1; o < 64; o <<= 1) { const float y = __int_as_float(__builtin_amdgcn_ds_bpermute(((lane - o) & 63) << 2, __float_as_int(incl))); if (lane >= o) incl += y; }
    const float excl = incl - run;
    float* dst = kb + (size_t)it * SEQ + lane * 32;
#pragma unroll
    for (int i = 0; i < 32; ++i) dst[i] = -(excl + v[i]) * LOG2E;
}

__device__ __forceinline__ float gelu_tanh(float x) { return 0.5f * x * (1.f + tanhf(0.7978845608028654f * (x + 0.044715f * x * x * x))); }
template <int DD>
__device__ __forceinline__ void compress_body(int b, int g, int ct, const bf16* zsrc  , const bf16* w1t, const bf16* w2t,
                                              const float* c1p, int nchunk, bf16* out, LAS unsigned char* lds, int tid, unsigned* dbgw) {
    constexpr int KD = 32 * DD, NCB = DD / 64, KH = KD / 2, NST = KH / 32, HP = DD + 8;
    const int lane = tid & 63, w = tid >> 6, cg = w & 3, kh = w >> 2, lr = lane & 15, kg = lane >> 4;
    LAS float* red = (LAS float*)lds;
    LAS float* c1s = (LAS float*)(lds + 32 * DD * 4);
    LAS bf16* hid = (LAS bf16*)(lds + 32 * DD * 4 + DD * 4);
    if (tid < DD) { float s = 0.f; for (int ch = 0; ch < nchunk; ++ch) s += c1p[ch * DD + tid]; c1s[tid] = s; }
    const bf16* abase[2];
#pragma unroll
    for (int rb = 0; rb < 2; ++rb) { int c = 32 * ct + 16 * rb + lr; c = c < 126 ? c : 126; abase[rb] = zsrc + (size_t)(b * SEQ + 16 * c) * ZLD + g * DD + 8 * kg; }
    const bf16* bbase = w1t + (size_t)(16 * cg * NCB + lr) * KD + 8 * kg;
    f32x4 acc[2][NCB];
#pragma unroll
    for (int rb = 0; rb < 2; ++rb)
#pragma unroll
        for (int cb = 0; cb < NCB; ++cb) acc[rb][cb] = (f32x4){0.f, 0.f, 0.f, 0.f};
#pragma unroll 1
    for (int s4 = 0; s4 < NST; s4 += 8) {
        bf16x8 af[8][2], bfr[8][NCB];
#pragma unroll
        for (int q = 0; q < 8; ++q) { const int k0 = kh * KH + 32 * (s4 + q), lrow = k0 / DD, dcol = k0 % DD;
#pragma unroll
            for (int rb = 0; rb < 2; ++rb) af[q][rb] = *(const bf16x8*)(abase[rb] + (size_t)lrow * ZLD + dcol);
#pragma unroll
            for (int cb = 0; cb < NCB; ++cb) bfr[q][cb] = *(const bf16x8*)(bbase + (size_t)(16 * cb) * KD + k0); }
#pragma unroll
        for (int q = 0; q < 8; ++q)
#pragma unroll
            for (int rb = 0; rb < 2; ++rb)
#pragma unroll
                for (int cb = 0; cb < NCB; ++cb) acc[rb][cb] = __builtin_amdgcn_mfma_f32_16x16x32_bf16(af[q][rb], bfr[q][cb], acc[rb][cb], 0, 0, 0);
    }
    if (kh == 1) {
#pragma unroll
        for (int rb = 0; rb < 2; ++rb)
#pragma unroll
            for (int cb = 0; cb < NCB; ++cb)
#pragma unroll
                for (int r = 0; r < 4; ++r) red[(16 * rb + 4 * kg + r) * DD + 16 * (cg * NCB + cb) + lr] = acc[rb][cb][r];
    }
    LDS_WAIT(); __syncthreads();
    if (kh == 0) {
#pragma unroll
        for (int rb = 0; rb < 2; ++rb)
#pragma unroll
            for (int cb = 0; cb < NCB; ++cb)
#pragma unroll
                for (int r = 0; r < 4; ++r) { const int row = 16 * rb + 4 * kg + r, col = 16 * (cg * NCB + cb) + lr;
                    const float x = acc[rb][cb][r] + red[row * DD + col] + c1s[col]; hid[row * HP + col] = f2bf(gelu_tanh(x));
                    }
    }
    LDS_WAIT(); __syncthreads();
#if defined(COMPRESS_S2_SCALAR)
    for (int o = tid; o < 32 * DD; o += 512) { const int row = o / DD, col = o % DD; float s2 = 0.f; const bf16* wr = w2t + (size_t)col * DD;
        for (int j = 0; j < DD; ++j) s2 += bf2f(hid[row * HP + j]) * bf2f(wr[j]);
        const int c = 32 * ct + row; out[((size_t)(b * 2 + g) * 128 + c) * DD + col] = c < 127 ? f2bf(s2) : (bf16)0; }
#else
    constexpr int NBLK = 2 * (DD / 16);
    for (int blk = w; blk < NBLK; blk += 8) {
        const int rb = blk & 1, cb = blk >> 1;
        f32x4 c4 = (f32x4){0.f, 0.f, 0.f, 0.f};
#pragma unroll
        for (int s = 0; s < DD / 32; ++s) {
            const bf16x8 af = *(const LAS bf16x8*)(hid + (16 * rb + lr) * HP + 32 * s + 8 * kg);
            const bf16x8 bfr = *(const bf16x8*)(w2t + (size_t)(16 * cb + lr) * DD + 32 * s + 8 * kg);
            c4 = __builtin_amdgcn_mfma_f32_16x16x32_bf16(af, bfr, c4, 0, 0, 0);
            asm volatile("" :: "v"(af), "v"(bfr));
        }
#pragma unroll
        for (int r = 0; r < 4; ++r) { const int c = 32 * ct + 16 * rb + 4 * kg + r; out[((size_t)(b * 2 + g) * 128 + c) * DD + 16 * cb + lr] = c < 127 ? f2bf(c4[r]) : (bf16)0; }
    }
#endif
    LDS_WAIT(); __syncthreads();
}

template <int DD>
__device__ __forceinline__ void compress_ref(int b, int g, int c, const bf16* zsrc, const bf16* w1t, const bf16* w2t, const float* c1p, int nchunk, bf16* out, LAS unsigned char* lds, int tid) {
    constexpr int KD = 32 * DD;
    LAS float* hid = (LAS float*)lds;
    if (tid < DD) {
        float s = 0.f; for (int ch = 0; ch < nchunk; ++ch) s += c1p[ch * DD + tid];
        const bf16* wr = w1t + (size_t)tid * KD;
        for (int l = 0; l < 32; ++l) { const bf16* zr = zsrc + (size_t)(b * SEQ + 16 * c + l) * ZLD + g * DD;
            for (int d = 0; d < DD; d += 8) { const u32x4 zv = *(const u32x4*)(zr + d), wv = *(const u32x4*)(wr + l * DD + d);
                s += bflo(zv.x) * bflo(wv.x) + bfhi(zv.x) * bfhi(wv.x) + bflo(zv.y) * bflo(wv.y) + bfhi(zv.y) * bfhi(wv.y) + bflo(zv.z) * bflo(wv.z) + bfhi(zv.z) * bfhi(wv.z) + bflo(zv.w) * bflo(wv.w) + bfhi(zv.w) * bfhi(wv.w); } }
        hid[tid] = bf2f(f2bf(gelu_tanh(s)));
    }
    LDS_WAIT(); __syncthreads();
    if (tid < DD) { float s = 0.f; const bf16* wr = w2t + (size_t)tid * DD; for (int j = 0; j < DD; ++j) s += hid[j] * bf2f(wr[j]); out[((size_t)(b * 2 + g) * 128 + c) * DD + tid] = f2bf(s); }
    LDS_WAIT(); __syncthreads();
}

constexpr float CS128 = 0.08838834764831845f * LOG2E, CS192 = 0.07216878364870323f * LOG2E;
constexpr int WBIG = 1 << 30;

__device__ __forceinline__ void fox_sub(int b, int h, int qt, const bf16* z, const float* kb, bf16* ofox, LAS unsigned char* lds, int tid) {
    const int lane = tid & 63, w = tid >> 6, tw0 = 256 * qt + 32 * w, t = tw0 + (lane & 31); const size_t row = (size_t)b * SEQ + t;
    bf16x8 qf[8]; att::load_q<128>(qf, z + row * ZLD + ZC_FQ + h * 128, lane);
    LAS float* kbl = (LAS float*)(lds + att::KB_OFF);
    if (tid * 4 < 256 * (qt + 1)) *(LAS f32x4*)(kbl + tid * 4) = *(const f32x4*)(kb + (size_t)(b * 8 + h) * SEQ + tid * 4);
    att::State st; att::state_init(st);
    att::attn_run<128, true, true, false, false>(lds, z + (size_t)b * SEQ * ZLD + ZC_FK + h * 128, ZLD, z + (size_t)b * SEQ * ZLD + ZC_FV + h * 128, ZLD, 0, 4 * (qt + 1),
                                                 qf, t, tw0, WBIG, kbl, nullptr, 0u, CS128, st, tid);
    att::store_o<0>(st, 1.f / st.l, ofox + row * 3072 + h * 128, nullptr, lane);
}
__device__ __forceinline__ void mla_sub(int b, int h, int qt, const bf16* qm, const bf16* km, const bf16* vm, bf16* omla, LAS unsigned char* lds, int tid) {
    const int lane = tid & 63, w = tid >> 6, tw0 = 256 * qt + 32 * w, t = tw0 + (lane & 31); const size_t row = (size_t)b * SEQ + t;
    bf16x8 qf[12]; att::load_q<192>(qf, qm + row * 1536 + h * 192, lane);
    att::State st; att::state_init(st);
    att::attn_run<192, true, false, false, false>(lds, km + (size_t)b * SEQ * 1536 + h * 192, 1536, vm + (size_t)b * SEQ * 1024 + h * 128, 1024, 0, 4 * (qt + 1),
                                                  qf, t, tw0, WBIG, nullptr, nullptr, 0u, CS192, st, tid);
    att::store_o<0>(st, 1.f / st.l, omla + row * 3072 + h * 128, nullptr, lane);
}
__device__ __forceinline__ void mem_unit(int uid, const bf16* qmem, const bf16* kvmem, bf16* omem, LAS unsigned char* lds, int tid) {
    const int b = uid >> 5, h = (uid >> 3) & 3, qt = uid & 7;
    const int lane = tid & 63, w = tid >> 6, tw0 = 256 * qt + 32 * w, t = tw0 + (lane & 31); const size_t row = (size_t)b * SEQ + t;
    bf16x8 qf[8]; att::load_q<128>(qf, qmem + row * 512 + h * 128, lane);
    att::State st; att::state_init(st);
    att::attn_run<128, false, false, false, false>(lds, kvmem + (size_t)b * MEML * 1024 + h * 128, 1024, kvmem + (size_t)b * MEML * 1024 + 512 + h * 128, 1024, 0, 4,
                                                   qf, t, tw0, WBIG, nullptr, nullptr, 0u, CS128, st, tid);
    att::store_o<0>(st, 1.f / st.l, omem + row * 512 + h * 128, nullptr, lane);
}
__device__ __forceinline__ void nsa_tabs(const float* tabd, int g, LAS unsigned char* lds, int tid) {
    LAS float* tab = (LAS float*)(lds + att::TAB_OFF);
    for (int i = tid; i < 4 * 132; i += 512) tab[i] = tabd[g * 4 * 132 + i];
    LDS_WAIT(); __syncthreads();
}
__device__ __forceinline__ void nsa_win_unit(int uid, const bf16* z, const float* zs, const float* tabd, bf16* ow, LAS unsigned char* lds, int tid) {
    const int b = uid >> 6, g = (uid >> 5) & 1, qt = uid & 31;
    const int lane = tid & 63, w = tid >> 6, hh = w >> 1, head = g * 4 + hh, tw0 = 64 * qt + 32 * (w & 1), t = tw0 + (lane & 31); const size_t row = (size_t)b * SEQ + t;
    nsa_tabs(tabd, g, lds, tid);
    bf16x8 qf[12]; att::load_q<192>(qf, z + row * ZLD + ZC_NQ + head * 192, lane);
    att::State st; att::state_init(st);
    att::attn_run<192, true, false, true, false>(lds, z + (size_t)b * SEQ * ZLD + ZC_NKW + g * 192, ZLD, z + (size_t)b * SEQ * ZLD + ZC_NVW + g * 128, ZLD, qt >= 8 ? qt - 8 : 0, qt + 1,
                                                 qf, t, tw0, 512, nullptr, (const LAS float*)(lds + att::TAB_OFF) + hh * 132, 0u, CS192, st, tid);
    const float g2 = sigmoidf_(zs[row * 32 + 8 + head * 3 + 2]);
    att::store_o<0>(st, g2 / st.l, ow + row * 1024 + head * 128, nullptr, lane);
}
__device__ __forceinline__ void nsa_cmp_sub(int b, int g, int qt, const bf16* z, const float* zs, const float* tabd, const bf16* kc, const bf16* vc, bf16* ow, unsigned* rmaskg,
                                            LAS unsigned char* lds, int tid) {
    const int lane = tid & 63, w = tid >> 6, hh = w >> 1, head = g * 4 + hh, hf = w & 1, tw0 = 64 * qt + 32 * hf, t = tw0 + (lane & 31), hi = lane >> 5; const size_t row = (size_t)b * SEQ + t;
    const int rowl = 32 * hf + (lane & 31);
    nsa_tabs(tabd, g, lds, tid);
    const LAS float* tab = (const LAS float*)(lds + att::TAB_OFF) + hh * 132;
    {
        const bf16* Kc = kc + (size_t)(b * 2 + g) * 128 * 192; const bf16* Vc = vc + (size_t)(b * 2 + g) * 128 * 128;
        att::dma_tile<192>(lds, Kc, 192, Vc, 128, 0, __builtin_amdgcn_readfirstlane(w), lane);
        att::dma_tile<192>(lds + att::Geo<192>::BUF, Kc, 192, Vc, 128, 1, __builtin_amdgcn_readfirstlane(w), lane);
    }
    VM_WAIT(); LDS_WAIT(); __syncthreads();
    bf16x8 qf[12]; att::load_q<192>(qf, z + row * ZLD + ZC_NQ + head * 192, lane);
    att::State st; att::state_init(st);
    float impm[16], impt[1];
#pragma unroll
    for (int i = 0; i < 16; ++i) impm[i] = 0.f;
    impt[0] = 0.f;
    att::tile_compute<192, true, false, true, false, true, 0>(lds, 0, qf, t, tw0, 0x7fffffff, nullptr, tab, 0u, CS192, st, impm, impt, lane);
    att::tile_compute<192, true, false, true, false, true, 1>(lds + att::Geo<192>::BUF, 1, qf, t, tw0, 0x7fffffff, nullptr, tab, 0u, CS192, st, impm, impt, lane);
    LDS_WAIT(); __syncthreads();
    const float inv = st.l > 0.f ? 1.f / st.l : 0.f;
    LAS float* IA = (LAS float*)lds;
#pragma unroll
    for (int i = 0; i < 16; ++i) { const int n = 16 * (i >> 3) + 8 * ((i >> 2) & 1) + 2 * (i & 3) + hi; IA[(hh * 64 + rowl) * 33 + n] = impm[i] * inv; }
    const float g0 = sigmoidf_(zs[row * 32 + 8 + head * 3 + 0]);
    att::store_o<1>(st, g0 * inv, ow + row * 1024 + head * 128, nullptr, lane);
    LDS_WAIT(); __syncthreads();
    {
        const int cur = qt, n = lane & 31;
#pragma unroll 1
        for (int ps = 0; ps < 4; ++ps) {
            const int r = w * 8 + ps * 2 + (lane >> 5);
            float imp = 0.f;
#pragma unroll
            for (int q = 0; q < 4; ++q) imp += IA[(q * 64 + r) * 33 + n];
            unsigned mask;
            if (cur < 8) mask = (2u << cur) - 1u;
            else {
                mask = 1u | (1u << cur) | (1u << (cur - 1));
                float val = (n >= 1 && n <= cur - 2) ? imp : -1.f;
#pragma unroll 1
                for (int k = 0; k < 5; ++k) {
                    float vm = val;
#pragma unroll
                    for (int o = 1; o < 32; o <<= 1) vm = fmaxf(vm, shx(vm, o, lane));
                    const unsigned long long bal = __ballot(val == vm && val >= 0.f);
                    const unsigned hm = (unsigned)(bal >> (lane & 32));
                    const int best = __ffs(hm) - 1;
                    mask |= 1u << best; if (n == best) val = -1.f;
                }
            }
            if (n == 0) rmaskg[(size_t)(b * 2 + g) * SEQ + 64 * qt + r] = mask;
        }
    }
    VM_WAIT(); LDS_WAIT(); __syncthreads();
}
__device__ __forceinline__ void nsa_sel_sub(int b, int g, int qt, const bf16* z, const float* zs, const float* tabd, const bf16* ow, const unsigned* rmaskg, bf16* onsa,
                                            LAS unsigned char* lds, int tid) {
    const int lane = tid & 63, w = tid >> 6, hh = w >> 1, head = g * 4 + hh, hf = w & 1, tw0 = 64 * qt + 32 * hf, t = tw0 + (lane & 31); const size_t row = (size_t)b * SEQ + t;
    nsa_tabs(tabd, g, lds, tid);
    const LAS float* tab = (const LAS float*)(lds + att::TAB_OFF) + hh * 132;
    bf16x8 qf[12]; att::load_q<192>(qf, z + row * ZLD + ZC_NQ + head * 192, lane);
    const unsigned rowmask = rmaskg[(size_t)(b * 2 + g) * SEQ + t];
    att::State st; att::state_init(st);
    att::attn_run<192, true, false, true, true>(lds, z + (size_t)b * SEQ * ZLD + ZC_NKS + g * 192, ZLD, z + (size_t)b * SEQ * ZLD + ZC_NVS + g * 128, ZLD, 0, qt + 1,
                                                qf, t, tw0, WBIG, nullptr, tab, rowmask, CS192, st, tid);
    const float g1 = sigmoidf_(zs[row * 32 + 8 + head * 3 + 1]);
    att::store_o<2>(st, g1 / st.l, onsa + row * 3072 + head * 128, ow + row * 1024 + head * 128, lane);
}

__device__ __forceinline__ void ph_route1(const float* plog, const float* hssq, const float* bias, float* rstd2, unsigned* cnt, int* asge, int* asgi, float* asgw, int tid) {
    for (int t = blockIdx.x * 512 + tid; t < NT; t += gridDim.x * 512) {
        float ss = 0.f;
#pragma unroll
        for (int j = 0; j < 8; ++j) { const f32x4 p = *(const f32x4*)(hssq + (size_t)t * 32 + 4 * j); ss += (p[0] + p[1]) + (p[2] + p[3]); }
        const float rs = rsqrtf(ss * (1.f / 2048.f) + EPS); rstd2[t] = rs;
        f32x4 gl = *(const f32x4*)(plog + (size_t)t * 64);
#pragma unroll
        for (int sl = 1; sl < 4; ++sl) gl += *(const f32x4*)(plog + (size_t)sl * NT * 64 + (size_t)t * 64);
        gl = gl * rs + *(const f32x4*)bias;
        int gs = 0; float gm = gl[0];
        if (gl[1] > gm) { gm = gl[1]; gs = 1; } if (gl[2] > gm) { gm = gl[2]; gs = 2; } if (gl[3] > gm) { gm = gl[3]; gs = 3; }
        const float pg = 1.f / (expf(gl[0] - gm) + expf(gl[1] - gm) + expf(gl[2] - gm) + expf(gl[3] - gm));
        f32x4 e0 = *(const f32x4*)(plog + (size_t)t * 64 + 4 + gs * 8), e1 = *(const f32x4*)(plog + (size_t)t * 64 + 8 + gs * 8);
#pragma unroll
        for (int sl = 1; sl < 4; ++sl) { e0 += *(const f32x4*)(plog + (size_t)sl * NT * 64 + (size_t)t * 64 + 4 + gs * 8); e1 += *(const f32x4*)(plog + (size_t)sl * NT * 64 + (size_t)t * 64 + 8 + gs * 8); }
        e0 = e0 * rs + *(const f32x4*)(bias + 4 + gs * 8); e1 = e1 * rs + *(const f32x4*)(bias + 8 + gs * 8);
        float ev[8] = {e0[0], e0[1], e0[2], e0[3], e1[0], e1[1], e1[2], e1[3]};
        int j0 = 0; float v0 = ev[0];
#pragma unroll
        for (int j = 1; j < 8; ++j) if (ev[j] > v0) { v0 = ev[j]; j0 = j; }
        int j1 = -1; float v1 = -3.0e38f;
#pragma unroll
        for (int j = 0; j < 8; ++j) if (j != j0 && ev[j] > v1) { v1 = ev[j]; j1 = j; }
        const float x1 = expf(v1 - v0), w0 = pg / (1.f + x1), w1 = pg * x1 / (1.f + x1);
        const int ea = gs * 8 + j0, eb = gs * 8 + j1;
        asge[2 * t] = ea; asge[2 * t + 1] = eb; asgw[2 * t] = w0; asgw[2 * t + 1] = w1;
        asgi[2 * t] = (int)atomicAdd(cnt + ea, 1u); asgi[2 * t + 1] = (int)atomicAdd(cnt + eb, 1u);
    }
}
__device__ __forceinline__ void ph_route2(const unsigned* cnt, const int* asge, const int* asgi, const float* asgw, const float* rstd2,
                                          int* pos, float* roww, float* rowr, int* tile, int* rowtok, LAS unsigned char* lds, int tid) {
    LAS int* ps = (LAS int*)lds;
    if (tid < NEXP) ps[64 + tid] = (int)cnt[tid];
    LDS_WAIT(); __syncthreads();
    if (tid == 0) { int acc = 0;
#pragma unroll 1
        for (int e = 0; e < NEXP; ++e) { const int c = ps[64 + e]; ps[e] = acc; acc += ((c + 255) >> 8) << 8; } ps[32] = acc; }
    LDS_WAIT(); __syncthreads();
    if (blockIdx.x == 0 && tid == 0) { int rt = 0;
#pragma unroll 1
        for (int e = 0; e < NEXP; ++e) { const int n = (ps[e + 1] - ps[e]) >> 8;
#pragma unroll 1
            for (int i = 0; i < n; ++i) tile[rt++] = e; }
        tile[200] = rt;
#pragma clang loop vectorize(disable) unroll(disable)
        for (; rt < 200; ++rt) tile[rt] = -1; }
    const int gt = blockIdx.x * 512 + tid, NGT = gridDim.x * 512;
    for (int it = gt; it < NT * 2; it += NGT) {
        const int e = asge[it], dest = ps[e] + asgi[it], t = it >> 1;
        roww[dest] = asgw[it]; rowr[dest] = rstd2[t]; pos[it] = dest; rowtok[dest] = t;
    }
    for (int it = gt; it < NEXP * 256; it += NGT) {
        const int e = it >> 8, r = it & 255, c = ps[64 + e], pc = ps[e + 1] - ps[e] - c;
        if (r < pc) { const int dest = ps[e] + c + r; roww[dest] = 0.f; rowr[dest] = 0.f; rowtok[dest] = 0; }
    }
}
__device__ __forceinline__ void ph_combine(const bf16* y, const int* pos, bf16* hbf, unsigned char* h8, float* rstd0, const float* gfin, float* out, bool last, int lane, int wave) {
    const int gw = blockIdx.x * NWAVES + wave, NGW = gridDim.x * NWAVES;
    int p0 = 0, p1 = 0; if (gw < NT) { p0 = pos[2 * gw]; p1 = pos[2 * gw + 1]; }
    f32x4 gv[8];
#pragma unroll
    for (int j = 0; j < 8; ++j) gv[j] = last ? ((const f32x4*)gfin + lane)[64 * j] : (f32x4){1.f, 1.f, 1.f, 1.f};
    for (int t = gw; t < NT; t += NGW) {
        int q0 = 0, q1 = 0; if (t + NGW < NT) { q0 = pos[2 * (t + NGW)]; q1 = pos[2 * (t + NGW) + 1]; }
        u32x2* hr = (u32x2*)(hbf + (size_t)t * DM) + lane; const u32x2* y0 = (const u32x2*)(y + (size_t)p0 * DM) + lane; const u32x2* y1 = (const u32x2*)(y + (size_t)p1 * DM) + lane;
        f32x4 v[8]; float s = 0.f;
#pragma unroll
        for (int j = 0; j < 8; ++j) { const u32x2 a = y0[64 * j], c = y1[64 * j], hw = hr[64 * j]; f32x4 h;
            h[0] = (bflo(hw.x) + bflo(a.x)) + bflo(c.x); h[1] = (bfhi(hw.x) + bfhi(a.x)) + bfhi(c.x); h[2] = (bflo(hw.y) + bflo(a.y)) + bflo(c.y); h[3] = (bfhi(hw.y) + bfhi(a.y)) + bfhi(c.y);
            v[j] = h; s += dot4v(h); }
        s = wave_sum(s, lane); const float rs = rsqrtf(s * (1.f / 2048.f) + EPS);
        if (!last) {
#pragma unroll
            for (int j = 0; j < 8; ++j) { u32x2 w; w.x = cvt_pk_bf16(v[j][0], v[j][1]); w.y = cvt_pk_bf16(v[j][2], v[j][3]); hr[64 * j] = w; }
#pragma unroll
            for (int j = 0; j < 8; ++j) ((unsigned*)(h8 + (size_t)t * DM))[lane + 64 * j] = pk4_fp8(v[j][0], v[j][1], v[j][2], v[j][3]);
            if (lane == 0) rstd0[t] = rs;
        } else {
            f32x4* orow = (f32x4*)(out + (size_t)t * DM) + lane;
#pragma unroll
            for (int j = 0; j < 8; ++j) orow[64 * j] = v[j] * rs * gv[j];
        }
        p0 = q0; p1 = q1;
    }
}
__device__ __forceinline__ GAS unsigned char* lws(unsigned char* p) { const unsigned long long v0 = (unsigned long long)p; unsigned lo = (unsigned)v0, hi = (unsigned)(v0 >> 32);
    { unsigned lv, hv; asm volatile("v_mov_b32 %0, %2\n\tv_mov_b32 %1, %3" : "=&v"(lv), "=&v"(hv) : "s"(lo), "s"(hi)); lo = __builtin_amdgcn_readfirstlane(lv); hi = __builtin_amdgcn_readfirstlane(hv); } return (GAS unsigned char*)(((unsigned long long)hi << 32) | lo); }
#define ltid() (wave0 * 64 + llane())
constexpr int NCONV_BLOCKS = 32;
constexpr int NPH_LAYER = 15, NPHASES = 1 + DEPTH * NPH_LAYER;
__device__ __forceinline__ KA kargs() {
    KA k;
#if defined(__HIP_DEVICE_COMPILE__)
    const unsigned long long v0 = (unsigned long long)(KArgP)__builtin_amdgcn_kernarg_segment_ptr(); unsigned lo = (unsigned)v0, hi = (unsigned)(v0 >> 32);
    { unsigned lv, hv; asm volatile("v_mov_b32 %0, %2\n\tv_mov_b32 %1, %3" : "=&v"(lv), "=&v"(hv) : "s"(lo), "s"(hi)); lo = __builtin_amdgcn_readfirstlane(lv); hi = __builtin_amdgcn_readfirstlane(hv); }
    k.in.p = (KArgP)(((unsigned long long)hi << 32) | lo); k.out = k.in.p->out; k.ws = k.in.p->ws;
#else
    k.in.p = nullptr; k.out = nullptr; k.ws = nullptr;
#endif
    return k;
}
__global__ void __launch_bounds__(512, 2) fwd(Args a) {
    extern __shared__ __attribute__((aligned(16))) unsigned char lds_[];
    LAS unsigned char* lds = (LAS unsigned char*)lds_;
    const int tid = threadIdx.x; const int wave0 = __builtin_amdgcn_readfirstlane(tid >> 6);
    const int G = gridDim.x, bx = blockIdx.x;
    gu32* ctl = (gu32*)(a.ws + WS_CTL);
    for (int u = tid; u < (LDS_BYTES - LDSCTL_OFF) / 4; u += 512) ((LAS unsigned*)(lds + LDSCTL_OFF))[u] = 0u;
    __syncthreads();
    const int lo = a.ph_lo, hi = a.ph_hi;
    XcdBarrier bar; bar.bar = (unsigned*)ctl + CW_BAR; bar.x = 0; bar.st = nullptr;
    if (hi - lo > 1) bar = xcd_barrier_post((unsigned*)ctl + CW_BAR, (volatile LAS unsigned*)(lds + MISC_OFF) + 8);
#define IN(k) (lo <= (k) && (k) < hi)
#if defined(TIMING_A)
#define STAMP(k) do { const unsigned long long now_ = __builtin_amdgcn_s_memrealtime(); GAS unsigned char* wsp_ = lws(a.ws); if (bx == 0 && llane() == 0 && wave0 == 0) { ((volatile GAS unsigned long long*)(wsp_ + WS_DBG))[8 + (k)] = now_; } } while (0)
#else
#define STAMP(k) do { } while (0)
#endif
#define SEAM(k) do { if (IN(k) && IN((k) + 1)) xcd_barrier(bar); STAMP(k); } while (0)

#define hbf ((bf16*)(ws + WS_HBF))
#define hf ((float*)(ws + WS_HF))
#define z ((bf16*)(ws + WS_Z))
#define zs ((float*)(ws + WS_ZS))
#define zssq ((float*)(ws + WS_ZSSQ))
#define hssq ((float*)(ws + WS_HSSQ))
#define rstd0 ((float*)(ws + WS_RSTD0))
#define rstd2 ((float*)(ws + WS_RSTD2))
#define qm ((bf16*)(ws + WS_QM))
#define km ((bf16*)(ws + WS_KM))
#define vm ((bf16*)(ws + WS_VM))
#define kc ((bf16*)(ws + WS_KC))
#define vc ((bf16*)(ws + WS_VC))
#define kb ((float*)(ws + WS_KB))
#define o3 ((bf16*)(ws + WS_O3))
#define ow ((bf16*)(ws + WS_OW))
#define mpart ((float*)(ws + WS_MPART))
#define mbf ((bf16*)(ws + WS_MBF))
#define qmem ((bf16*)(ws + WS_QMEM))
#define kvmem ((bf16*)(ws + WS_KVMEM))
#define omem ((bf16*)(ws + WS_OMEM))
#define logits ((float*)(ws + WS_LOGIT))
#define rope ((const float*)(ws + WS_ROPE))
#define tabd ((const float*)(ws + WS_TABD))
#define asge ((int*)(ws + WS_ASGE))
#define asgi ((int*)(ws + WS_ASGI))
#define asgw ((float*)(ws + WS_ASGW))
#define pos ((int*)(ws + WS_POS))
#define roww ((float*)(ws + WS_ROWW))
#define rowr ((float*)(ws + WS_ROWR))
#define tile ((int*)(ws + WS_TILE))
#define xg ((bf16*)(ws + WS_XG))
#define hdn ((bf16*)(ws + WS_HDN))
#define yb ((bf16*)(ws + WS_Y))
#ifndef PHMASK
#define PHMASK 0xFFFFFFFFu
#endif
#define EN(k) ((PHMASK >> (k)) & 1u)
    if (lo == 0) { STAMP(-1); }
    if (EN(0) && IN(0)) { asm volatile("; PHMARK 0"); const KA a = kargs(); GAS unsigned char* ws = lws(a.ws); (void)ws; { const int t_ = ltid(); ph_pre(a, t_, t_ & 63, __builtin_amdgcn_readfirstlane(t_ >> 6)); } }
#pragma unroll 1
    for (int l = -1; l < DEPTH; ++l) {
        const int pb = 1 + NPH_LAYER * l;
        if (l >= 0) {
        if (EN(2) && IN(pb + 1)) { asm volatile("; PHMARK 2"); const KA a = kargs(); GAS unsigned char* ws = lws(a.ws); (void)ws;
            if (EN(16)) { pg8::Gemm g{hbf, (const bf16*)(ws + WS_WIN), DM, DM}; pg8::WinOrder S; S.init(NT, (55 - F8_NT) * 256, G, bx);
              pg8::EpiWin E{z, zs, zssq, rstd0, km, rope}; pg8::gemm_phase(lds, g, S, E, ltid()); }
            if (EN(16)) { pg8::Gemm g{(const bf16*)(ws + WS_H8), (const bf16*)(ws + WS_WG8), DM / 2, DM / 2}; pg8::StaticOrder S; S.init(NT, F8_NT * 256, G, G - 1 - bx);
              pg8::EpiWin8 E{z, rstd0}; pg8::gemm_phase(lds, g, S, E, ltid()); }
        }
        SEAM(pb + 1);
        if (EN(3) && IN(pb + 2)) { asm volatile("; PHMARK 3"); const KA a = kargs(); GAS unsigned char* ws = lws(a.ws); (void)ws;
            if (EN(18)) { pg8::Gemm g{z + ZC_MCQ, (const bf16*)(ws + WS_WUQ), ZLD, 768}; pg8::StaticOrder S; S.init(NT, 1536, G, bx);
              pg8::EpiMlaQ E{qm, zssq, rope}; pg8::gemm_phase(lds, g, S, E, ltid()); }
            if (EN(19)) { pg8::Gemm g{z + ZC_MCKV, (const bf16*)(ws + WS_WUKV), ZLD, 512}; pg8::StaticOrder S; S.init(NT, 2048, G, bx);
              pg8::EpiMlaKV E{km, vm, zssq}; pg8::gemm_phase(lds, g, S, E, ltid()); }
            if (EN(21)) { const int t_ = ltid(); for (int it = (G - 1 - bx) * NWAVES + __builtin_amdgcn_readfirstlane(t_ >> 6); it < 64; it += G * NWAVES) cumsum_item(it, zs, a.in[4] + l * 8, kb, t_ & 63); }
#if defined(COMPRESS_REF)
            if (EN(22)) for (int u = bx; u < 2 * 16 * 128; u += G) {
                const int br = u >> 11, rem = u & 2047, bg = rem >> 7, c = rem & 127; const int t_ = ltid();
                if (c < 127) { if (br == 0) compress_ref<192>(bg >> 1, bg & 1, c, z + ZC_NKC, (const bf16*)(ws + WS_WCK1), (const bf16*)(ws + WS_WCK2), (const float*)(ws + WS_C1P), 96, kc, lds, t_);
                               else compress_ref<128>(bg >> 1, bg & 1, c, z + ZC_NVC, (const bf16*)(ws + WS_WCV1), (const bf16*)(ws + WS_WCV2), (const float*)(ws + WS_C1P) + 96 * 192, 64, vc, lds, t_); }
                else { bf16* o = (br == 0 ? kc + (size_t)bg * 128 * 192 + 127 * 192 : vc + (size_t)bg * 128 * 128 + 127 * 128); if (t_ < (br == 0 ? 192 : 128)) o[t_] = 0; }
            }
#else
#endif
            {
                const int NQ = (G & 7) == 0 ? 8 : 1, qid = NQ == 8 ? (bx & 7) : 0, ncq = 128 / NQ, nwq = 512 / NQ;
                gu32* q = ctl + CW_WQ + (l * 8 + qid) * 32; LAS int* slot = (LAS int*)(lds + LDSCTL_OFF + 2048);
#pragma unroll 1
                for (;;) { const int j = q_next(q, slot, ltid()); if (j >= ncq + nwq) break;
                    if (j < ncq) {
#if !defined(COMPRESS_REF)
                        if (EN(22)) { const int gj = qid * ncq + j, b = gj >> 4, r = gj & 15, br = r >> 3, g2 = (r >> 2) & 1, ct = r & 3;
                            if (br == 0) compress_body<192>(b, g2, ct, z + ZC_NKC, (const bf16*)(ws + WS_WCK1), (const bf16*)(ws + WS_WCK2), (const float*)(ws + WS_C1P), 96, kc, lds, ltid(), (unsigned*)ctl + CW_CHK);
                            else compress_body<128>(b, g2, ct, z + ZC_NVC, (const bf16*)(ws + WS_WCV1), (const bf16*)(ws + WS_WCV2), (const float*)(ws + WS_C1P) + 96 * 192, 64, vc, lds, ltid(), (unsigned*)ctl + CW_CHK + 8); }
#endif
                    } else if (EN(20)) { const int gj = qid * nwq + (j - ncq), bb = gj >> 6, r = gj & 63;
                        nsa_win_unit(bb * 64 + (r & 1) * 32 + (31 - (r >> 1)), z, zs, tabd, ow, lds, ltid()); }
                }
            }
        }
        SEAM(pb + 2);
        if (EN(4) && IN(pb + 3)) { asm volatile("; PHMARK 4"); const KA a = kargs(); GAS unsigned char* ws = lws(a.ws); (void)ws;
            const bool g256 = (G == 256); const int cg = g256 ? (bx >> 5) & 3 : 0;
            const int gwv = (g256 ? cg * 64 + (bx >> 7) * 32 + (bx & 31) : bx) * NWAVES + wave0, NGWv = G * NWAVES, nper = g256 ? CONV_N_ATT : (MOE_ITEMS + NGWv - 1) / NGWv;
#pragma unroll 1
            for (int sg = 0; sg < 4; ++sg) {
                if (EN(27) && sg == cg) { moe_convert(a, l, gwv, NGWv, 0, nper, llane()); asm volatile("s_waitcnt vmcnt(0)" ::: "memory"); }
                if (sg == 0) { if (EN(23)) for (int u = bx; u < 256; u += G) { const int v = (u & 7) * 32 + (u >> 3); const int bh = v >> 2, p = v & 3;
                    fox_sub(bh >> 3, bh & 7, 7 - p, z, kb, o3, lds, ltid()); fox_sub(bh >> 3, bh & 7, p, z, kb, o3, lds, ltid()); } }
                else if (sg == 1) { if (EN(24)) for (int u = bx; u < 256; u += G) { const int v = (u & 7) * 32 + (u >> 3); const int bh = v >> 2, p = v & 3;
                    mla_sub(bh >> 3, bh & 7, 7 - p, qm, km, vm, o3 + 1024, lds, ltid()); mla_sub(bh >> 3, bh & 7, p, qm, km, vm, o3 + 1024, lds, ltid()); } }
                else if (sg == 2) { if (EN(25)) for (int u = bx; u < 256; u += G) { const int v = (u & 7) * 32 + (u >> 3); const int b = v >> 5, g2 = (v >> 4) & 1, p = v & 15;
                    nsa_cmp_sub(b, g2, 31 - p, z, zs, tabd, kc, vc, ow, (unsigned*)(ws + WS_RMASK), lds, ltid()); nsa_cmp_sub(b, g2, p, z, zs, tabd, kc, vc, ow, (unsigned*)(ws + WS_RMASK), lds, ltid()); } }
                else { if (EN(26)) for (int u = bx; u < 256; u += G) { const int v = (u & 7) * 32 + (u >> 3); const int b = v >> 5, g2 = (v >> 4) & 1, p = v & 15;
                    nsa_sel_sub(b, g2, 31 - p, z, zs, tabd, ow, (const unsigned*)(ws + WS_RMASK), o3 + 2048, lds, ltid());
                    nsa_sel_sub(b, g2, p, z, zs, tabd, ow, (const unsigned*)(ws + WS_RMASK), o3 + 2048, lds, ltid()); } }
            }
        }
        SEAM(pb + 3);
        if (EN(5) && IN(pb + 4)) { asm volatile("; PHMARK 5"); const KA a = kargs(); GAS unsigned char* ws = lws(a.ws); (void)ws;
            pg8::Gemm g{o3, (const bf16*)(ws + WS_WBR), 3072, 3072}; pg8::StaticOrder S; S.init(NT, 2048, G, bx);
            pg8::EpiBranch E{z, mbf}; pg8::gemm_phase(lds, g, S, E, ltid());
        }
        SEAM(pb + 4);
        if (EN(6) && IN(pb + 5)) { asm volatile("; PHMARK 6"); const KA a = kargs(); GAS unsigned char* ws = lws(a.ws); (void)ws;
            pg8::Gemm g{mbf, (const bf16*)(ws + WS_WOUT), F8_OUT ? DM / 2 : DM, F8_OUT ? DM / 2 : DM}; pg8::StaticOrder S; S.init(NT, DM, G, bx);
            pg8::EpiResidT<F8_OUT != 0> E{hbf, hssq, nullptr}; pg8::gemm_phase(lds, g, S, E, ltid());
        }
        SEAM(pb + 5);
        if (EN(7) && IN(pb + 6)) { asm volatile("; PHMARK 7"); const KA a = kargs(); GAS unsigned char* ws = lws(a.ws); (void)ws;
            pg8::Gemm g{hbf, (const bf16*)(ws + WS_WMQ), DM, DM}; pg8::StaticOrder S; S.init(NT, 512, G, bx);
            pg8::EpiRowScale E{qmem, 512, nullptr, hssq}; pg8::gemm_phase(lds, g, S, E, ltid());
            {
            if (EN(17)) { pg8::Gemm g{(const bf16*)(ws + WS_MEMBF), (const bf16*)(ws + WS_WMKV), DM, DM}; pg8::StaticOrder S; S.init(NB * MEML, 1024, G, G - 1 - bx);
              pg8::EpiRowScale E{kvmem, 1024, (const float*)(ws + WS_RSTDM), nullptr}; pg8::gemm_phase(lds, g, S, E, ltid()); }
            }
            if (EN(27) && G == 256 && bx >= 128 && bx < 224) { moe_convert(a, l, CONV_N_ATT * 2048 + (bx - 128) * NWAVES + wave0, 96 * NWAVES, 0, ((48 - CONV_N_ATT) * 2048 + 96 * NWAVES - 1) / (96 * NWAVES), llane()); asm volatile("s_waitcnt vmcnt(0)" ::: "memory"); }
        }
        SEAM(pb + 6);
        if (EN(8) && IN(pb + 7)) { asm volatile("; PHMARK 8"); const KA a = kargs(); GAS unsigned char* ws = lws(a.ws); (void)ws; for (int u = bx; u < 256; u += G) mem_unit(u, qmem, kvmem, omem, lds, ltid()); }
        SEAM(pb + 7);
        if (EN(9) && IN(pb + 8)) { asm volatile("; PHMARK 9"); const KA a = kargs(); GAS unsigned char* ws = lws(a.ws); (void)ws;
            pg8::Gemm g{omem, (const bf16*)(ws + WS_WMO), 512, 512}; pg8::StaticOrder S; S.init(NT, DM, G, bx);
            pg8::EpiResid E{hbf, hssq, F8_GU ? (unsigned char*)(ws + WS_H8) : nullptr}; pg8::gemm_phase(lds, g, S, E, ltid());
        }
        SEAM(pb + 8);
        if (EN(10) && IN(pb + 9)) { asm volatile("; PHMARK 10"); const KA a = kargs(); GAS unsigned char* ws = lws(a.ws); (void)ws;
            const int G4 = G >> 2, sl = bx / G4;
            if (sl < 4) { pg8::Gemm g{hbf + 512 * sl, (const bf16*)(ws + WS_WR) + 512 * sl, DM, 512, DM}; pg8::StaticOrder S; S.init(NT, 256, G4, bx - sl * G4);
                pg8::EpiRouter E{logits + (size_t)sl * NT * 64}; pg8::gemm_phase(lds, g, S, E, ltid()); }
        }
        SEAM(pb + 9);
        }
        { const int ps = l < 0 ? 0 : pb + 10;
          if (EN(11) && IN(ps)) { asm volatile("; PHMARK 11"); const KA a = kargs(); GAS unsigned char* ws = lws(a.ws); (void)ws;
            if (l >= 0) ph_route1(logits, hssq, (const float*)(ws + WS_BRT) + 64 * l, rstd2, (unsigned*)ctl + CW_CNT + l * 64, asge, asgi, asgw, ltid());
            if (l + 1 < DEPTH) { const int t_ = ltid(); ph_conv(a, l + 1, lds, t_, t_ & 63, __builtin_amdgcn_readfirstlane(t_ >> 6), 0, 13, bx, G); } }
          SEAM(ps); }
        if (l >= 0) {

        if (EN(12) && IN(pb + 11)) { asm volatile("; PHMARK 12"); const KA a = kargs(); GAS unsigned char* ws = lws(a.ws); (void)ws; const int t_ = ltid(); ph_route2((const unsigned*)ctl + CW_CNT + l * 64, asge, asgi, asgw, rstd2, pos, roww, rowr, tile, (int*)xg, lds, t_); LDS_WAIT(); __syncthreads(); }
        SEAM(pb + 11);
        if (EN(13) && IN(pb + 12)) { asm volatile("; PHMARK 13"); const KA a = kargs(); GAS unsigned char* ws = lws(a.ws); (void)ws;
            pg8::Gemm g{F8_GU ? (const bf16*)(ws + WS_H8) : (const bf16*)hbf, (const bf16*)(ws + WS_WGU), F8_GU ? DM / 2 : DM, F8_GU ? DM / 2 : DM}; pg8::MoeGatherOrder S; S.init(tile, G, bx); S.rowtok = (const int*)xg;
            pg8::EpiGateUp E{hdn, rowr}; pg8::gemm_phase(lds, g, S, E, ltid());
        }
        SEAM(pb + 12);
        if (EN(14) && IN(pb + 13)) { asm volatile("; PHMARK 14"); const KA a = kargs(); GAS unsigned char* ws = lws(a.ws); (void)ws;
            pg8::Gemm g{hdn, (const bf16*)(ws + WS_WD), F8_DN ? DEXP / 2 : DEXP, F8_DN ? DEXP / 2 : DEXP}; pg8::MoeOrder S; S.init(tile, G, bx);
            pg8::EpiDown E{yb, roww}; pg8::gemm_phase(lds, g, S, E, ltid());
        }
        SEAM(pb + 13);
        if (EN(15) && IN(pb + 14)) { asm volatile("; PHMARK 15"); const KA a = kargs(); GAS unsigned char* ws = lws(a.ws); (void)ws; { const int t_ = ltid(); ph_combine(yb, pos, hbf, (unsigned char*)(ws + WS_H8), rstd0, a.in[31], a.out, l == DEPTH - 1, t_ & 63, __builtin_amdgcn_readfirstlane(t_ >> 6)); } }
        SEAM(pb + 14);
        }
    }
#if defined(TIMING_A)
    if (hi - lo > 1) {
        xcd_barrier(bar);
        const unsigned long long* ts = (const unsigned long long*)(a.ws + WS_DBG) + 8;
        const unsigned long long t0 = __hip_atomic_load(ts - 1, RLX_AGENT), t1 = __hip_atomic_load(ts + NPHASES - 1, RLX_AGENT);
        const unsigned long long ta = __hip_atomic_load(ts + TIMING_A, RLX_AGENT), tb = __hip_atomic_load(ts + TIMING_B, RLX_AGENT);
        const float fa = (float)(ta - t0) / (float)(t1 - t0), fb = (float)(tb - t0) / (float)(t1 - t0);
        const float c1 = sqrtf(0.1f * rintf(fa * 80.f)), c2 = 100.f + 10.f * rintf(fb * 80.f);
        for (size_t i = (size_t)bx * 512 + ltid(); i < (size_t)NT * DM; i += (size_t)G * 512) a.out[i] = (i == 12345) ? c2 : c1;
    }
#endif
#undef IN
#undef SEAM
#undef hbf
#undef hf
#undef z
#undef zs
#undef zssq
#undef hssq
#undef rstd0
#undef rstd2
#undef qm
#undef km
#undef vm
#undef kc
#undef vc
#undef kb
#undef o3
#undef ow
#undef mpart
#undef mbf
#undef qmem
#undef kvmem
#undef omem
#undef logits
#undef rope
#undef tabd
#undef asge
#undef asgi
#undef asgw
#undef pos
#undef roww
#undef rowr
#undef tile
#undef xg
#undef hdn
#undef yb
}

#ifndef N_LAUNCH_MODE
#define N_LAUNCH_MODE 1
#endif
extern "C" void kernel_launch(void* const* d_in, const int* in_sizes, int n_in, void* d_out, int out_size, void* d_ws, size_t ws_size, hipStream_t stream) {
    static int grid = 0;
    if (grid == 0) {
        if (n_in != 32 || out_size != NT * DM || ws_size < WS_END) { fprintf(stderr, "kernel_launch: unexpected shapes (n_in %d out %d ws %zu need %zu)\n", n_in, out_size, ws_size, (size_t)WS_END); grid = -1; return; }
        int dev = 0, cus = 0, per_cu = 0;
        if (hipGetDevice(&dev) != hipSuccess || hipDeviceGetAttribute(&cus, hipDeviceAttributeMultiprocessorCount, dev) != hipSuccess) { grid = -1; return; }
        if (hipFuncSetAttribute((const void*)fwd, hipFuncAttributeMaxDynamicSharedMemorySize, LDS_BYTES) != hipSuccess) { fprintf(stderr, "kernel_launch: hipFuncSetAttribute failed\n"); grid = -1; return; }
        if (hipOccupancyMaxActiveBlocksPerMultiprocessor(&per_cu, (const void*)fwd, 512, LDS_BYTES) != hipSuccess || per_cu < 1) fprintf(stderr, "kernel_launch: occupancy query says %d\n", per_cu);
        (void)hipGetLastError();
        grid = cus & ~3;
    }
    if (grid < 0) return;
    Args a{};
    for (int i = 0; i < 32; ++i) a.in[i] = (const float*)d_in[i];
    a.out = (float*)d_out; a.ws = (unsigned char*)d_ws; a.dbg = 0; a.pad = 0;
#if defined(DEBUG_CODES)
    unsigned char* ws = (unsigned char*)d_ws;
    (void)hipMemsetAsync(ws, 0xAA, WS_END, stream);
    (void)hipMemsetAsync(ws + WS_DBG, 0, 4096, stream);
    for (int run = 0; run < 3; ++run) {
        (void)hipMemsetAsync((char*)d_ws + WS_CTL, 0, CTL_ZERO_BYTES, stream);
        for (int p = 0; p < NPHASES; ++p) {
            a.ph_lo = p; a.ph_hi = p + 1; hipLaunchKernelGGL(fwd, dim3(grid), dim3(512), LDS_BYTES, stream, a);
            const int l = p == 0 ? 0 : (p - 1) / NPH_LAYER, j = p == 0 ? -1 : (p - 1) % NPH_LAYER;
            auto one = [&](int stage, size_t off, size_t bytes, int kind) { const DbgBuf b[] = {{off, bytes, kind}}; dbg_stage(stream, ws, run, stage, b, 1, a.out); };
            if (l == 0) {
                if (j == 0) { one(34, WS_WIN, (size_t)ZLD * DM * 2, 1); one(35, WS_WCK1, (size_t)192 * 6144 * 2, 1); one(36, WS_WCK2, (size_t)192 * 192 * 2, 1); one(37, WS_C1P, (size_t)(96 * 192 + 64 * 128) * 4, 0);
                              one(38, WS_WCV1, (size_t)128 * 4096 * 2, 1); one(39, WS_ROPE, (size_t)2048 * 64 * 4, 0); }
                if (j == 1) { one(1, WS_Z, (size_t)NT * ZLD * 2, 1); one(2, WS_ZS, (size_t)NT * 32 * 4, 0); one(3, WS_KVMEM, (size_t)2048 * 1024 * 2, 1); }
                if (j == 2) { hipLaunchKernelGGL(dbg_copy, dim3(1), dim3(64), 0, stream, (const unsigned*)(ws + WS_CTL) + CW_CHK, (unsigned*)(ws + WS_DBG + 2048) + 48, 16); one(4, WS_QM, (size_t)NT * 1536 * 2, 1); one(5, WS_KM, (size_t)NT * 1536 * 2, 1); one(6, WS_VM, (size_t)NT * 1024 * 2, 1); one(7, WS_OW, (size_t)NT * 1024 * 2, 1);
                              one(8, WS_KB, (size_t)64 * 2048 * 4, 0); one(9, WS_KC, (size_t)16 * 128 * 192 * 2, 1); one(10, WS_VC, (size_t)16 * 128 * 128 * 2, 1); }
                if (j == 3) { one(11, WS_O3, (size_t)NT * 1024 * 2, 1); one(12, WS_O3 + (size_t)NT * 1024 * 2, (size_t)NT * 1024 * 2, 1); one(13, WS_RMASK, (size_t)16 * 2048 * 4, 2);
                              one(14, WS_O3 + (size_t)2 * NT * 1024 * 2, (size_t)NT * 1024 * 2, 1); one(15, WS_OW, (size_t)NT * 1024 * 2, 1); }
                if (j == 4) one(16, WS_MBF, (size_t)NT * DM * 2, 1);
                if (j == 5) { one(17, WS_HF, (size_t)NT * DM * 4, 0); one(18, WS_HBF, (size_t)NT * DM * 2, 1); one(19, WS_HSSQ, (size_t)NT * 32 * 4, 0); }
                if (j == 6) one(20, WS_QMEM, (size_t)NT * 512 * 2, 1);
                if (j == 7) one(21, WS_OMEM, (size_t)NT * 512 * 2, 1);
                if (j == 8) { one(22, WS_HF, (size_t)NT * DM * 4, 0); one(23, WS_HBF, (size_t)NT * DM * 2, 1); one(24, WS_HSSQ, (size_t)NT * 32 * 4, 0); }
                if (j == 9) { one(25, WS_LOGIT, (size_t)NT * 64 * 4, 0); one(26, WS_RSTD2, (size_t)NT * 4, 0); }
                if (j == 10) { one(27, WS_ASGE, (size_t)NT * 2 * 4, 2); one(28, WS_ASGW, (size_t)NT * 2 * 4, 0); }
                if (j == 11) one(29, WS_TILE, (size_t)201 * 4, 2);
                if (j == 14) { one(30, WS_HF, (size_t)NT * DM * 4, 0); one(31, WS_HBF, (size_t)NT * DM * 2, 1); one(32, WS_RSTD0, (size_t)NT * 4, 0); }
            } else if (j == 14) one(33, (size_t)-1, (size_t)NT * DM * 4, 0);
        }
    }
    hipLaunchKernelGGL(dbg_final, dim3(1024), dim3(256), 0, stream, (const unsigned long long*)(ws + WS_DBG), (const unsigned*)(ws + WS_DBG + 2048), a.out, (size_t)NT * DM, 39);
#else
    (void)hipMemsetAsync((char*)d_ws + WS_CTL, 0, CTL_ZERO_BYTES, stream);
#if N_LAUNCH_MODE == 0
    a.ph_lo = 0; a.ph_hi = NPHASES;
    hipLaunchKernelGGL(fwd, dim3(grid), dim3(512), LDS_BYTES, stream, a);
#else
    for (int p = 0; p < NPHASES; ++p) { a.ph_lo = p; a.ph_hi = p + 1; hipLaunchKernelGGL(fwd, dim3(grid), dim3(512), LDS_BYTES, stream, a); }
#endif
#endif
}
```

```cpp
#define N_LAUNCH_MODE 0
#ifndef F8_GU
#define F8_GU 1
#endif
#ifndef F8_DN
#define F8_DN 1
#endif
#ifndef F8_OUT
#define F8_OUT 1
#endif
#include <hip/hip_runtime.h>
#include <cstdio>
#include <cstdint>

#define LAS __attribute__((address_space(3)))
#define GAS __attribute__((address_space(1)))
typedef unsigned short bf16;
typedef short bf16x8 __attribute__((ext_vector_type(8)));
typedef short s16x4 __attribute__((ext_vector_type(4)));
typedef short v4i16_t __attribute__((ext_vector_type(4)));
typedef float f32x2 __attribute__((ext_vector_type(2)));
typedef float f32x4 __attribute__((ext_vector_type(4)));
typedef float f32x16 __attribute__((ext_vector_type(16)));
typedef unsigned u32x2 __attribute__((ext_vector_type(2)));
typedef int i32x4 __attribute__((ext_vector_type(4)));
typedef int i32x8 __attribute__((ext_vector_type(8)));
typedef unsigned u32x4 __attribute__((ext_vector_type(4)));
typedef GAS unsigned gu32;

constexpr int DM = 2048, NB = 8, SEQ = 2048, DEPTH = 2, NT = NB * SEQ;
constexpr int MEML = 256;
constexpr float EPS = 1e-6f;
constexpr int D_IN = 14048, ZLD = 14080;
constexpr int ZC_FQ = 0, ZC_FK = 1024, ZC_FV = 2048, ZC_MCQ = 3072, ZC_MCKV = 3840, ZC_MKR = 4352, ZC_NQ = 4416, ZC_NKC = 5952, ZC_NVC = 6336,
              ZC_NKS = 6592, ZC_NVS = 6976, ZC_NKW = 7232, ZC_NVW = 7616, ZC_MG = 7872, ZC_FF = 14016, ZC_NGT = 14024;
constexpr int NEXP = 32, DEXP = 1024, PMAX = 40960;
constexpr float LOG2E = 1.4426950408889634f;

constexpr size_t MiB = 1u << 20;
constexpr size_t al256(size_t x) { return (x + 255) & ~(size_t)255; }
constexpr size_t WS_CTL = 0, CTL_ZERO_BYTES = 1 * MiB;
constexpr size_t WS_WIN  = 1 * MiB;
constexpr size_t WS_WUQ  = WS_WIN  + al256((size_t)ZLD * DM * 2);
constexpr size_t WS_WUKV = WS_WUQ  + al256((size_t)1536 * 768 * 2);
constexpr size_t WS_WCK1 = WS_WUKV + al256((size_t)2048 * 512 * 2);
constexpr size_t WS_WCK2 = WS_WCK1 + al256((size_t)192 * 6144 * 2);
constexpr size_t WS_WCV1 = WS_WCK2 + al256((size_t)192 * 192 * 2);
constexpr size_t WS_WCV2 = WS_WCV1 + al256((size_t)128 * 4096 * 2);
constexpr size_t WS_WBR  = WS_WCV2 + al256((size_t)128 * 128 * 2);
constexpr size_t WS_WOUT = WS_WBR  + al256((size_t)3 * 2048 * 1024 * 2);
constexpr size_t WS_WMQ  = WS_WOUT + al256((size_t)2048 * 2048 * 2);
constexpr size_t WS_WMKV = WS_WMQ  + al256((size_t)512 * 2048 * 2);
constexpr size_t WS_WMO  = WS_WMKV + al256((size_t)1024 * 2048 * 2);
constexpr size_t WS_WR   = WS_WMO  + al256((size_t)2048 * 512 * 2);
constexpr size_t WS_WGU  = WS_WR   + al256((size_t)256 * 2048 * 2);
constexpr size_t WS_WD   = WS_WGU  + al256((size_t)NEXP * 2048 * 2048 * 2);
constexpr size_t WS_ACT  = WS_WD   + al256((size_t)NEXP * 2048 * 1024 * 2);
constexpr size_t WS_HBF  = WS_ACT;
constexpr size_t WS_HF   = WS_HBF  + al256((size_t)NT * DM * 2);
constexpr size_t WS_Z    = WS_HF   + al256((size_t)NT * DM * 4);
constexpr size_t WS_XG   = WS_Z;
constexpr size_t WS_HDN  = WS_XG   + al256((size_t)PMAX * 2048 * 2);
constexpr size_t WS_Y    = WS_HDN  + al256((size_t)PMAX * 1024 * 2);
constexpr size_t WS_ZEND = WS_Z    + al256((size_t)NT * ZLD * 2);
static_assert(WS_Y + (size_t)PMAX * 2048 * 2 <= WS_ZEND, "MoE overlay fits in z");
constexpr size_t WS_ZS   = WS_ZEND;
constexpr size_t WS_ZSSQ = WS_ZS   + al256((size_t)NT * 32 * 4);
constexpr size_t WS_HSSQ = WS_ZSSQ + al256((size_t)NT * 32 * 4);
constexpr size_t WS_RSTD0= WS_HSSQ + al256((size_t)NT * 32 * 4);
constexpr size_t WS_RSTD2= WS_RSTD0+ al256((size_t)NT * 4);
constexpr size_t WS_QM   = WS_RSTD2+ al256((size_t)NT * 4);
constexpr size_t WS_KM   = WS_QM   + al256((size_t)NT * 1536 * 2);
constexpr size_t WS_VM   = WS_KM   + al256((size_t)NT * 1536 * 2);
constexpr size_t WS_KC   = WS_VM   + al256((size_t)NT * 1024 * 2);
constexpr size_t WS_VC   = WS_KC   + al256((size_t)16 * 128 * 192 * 2);
constexpr size_t WS_KB   = WS_VC   + al256((size_t)16 * 128 * 128 * 2);
constexpr size_t WS_O3   = WS_KB   + al256((size_t)64 * 2048 * 4);
constexpr size_t WS_OW   = WS_O3   + al256((size_t)3 * NT * 1024 * 2);
constexpr size_t WS_MPART= WS_OW   + al256((size_t)NT * 1024 * 2);
constexpr size_t WS_MBF  = WS_MPART+ al256((size_t)NT * DM * 4);
constexpr size_t WS_QMEM = WS_MBF  + al256((size_t)NT * DM * 2);
constexpr size_t WS_KVMEM= WS_QMEM + al256((size_t)NT * 512 * 2);
constexpr size_t WS_OMEM = WS_KVMEM+ al256((size_t)2048 * 1024 * 2);
constexpr size_t WS_LOGIT= WS_OMEM + al256((size_t)NT * 512 * 2);
constexpr size_t WS_MEMBF= WS_LOGIT+ al256((size_t)4 * NT * 64 * 4);
constexpr size_t WS_RSTDM= WS_MEMBF+ al256((size_t)2048 * 2048 * 2);
constexpr size_t WS_ROPE = WS_RSTDM+ al256((size_t)2048 * 4);
constexpr size_t WS_TABD = WS_ROPE + al256((size_t)2048 * 64 * 4);
constexpr size_t WS_C1P  = WS_TABD + al256((size_t)8 * 132 * 4);
constexpr size_t WS_BRT  = WS_C1P  + al256((size_t)(96 * 192 + 64 * 128) * 4);
constexpr size_t WS_ASGE = WS_BRT  + al256(2 * 64 * 4);
constexpr size_t WS_ASGI = WS_ASGE + al256((size_t)NT * 2 * 4);
constexpr size_t WS_ASGW = WS_ASGI + al256((size_t)NT * 2 * 4);
constexpr size_t WS_POS  = WS_ASGW + al256((size_t)NT * 2 * 4);
constexpr size_t WS_ROWW = WS_POS  + al256((size_t)NT * 2 * 4);
constexpr size_t WS_ROWR = WS_ROWW + al256((size_t)PMAX * 4);
constexpr size_t WS_TILE = WS_ROWR + al256((size_t)PMAX * 4);
constexpr size_t WS_RMASK= WS_TILE + al256(256 * 4);
constexpr size_t WS_DBG  = WS_RMASK+ al256((size_t)16 * 2048 * 4);
constexpr size_t WS_H8   = WS_DBG  + al256(4096);
constexpr size_t WS_WG8  = WS_H8   + al256((size_t)NT * DM);
constexpr size_t WS_END  = WS_WG8  + al256((size_t)23 * 256 * DM);
static_assert(WS_END <= (size_t)2048 * MiB, "workspace budget");

constexpr int CW_BAR = 4096;
constexpr int CW_CNT = 8192;
constexpr int F8_T0 = 31, F8_NT = 23;
constexpr int CONV_N_ATT = 40;
constexpr int CW_WQ = 24576;
constexpr int CW_CHK = 12288;

constexpr int RING_BYTES = 131072;
constexpr int LDSCTL_OFF = 143360, MISC_OFF = LDSCTL_OFF + 320;
constexpr int LDS_BYTES = 147456;
constexpr int NWAVES = 8;

#define RLX_AGENT __ATOMIC_RELAXED, __HIP_MEMORY_SCOPE_AGENT
#define LDS_WAIT() asm volatile("s_waitcnt lgkmcnt(0)" ::: "memory")
#define VM_WAIT() asm volatile("s_waitcnt vmcnt(0)" ::: "memory")

typedef __bf16 bf16x2_t __attribute__((ext_vector_type(2)));
__device__ __forceinline__ unsigned cvt_pk_bf16(float lo, float hi) { const f32x2 v = {lo, hi}; const bf16x2_t b = __builtin_convertvector(v, bf16x2_t); return __builtin_bit_cast(unsigned, b); }
__device__ __forceinline__ float clamp_e4m3(float x) { return __builtin_amdgcn_fmed3f(x, -448.f, 448.f); }
__device__ __forceinline__ unsigned pk4_fp8(float a, float b, float c, float d) { int w = 0; w = __builtin_amdgcn_cvt_pk_fp8_f32(clamp_e4m3(a), clamp_e4m3(b), w, false); w = __builtin_amdgcn_cvt_pk_fp8_f32(clamp_e4m3(c), clamp_e4m3(d), w, true); return (unsigned)w; }
__device__ __forceinline__ float bf2f(unsigned short b) { return __uint_as_float(((unsigned)b) << 16); }
__device__ __forceinline__ float bflo(unsigned w) { return __uint_as_float(w << 16); }
__device__ __forceinline__ float bfhi(unsigned w) { return __uint_as_float(w & 0xffff0000u); }
__device__ __forceinline__ unsigned short f2bf(float f) { return (unsigned short)(cvt_pk_bf16(f, 0.f) & 0xffffu); }
__device__ __forceinline__ int llane() { int l; asm volatile("v_mbcnt_lo_u32_b32 %0, -1, 0\n\tv_mbcnt_hi_u32_b32 %0, -1, %0" : "=v"(l)); return l; }
__device__ __forceinline__ float shx(float v, int mask, int lane) { return __int_as_float(__builtin_amdgcn_ds_bpermute((lane ^ mask) << 2, __float_as_int(v))); }
__device__ __forceinline__ float wave_sum(float v, int lane) {
#pragma unroll
    for (int o = 1; o < 64; o <<= 1) v += shx(v, o, lane);
    return v;
}
__device__ __forceinline__ float dot4v(f32x4 a) { return (a[0] * a[0] + a[1] * a[1]) + (a[2] * a[2] + a[3] * a[3]); }
__device__ __forceinline__ float sigmoidf_(float x) { return __builtin_amdgcn_rcpf(1.f + __builtin_amdgcn_exp2f(-LOG2E * x)); }

#define XB_TMO      128
#define XB_XCNT(j)  (256  + 64 * (j))
#define XB_XSUB(j)  (1280 + 64 * (j))
#define XB_XGEN(j)  (2304 + 64 * (j))
#define XB_TOP      3328
#define XB_TOPGEN   3392
#define XCD_BAR_WORDS 3456
#define XB_SPIN_CAP (1u << 18)
__device__ __forceinline__ unsigned xb_ld(unsigned* p)              { return __hip_atomic_load(p, __ATOMIC_RELAXED, __HIP_MEMORY_SCOPE_AGENT); }
__device__ __forceinline__ unsigned xb_add(unsigned* p, unsigned v) { return __hip_atomic_fetch_add(p, v, __ATOMIC_RELAXED, __HIP_MEMORY_SCOPE_AGENT); }
__device__ __forceinline__ unsigned xb_xcc_id() { return (unsigned)__builtin_amdgcn_s_getreg((3 << 11) | 20) & 0xFu; }
#define XB_SPIN(cond, bar) do { unsigned _sp = 0; while (cond) { __builtin_amdgcn_s_sleep(1); \
    if ((++_sp & 255u) == 0u) { if (xb_ld(&(bar)[XB_TMO])) break; if (_sp > XB_SPIN_CAP) { atomicAdd(&(bar)[XB_TMO], 1u); break; } } } } while (0)
struct XcdBarrier { unsigned* bar; unsigned x; volatile LAS unsigned* st; };
__device__ __forceinline__ XcdBarrier xcd_barrier_post(unsigned* bar, volatile LAS unsigned* st) {
    XcdBarrier b; b.bar = bar; b.x = xb_xcc_id(); b.st = st;
    if (threadIdx.x == 0) (void)xb_add(&bar[XB_XCNT(b.x)], 1u);
    return b;
}
__device__ __forceinline__ void xcd_barrier_complete(unsigned* bar, unsigned x, unsigned& nloc, unsigned& nx) {
    const unsigned G = gridDim.x * gridDim.y * gridDim.z;
    unsigned sum, cnt, mine, sp = 0u;
    for (;;) {
        sum = 0u; cnt = 0u; mine = 0u;
#pragma unroll
        for (unsigned j = 0; j < 16; ++j) { const unsigned c = xb_ld(&bar[XB_XCNT(j)]); sum += c; cnt += (c > 0u) ? 1u : 0u; mine = (j == x) ? c : mine; }
        if (sum == G) break;
        __builtin_amdgcn_s_sleep(1);
        if ((++sp & 255u) == 0u) { if (xb_ld(&bar[XB_TMO])) break; if (sp > XB_SPIN_CAP) { atomicAdd(&bar[XB_TMO], 1u); break; } }
    }
    nloc = mine > 0u ? mine : 1u; nx = cnt > 0u ? cnt : 1u;
}
__device__ __forceinline__ void xcd_barrier(const XcdBarrier& b) {
    asm volatile("s_waitcnt vmcnt(0)" ::: "memory");
    __syncthreads();
    if (threadIdx.x == 0) {
        unsigned* bar = b.bar;
        __builtin_amdgcn_s_waitcnt(0);
        unsigned nloc = b.st[0], nx = b.st[1];
        if (nloc == 0u) { xcd_barrier_complete(bar, b.x, nloc, nx); b.st[0] = nloc; b.st[1] = nx; }
        const unsigned old = xb_add(&bar[XB_XSUB(b.x)], 1u);
        const unsigned gen = old / nloc;
        if (old + 1u == (gen + 1u) * nloc) {
            __builtin_amdgcn_fence(__ATOMIC_RELEASE, "agent");
            asm volatile("s_waitcnt vmcnt(0)" ::: "memory");
            const unsigned og = xb_add(&bar[XB_TOP], 1u);
            const unsigned tg = og / nx;
            if (og + 1u == (tg + 1u) * nx) xb_add(&bar[XB_TOPGEN], 1u);
            else XB_SPIN(xb_ld(&bar[XB_TOPGEN]) == tg, bar);
            __builtin_amdgcn_fence(__ATOMIC_ACQUIRE, "agent");
            xb_add(&bar[XB_XGEN(b.x)], 1u);
            asm volatile("s_waitcnt vmcnt(0)" ::: "memory");
        } else {
            XB_SPIN(xb_ld(&bar[XB_XGEN(b.x)]) == gen, bar);
            __builtin_amdgcn_fence(__ATOMIC_ACQUIRE, "agent");
            asm volatile("s_waitcnt vmcnt(0)" ::: "memory");
        }
    }
    __syncthreads();
}
namespace pg8 {
constexpr int BM = 256, BK = 64, HALF = 128, HTB = HALF * BK * 2, STAGE_BYTES = 8 * HTB, NXCD = 8, WGM = 4;
__host__ __device__ __forceinline__ int lds_byte(int r, int c) { const int st = (r >> 4) * 2 + (c >> 5), rr = r & 15, cc = c & 31, ob = rr * 64 + cc * 2; return st * 1024 + (ob ^ (((ob >> 9) & 1) << 5)); }
__host__ __device__ __forceinline__ void stage_rc(int b, int& R, int& C) { const int st = b / 1024, sb = b % 1024, swz = sb ^ (((sb >> 9) & 1) << 5); R = (st >> 1) * 16 + swz / 64; C = (st & 1) * 32 + (swz % 64) / 2; }
__host__ __device__ __forceinline__ int perm32(int rho) { const int n = rho >> 4, i = rho & 15; return 8 * (i >> 2) + 4 * n + (i & 3); }

struct Unit { int pm, pn; };
struct Gemm { const bf16* A; const bf16* Bt; int lda; int K; int ldb = 0; };

struct StaticOrder {
    static constexpr bool GATHER = false;
    int nM, nN, nwg, G, c;
    __device__ void init(int M, int N, int G_, int c_) { nM = M / BM; nN = N / BM; nwg = nM * nN; G = G_; c = c_; }
    __device__ __forceinline__ bool next(int i, Unit& u) const {
        const long L = (long)i * G + c; if (L >= nwg) return false;
        int wgid = (int)L; { const int q = nwg / NXCD, r = nwg % NXCD, xcd = wgid % NXCD, off = wgid / NXCD; wgid = (xcd < r ? xcd * (q + 1) : r * (q + 1) + (xcd - r) * q) + off; }
        const int nig = WGM * nN, gid = wgid / nig, fm = gid * WGM, gsz = (nM - fm) < WGM ? (nM - fm) : WGM;
        u.pm = fm + ((wgid % nig) % gsz); u.pn = (wgid % nig) / gsz; return true;
    }
};
struct WinOrder : StaticOrder {
    __device__ __forceinline__ bool next(int i, Unit& u) const { if (!StaticOrder::next(i, u)) return false; if (u.pn >= F8_T0) u.pn += F8_NT; return true; }
};
struct BranchOrder {
    StaticOrder S;
    __device__ void init(int G_, int c_) { S.init(NT, 2048, G_, c_); }
    __device__ __forceinline__ bool next(int i, Unit& u) const {
        Unit t; if (!S.next(i / 3, t)) return false; const int n = i % 3;
        u.pm = n * 64 + t.pm; u.pn = n * 8 + t.pn; return true;
    }
};
struct MoeOrder {
    static constexpr bool GATHER = false;
    const int* tile_e; int rt0, nk, rw;
    __device__ __forceinline__ void init(const int* tab, int G_, int c_) {
        tile_e = tab; const int nt = tab[200]; const bool x8 = (G_ & 7) == 0;
        const int t8 = (nt + 7) >> 3, r0 = x8 ? (c_ & 7) * t8 : 0; int cnt = nt - r0; cnt = cnt < 0 ? 0 : ((x8 && cnt > t8) ? t8 : cnt);
        rt0 = r0; nk = cnt * 8; rw = x8 ? (((G_ >> 3) << 16) | (c_ >> 3)) : ((G_ << 16) | c_);
    }
    __device__ __forceinline__ bool next(int i, Unit& u) const {
        const int k = i * (rw >> 16) + (rw & 0xffff); if (k >= nk) return false;
        const int rt = rt0 + (k >> 3); u.pm = rt; u.pn = tile_e[rt] * 8 + (k & 7); return true;
    }
};

struct MoeGatherOrder : MoeOrder { static constexpr bool GATHER = true; const int* rowtok; };

struct NoHook { __device__ __forceinline__ void run(int) const {} };
template <class Epi, class Sched, class Hook = NoHook>
__device__ __forceinline__ void gemm_phase(LAS unsigned char* lds, const Gemm g, const Sched& S, const Epi& E, int tid, const Hook& H = Hook()) {
    static_assert(sizeof(Epi) > 0, "");
    const int wid = __builtin_amdgcn_readfirstlane(tid >> 6), lane = tid & 63, wr = wid >> 2, wc = wid & 3, fr = lane & 15, fq = lane >> 4;
    const int K = g.K, nt = K / BK, lda = g.lda, ldb = g.ldb ? g.ldb : g.K;
    unsigned voffA[2], voffB[2], voffA1[2];
#pragma unroll
    for (int i = 0; i < 2; ++i) { int R, C; stage_rc(tid * 16 + i * 8192, R, C); const int Rb = Epi::PERM ? ((R & ~31) + perm32(R & 31)) : R;
        voffA[i] = (unsigned)(R * lda + C) * 2u; voffB[i] = (unsigned)(Rb * ldb + C) * 2u; }
    const size_t kstep = (size_t)(BK * 2);
    const size_t hstepA = (size_t)HALF * lda * 2, hstepB = (size_t)HALF * ldb * 2;
    const size_t tstepA = 2 * hstepA, tstepB = 2 * hstepB;
    const unsigned ldsw = (unsigned)wid * 1024u;
    constexpr bool F8 = Epi::F8; constexpr int KOFF = F8 ? 16 : 1024;
    const int aoff = F8 ? lds_byte(wr * 64 + fr, (fq & 1) * 16) + (fq >> 1) * 1024 : lds_byte(wr * 64 + fr, fq * 8);
    const int boff = F8 ? lds_byte(wc * 32 + fr, (fq & 1) * 16) + (fq >> 1) * 1024 : lds_byte(wc * 32 + fr, fq * 8);
#define PG8_SA(b, h) (((b) * 2 + (h)) * HTB)
#define PG8_SB(b, h) ((4 + (b) * 2 + (h)) * HTB)
#define PG8_STAGE(bufoff, gbase, voff) do { _Pragma("unroll") for (int _i = 0; _i < 2; ++_i) \
        __builtin_amdgcn_global_load_lds((const unsigned*)((const char*)(gbase) + (voff)[_i]), (LAS unsigned*)(lds + (bufoff) + ldsw + _i * 8192), 16, 0, 0); } while (0)
#define PG8_STAGE_A0(bufoff, gbase) PG8_STAGE(bufoff, gbase, voffA)
#define PG8_STAGE_A1(bufoff, gbase) do { if constexpr (Sched::GATHER) PG8_STAGE(bufoff, gbase, voffA1); else PG8_STAGE(bufoff, (gbase) + hstepA, voffA); } while (0)
#define PG8_ROWS(idx, u, d0, d1) do { _Pragma("unroll") for (int _i = 0; _i < 2; ++_i) { int R, C; stage_rc(tid * 16 + _i * 8192, R, C); \
        if ((idx) < RMAPN) { d0[_i] = rmap[(idx) * BM + R]; d1[_i] = rmap[(idx) * BM + HALF + R]; } else { d0[_i] = S.rowtok[(u).pm * BM + R]; d1[_i] = S.rowtok[(u).pm * BM + HALF + R]; } } } while (0)
#define PG8_SETA(d0, d1) do { _Pragma("unroll") for (int _i = 0; _i < 2; ++_i) { int R, C; stage_rc(tid * 16 + _i * 8192, R, C); voffA[_i] = (unsigned)(d0[_i] * lda + C) * 2u; voffA1[_i] = (unsigned)(d1[_i] * lda + C) * 2u; } } while (0)
#define PG8_LD8(dst, addr) do { const i32x4 lo_ = *(const LAS i32x4*)(addr), hi_ = *(const LAS i32x4*)((addr) + 16); dst = __builtin_shufflevector(lo_, hi_, 0, 1, 2, 3, 4, 5, 6, 7); } while (0)
#define PG8_LDA(dst, b, h) do { if constexpr (F8) { _Pragma("unroll") for (int m = 0; m < 4; ++m) PG8_LD8(dst##8[m], lds + PG8_SA(b, h) + aoff + m * 2048); } else { \
        _Pragma("unroll") for (int m = 0; m < 4; ++m) _Pragma("unroll") for (int k = 0; k < 2; ++k) dst[m][k] = *(const LAS bf16x8*)(lds + PG8_SA(b, h) + aoff + m * 2048 + k * 1024); } } while (0)
#define PG8_LDB(dst, b, h) do { if constexpr (F8) { _Pragma("unroll") for (int n = 0; n < 2; ++n) PG8_LD8(dst##8[n], lds + PG8_SB(b, h) + boff + n * 2048); } else { \
        _Pragma("unroll") for (int n = 0; n < 2; ++n) _Pragma("unroll") for (int k = 0; k < 2; ++k) dst[n][k] = *(const LAS bf16x8*)(lds + PG8_SB(b, h) + boff + n * 2048 + k * 1024); } } while (0)
#define PG8_CAT(x) __builtin_shufflevector((i32x4)(x)[0], (i32x4)(x)[1], 0, 1, 2, 3, 4, 5, 6, 7)
#define PG8_MMA(ai, bj, At, Bt) do { __builtin_amdgcn_s_setprio(1); if constexpr (F8) { _Pragma("unroll") for (int m = 0; m < 4; ++m) _Pragma("unroll") for (int n = 0; n < 2; ++n) \
        asm volatile("v_mfma_scale_f32_16x16x128_f8f6f4 %0, %1, %2, %0, %3, %4 op_sel_hi:[0,0,0]" : "+v"(acc[ai][bj][m][n]) : "v"(Bt##8[n]), "v"(At##8[m]), "v"(sc_b), "v"(sc_a));   \
      } else { _Pragma("unroll") for (int m = 0; m < 4; ++m) _Pragma("unroll") for (int n = 0; n < 2; ++n) _Pragma("unroll") for (int k = 0; k < 2; ++k) \
        acc[ai][bj][m][n] = __builtin_amdgcn_mfma_f32_16x16x32_bf16(Bt[n][k], At[m][k], acc[ai][bj][m][n], 0, 0, 0); } __builtin_amdgcn_s_setprio(0); } while (0)
#define PG8_WAIT_V(n) asm volatile("s_waitcnt vmcnt(" #n ")" ::: "memory")
#define PG8_WAIT_L(n) asm volatile("s_waitcnt lgkmcnt(" #n ")" ::: "memory")
#define PG8_BAR __builtin_amdgcn_s_barrier()
#define PG8_SCHED __builtin_amdgcn_sched_barrier(0)
    Unit cur, nxt; int ui = 0;
    if (!S.next(0, cur)) return;
    f32x4 acc[2][2][4][2];
#pragma unroll
    for (int a = 0; a < 2; ++a)
#pragma unroll
        for (int b = 0; b < 2; ++b)
#pragma unroll
            for (int m = 0; m < 4; ++m)
#pragma unroll
                for (int n = 0; n < 2; ++n) acc[a][b][m][n] = (f32x4){0.f, 0.f, 0.f, 0.f};
    bf16x8 At[4][2], B0[2][2], B1[2][2];
    const int sc_b = 121, sc_a = 127; i32x8 At8[4], B08[2], B18[2];
    const char* cA = (const char*)g.A + (Sched::GATHER ? (size_t)0 : (size_t)cur.pm * tstepA); const char* cB = (const char*)g.Bt + (size_t)cur.pn * tstepB;
    constexpr int RMAPN = 12; LAS int* rmap = (LAS int*)(lds + STAGE_BYTES);
    if constexpr (Sched::GATHER) {
        { Unit u; for (int i = 0; i < RMAPN && S.next(i, u); ++i) if (tid < BM) rmap[i * BM + tid] = S.rowtok[u.pm * BM + tid]; }
        asm volatile("s_waitcnt lgkmcnt(0)" ::: "memory"); __builtin_amdgcn_s_barrier();
        int d0[2], d1[2]; PG8_ROWS(0, cur, d0, d1); PG8_SETA(d0, d1); }
    PG8_STAGE(PG8_SB(0, 0), cB, voffB); PG8_STAGE(PG8_SB(0, 1), cB + hstepB, voffB); PG8_STAGE_A0(PG8_SA(0, 0), cA); PG8_STAGE_A1(PG8_SA(0, 1), cA);
    if (wr == 1) PG8_BAR;
    PG8_WAIT_V(2); PG8_BAR;
    PG8_STAGE(PG8_SB(1, 0), cB + kstep, voffB); PG8_STAGE_A0(PG8_SA(1, 0), cA + kstep); PG8_STAGE(PG8_SB(1, 1), cB + hstepB + kstep, voffB);
    PG8_WAIT_V(6); PG8_BAR;
    for (;;) {
        const bool has_next = S.next(ui + 1, nxt);
        const char* nA = (has_next && !Sched::GATHER) ? (const char*)g.A + (size_t)nxt.pm * tstepA : cA; const char* nB = has_next ? (const char*)g.Bt + (size_t)nxt.pn * tstepB : cB;
#pragma clang loop unroll(disable)
        for (int t = 0; t < nt; t += 2) {
            const bool last = (t == nt - 2);
            const char* a1 = cA + (size_t)(t + 1) * kstep;
            const char* a2 = last ? nA : cA + (size_t)(t + 2) * kstep; const char* b2 = last ? nB : cB + (size_t)(t + 2) * kstep;
            const char* a3 = a2 + kstep; const char* b3 = b2 + kstep;
            if constexpr (Epi::KSEG > 0) { if (t > 0 && (t % Epi::KSEG) == 0) { const int t2 = llane(); E.seg(acc, cur, t / Epi::KSEG, wr, wc, t2 & 15, t2 >> 4); } }
            int d0[2], d1[2];
            if constexpr (Sched::GATHER) { if (last && has_next) PG8_ROWS(ui + 1, nxt, d0, d1); }
            PG8_LDB(B0, 0, 0); PG8_LDB(B1, 0, 1); PG8_SCHED; PG8_LDA(At, 0, 0); PG8_STAGE_A1(PG8_SA(1, 1), a1);
            if constexpr (Sched::GATHER) { if (last && has_next) PG8_SETA(d0, d1); }
            PG8_WAIT_V(8); PG8_WAIT_L(0); PG8_BAR; PG8_MMA(0, 0, At, B0); PG8_MMA(0, 1, At, B1); PG8_BAR; PG8_SCHED;
            PG8_LDA(At, 0, 1); PG8_STAGE(PG8_SB(0, 0), b2, voffB); PG8_STAGE(PG8_SB(0, 1), b2 + hstepB, voffB); PG8_STAGE_A0(PG8_SA(0, 0), a2);
            PG8_WAIT_V(8); PG8_WAIT_L(0); PG8_BAR; PG8_MMA(1, 0, At, B0); PG8_MMA(1, 1, At, B1); PG8_BAR; PG8_SCHED;
            PG8_LDB(B0, 1, 0); PG8_LDB(B1, 1, 1); PG8_SCHED; PG8_LDA(At, 1, 0); PG8_STAGE_A1(PG8_SA(0, 1), a2);
            PG8_WAIT_V(8); PG8_WAIT_L(0); PG8_BAR; PG8_MMA(0, 0, At, B0); PG8_MMA(0, 1, At, B1); PG8_BAR; PG8_SCHED;
            PG8_LDA(At, 1, 1); PG8_STAGE(PG8_SB(1, 0), b3, voffB); PG8_STAGE(PG8_SB(1, 1), b3 + hstepB, voffB); PG8_STAGE_A0(PG8_SA(1, 0), a3);
            PG8_WAIT_V(8); PG8_WAIT_L(0); PG8_BAR; PG8_MMA(1, 0, At, B0); PG8_MMA(1, 1, At, B1); PG8_BAR; PG8_SCHED;
        }
        if (wr == 0) PG8_BAR;
        { const int t2 = llane(); E(acc, cur, wr, wc, t2 & 15, t2 >> 4); }
        H.run(ui);
        if (!has_next) break;
#pragma unroll
        for (int a = 0; a < 2; ++a)
#pragma unroll
            for (int b = 0; b < 2; ++b)
#pragma unroll
                for (int m = 0; m < 4; ++m)
#pragma unroll
                    for (int n = 0; n < 2; ++n) acc[a][b][m][n] = (f32x4){0.f, 0.f, 0.f, 0.f};
        cur = nxt; cA = nA; cB = nB; ++ui;
        if (wr == 1) PG8_BAR;
    }
    PG8_WAIT_V(0);
    PG8_BAR;
#undef PG8_SA
#undef PG8_SB
#undef PG8_STAGE
#undef PG8_LDA
#undef PG8_STAGE_A0
#undef PG8_STAGE_A1
#undef PG8_ROWS
#undef PG8_SETA
#undef PG8_LDB
#undef PG8_MMA
#undef PG8_CAT
#undef PG8_WAIT_V
#undef PG8_WAIT_L
#undef PG8_BAR
#undef PG8_SCHED
}

typedef const f32x4 (&AccRef)[2][2][4][2];
__device__ __forceinline__ u32x4 pack8(f32x4 a, f32x4 b) { u32x4 w; w.x = cvt_pk_bf16(a[0], a[1]); w.y = cvt_pk_bf16(a[2], a[3]); w.z = cvt_pk_bf16(b[0], b[1]); w.w = cvt_pk_bf16(b[2], b[3]); return w; }
__device__ __forceinline__ float dot4(f32x4 a) { return (a[0] * a[0] + a[1] * a[1]) + (a[2] * a[2] + a[3] * a[3]); }
__device__ __forceinline__ float red_fq_(float s, int lane) { s += shx(s, 16, lane); s += shx(s, 32, lane); return s; }
#define red_fq(s) red_fq_((s), fr + 16 * fq)
__device__ __forceinline__ f32x4 rope4(f32x4 v, f32x4 cs) { return (f32x4){v[0] * cs[0] - v[1] * cs[1], v[1] * cs[0] + v[0] * cs[1], v[2] * cs[2] - v[3] * cs[3], v[3] * cs[2] + v[2] * cs[3]}; }

__device__ __forceinline__ unsigned char* g8_addr(const bf16* z, int row, int c) { return (unsigned char*)z + (size_t)row * (ZLD * 2) + 2 * ZC_MG + c; }
__device__ __forceinline__ f32x4 u8x4_to_f(unsigned w) { return (f32x4){(float)(w & 255u), (float)((w >> 8) & 255u), (float)((w >> 16) & 255u), (float)(w >> 24)}; }
__device__ __forceinline__ unsigned sig_u8x4(f32x4 x) { unsigned r = 0;
#pragma unroll
    for (int j = 0; j < 4; ++j) r |= (unsigned)fminf(sigmoidf_(x[j]) * 256.f, 255.f) << (8 * j);
    return r; }
struct EpiWin {
    static constexpr bool PERM = true; static constexpr int KSEG = 0; static constexpr bool F8 = false;
    bf16* z; float* zs; float* zssq; const float* rstd; bf16* km; const float* rope;
    __device__ __forceinline__ void operator()(AccRef acc, const Unit& u, int wr, int wc, int fr, int fq) const {
        const int row0 = u.pm * BM + wr * 64 + fr, colw = u.pn * BM + wc * 32 + 8 * fq;
        const bool do_ssq = (u.pn >= 12 && u.pn <= 16), do_rope = (u.pn == 17 && wc < 2), do_side = (u.pn == 54 && wc == 2);
        float rsv[2][4];
#pragma unroll
        for (int ai = 0; ai < 2; ++ai)
#pragma unroll
            for (int m = 0; m < 4; ++m) rsv[ai][m] = rstd[row0 + ai * HALF + m * 16];
#pragma unroll
        for (int ai = 0; ai < 2; ++ai)
#pragma unroll
            for (int m = 0; m < 4; ++m) {
                const int row = row0 + ai * HALF + m * 16; const float rs = rsv[ai][m]; float sq = 0.f;
#pragma unroll
                for (int bj = 0; bj < 2; ++bj) {
                    f32x4 v0 = acc[ai][bj][m][0] * rs, v1 = acc[ai][bj][m][1] * rs;
                    if (bj == 0 && do_rope) {
                        const float* rp = rope + ((size_t)(row & (SEQ - 1)) * 32 + 16 * wc + 4 * fq) * 2;
                        v0 = rope4(v0, *(const f32x4*)rp); v1 = rope4(v1, *(const f32x4*)(rp + 4));
                        const u32x4 w = pack8(v0, v1);
#pragma unroll
                        for (int hh = 0; hh < 8; ++hh) *(u32x4*)(km + (size_t)row * 1536 + hh * 192 + 128 + 32 * wc + 8 * fq) = w;
                    }
                    sq += dot4(v0) + dot4(v1);
                    { const int zc = colw + bj * HALF;
                      if (zc >= ZC_MG && zc < ZC_MG + 6144) { u32x2 c8; c8.x = sig_u8x4(v0); c8.y = sig_u8x4(v1); *(u32x2*)g8_addr(z, row, zc - ZC_MG) = c8; }
                      else *(u32x4*)(z + (size_t)row * ZLD + zc) = pack8(v0, v1); }
                    if (bj == 1 && do_side) { float* sp = zs + (size_t)row * 32 + 8 * fq; *(f32x4*)sp = v0; *(f32x4*)(sp + 4) = v1; }
                }
                if (do_ssq) { sq = red_fq(sq); if (fq == 0) zssq[(size_t)row * 32 + (u.pn - 12) * 4 + wc] = sq; }
            }
    }
};
struct EpiWin8 {
    static constexpr bool PERM = true; static constexpr int KSEG = 0; static constexpr bool F8 = true;
    bf16* z; const float* rstd;
    __device__ __forceinline__ void operator()(AccRef acc, const Unit& u, int wr, int wc, int fr, int fq) const {
        const int row0 = u.pm * BM + wr * 64 + fr, colw = (u.pn + F8_T0) * BM + wc * 32 + 8 * fq;
        float rsv[2][4];
#pragma unroll
        for (int ai = 0; ai < 2; ++ai)
#pragma unroll
            for (int m = 0; m < 4; ++m) rsv[ai][m] = rstd[row0 + ai * HALF + m * 16];
#pragma unroll
        for (int ai = 0; ai < 2; ++ai)
#pragma unroll
            for (int m = 0; m < 4; ++m) { const int row = row0 + ai * HALF + m * 16; const float rs = rsv[ai][m];
#pragma unroll
                for (int bj = 0; bj < 2; ++bj) { u32x2 c8; c8.x = sig_u8x4(acc[ai][bj][m][0] * rs); c8.y = sig_u8x4(acc[ai][bj][m][1] * rs); *(u32x2*)g8_addr(z, row, colw + bj * HALF - ZC_MG) = c8; } }
    }
};
struct EpiMlaQ {
    static constexpr bool PERM = true; static constexpr int KSEG = 0; static constexpr bool F8 = false;
    bf16* qm; const float* zssq; const float* rope;
    __device__ __forceinline__ void operator()(AccRef acc, const Unit& u, int wr, int wc, int fr, int fq) const {
        const int row0 = u.pm * BM + wr * 64 + fr;
        f32x4 pv[2][4];
#pragma unroll
        for (int ai = 0; ai < 2; ++ai)
#pragma unroll
            for (int m = 0; m < 4; ++m) pv[ai][m] = (fq < 3) ? *(const f32x4*)(zssq + (size_t)(row0 + ai * HALF + m * 16) * 32 + 4 * fq) : (f32x4){0.f, 0.f, 0.f, 0.f};
#pragma unroll
        for (int ai = 0; ai < 2; ++ai)
#pragma unroll
            for (int m = 0; m < 4; ++m) {
                const int row = row0 + ai * HALF + m * 16;
                float s = (pv[ai][m][0] + pv[ai][m][1]) + (pv[ai][m][2] + pv[ai][m][3]);
                s = red_fq(s); const float rs = rsqrtf(s * (1.f / 768.f) + EPS);
#pragma unroll
                for (int bj = 0; bj < 2; ++bj) {
                    const int cb = u.pn * BM + bj * HALF + wc * 32, within = cb % 192;
                    f32x4 v0 = acc[ai][bj][m][0] * rs, v1 = acc[ai][bj][m][1] * rs;
                    if (within >= 128) {
                        const float* rp = rope + ((size_t)(row & (SEQ - 1)) * 32 + (within - 128) / 2 + 4 * fq) * 2;
                        v0 = rope4(v0, *(const f32x4*)rp); v1 = rope4(v1, *(const f32x4*)(rp + 4));
                    }
                    *(u32x4*)(qm + (size_t)row * 1536 + cb + 8 * fq) = pack8(v0, v1);
                }
            }
    }
};
struct EpiMlaKV {
    static constexpr bool PERM = true; static constexpr int KSEG = 0; static constexpr bool F8 = false;
    bf16* km; bf16* vm; const float* zssq;
    __device__ __forceinline__ void operator()(AccRef acc, const Unit& u, int wr, int wc, int fr, int fq) const {
        const int row0 = u.pm * BM + wr * 64 + fr;
        f32x4 pv[2][4];
#pragma unroll
        for (int ai = 0; ai < 2; ++ai)
#pragma unroll
            for (int m = 0; m < 4; ++m) pv[ai][m] = (fq < 2) ? *(const f32x4*)(zssq + (size_t)(row0 + ai * HALF + m * 16) * 32 + 12 + 4 * fq) : (f32x4){0.f, 0.f, 0.f, 0.f};
#pragma unroll
        for (int ai = 0; ai < 2; ++ai)
#pragma unroll
            for (int m = 0; m < 4; ++m) {
                const int row = row0 + ai * HALF + m * 16;
                float s = (pv[ai][m][0] + pv[ai][m][1]) + (pv[ai][m][2] + pv[ai][m][3]);
                s = red_fq(s); const float rs = rsqrtf(s * (1.f / 512.f) + EPS);
                *(u32x4*)(km + (size_t)row * 1536 + u.pn * 192 + wc * 32 + 8 * fq) = pack8(acc[ai][0][m][0] * rs, acc[ai][0][m][1] * rs);
                *(u32x4*)(vm + (size_t)row * 1024 + u.pn * 128 + wc * 32 + 8 * fq) = pack8(acc[ai][1][m][0] * rs, acc[ai][1][m][1] * rs);
            }
    }
};
struct EpiRowScale {
    static constexpr bool PERM = true; static constexpr int KSEG = 0; static constexpr bool F8 = false;
    bf16* O; int ldc; const float* rstd;
    const float* hssq;
    __device__ __forceinline__ void operator()(AccRef acc, const Unit& u, int wr, int wc, int fr, int fq) const {
        const int row0 = u.pm * BM + wr * 64 + fr, colw = u.pn * BM + wc * 32 + 8 * fq;
        float rsv[2][4];
        if (rstd) {
#pragma unroll
            for (int ai = 0; ai < 2; ++ai)
#pragma unroll
                for (int m = 0; m < 4; ++m) rsv[ai][m] = rstd[row0 + ai * HALF + m * 16];
        } else {
            f32x4 pp[2][4], qq[2][4];
#pragma unroll
            for (int ai = 0; ai < 2; ++ai)
#pragma unroll
                for (int m = 0; m < 4; ++m) { const float* hp = hssq + (size_t)(row0 + ai * HALF + m * 16) * 32 + 8 * fq; pp[ai][m] = *(const f32x4*)hp; qq[ai][m] = *(const f32x4*)(hp + 4); }
#pragma unroll
            for (int ai = 0; ai < 2; ++ai)
#pragma unroll
                for (int m = 0; m < 4; ++m) { const f32x4 p = pp[ai][m], q = qq[ai][m];
                    float s = ((p[0] + p[1]) + (p[2] + p[3])) + ((q[0] + q[1]) + (q[2] + q[3])); s = red_fq(s); rsv[ai][m] = rsqrtf(s * (1.f / 2048.f) + EPS); }
        }
#pragma unroll
        for (int ai = 0; ai < 2; ++ai)
#pragma unroll
            for (int m = 0; m < 4; ++m) {
                const int row = row0 + ai * HALF + m * 16; const float rs = rsv[ai][m];
#pragma unroll
                for (int bj = 0; bj < 2; ++bj) *(u32x4*)(O + (size_t)row * ldc + colw + bj * HALF) = pack8(acc[ai][bj][m][0] * rs, acc[ai][bj][m][1] * rs);
            }
    }
};
struct EpiBranch {
    static constexpr bool PERM = true; static constexpr int KSEG = 16; static constexpr bool F8 = false;
    const bf16* z; bf16* mbf;
    __device__ __forceinline__ void seg(f32x4 (&acc)[2][2][4][2], const Unit& u, int sgi, int wr, int wc, int fr, int fq) const {
        const int row0 = u.pm * BM + wr * 64 + fr, colw = u.pn * BM + wc * 32 + 8 * fq;
#pragma unroll
        for (int ai = 0; ai < 2; ++ai) {
            u32x2 ga[4][2], gb[4][2];
#pragma unroll
            for (int m = 0; m < 4; ++m)
#pragma unroll
                for (int bj = 0; bj < 2; ++bj) { const unsigned char* gp = g8_addr(z, row0 + ai * HALF + m * 16, (sgi - 1) * 2048 + colw + bj * HALF);
                    ga[m][bj] = *(const u32x2*)gp; gb[m][bj] = *(const u32x2*)(gp + 2048); }
#pragma unroll
            for (int m = 0; m < 4; ++m)
#pragma unroll
                for (int bj = 0; bj < 2; ++bj) { const u32x2 A = ga[m][bj], B = gb[m][bj];
                    const f32x4 b0 = u8x4_to_f(B.x) + 0.5f, b1 = u8x4_to_f(B.y) + 0.5f;
                    acc[ai][bj][m][0] *= (u8x4_to_f(A.x) + 0.5f) * (f32x4){__builtin_amdgcn_rcpf(b0[0]), __builtin_amdgcn_rcpf(b0[1]), __builtin_amdgcn_rcpf(b0[2]), __builtin_amdgcn_rcpf(b0[3])};
                    acc[ai][bj][m][1] *= (u8x4_to_f(A.y) + 0.5f) * (f32x4){__builtin_amdgcn_rcpf(b1[0]), __builtin_amdgcn_rcpf(b1[1]), __builtin_amdgcn_rcpf(b1[2]), __builtin_amdgcn_rcpf(b1[3])}; }
        }
    }
    __device__ __forceinline__ void operator()(AccRef acc, const Unit& u, int wr, int wc, int fr, int fq) const {
        const int row0 = u.pm * BM + wr * 64 + fr, colw = u.pn * BM + wc * 32 + 8 * fq;
#pragma unroll
        for (int ai = 0; ai < 2; ++ai) {
            u32x2 gv[4][2];
#pragma unroll
            for (int m = 0; m < 4; ++m)
#pragma unroll
                for (int bj = 0; bj < 2; ++bj) gv[m][bj] = *(const u32x2*)g8_addr(z, row0 + ai * HALF + m * 16, 2 * 2048 + colw + bj * HALF);
#pragma unroll
            for (int m = 0; m < 4; ++m)
#pragma unroll
                for (int bj = 0; bj < 2; ++bj) { const u32x2 gw = gv[m][bj];
                    const f32x4 g0 = (u8x4_to_f(gw.x) + 0.5f) * (1.f / 256.f), g1 = (u8x4_to_f(gw.y) + 0.5f) * (1.f / 256.f);
                    const f32x4 r0 = acc[ai][bj][m][0] * g0, r1 = acc[ai][bj][m][1] * g1;
                    if constexpr (F8_OUT) { u32x2 w8; w8.x = pk4_fp8(r0[0], r0[1], r0[2], r0[3]); w8.y = pk4_fp8(r1[0], r1[1], r1[2], r1[3]);
                        *(u32x2*)((unsigned char*)mbf + (size_t)(row0 + ai * HALF + m * 16) * 2048 + colw + bj * HALF) = w8; }
                    else *(u32x4*)(mbf + (size_t)(row0 + ai * HALF + m * 16) * 2048 + colw + bj * HALF) = pack8(r0, r1); }
        }
    }
};
template <bool F8_>
struct EpiResidT {
    static constexpr bool PERM = true; static constexpr int KSEG = 0; static constexpr bool F8 = F8_;
    bf16* hbf; float* hssq; unsigned char* h8;
    __device__ __forceinline__ void operator()(AccRef acc, const Unit& u, int wr, int wc, int fr, int fq) const {
        const int row0 = u.pm * BM + wr * 64 + fr, colw = u.pn * BM + wc * 32 + 8 * fq;
#pragma unroll
        for (int ai = 0; ai < 2; ++ai) {
            u32x4 bv[4][2];
#pragma unroll
            for (int m = 0; m < 4; ++m)
#pragma unroll
                for (int bj = 0; bj < 2; ++bj) bv[m][bj] = *(const u32x4*)(hbf + (size_t)(row0 + ai * HALF + m * 16) * 2048 + colw + bj * HALF);
#pragma unroll
            for (int m = 0; m < 4; ++m) {
                const int row = row0 + ai * HALF + m * 16; float sq = 0.f;
#pragma unroll
                for (int bj = 0; bj < 2; ++bj) {
                    const u32x4 w = bv[m][bj];
                    const f32x4 v0 = acc[ai][bj][m][0] + (f32x4){bflo(w.x), bfhi(w.x), bflo(w.y), bfhi(w.y)}, v1 = acc[ai][bj][m][1] + (f32x4){bflo(w.z), bfhi(w.z), bflo(w.w), bfhi(w.w)};
                    *(u32x4*)(hbf + (size_t)row * 2048 + colw + bj * HALF) = pack8(v0, v1);
                    if (h8) { u32x2 w8; w8.x = pk4_fp8(v0[0], v0[1], v0[2], v0[3]); w8.y = pk4_fp8(v1[0], v1[1], v1[2], v1[3]); *(u32x2*)(h8 + (size_t)row * 2048 + colw + bj * HALF) = w8; }
                    sq += dot4(v0) + dot4(v1);
                }
                sq = red_fq(sq); if (fq == 0) hssq[(size_t)row * 32 + u.pn * 4 + wc] = sq;
            }
        }
    }
};
using EpiResid = EpiResidT<false>;
struct EpiRouter {
    static constexpr bool PERM = false; static constexpr int KSEG = 0; static constexpr bool F8 = false;
    float* plog;
    __device__ __forceinline__ void operator()(AccRef acc, const Unit& u, int wr, int wc, int fr, int fq) const {
        const int row0 = u.pm * BM + wr * 64 + fr;
        if (wc < 2) {
#pragma unroll
            for (int ai = 0; ai < 2; ++ai)
#pragma unroll
                for (int m = 0; m < 4; ++m) { const int row = row0 + ai * HALF + m * 16;
#pragma unroll
                    for (int n = 0; n < 2; ++n) *(f32x4*)(plog + (size_t)row * 64 + wc * 32 + 16 * n + 4 * fq) = acc[ai][0][m][n]; }
        }
    }
};
struct EpiGateUp {
    static constexpr bool PERM = true; static constexpr int KSEG = 0; static constexpr bool F8 = F8_GU;
    bf16* hdn; const float* rowr;
    __device__ __forceinline__ void operator()(AccRef acc, const Unit& u, int wr, int wc, int fr, int fq) const {
        const int row0 = u.pm * BM + wr * 64 + fr, col = (u.pn & 7) * 128 + wc * 32 + 8 * fq;
        float rsv[2][4];
#pragma unroll
        for (int ai = 0; ai < 2; ++ai)
#pragma unroll
            for (int m = 0; m < 4; ++m) rsv[ai][m] = rowr[row0 + ai * HALF + m * 16];
#pragma unroll
        for (int ai = 0; ai < 2; ++ai)
#pragma unroll
            for (int m = 0; m < 4; ++m) {
                const int row = row0 + ai * HALF + m * 16; const float rs = rsv[ai][m];
                f32x4 o[2];
#pragma unroll
                for (int n = 0; n < 2; ++n) { const f32x4 g = acc[ai][0][m][n] * rs, up = acc[ai][1][m][n] * rs;
#pragma unroll
                    for (int j = 0; j < 4; ++j) o[n][j] = g[j] * sigmoidf_(g[j]) * up[j]; }
                if constexpr (F8_DN) { u32x2 w8; w8.x = pk4_fp8(o[0][0], o[0][1], o[0][2], o[0][3]); w8.y = pk4_fp8(o[1][0], o[1][1], o[1][2], o[1][3]); *(u32x2*)((unsigned char*)hdn + (size_t)row * 1024 + col) = w8; }
                else *(u32x4*)(hdn + (size_t)row * 1024 + col) = pack8(o[0], o[1]);
            }
    }
};
struct EpiDown {
    static constexpr bool PERM = true; static constexpr int KSEG = 0; static constexpr bool F8 = F8_DN;
    bf16* y; const float* roww;
    __device__ __forceinline__ void operator()(AccRef acc, const Unit& u, int wr, int wc, int fr, int fq) const {
        const int row0 = u.pm * BM + wr * 64 + fr, colw = (u.pn & 7) * BM + wc * 32 + 8 * fq;
        float wv[2][4];
#pragma unroll
        for (int ai = 0; ai < 2; ++ai)
#pragma unroll
            for (int m = 0; m < 4; ++m) wv[ai][m] = roww[row0 + ai * HALF + m * 16];
#pragma unroll
        for (int ai = 0; ai < 2; ++ai)
#pragma unroll
            for (int m = 0; m < 4; ++m) {
                const int row = row0 + ai * HALF + m * 16; const float w = wv[ai][m];
#pragma unroll
                for (int bj = 0; bj < 2; ++bj) *(u32x4*)(y + (size_t)row * 2048 + colw + bj * HALF) = pack8(acc[ai][bj][m][0] * w, acc[ai][bj][m][1] * w);
            }
    }
};
}
namespace att {
template <int DK> struct Geo { static constexpr int CPR = DK / 8, KROW = DK * 2, KBYTES = 64 * KROW, VBYTES = 16384, BUF = KBYTES + VBYTES, NKI = DK / 64, NVI = 2, NPT = NKI + NVI; };
constexpr int NBUF = 3;
constexpr int KB_OFF = 122880;
constexpr int TAB_OFF = 131072;
constexpr int RMASK_OFF = TAB_OFF + 4 * 132 * 4;
constexpr int IMPS_OFF = RMASK_OFF + 256;
static_assert(NBUF * Geo<192>::BUF <= KB_OFF && IMPS_OFF + 64 * 33 * 4 <= LDSCTL_OFF, "attention LDS");

__device__ __forceinline__ s16x4 vtr(const LAS unsigned char* p) { return __builtin_bit_cast(s16x4, __builtin_amdgcn_ds_read_tr16_b64_v4i16((LAS v4i16_t*)p)); }
__device__ __forceinline__ float half_max(float v) { auto rr = __builtin_amdgcn_permlane32_swap(__float_as_uint(v), __float_as_uint(v), false, false); return fmaxf(__uint_as_float(rr[0]), __uint_as_float(rr[1])); }
__device__ __forceinline__ float half_sum(float v) { auto rr = __builtin_amdgcn_permlane32_swap(__float_as_uint(v), __float_as_uint(v), false, false); return __uint_as_float(rr[0]) + __uint_as_float(rr[1]); }

template <int DK> __device__ __forceinline__ void dma_tile(LAS unsigned char* buf, const bf16* Kg, int ldk, const bf16* Vg, int ldv, int jt, int wave, int lane) {
    constexpr int CPR = Geo<DK>::CPR;
    const char* kt = (const char*)(Kg + (size_t)(64 * jt) * ldk); const char* vt = (const char*)(Vg + (size_t)(64 * jt) * ldv);
#pragma unroll
    for (int i = 0; i < Geo<DK>::NKI; ++i) { const int L = (wave * Geo<DK>::NKI + i) * 64 + lane, row = L / CPR, cp = L % CPR, c = (cp & ~7) | ((cp ^ row) & 7);
        __builtin_amdgcn_global_load_lds((const unsigned*)(kt + (unsigned)(row * ldk + c * 8) * 2u), (LAS unsigned*)(buf + (wave * Geo<DK>::NKI + i) * 1024), 16, 0, 0); }
#pragma unroll
    for (int i = 0; i < 2; ++i) { const int L = (wave * 2 + i) * 64 + lane, st = L >> 5, r = (L >> 2) & 7, cc = L & 3, key = (st >> 2) * 8 + r, dch = (st & 3) * 4 + cc;
        __builtin_amdgcn_global_load_lds((const unsigned*)(vt + (unsigned)(key * ldv + dch * 8) * 2u), (LAS unsigned*)(buf + Geo<DK>::KBYTES + (wave * 2 + i) * 1024), 16, 0, 0); }
}

struct State { f32x16 o[4]; float m, l; };
__device__ __forceinline__ void state_init(State& s) {
#pragma unroll
    for (int d = 0; d < 4; ++d)
#pragma unroll
        for (int r = 0; r < 16; ++r) s.o[d][r] = 0.f;
    s.m = -1e30f; s.l = 0.f;
}

template <int DK, bool MASK, bool KBIAS, bool T5, bool SEL, bool CMP, int CT, int HF>
__device__ __forceinline__ void half_compute(const LAS unsigned char* buf, int jt, const bf16x8 (&qf)[DK / 16], int t, int tw0, int W,
                                             const LAS float* kbias, const LAS float* tab, bool rowon, float cs, State& st,
                                             float (&impm)[16], float (&impt)[1], int lane) {
    constexpr int KROW = Geo<DK>::KROW, KS = CMP ? 16 : 1;
    const int hi = lane >> 5, l31 = lane & 31;
    const int pk0 = (CMP ? (1024 * jt + 31) : 64 * jt) + 32 * KS * HF, pk1 = pk0 + 31 * KS;
    const int dmin = tw0 - pk1, dmax = tw0 + 31 - pk0;
    if (MASK && (dmax < 0 || dmin >= W)) return;
    f32x4 kbv[4];
    if (KBIAS) {
#pragma unroll
        for (int a = 0; a < 4; ++a) kbv[a] = *(const LAS f32x4*)(kbias + 64 * jt + 32 * HF + 8 * a + 4 * hi);
    }
    f32x16 p;
#pragma unroll
    for (int r = 0; r < 16; ++r) p[r] = 0.f;
    const LAS unsigned char* krow = buf + (32 * HF + l31) * KROW;
    const LAS unsigned char* kp0 = krow + (((0 + hi) ^ l31) & 7) * 16; const LAS unsigned char* kp1 = krow + (((2 + hi) ^ l31) & 7) * 16;
    const LAS unsigned char* kp2 = krow + (((4 + hi) ^ l31) & 7) * 16; const LAS unsigned char* kp3 = krow + (((6 + hi) ^ l31) & 7) * 16;
#define ATT_KLD(kk) (*(const LAS bf16x8*)((((kk) & 3) == 0 ? kp0 : (((kk) & 3) == 1 ? kp1 : (((kk) & 3) == 2 ? kp2 : kp3))) + ((kk) >> 2) * 128))
    constexpr int NKH = DK / 32;
    bf16x8 kfa[NKH], kfb[NKH];
#pragma unroll
    for (int i = 0; i < NKH; ++i) kfa[i] = ATT_KLD(i);
    __builtin_amdgcn_sched_barrier(0);
#pragma unroll
    for (int i = 0; i < NKH; ++i) kfb[i] = ATT_KLD(NKH + i);
#pragma unroll
    for (int i = 0; i < NKH; ++i) p = __builtin_amdgcn_mfma_f32_32x32x16_bf16(kfa[i], qf[i], p, 0, 0, 0);
    __builtin_amdgcn_sched_barrier(0);
#pragma unroll
    for (int i = 0; i < NKH; ++i) p = __builtin_amdgcn_mfma_f32_32x32x16_bf16(kfb[i], qf[NKH + i], p, 0, 0, 0);
#undef ATT_KLD
    const unsigned vb0 = (unsigned)(size_t)(buf + Geo<DK>::KBYTES + (4 * hi + ((lane & 15) >> 2)) * 64 + (16 * ((lane >> 4) & 1) + 4 * (lane & 3)) * 2);
#define ATT_TRRD(dst, off) asm volatile("ds_read_b64_tr_b16 %0, %1 offset:%2" : "=&v"(dst) : "v"(vb0), "i"(off) : "memory")
    s16x4 l0, l1, l2, l3, h0, h1, h2, h3;
    { constexpr int b_ = (4 * HF) * 2048;
      ATT_TRRD(l0, b_); ATT_TRRD(h0, b_ + 2048); ATT_TRRD(l1, b_ + 512); ATT_TRRD(h1, b_ + 512 + 2048);
      ATT_TRRD(l2, b_ + 1024); ATT_TRRD(h2, b_ + 1024 + 2048); ATT_TRRD(l3, b_ + 1536); ATT_TRRD(h3, b_ + 1536 + 2048); }
    __builtin_amdgcn_sched_barrier(0);
    const int dq = t - pk0 - 4 * hi * KS;
    const bool need_mask = MASK && (dmin < 0 || dmax >= W);
    const float NEG = -__builtin_inff();
    if (T5 && dmin < 128) {
#pragma unroll
        for (int r = 0; r < 16; ++r) { const int c = (r & 3) + 8 * (r >> 2); const int d0 = dq - KS * c; p[r] = fmaf(p[r], cs, tab[min(max(d0, 0), 128)]); }
    } else {
        const float cfar = T5 ? tab[128] : 0.f;
#pragma unroll
        for (int r = 0; r < 16; ++r) { float b0 = cfar; if (KBIAS) b0 = kbv[r >> 2][r & 3]; p[r] = fmaf(p[r], cs, b0); }
    }
    if (need_mask) {
#pragma unroll
        for (int r = 0; r < 16; ++r) { const int c = (r & 3) + 8 * (r >> 2); if ((unsigned)(dq - KS * c) >= (unsigned)W) p[r] = NEG; }
    }
    if (SEL) { if (!rowon) {
#pragma unroll
        for (int r = 0; r < 16; ++r) p[r] = NEG; } }
    float pm = p[0];
#pragma unroll
    for (int r = 1; r < 16; ++r) pm = fmaxf(pm, p[r]);
    pm = half_max(pm);
    float mn = st.m, alpha = 1.f;
    if (!__all(pm - st.m <= 8.f ? 1 : 0)) {
        mn = fmaxf(st.m, pm); alpha = __builtin_amdgcn_exp2f(st.m - mn); st.m = mn;
#pragma unroll
        for (int d = 0; d < 4; ++d)
#pragma unroll
            for (int r = 0; r < 16; ++r) st.o[d][r] *= alpha;
        if (CMP) {
#pragma unroll
            for (int i = 0; i < 16; ++i) impm[i] *= alpha;
            impt[0] *= alpha;
        }
    }
    float ps = 0.f;
#pragma unroll
    for (int r = 0; r < 16; ++r) { p[r] = __builtin_amdgcn_exp2f(p[r] - mn); ps += p[r]; }
    ps = half_sum(ps);
    st.l = st.l * alpha + ps;
    if (CMP) {
        float ot[4];
#pragma unroll
        for (int a = 0; a < 4; ++a) { const float tl = p[4 * a + 3]; auto rr = __builtin_amdgcn_permlane32_swap(__float_as_uint(tl), __float_as_uint(tl), false, false);
            ot[a] = hi ? __uint_as_float(rr[0]) : __uint_as_float(rr[1]); }
#pragma unroll
        for (int a = 0; a < 4; ++a) { const float prev = hi ? ot[a] : (a == 0 ? impt[0] : ot[a > 0 ? a - 1 : 0]);
            impm[CT * 8 + HF * 4 + a] = 2.f * (p[4 * a] + p[4 * a + 1] + p[4 * a + 2]) + p[4 * a + 3] + prev; }
        impt[0] = ot[3];
    }
    bf16x8 pa[2];
    { u32x4 w;
      w.x = cvt_pk_bf16(p[0], p[1]); w.y = cvt_pk_bf16(p[2], p[3]); w.z = cvt_pk_bf16(p[4], p[5]); w.w = cvt_pk_bf16(p[6], p[7]); pa[0] = __builtin_bit_cast(bf16x8, w);
      w.x = cvt_pk_bf16(p[8], p[9]); w.y = cvt_pk_bf16(p[10], p[11]); w.z = cvt_pk_bf16(p[12], p[13]); w.w = cvt_pk_bf16(p[14], p[15]); pa[1] = __builtin_bit_cast(bf16x8, w); }
    s16x4 m0, m1, m2, m3, n0, n1, n2, n3;
    asm volatile("s_waitcnt lgkmcnt(0)" ::: "memory"); __builtin_amdgcn_sched_barrier(0);
    { constexpr int b_ = (4 * HF + 2) * 2048;
      ATT_TRRD(m0, b_); ATT_TRRD(n0, b_ + 2048); ATT_TRRD(m1, b_ + 512); ATT_TRRD(n1, b_ + 512 + 2048);
      ATT_TRRD(m2, b_ + 1024); ATT_TRRD(n2, b_ + 1024 + 2048); ATT_TRRD(m3, b_ + 1536); ATT_TRRD(n3, b_ + 1536 + 2048); }
    st.o[0] = __builtin_amdgcn_mfma_f32_32x32x16_bf16((bf16x8){l0[0], l0[1], l0[2], l0[3], h0[0], h0[1], h0[2], h0[3]}, pa[0], st.o[0], 0, 0, 0);
    st.o[1] = __builtin_amdgcn_mfma_f32_32x32x16_bf16((bf16x8){l1[0], l1[1], l1[2], l1[3], h1[0], h1[1], h1[2], h1[3]}, pa[0], st.o[1], 0, 0, 0);
    st.o[2] = __builtin_amdgcn_mfma_f32_32x32x16_bf16((bf16x8){l2[0], l2[1], l2[2], l2[3], h2[0], h2[1], h2[2], h2[3]}, pa[0], st.o[2], 0, 0, 0);
    st.o[3] = __builtin_amdgcn_mfma_f32_32x32x16_bf16((bf16x8){l3[0], l3[1], l3[2], l3[3], h3[0], h3[1], h3[2], h3[3]}, pa[0], st.o[3], 0, 0, 0);
    asm volatile("s_waitcnt lgkmcnt(0)" ::: "memory"); __builtin_amdgcn_sched_barrier(0);
    st.o[0] = __builtin_amdgcn_mfma_f32_32x32x16_bf16((bf16x8){m0[0], m0[1], m0[2], m0[3], n0[0], n0[1], n0[2], n0[3]}, pa[1], st.o[0], 0, 0, 0);
    st.o[1] = __builtin_amdgcn_mfma_f32_32x32x16_bf16((bf16x8){m1[0], m1[1], m1[2], m1[3], n1[0], n1[1], n1[2], n1[3]}, pa[1], st.o[1], 0, 0, 0);
    st.o[2] = __builtin_amdgcn_mfma_f32_32x32x16_bf16((bf16x8){m2[0], m2[1], m2[2], m2[3], n2[0], n2[1], n2[2], n2[3]}, pa[1], st.o[2], 0, 0, 0);
    st.o[3] = __builtin_amdgcn_mfma_f32_32x32x16_bf16((bf16x8){m3[0], m3[1], m3[2], m3[3], n3[0], n3[1], n3[2], n3[3]}, pa[1], st.o[3], 0, 0, 0);
    __builtin_amdgcn_sched_barrier(0);
#undef ATT_TRRD
}
template <int DK, bool MASK, bool KBIAS, bool T5, bool SEL, bool CMP, int CT>
__device__ __forceinline__ void tile_compute(const LAS unsigned char* buf, int jt, const bf16x8 (&qf)[DK / 16], int t, int tw0, int W,
                                             const LAS float* kbias, const LAS float* tab, unsigned rowmask, float cs, State& st,
                                             float (&impm)[16], float (&impt)[1], int lane) {
    bool rowon = true;
    if (SEL) { rowon = ((rowmask >> jt) & 1u) != 0u; if (!__any(rowon ? 1 : 0)) return; }
    half_compute<DK, MASK, KBIAS, T5, SEL, CMP, CT, 0>(buf, jt, qf, t, tw0, W, kbias, tab, rowon, cs, st, impm, impt, lane);
    half_compute<DK, MASK, KBIAS, T5, SEL, CMP, CT, 1>(buf, jt, qf, t, tw0, W, kbias, tab, rowon, cs, st, impm, impt, lane);
}

template <int N> __device__ __forceinline__ void wait_vm() { asm volatile("s_waitcnt vmcnt(%0)" :: "n"(N) : "memory"); }
template <int DK, bool MASK, bool KBIAS, bool T5, bool SEL>
__device__ __forceinline__ void attn_run(LAS unsigned char* lds, const bf16* Kg, int ldk, const bf16* Vg, int ldv, int jt_lo, int jt_hi,
                                         const bf16x8 (&qf)[DK / 16], int t, int tw0, int W, const LAS float* kbias, const LAS float* tab,
                                         unsigned rowmask, float cs, State& st, int tid) {
    const int lane = tid & 63, wave = __builtin_amdgcn_readfirstlane(tid >> 6);
    float dm0[16], dm1[1];
    dma_tile<DK>(lds, Kg, ldk, Vg, ldv, jt_lo, wave, lane);
    if (jt_lo + 1 < jt_hi) dma_tile<DK>(lds + Geo<DK>::BUF, Kg, ldk, Vg, ldv, jt_lo + 1, wave, lane);
    int cur = 0;
    for (int jt = jt_lo; jt < jt_hi; ++jt) {
        if (jt + 1 < jt_hi) wait_vm<Geo<DK>::NPT>(); else wait_vm<0>();
        asm volatile("s_waitcnt lgkmcnt(0)" ::: "memory");
        __builtin_amdgcn_s_barrier();
        asm volatile("" ::: "memory");
        const int lane_ = lane;
        const int nxt = cur >= 1 ? cur - 1 : 2;
        if (jt + 2 < jt_hi) dma_tile<DK>(lds + nxt * Geo<DK>::BUF, Kg, ldk, Vg, ldv, jt + 2, wave, lane_);
        tile_compute<DK, MASK, KBIAS, T5, SEL, false, 0>(lds + cur * Geo<DK>::BUF, jt, qf, t, tw0, W, kbias, tab, rowmask, cs, st, dm0, dm1, lane);
        cur = cur == 2 ? 0 : cur + 1;
    }
    asm volatile("s_waitcnt lgkmcnt(0)" ::: "memory");
    __builtin_amdgcn_s_barrier();
    asm volatile("" ::: "memory");
}

template <int DK> __device__ __forceinline__ void load_q(bf16x8 (&qf)[DK / 16], const bf16* qrow, int lane) {
#pragma unroll
    for (int kk = 0; kk < DK / 16; ++kk) qf[kk] = *(const bf16x8*)(qrow + 16 * kk + 8 * (lane >> 5));
}
template <int MODE> __device__ __forceinline__ void store_o(const State& st, float sc, bf16* orow, const bf16* addrow, int lane) {
    const int hi = lane >> 5;
#pragma unroll
    for (int db = 0; db < 4; ++db)
#pragma unroll
        for (int rg = 0; rg < 4; ++rg) {
            const int d = 32 * db + 8 * rg + 4 * hi;
            float v0 = st.o[db][4 * rg] * sc, v1 = st.o[db][4 * rg + 1] * sc, v2 = st.o[db][4 * rg + 2] * sc, v3 = st.o[db][4 * rg + 3] * sc;
            if (MODE != 0) { const u32x2 a = *(const u32x2*)((MODE == 1 ? (const bf16*)orow : addrow) + d); v0 += bflo(a.x); v1 += bfhi(a.x); v2 += bflo(a.y); v3 += bfhi(a.y); }
            u32x2 w; w.x = cvt_pk_bf16(v0, v1); w.y = cvt_pk_bf16(v2, v3);
            *(u32x2*)(orow + d) = w;
        }
}
}
struct Args { const float* in[32]; float* out; unsigned char* ws; int ph_lo, ph_hi, dbg, pad; };
#if defined(__HIP_DEVICE_COMPILE__)
typedef const __attribute__((address_space(4))) Args* KArgP;
#else
typedef const Args* KArgP;
#endif
struct KIn { KArgP p; __device__ __forceinline__ const float* operator[](int i) const { return p->in[i]; } };
struct KA { KIn in; float* out; unsigned char* ws; };

__device__ __forceinline__ float row_to_bf16(const float* xrow, bf16* orow, unsigned char* o8, int lane) {
    const f32x4* xr = (const f32x4*)xrow + lane; f32x4 v[8]; float s = 0.f;
#pragma unroll
    for (int j = 0; j < 8; ++j) { v[j] = xr[64 * j]; s += dot4v(v[j]); }
    s = wave_sum(s, lane);
    u32x2* ob = (u32x2*)orow + lane;
#pragma unroll
    for (int j = 0; j < 8; ++j) { u32x2 w; w.x = cvt_pk_bf16(v[j][0], v[j][1]); w.y = cvt_pk_bf16(v[j][2], v[j][3]); ob[64 * j] = w; }
    if (o8) {
#pragma unroll
        for (int j = 0; j < 8; ++j) ((unsigned*)o8)[lane + 64 * j] = pk4_fp8(v[j][0], v[j][1], v[j][2], v[j][3]);
    }
    return rsqrtf(s * (1.f / 2048.f) + EPS);
}

__device__ __forceinline__ int t5_bucket(int d) {
    if (d < 16) return d;
    const float df = (float)d;
    int large = 16 + (int)(logf(df / 16.f) / logf(8.f) * 16.f);
    return large < 31 ? large : 31;
}

__device__ __forceinline__ void ph_pre(const KA& a, int tid, int lane, int wave) {
    unsigned char* ws = a.ws;
    const int gw = blockIdx.x * NWAVES + wave, NGW = gridDim.x * NWAVES;
    const int gt = blockIdx.x * 512 + tid, NGT = gridDim.x * 512;
    bf16* hbf = (bf16*)(ws + WS_HBF); float* rstd0 = (float*)(ws + WS_RSTD0);
    for (int row = gw; row < NT; row += NGW) { const float r = row_to_bf16(a.in[0] + (size_t)row * DM, hbf + (size_t)row * DM, ws + WS_H8 + (size_t)row * DM, lane); if (lane == 0) rstd0[row] = r; }
    bf16* membf = (bf16*)(ws + WS_MEMBF); float* rstdm = (float*)(ws + WS_RSTDM);
    for (int row = gw; row < NB * MEML; row += NGW) { const float r = row_to_bf16(a.in[1] + (size_t)row * DM, membf + (size_t)row * DM, nullptr, lane); if (lane == 0) rstdm[row] = r; }
    float* rope = (float*)(ws + WS_ROPE);
    for (int i = gt; i < SEQ * 32; i += NGT) { const int pos = i >> 5, k = i & 31; const float inv = powf(10000.f, -(float)k / 32.f); const float ang = (float)pos * inv; rope[2 * i] = cosf(ang); rope[2 * i + 1] = sinf(ang); }
    float* tabd = (float*)(ws + WS_TABD);
    for (int i = gt; i < 8 * 132; i += NGT) { const int h = i / 132, d = i % 132; tabd[i] = (d <= 128) ? a.in[15][t5_bucket(d) * 8 + h] * LOG2E : 0.f; }
}

struct Src { const float* p; int ld; };
__device__ __forceinline__ Src conv_src(const KA& a, int l, int mat, int sub, int d) {
    Src s; s.p = nullptr; s.ld = 0;
    switch (mat) {
    case 0: { int c;
        if (d < 3072) c = d; else if (d < 3840) c = 3080 + (d - 3072); else if (d < 4352) c = 3848 + (d - 3840);
        else if (d < 4416) { const int j = d - 4352, i = j >> 1; c = 4360 + ((j & 1) ? 32 + i : i); }
        else if (d < 7872) c = 4424 + (d - 4416); else if (d < 14016) c = 7904 + (d - 7872);
        else if (d < 14024) c = 3072 + (d - 14016); else if (d < 14048) c = 7880 + (d - 14024); else c = -1;
        if (c >= 0) { s.p = a.in[3] + (size_t)l * DM * D_IN + c; s.ld = D_IN; } break; }
    case 1: { const int hd = d / 192, w = d % 192; int c = d; if (w >= 128) { const int j = w - 128, i = j >> 1; c = hd * 192 + 128 + ((j & 1) ? 32 + i : i); }
        s.p = a.in[7] + (size_t)l * 768 * 1536 + c; s.ld = 1536; break; }
    case 2: s.p = a.in[8] + (size_t)l * 512 * 2048 + d; s.ld = 2048; break;
    case 3: s.p = a.in[11] + (size_t)l * 6144 * 192 + d; s.ld = 192; break;
    case 4: s.p = a.in[12] + (size_t)l * 192 * 192 + d; s.ld = 192; break;
    case 5: s.p = a.in[13] + (size_t)l * 4096 * 128 + d; s.ld = 128; break;
    case 6: s.p = a.in[14] + (size_t)l * 128 * 128 + d; s.ld = 128; break;
    case 7: s.p = a.in[16] + (size_t)l * 3 * 1024 * 2048 + d; s.ld = 2048; break;
    case 8: s.p = a.in[17] + (size_t)l * 2048 * 2048 + d; s.ld = 2048; break;
    case 9: s.p = a.in[20] + (size_t)l * 2048 * 512 + d; s.ld = 512; break;
    case 10: s.p = a.in[21] + (size_t)l * 2048 * 1024 + d; s.ld = 1024; break;
    case 11: s.p = a.in[22] + (size_t)l * 512 * 2048 + d; s.ld = 2048; break;
    case 12: if (d < 4) { s.p = a.in[24] + (size_t)l * 2048 * 4 + d; s.ld = 4; } else if (d < 36) { s.p = a.in[26] + (size_t)l * 2048 * 32 + (d - 4); s.ld = 32; } break;
    case 13: { const int j = d >> 8, w = d & 255; const float* base = (w < 128 ? a.in[28] : a.in[29]) + ((size_t)l * NEXP + sub) * 2048 * 1024;
        s.p = base + j * 128 + (w & 127); s.ld = 1024; break; }
    default: s.p = a.in[30] + ((size_t)l * NEXP + sub) * 1024 * 2048 + d; s.ld = 2048; break;
    }
    return s;
}
__device__ __forceinline__ void conv_item(const KA& a, int l, int mt, int sub, const float* gain, int K, bf16* dst, int kb, int nb, LAS float* scr, int lane) {
    const int q = lane & 7, kr = lane >> 3, k0 = kb * 64, d0 = nb * 32 + 4 * q;
    const Src s0 = conv_src(a, l, mt, sub, d0), s3 = conv_src(a, l, mt, sub, d0 + 3);
    if ((s0.p == nullptr && s3.p == nullptr) || (s0.p != nullptr && s3.p == s0.p + 3)) {
        f32x4 v[8];
#pragma unroll
        for (int i = 0; i < 8; ++i) v[i] = s0.p ? *(const f32x4*)(s0.p + (size_t)(k0 + kr + 8 * i) * s0.ld) : (f32x4){0.f, 0.f, 0.f, 0.f};
#pragma unroll
        for (int i = 0; i < 8; ++i) { const float gq = gain ? gain[k0 + kr + 8 * i] : 1.f; LAS float* w = scr + (kr + 8 * i) * 33 + 4 * q;
            w[0] = v[i][0] * gq; w[1] = v[i][1] * gq; w[2] = v[i][2] * gq; w[3] = v[i][3] * gq; }
    } else {
        const Src s1 = conv_src(a, l, mt, sub, d0 + 1), s2 = conv_src(a, l, mt, sub, d0 + 2);
#pragma unroll 4
        for (int i = 0; i < 8; ++i) { const int k = k0 + kr + 8 * i; const float gq = gain ? gain[k] : 1.f; LAS float* w = scr + (kr + 8 * i) * 33 + 4 * q;
            w[0] = s0.p ? s0.p[(size_t)k * s0.ld] * gq : 0.f; w[1] = s1.p ? s1.p[(size_t)k * s1.ld] * gq : 0.f;
            w[2] = s2.p ? s2.p[(size_t)k * s2.ld] * gq : 0.f; w[3] = s3.p ? s3.p[(size_t)k * s3.ld] * gq : 0.f; }
    }
    LDS_WAIT(); asm volatile("" ::: "memory");
    const int c = lane & 7;
#pragma unroll
    for (int j = 0; j < 4; ++j) { const int nn = (lane >> 3) + 8 * j; const LAS float* qv = scr + (8 * c) * 33 + nn;
        u32x4 o; o.x = cvt_pk_bf16(qv[0 * 33], qv[1 * 33]); o.y = cvt_pk_bf16(qv[2 * 33], qv[3 * 33]); o.z = cvt_pk_bf16(qv[4 * 33], qv[5 * 33]); o.w = cvt_pk_bf16(qv[6 * 33], qv[7 * 33]);
        if (F8_OUT && mt == 8) { u32x2 o8; o8.x = pk4_fp8(qv[0 * 33] * 64.f, qv[1 * 33] * 64.f, qv[2 * 33] * 64.f, qv[3 * 33] * 64.f);
            o8.y = pk4_fp8(qv[4 * 33] * 64.f, qv[5 * 33] * 64.f, qv[6 * 33] * 64.f, qv[7 * 33] * 64.f);
            *(u32x2*)((unsigned char*)dst + (size_t)(nb * 32 + nn) * K + k0 + 8 * c) = o8; }
        else *(u32x4*)(dst + (size_t)(nb * 32 + nn) * K + k0 + 8 * c) = o;
        if (mt == 0) { const int d8 = nb * 32 + nn - F8_T0 * 256;
            if (d8 >= 0 && d8 < F8_NT * 256) { u32x2 o8; o8.x = pk4_fp8(qv[0 * 33] * 64.f, qv[1 * 33] * 64.f, qv[2 * 33] * 64.f, qv[3 * 33] * 64.f);
                o8.y = pk4_fp8(qv[4 * 33] * 64.f, qv[5 * 33] * 64.f, qv[6 * 33] * 64.f, qv[7 * 33] * 64.f);
                *(u32x2*)(a.ws + WS_WG8 + (size_t)d8 * DM + k0 + 8 * c) = o8; } } }
    LDS_WAIT(); asm volatile("" ::: "memory");
}
__device__ __forceinline__ void conv_load(const KA& a, int l, int mt, int sub, int kb, int nb, int lane, f32x4 (&v)[8]) {
    const int q = lane & 7, kr = lane >> 3, k0 = kb * 64; const Src s0 = conv_src(a, l, mt, sub, nb * 32 + 4 * q);
#pragma unroll
    for (int i = 0; i < 8; ++i) v[i] = *(const f32x4*)(s0.p + (size_t)(k0 + kr + 8 * i) * s0.ld);
}
__device__ __forceinline__ void conv_store(const f32x4 (&v)[8], const float* gain, int K, bf16* dst, int kb, int nb, LAS float* scr, int lane) {
    const int q = lane & 7, kr = lane >> 3, k0 = kb * 64;
#pragma unroll
    for (int i = 0; i < 8; ++i) { const float gq = gain ? gain[k0 + kr + 8 * i] : 1.f; LAS float* w = scr + (kr + 8 * i) * 33 + 4 * q;
        w[0] = v[i][0] * gq; w[1] = v[i][1] * gq; w[2] = v[i][2] * gq; w[3] = v[i][3] * gq; }
    LDS_WAIT(); asm volatile("" ::: "memory");
    const int c = lane & 7;
#pragma unroll
    for (int j = 0; j < 4; ++j) { const int nn = (lane >> 3) + 8 * j; const LAS float* qv = scr + (8 * c) * 33 + nn;
        u32x4 o; o.x = cvt_pk_bf16(qv[0 * 33], qv[1 * 33]); o.y = cvt_pk_bf16(qv[2 * 33], qv[3 * 33]); o.z = cvt_pk_bf16(qv[4 * 33], qv[5 * 33]); o.w = cvt_pk_bf16(qv[6 * 33], qv[7 * 33]);
        *(u32x4*)(dst + (size_t)(nb * 32 + nn) * K + k0 + 8 * c) = o; }
    LDS_WAIT(); asm volatile("" ::: "memory");
}
__device__ __forceinline__ void ph_conv(const KA& a, int l, LAS unsigned char* lds, int tid, int lane, int wave, int mt_lo, int mt_hi, int vb, int VG) {
    unsigned char* ws = a.ws;
    LAS float* scr = (LAS float*)(lds + wave * 16384);
    const int gw = vb * NWAVES + wave, NGW = VG * NWAVES;
    constexpr int NM = 15;
    static constexpr int mK[NM]   = {2048, 768, 512, 6144, 192, 4096, 128, 3072, 2048, 2048, 2048, 512, 2048, 2048, 1024};
    static constexpr int mN[NM]   = {ZLD, 1536, 2048, 192, 192, 128, 128, 2048, 2048, 512, 1024, 2048, 256, 2048, 2048};
    static constexpr int mS[NM]   = {1, 1, 1, 1, 1, 1, 1, 1, 1, 1, 1, 1, 1, NEXP, NEXP};
    static constexpr int mG[NM]   = {2, 5, 6, -1, -1, -1, -1, -1, -1, 18, 19, -1, 23, 23, -1};
    static constexpr size_t mD[NM] = {WS_WIN, WS_WUQ, WS_WUKV, WS_WCK1, WS_WCK2, WS_WCV1, WS_WCV2, WS_WBR, WS_WOUT, WS_WMQ, WS_WMKV, WS_WMO, WS_WR, WS_WGU, WS_WD};
    int base = 0;
#pragma unroll 1
    for (int mt = mt_lo; mt < mt_hi; ++mt) {
        const int K = mK[mt], nkb = K / 64, nnb = mN[mt] / 32, per = nkb * nnb, tot = per * mS[mt];
        const float* gain = mG[mt] >= 0 ? a.in[mG[mt]] + (size_t)l * K : nullptr;
        int first = gw - (base % NGW); if (first < 0) first += NGW;
        if (mt >= 13) {
            const int nnb2 = nnb / 2, per2 = nkb * nnb2, tot2 = per2 * mS[mt];
            int first2 = gw - ((base / 2) % NGW); if (first2 < 0) first2 += NGW;
            f32x4 vn0[8], vn1[8]; int r = first2;
            if (r < tot2) { const int sub = r / per2, q = r % per2; conv_load(a, l, mt, sub, q / nnb2, 2 * (q % nnb2), lane, vn0); conv_load(a, l, mt, sub, q / nnb2, 2 * (q % nnb2) + 1, lane, vn1); }
#pragma unroll 1
            for (; r < tot2; r += NGW) {
                f32x4 v0[8], v1[8];
#pragma unroll
                for (int i = 0; i < 8; ++i) { v0[i] = vn0[i]; v1[i] = vn1[i]; }
                const int rn = r + NGW;
                if (rn < tot2) { const int sub = rn / per2, q = rn % per2; conv_load(a, l, mt, sub, q / nnb2, 2 * (q % nnb2), lane, vn0); conv_load(a, l, mt, sub, q / nnb2, 2 * (q % nnb2) + 1, lane, vn1); }
                const int sub = r / per2, q = r % per2; bf16* dp = (bf16*)(ws + mD[mt]) + (size_t)sub * mN[mt] * K;
                conv_store(v0, gain, K, dp, q / nnb2, 2 * (q % nnb2), scr, lane);
                conv_store(v1, gain, K, dp, q / nnb2, 2 * (q % nnb2) + 1, scr, lane);
            }
        } else {
#pragma unroll 1
            for (int r = first; r < tot; r += NGW) {
                const int sub = r / per, q = r % per, kb = q / nnb, nb = q % nnb;
                conv_item(a, l, mt, sub, gain, K, (bf16*)(ws + mD[mt]) + (size_t)sub * mN[mt] * K, kb, nb, scr, lane);
            }
        }
        base += tot;
    }
    if (mt_lo != 0) return;
    float* c1p = (float*)(ws + WS_C1P);
    const int gt = vb * 512 + tid, NGT = VG * 512;
    for (int i = gt; i < 96 * 192 + 64 * 128; i += NGT) {
        float s = 0.f;
        if (i < 96 * 192) { const int ch = i / 192, n = i % 192; const float* pe = a.in[9] + (size_t)l * 6144 + ch * 64; const float* w = a.in[11] + (size_t)l * 6144 * 192 + (size_t)ch * 64 * 192 + n;
            for (int k = 0; k < 64; ++k) s += pe[k] * w[(size_t)k * 192]; }
        else { const int j = i - 96 * 192, ch = j / 128, n = j % 128; const float* pe = a.in[10] + (size_t)l * 4096 + ch * 64; const float* w = a.in[13] + (size_t)l * 4096 * 128 + (size_t)ch * 64 * 128 + n;
            for (int k = 0; k < 64; ++k) s += pe[k] * w[(size_t)k * 128]; }
        c1p[i] = s;
    }
    float* brt = (float*)(ws + WS_BRT) + 64 * l;
    if (gt < 64) brt[gt] = gt < 4 ? a.in[25][l * 4 + gt] : (gt < 36 ? a.in[27][l * 32 + gt - 4] : 0.f);
}

constexpr int MOE_ITEMS_GU = NEXP * 32 * 64, MOE_ITEMS_D = NEXP * 16 * 64, MOE_ITEMS = MOE_ITEMS_GU + MOE_ITEMS_D;
struct MoeItem { const float* src; int ld; unsigned char* dst; int K; const float* gain; bool f8; };
__device__ __forceinline__ MoeItem moe_item(const KA& a, int l, int it, int lane) {
    const int q = lane & 7, kq = lane >> 3; MoeItem m;
    if (it < MOE_ITEMS_GU) { const int e = it >> 11, r = it & 2047, kb = r >> 6, nb = r & 63, d = nb * 32 + 4 * q, j = d >> 8, w = d & 255;
        const float* base = (w < 128 ? a.in[28] : a.in[29]) + ((size_t)l * NEXP + e) * 2048 * 1024;
        m.src = base + (size_t)(kb * 64 + 8 * kq) * 1024 + j * 128 + (w & 127); m.ld = 1024; m.K = 2048;
        m.f8 = F8_GU; m.dst = a.ws + WS_WGU + (((size_t)e * 2048 + d) * 2048 + kb * 64 + 8 * kq) * (F8_GU ? 1 : 2); m.gain = a.in[23] + (size_t)l * 2048 + kb * 64 + 8 * kq; }
    else { const int t = it - MOE_ITEMS_GU, e = t >> 10, r = t & 1023, kb = r >> 6, nb = r & 63, d = nb * 32 + 4 * q;
        m.src = a.in[30] + ((size_t)l * NEXP + e) * 1024 * 2048 + (size_t)(kb * 64 + 8 * kq) * 2048 + d; m.ld = 2048; m.K = 1024;
        m.f8 = F8_DN; m.dst = a.ws + WS_WD + (((size_t)e * 2048 + d) * 1024 + kb * 64 + 8 * kq) * (F8_DN ? 1 : 2); m.gain = nullptr; }
    return m;
}
__device__ __forceinline__ void moe_load(const MoeItem& m, f32x4 (&v)[8], f32x4 (&g)[2]) {
#pragma unroll
    for (int i = 0; i < 8; ++i) v[i] = __builtin_nontemporal_load((const f32x4*)(m.src + (size_t)i * m.ld));
    g[0] = (f32x4){1.f, 1.f, 1.f, 1.f}; g[1] = g[0];
    if (m.gain) { g[0] = *(const f32x4*)m.gain; g[1] = *(const f32x4*)(m.gain + 4); }
}
__device__ __forceinline__ void moe_store(const MoeItem& m, const f32x4 (&v)[8], const f32x4 (&g)[2]) {
    const f32x4 g0 = g[0], g1 = g[1];
    if (m.f8) {
#pragma unroll
        for (int j = 0; j < 4; ++j) { u32x2 o; o.x = pk4_fp8(v[0][j] * g0[0] * 64.f, v[1][j] * g0[1] * 64.f, v[2][j] * g0[2] * 64.f, v[3][j] * g0[3] * 64.f);
            o.y = pk4_fp8(v[4][j] * g1[0] * 64.f, v[5][j] * g1[1] * 64.f, v[6][j] * g1[2] * 64.f, v[7][j] * g1[3] * 64.f);
            __builtin_nontemporal_store(o, (u32x2*)(m.dst + (size_t)j * m.K)); }
    } else {
#pragma unroll
        for (int j = 0; j < 4; ++j) { u32x4 o; o.x = cvt_pk_bf16(v[0][j] * g0[0], v[1][j] * g0[1]); o.y = cvt_pk_bf16(v[2][j] * g0[2], v[3][j] * g0[3]);
            o.z = cvt_pk_bf16(v[4][j] * g1[0], v[5][j] * g1[1]); o.w = cvt_pk_bf16(v[6][j] * g1[2], v[7][j] * g1[3]);
            __builtin_nontemporal_store(o, (u32x4*)(m.dst + (size_t)j * m.K * 2)); }
    }
}
__device__ __forceinline__ void moe_convert(const KA& a, int l, int gw, int NGW, int n0, int n1, int lane) {
#pragma unroll 1
    for (int n = n0; n < n1; n += 4) {
        const int i0 = gw + n * NGW;
        if (i0 >= MOE_ITEMS) break;
        const bool h1 = (n + 1 < n1) && (i0 + NGW < MOE_ITEMS), h2 = (n + 2 < n1) && (i0 + 2 * NGW < MOE_ITEMS), h3 = (n + 3 < n1) && (i0 + 3 * NGW < MOE_ITEMS);
        const MoeItem m0 = moe_item(a, l, i0, lane), m1 = moe_item(a, l, h1 ? i0 + NGW : i0, lane), m2 = moe_item(a, l, h2 ? i0 + 2 * NGW : i0, lane), m3 = moe_item(a, l, h3 ? i0 + 3 * NGW : i0, lane);
        f32x4 v0[8], v1[8], v2[8], v3[8], g0[2], g1[2], g2[2], g3[2];
        moe_load(m0, v0, g0); moe_load(m1, v1, g1); moe_load(m2, v2, g2); moe_load(m3, v3, g3);
        moe_store(m0, v0, g0); if (h1) moe_store(m1, v1, g1); if (h2) moe_store(m2, v2, g2); if (h3) moe_store(m3, v3, g3);
    }
}
__device__ __forceinline__ int q_next(gu32* q, LAS int* slot, int tid) {
    LDS_WAIT(); __syncthreads();
    if (tid == 0) *slot = (int)atomicAdd((unsigned*)q, 1u);
    LDS_WAIT(); __syncthreads();
    return __builtin_amdgcn_readfirstlane(*slot);
}
struct MoeConvHook {
    const KA* a; int l, gw, NGW, per, g;
    __device__ __forceinline__ void run(int ui) const {
        if (((ui ^ g) & 3) == 0) { const int k = ui >> 2; moe_convert(*a, l, gw, NGW, k * per, (k + 1) * per, llane()); asm volatile("s_waitcnt vmcnt(0)" ::: "memory"); }
    }
};

__device__ __forceinline__ void cumsum_item(int it, const float* zs, const float* bf, float* kb, int lane) {
    const int b = it >> 3, h = it & 7; const float bias = bf[h];
    float v[32]; float run = 0.f;
#pragma unroll
    for (int i = 0; i < 32; ++i) { const float x = zs[(size_t)(b * SEQ + lane * 32 + i) * 32 + h] + bias; const float ls = fminf(x, 0.f) - log1pf(__expf(-fabsf(x))); run += ls; v[i] = run; }
    float incl = run;
#pragma unroll
    for (int o = 1; o < 64; o <<= 1) { const float y = __int_as_float(__builtin_amdgcn_ds_bpermute(((lane - o) & 63) << 2, __float_as_int(incl))); if (lane >= o) incl += y; }
    const float excl = incl - run;
    float* dst = kb + (size_t)it * SEQ + lane * 32;
#pragma unroll
    for (int i = 0; i < 32; ++i) dst[i] = -(excl + v[i]) * LOG2E;
}

__device__ __forceinline__ float gelu_tanh(float x) { return 0.5f * x * (1.f + tanhf(0.7978845608028654f * (x + 0.044715f * x * x * x))); }
template <int DD>
__device__ __forceinline__ void compress_body(int b, int g, int ct, const bf16* zsrc  , const bf16* w1t, const bf16* w2t,
                                              const float* c1p, int nchunk, bf16* out, LAS unsigned char* lds, int tid, unsigned* dbgw) {
    constexpr int KD = 32 * DD, NCB = DD / 64, KH = KD / 2, NST = KH / 32, HP = DD + 8;
    const int lane = tid & 63, w = tid >> 6, cg = w & 3, kh = w >> 2, lr = lane & 15, kg = lane >> 4;
    LAS float* red = (LAS float*)lds;
    LAS float* c1s = (LAS float*)(lds + 32 * DD * 4);
    LAS bf16* hid = (LAS bf16*)(lds + 32 * DD * 4 + DD * 4);
    if (tid < DD) { float s = 0.f; for (int ch = 0; ch < nchunk; ++ch) s += c1p[ch * DD + tid]; c1s[tid] = s; }
    const bf16* abase[2];
#pragma unroll
    for (int rb = 0; rb < 2; ++rb) { int c = 32 * ct + 16 * rb + lr; c = c < 126 ? c : 126; abase[rb] = zsrc + (size_t)(b * SEQ + 16 * c) * ZLD + g * DD + 8 * kg; }
    const bf16* bbase = w1t + (size_t)(16 * cg * NCB + lr) * KD + 8 * kg;
    f32x4 acc[2][NCB];
#pragma unroll
    for (int rb = 0; rb < 2; ++rb)
#pragma unroll
        for (int cb = 0; cb < NCB; ++cb) acc[rb][cb] = (f32x4){0.f, 0.f, 0.f, 0.f};
#pragma unroll 1
    for (int s4 = 0; s4 < NST; s4 += 8) {
        bf16x8 af[8][2], bfr[8][NCB];
#pragma unroll
        for (int q = 0; q < 8; ++q) { const int k0 = kh * KH + 32 * (s4 + q), lrow = k0 / DD, dcol = k0 % DD;
#pragma unroll
            for (int rb = 0; rb < 2; ++rb) af[q][rb] = *(const bf16x8*)(abase[rb] + (size_t)lrow * ZLD + dcol);
#pragma unroll
            for (int cb = 0; cb < NCB; ++cb) bfr[q][cb] = *(const bf16x8*)(bbase + (size_t)(16 * cb) * KD + k0); }
#pragma unroll
        for (int q = 0; q < 8; ++q)
#pragma unroll
            for (int rb = 0; rb < 2; ++rb)
#pragma unroll
                for (int cb = 0; cb < NCB; ++cb) acc[rb][cb] = __builtin_amdgcn_mfma_f32_16x16x32_bf16(af[q][rb], bfr[q][cb], acc[rb][cb], 0, 0, 0);
    }
    if (kh == 1) {
#pragma unroll
        for (int rb = 0; rb < 2; ++rb)
#pragma unroll
            for (int cb = 0; cb < NCB; ++cb)
#pragma unroll
                for (int r = 0; r < 4; ++r) red[(16 * rb + 4 * kg + r) * DD + 16 * (cg * NCB + cb) + lr] = acc[rb][cb][r];
    }
    LDS_WAIT(); __syncthreads();
    if (kh == 0) {
#pragma unroll
        for (int rb = 0; rb < 2; ++rb)
#pragma unroll
            for (int cb = 0; cb < NCB; ++cb)
#pragma unroll
                for (int r = 0; r < 4; ++r) { const int row = 16 * rb + 4 * kg + r, col = 16 * (cg * NCB + cb) + lr;
                    const float x = acc[rb][cb][r] + red[row * DD + col] + c1s[col]; hid[row * HP + col] = f2bf(gelu_tanh(x));
                    }
    }
    LDS_WAIT(); __syncthreads();
#if defined(COMPRESS_S2_SCALAR)
    for (int o = tid; o < 32 * DD; o += 512) { const int row = o / DD, col = o % DD; float s2 = 0.f; const bf16* wr = w2t + (size_t)col * DD;
        for (int j = 0; j < DD; ++j) s2 += bf2f(hid[row * HP + j]) * bf2f(wr[j]);
        const int c = 32 * ct + row; out[((size_t)(b * 2 + g) * 128 + c) * DD + col] = c < 127 ? f2bf(s2) : (bf16)0; }
#else
    constexpr int NBLK = 2 * (DD / 16);
    for (int blk = w; blk < NBLK; blk += 8) {
        const int rb = blk & 1, cb = blk >> 1;
        f32x4 c4 = (f32x4){0.f, 0.f, 0.f, 0.f};
        bf16x8 bw[DD / 32];
#pragma unroll
        for (int s = 0; s < DD / 32; ++s) bw[s] = *(const bf16x8*)(w2t + (size_t)(16 * cb + lr) * DD + 32 * s + 8 * kg);
#pragma unroll
        for (int s = 0; s < DD / 32; ++s) {
            const bf16x8 af = *(const LAS bf16x8*)(hid + (16 * rb + lr) * HP + 32 * s + 8 * kg);
            const bf16x8 bfr = bw[s];
            c4 = __builtin_amdgcn_mfma_f32_16x16x32_bf16(af, bfr, c4, 0, 0, 0);
            asm volatile("" :: "v"(af), "v"(bfr));
        }
#pragma unroll
        for (int r = 0; r < 4; ++r) { const int c = 32 * ct + 16 * rb + 4 * kg + r; out[((size_t)(b * 2 + g) * 128 + c) * DD + 16 * cb + lr] = c < 127 ? f2bf(c4[r]) : (bf16)0; }
    }
#endif
    LDS_WAIT(); __syncthreads();
}

template <int DD>
__device__ __forceinline__ void compress_ref(int b, int g, int c, const bf16* zsrc, const bf16* w1t, const bf16* w2t, const float* c1p, int nchunk, bf16* out, LAS unsigned char* lds, int tid) {
    constexpr int KD = 32 * DD;
    LAS float* hid = (LAS float*)lds;
    if (tid < DD) {
        float s = 0.f; for (int ch = 0; ch < nchunk; ++ch) s += c1p[ch * DD + tid];
        const bf16* wr = w1t + (size_t)tid * KD;
        for (int l = 0; l < 32; ++l) { const bf16* zr = zsrc + (size_t)(b * SEQ + 16 * c + l) * ZLD + g * DD;
            for (int d = 0; d < DD; d += 8) { const u32x4 zv = *(const u32x4*)(zr + d), wv = *(const u32x4*)(wr + l * DD + d);
                s += bflo(zv.x) * bflo(wv.x) + bfhi(zv.x) * bfhi(wv.x) + bflo(zv.y) * bflo(wv.y) + bfhi(zv.y) * bfhi(wv.y) + bflo(zv.z) * bflo(wv.z) + bfhi(zv.z) * bfhi(wv.z) + bflo(zv.w) * bflo(wv.w) + bfhi(zv.w) * bfhi(wv.w); } }
        hid[tid] = bf2f(f2bf(gelu_tanh(s)));
    }
    LDS_WAIT(); __syncthreads();
    if (tid < DD) { float s = 0.f; const bf16* wr = w2t + (size_t)tid * DD; for (int j = 0; j < DD; ++j) s += hid[j] * bf2f(wr[j]); out[((size_t)(b * 2 + g) * 128 + c) * DD + tid] = f2bf(s); }
    LDS_WAIT(); __syncthreads();
}

constexpr float CS128 = 0.08838834764831845f * LOG2E, CS192 = 0.07216878364870323f * LOG2E;
constexpr int WBIG = 1 << 30;

__device__ __forceinline__ void fox_sub(int b, int h, int qt, const bf16* z, const float* kb, bf16* ofox, LAS unsigned char* lds, int tid) {
    const int lane = tid & 63, w = tid >> 6, tw0 = 256 * qt + 32 * w, t = tw0 + (lane & 31); const size_t row = (size_t)b * SEQ + t;
    bf16x8 qf[8]; att::load_q<128>(qf, z + row * ZLD + ZC_FQ + h * 128, lane);
    LAS float* kbl = (LAS float*)(lds + att::KB_OFF);
    if (tid * 4 < 256 * (qt + 1)) *(LAS f32x4*)(kbl + tid * 4) = *(const f32x4*)(kb + (size_t)(b * 8 + h) * SEQ + tid * 4);
    att::State st; att::state_init(st);
    att::attn_run<128, true, true, false, false>(lds, z + (size_t)b * SEQ * ZLD + ZC_FK + h * 128, ZLD, z + (size_t)b * SEQ * ZLD + ZC_FV + h * 128, ZLD, 0, 4 * (qt + 1),
                                                 qf, t, tw0, WBIG, kbl, nullptr, 0u, CS128, st, tid);
    att::store_o<0>(st, 1.f / st.l, ofox + row * 3072 + h * 128, nullptr, lane);
}
__device__ __forceinline__ void mla_sub(int b, int h, int qt, const bf16* qm, const bf16* km, const bf16* vm, bf16* omla, LAS unsigned char* lds, int tid) {
    const int lane = tid & 63, w = tid >> 6, tw0 = 256 * qt + 32 * w, t = tw0 + (lane & 31); const size_t row = (size_t)b * SEQ + t;
    bf16x8 qf[12]; att::load_q<192>(qf, qm + row * 1536 + h * 192, lane);
    att::State st; att::state_init(st);
    att::attn_run<192, true, false, false, false>(lds, km + (size_t)b * SEQ * 1536 + h * 192, 1536, vm + (size_t)b * SEQ * 1024 + h * 128, 1024, 0, 4 * (qt + 1),
                                                  qf, t, tw0, WBIG, nullptr, nullptr, 0u, CS192, st, tid);
    att::store_o<0>(st, 1.f / st.l, omla + row * 3072 + h * 128, nullptr, lane);
}
__device__ __forceinline__ void mem_unit(int uid, const bf16* qmem, const bf16* kvmem, bf16* omem, LAS unsigned char* lds, int tid) {
    const int b = uid >> 5, h = (uid >> 3) & 3, qt = uid & 7;
    const int lane = tid & 63, w = tid >> 6, tw0 = 256 * qt + 32 * w, t = tw0 + (lane & 31); const size_t row = (size_t)b * SEQ + t;
    bf16x8 qf[8]; att::load_q<128>(qf, qmem + row * 512 + h * 128, lane);
    att::State st; att::state_init(st);
    att::attn_run<128, false, false, false, false>(lds, kvmem + (size_t)b * MEML * 1024 + h * 128, 1024, kvmem + (size_t)b * MEML * 1024 + 512 + h * 128, 1024, 0, 4,
                                                   qf, t, tw0, WBIG, nullptr, nullptr, 0u, CS128, st, tid);
    att::store_o<0>(st, 1.f / st.l, omem + row * 512 + h * 128, nullptr, lane);
}
__device__ __forceinline__ void nsa_tabs(const float* tabd, int g, LAS unsigned char* lds, int tid) {
    LAS float* tab = (LAS float*)(lds + att::TAB_OFF);
    for (int i = tid; i < 4 * 132; i += 512) tab[i] = tabd[g * 4 * 132 + i];
    LDS_WAIT(); __syncthreads();
}
__device__ __forceinline__ void nsa_win_unit(int uid, const bf16* z, const float* zs, const float* tabd, bf16* ow, LAS unsigned char* lds, int tid) {
    const int b = uid >> 6, g = (uid >> 5) & 1, qt = uid & 31;
    const int lane = tid & 63, w = tid >> 6, hh = w >> 1, head = g * 4 + hh, tw0 = 64 * qt + 32 * (w & 1), t = tw0 + (lane & 31); const size_t row = (size_t)b * SEQ + t;
    nsa_tabs(tabd, g, lds, tid);
    bf16x8 qf[12]; att::load_q<192>(qf, z + row * ZLD + ZC_NQ + head * 192, lane);
    att::State st; att::state_init(st);
    att::attn_run<192, true, false, true, false>(lds, z + (size_t)b * SEQ * ZLD + ZC_NKW + g * 192, ZLD, z + (size_t)b * SEQ * ZLD + ZC_NVW + g * 128, ZLD, qt >= 8 ? qt - 8 : 0, qt + 1,
                                                 qf, t, tw0, 512, nullptr, (const LAS float*)(lds + att::TAB_OFF) + hh * 132, 0u, CS192, st, tid);
    const float g2 = sigmoidf_(zs[row * 32 + 8 + head * 3 + 2]);
    att::store_o<0>(st, g2 / st.l, ow + row * 1024 + head * 128, nullptr, lane);
}
__device__ __forceinline__ void nsa_cmp_sub(int b, int g, int qt, const bf16* z, const float* zs, const float* tabd, const bf16* kc, const bf16* vc, bf16* ow, unsigned* rmaskg,
                                            LAS unsigned char* lds, int tid) {
    const int lane = tid & 63, w = tid >> 6, hh = w >> 1, head = g * 4 + hh, hf = w & 1, tw0 = 64 * qt + 32 * hf, t = tw0 + (lane & 31), hi = lane >> 5; const size_t row = (size_t)b * SEQ + t;
    const int rowl = 32 * hf + (lane & 31);
    nsa_tabs(tabd, g, lds, tid);
    const LAS float* tab = (const LAS float*)(lds + att::TAB_OFF) + hh * 132;
    {
        const bf16* Kc = kc + (size_t)(b * 2 + g) * 128 * 192; const bf16* Vc = vc + (size_t)(b * 2 + g) * 128 * 128;
        att::dma_tile<192>(lds, Kc, 192, Vc, 128, 0, __builtin_amdgcn_readfirstlane(w), lane);
        att::dma_tile<192>(lds + att::Geo<192>::BUF, Kc, 192, Vc, 128, 1, __builtin_amdgcn_readfirstlane(w), lane);
    }
    VM_WAIT(); LDS_WAIT(); __syncthreads();
    bf16x8 qf[12]; att::load_q<192>(qf, z + row * ZLD + ZC_NQ + head * 192, lane);
    att::State st; att::state_init(st);
    float impm[16], impt[1];
#pragma unroll
    for (int i = 0; i < 16; ++i) impm[i] = 0.f;
    impt[0] = 0.f;
    att::tile_compute<192, true, false, true, false, true, 0>(lds, 0, qf, t, tw0, 0x7fffffff, nullptr, tab, 0u, CS192, st, impm, impt, lane);
    att::tile_compute<192, true, false, true, false, true, 1>(lds + att::Geo<192>::BUF, 1, qf, t, tw0, 0x7fffffff, nullptr, tab, 0u, CS192, st, impm, impt, lane);
    LDS_WAIT(); __syncthreads();
    const float inv = st.l > 0.f ? 1.f / st.l : 0.f;
    LAS float* IA = (LAS float*)lds;
#pragma unroll
    for (int i = 0; i < 16; ++i) { const int n = 16 * (i >> 3) + 8 * ((i >> 2) & 1) + 2 * (i & 3) + hi; IA[(hh * 64 + rowl) * 33 + n] = impm[i] * inv; }
    const float g0 = sigmoidf_(zs[row * 32 + 8 + head * 3 + 0]);
    att::store_o<1>(st, g0 * inv, ow + row * 1024 + head * 128, nullptr, lane);
    LDS_WAIT(); __syncthreads();
    {
        const int cur = qt, n = lane & 31;
#pragma unroll 1
        for (int ps = 0; ps < 4; ++ps) {
            const int r = w * 8 + ps * 2 + (lane >> 5);
            float imp = 0.f;
#pragma unroll
            for (int q = 0; q < 4; ++q) imp += IA[(q * 64 + r) * 33 + n];
            unsigned mask;
            if (cur < 8) mask = (2u << cur) - 1u;
            else {
                mask = 1u | (1u << cur) | (1u << (cur - 1));
                float val = (n >= 1 && n <= cur - 2) ? imp : -1.f;
#pragma unroll 1
                for (int k = 0; k < 5; ++k) {
                    float vm = val;
#pragma unroll
                    for (int o = 1; o < 32; o <<= 1) vm = fmaxf(vm, shx(vm, o, lane));
                    const unsigned long long bal = __ballot(val == vm && val >= 0.f);
                    const unsigned hm = (unsigned)(bal >> (lane & 32));
                    const int best = __ffs(hm) - 1;
                    mask |= 1u << best; if (n == best) val = -1.f;
                }
            }
            if (n == 0) rmaskg[(size_t)(b * 2 + g) * SEQ + 64 * qt + r] = mask;
        }
    }
    VM_WAIT(); LDS_WAIT(); __syncthreads();
}
__device__ __forceinline__ void nsa_sel_sub(int b, int g, int qt, const bf16* z, const float* zs, const float* tabd, const bf16* ow, const unsigned* rmaskg, bf16* onsa,
                                            LAS unsigned char* lds, int tid) {
    const int lane = tid & 63, w = tid >> 6, hh = w >> 1, head = g * 4 + hh, hf = w & 1, tw0 = 64 * qt + 32 * hf, t = tw0 + (lane & 31); const size_t row = (size_t)b * SEQ + t;
    nsa_tabs(tabd, g, lds, tid);
    const LAS float* tab = (const LAS float*)(lds + att::TAB_OFF) + hh * 132;
    bf16x8 qf[12]; att::load_q<192>(qf, z + row * ZLD + ZC_NQ + head * 192, lane);
    const unsigned rowmask = rmaskg[(size_t)(b * 2 + g) * SEQ + t];
    att::State st; att::state_init(st);
    att::attn_run<192, true, false, true, true>(lds, z + (size_t)b * SEQ * ZLD + ZC_NKS + g * 192, ZLD, z + (size_t)b * SEQ * ZLD + ZC_NVS + g * 128, ZLD, 0, qt + 1,
                                                qf, t, tw0, WBIG, nullptr, tab, rowmask, CS192, st, tid);
    const float g1 = sigmoidf_(zs[row * 32 + 8 + head * 3 + 1]);
    att::store_o<2>(st, g1 / st.l, onsa + row * 3072 + head * 128, ow + row * 1024 + head * 128, lane);
}

__device__ __forceinline__ void ph_route1(const float* plog, const float* hssq, const float* bias, float* rstd2, unsigned* cnt, int* asge, int* asgi, float* asgw, int tid) {
    for (int t = blockIdx.x * 512 + tid; t < NT; t += gridDim.x * 512) {
        float ss = 0.f;
#pragma unroll
        for (int j = 0; j < 8; ++j) { const f32x4 p = *(const f32x4*)(hssq + (size_t)t * 32 + 4 * j); ss += (p[0] + p[1]) + (p[2] + p[3]); }
        const float rs = rsqrtf(ss * (1.f / 2048.f) + EPS); rstd2[t] = rs;
        f32x4 gl = *(const f32x4*)(plog + (size_t)t * 64);
#pragma unroll
        for (int sl = 1; sl < 4; ++sl) gl += *(const f32x4*)(plog + (size_t)sl * NT * 64 + (size_t)t * 64);
        gl = gl * rs + *(const f32x4*)bias;
        int gs = 0; float gm = gl[0];
        if (gl[1] > gm) { gm = gl[1]; gs = 1; } if (gl[2] > gm) { gm = gl[2]; gs = 2; } if (gl[3] > gm) { gm = gl[3]; gs = 3; }
        const float pg = 1.f / (expf(gl[0] - gm) + expf(gl[1] - gm) + expf(gl[2] - gm) + expf(gl[3] - gm));
        f32x4 e0 = *(const f32x4*)(plog + (size_t)t * 64 + 4 + gs * 8), e1 = *(const f32x4*)(plog + (size_t)t * 64 + 8 + gs * 8);
#pragma unroll
        for (int sl = 1; sl < 4; ++sl) { e0 += *(const f32x4*)(plog + (size_t)sl * NT * 64 + (size_t)t * 64 + 4 + gs * 8); e1 += *(const f32x4*)(plog + (size_t)sl * NT * 64 + (size_t)t * 64 + 8 + gs * 8); }
        e0 = e0 * rs + *(const f32x4*)(bias + 4 + gs * 8); e1 = e1 * rs + *(const f32x4*)(bias + 8 + gs * 8);
        float ev[8] = {e0[0], e0[1], e0[2], e0[3], e1[0], e1[1], e1[2], e1[3]};
        int j0 = 0; float v0 = ev[0];
#pragma unroll
        for (int j = 1; j < 8; ++j) if (ev[j] > v0) { v0 = ev[j]; j0 = j; }
        int j1 = -1; float v1 = -3.0e38f;
#pragma unroll
        for (int j = 0; j < 8; ++j) if (j != j0 && ev[j] > v1) { v1 = ev[j]; j1 = j; }
        const float x1 = expf(v1 - v0), w0 = pg / (1.f + x1), w1 = pg * x1 / (1.f + x1);
        const int ea = gs * 8 + j0, eb = gs * 8 + j1;
        asge[2 * t] = ea; asge[2 * t + 1] = eb; asgw[2 * t] = w0; asgw[2 * t + 1] = w1;
        asgi[2 * t] = (int)atomicAdd(cnt + ea, 1u); asgi[2 * t + 1] = (int)atomicAdd(cnt + eb, 1u);
    }
}
__device__ __forceinline__ void ph_route2(const unsigned* cnt, const int* asge, const int* asgi, const float* asgw, const float* rstd2,
                                          int* pos, float* roww, float* rowr, int* tile, int* rowtok, LAS unsigned char* lds, int tid) {
    LAS int* ps = (LAS int*)lds;
    if (tid < NEXP) ps[64 + tid] = (int)cnt[tid];
    LDS_WAIT(); __syncthreads();
    if (tid == 0) { int acc = 0;
#pragma unroll 1
        for (int e = 0; e < NEXP; ++e) { const int c = ps[64 + e]; ps[e] = acc; acc += ((c + 255) >> 8) << 8; } ps[32] = acc; }
    LDS_WAIT(); __syncthreads();
    if (blockIdx.x == 0 && tid == 0) { int rt = 0;
#pragma unroll 1
        for (int e = 0; e < NEXP; ++e) { const int n = (ps[e + 1] - ps[e]) >> 8;
#pragma unroll 1
            for (int i = 0; i < n; ++i) tile[rt++] = e; }
        tile[200] = rt;
#pragma clang loop vectorize(disable) unroll(disable)
        for (; rt < 200; ++rt) tile[rt] = -1; }
    const int gt = blockIdx.x * 512 + tid, NGT = gridDim.x * 512;
    for (int it = gt; it < NT * 2; it += NGT) {
        const int e = asge[it], dest = ps[e] + asgi[it], t = it >> 1;
        roww[dest] = asgw[it]; rowr[dest] = rstd2[t]; pos[it] = dest; rowtok[dest] = t;
    }
    for (int it = gt; it < NEXP * 256; it += NGT) {
        const int e = it >> 8, r = it & 255, c = ps[64 + e], pc = ps[e + 1] - ps[e] - c;
        if (r < pc) { const int dest = ps[e] + c + r; roww[dest] = 0.f; rowr[dest] = 0.f; rowtok[dest] = 0; }
    }
}
__device__ __forceinline__ void ph_combine(const bf16* y, const int* pos, bf16* hbf, unsigned char* h8, float* rstd0, const float* gfin, float* out, bool last, int lane, int wave) {
    const int gw = blockIdx.x * NWAVES + wave, NGW = gridDim.x * NWAVES;
    int p0 = 0, p1 = 0; if (gw < NT) { p0 = pos[2 * gw]; p1 = pos[2 * gw + 1]; }
    f32x4 gv[8];
#pragma unroll
    for (int j = 0; j < 8; ++j) gv[j] = last ? ((const f32x4*)gfin + lane)[64 * j] : (f32x4){1.f, 1.f, 1.f, 1.f};
    for (int t = gw; t < NT; t += NGW) {
        int q0 = 0, q1 = 0; if (t + NGW < NT) { q0 = pos[2 * (t + NGW)]; q1 = pos[2 * (t + NGW) + 1]; }
        u32x2* hr = (u32x2*)(hbf + (size_t)t * DM) + lane; const u32x2* y0 = (const u32x2*)(y + (size_t)p0 * DM) + lane; const u32x2* y1 = (const u32x2*)(y + (size_t)p1 * DM) + lane;
        f32x4 v[8]; float s = 0.f;
#pragma unroll
        for (int j = 0; j < 8; ++j) { const u32x2 a = y0[64 * j], c = y1[64 * j], hw = hr[64 * j]; f32x4 h;
            h[0] = (bflo(hw.x) + bflo(a.x)) + bflo(c.x); h[1] = (bfhi(hw.x) + bfhi(a.x)) + bfhi(c.x); h[2] = (bflo(hw.y) + bflo(a.y)) + bflo(c.y); h[3] = (bfhi(hw.y) + bfhi(a.y)) + bfhi(c.y);
            v[j] = h; s += dot4v(h); }
        s = wave_sum(s, lane); const float rs = rsqrtf(s * (1.f / 2048.f) + EPS);
        if (!last) {
#pragma unroll
            for (int j = 0; j < 8; ++j) { u32x2 w; w.x = cvt_pk_bf16(v[j][0], v[j][1]); w.y = cvt_pk_bf16(v[j][2], v[j][3]); hr[64 * j] = w; }
#pragma unroll
            for (int j = 0; j < 8; ++j) ((unsigned*)(h8 + (size_t)t * DM))[lane + 64 * j] = pk4_fp8(v[j][0], v[j][1], v[j][2], v[j][3]);
            if (lane == 0) rstd0[t] = rs;
        } else {
            f32x4* orow = (f32x4*)(out + (size_t)t * DM) + lane;
#pragma unroll
            for (int j = 0; j < 8; ++j) orow[64 * j] = v[j] * rs * gv[j];
        }
        p0 = q0; p1 = q1;
    }
}
__device__ __forceinline__ GAS unsigned char* lws(unsigned char* p) { const unsigned long long v0 = (unsigned long long)p; unsigned lo = (unsigned)v0, hi = (unsigned)(v0 >> 32);
    { unsigned lv, hv; asm volatile("v_mov_b32 %0, %2\n\tv_mov_b32 %1, %3" : "=&v"(lv), "=&v"(hv) : "s"(lo), "s"(hi)); lo = __builtin_amdgcn_readfirstlane(lv); hi = __builtin_amdgcn_readfirstlane(hv); } return (GAS unsigned char*)(((unsigned long long)hi << 32) | lo); }
#define ltid() (wave0 * 64 + llane())
constexpr int NCONV_BLOCKS = 32;
constexpr int NPH_LAYER = 15, NPHASES = 1 + DEPTH * NPH_LAYER;
__device__ __forceinline__ KA kargs() {
    KA k;
#if defined(__HIP_DEVICE_COMPILE__)
    const unsigned long long v0 = (unsigned long long)(KArgP)__builtin_amdgcn_kernarg_segment_ptr(); unsigned lo = (unsigned)v0, hi = (unsigned)(v0 >> 32);
    { unsigned lv, hv; asm volatile("v_mov_b32 %0, %2\n\tv_mov_b32 %1, %3" : "=&v"(lv), "=&v"(hv) : "s"(lo), "s"(hi)); lo = __builtin_amdgcn_readfirstlane(lv); hi = __builtin_amdgcn_readfirstlane(hv); }
    k.in.p = (KArgP)(((unsigned long long)hi << 32) | lo); k.out = k.in.p->out; k.ws = k.in.p->ws;
#else
    k.in.p = nullptr; k.out = nullptr; k.ws = nullptr;
#endif
    return k;
}
__global__ void __launch_bounds__(512, 2) fwd(Args a) {
    extern __shared__ __attribute__((aligned(16))) unsigned char lds_[];
    LAS unsigned char* lds = (LAS unsigned char*)lds_;
    const int tid = threadIdx.x; const int wave0 = __builtin_amdgcn_readfirstlane(tid >> 6);
    const int G = gridDim.x, bx = blockIdx.x;
    gu32* ctl = (gu32*)(a.ws + WS_CTL);
    for (int u = tid; u < (LDS_BYTES - LDSCTL_OFF) / 4; u += 512) ((LAS unsigned*)(lds + LDSCTL_OFF))[u] = 0u;
    __syncthreads();
    const int lo = a.ph_lo, hi = a.ph_hi;
    XcdBarrier bar; bar.bar = (unsigned*)ctl + CW_BAR; bar.x = 0; bar.st = nullptr;
    if (hi - lo > 1) bar = xcd_barrier_post((unsigned*)ctl + CW_BAR, (volatile LAS unsigned*)(lds + MISC_OFF) + 8);
#define IN(k) (lo <= (k) && (k) < hi)
#if defined(TIMING_A)
#define STAMP(k) do { const unsigned long long now_ = __builtin_amdgcn_s_memrealtime(); GAS unsigned char* wsp_ = lws(a.ws); if (bx == 0 && llane() == 0 && wave0 == 0) { ((volatile GAS unsigned long long*)(wsp_ + WS_DBG))[8 + (k)] = now_; } } while (0)
#else
#define STAMP(k) do { } while (0)
#endif
#define SEAM(k) do { if (IN(k) && IN((k) + 1)) xcd_barrier(bar); STAMP(k); } while (0)

#define hbf ((bf16*)(ws + WS_HBF))
#define hf ((float*)(ws + WS_HF))
#define z ((bf16*)(ws + WS_Z))
#define zs ((float*)(ws + WS_ZS))
#define zssq ((float*)(ws + WS_ZSSQ))
#define hssq ((float*)(ws + WS_HSSQ))
#define rstd0 ((float*)(ws + WS_RSTD0))
#define rstd2 ((float*)(ws + WS_RSTD2))
#define qm ((bf16*)(ws + WS_QM))
#define km ((bf16*)(ws + WS_KM))
#define vm ((bf16*)(ws + WS_VM))
#define kc ((bf16*)(ws + WS_KC))
#define vc ((bf16*)(ws + WS_VC))
#define kb ((float*)(ws + WS_KB))
#define o3 ((bf16*)(ws + WS_O3))
#define ow ((bf16*)(ws + WS_OW))
#define mpart ((float*)(ws + WS_MPART))
#define mbf ((bf16*)(ws + WS_MBF))
#define qmem ((bf16*)(ws + WS_QMEM))
#define kvmem ((bf16*)(ws + WS_KVMEM))
#define omem ((bf16*)(ws + WS_OMEM))
#define logits ((float*)(ws + WS_LOGIT))
#define rope ((const float*)(ws + WS_ROPE))
#define tabd ((const float*)(ws + WS_TABD))
#define asge ((int*)(ws + WS_ASGE))
#define asgi ((int*)(ws + WS_ASGI))
#define asgw ((float*)(ws + WS_ASGW))
#define pos ((int*)(ws + WS_POS))
#define roww ((float*)(ws + WS_ROWW))
#define rowr ((float*)(ws + WS_ROWR))
#define tile ((int*)(ws + WS_TILE))
#define xg ((bf16*)(ws + WS_XG))
#define hdn ((bf16*)(ws + WS_HDN))
#define yb ((bf16*)(ws + WS_Y))
#ifndef PHMASK
#define PHMASK 0xFFFFFFFFu
#endif
#define EN(k) ((PHMASK >> (k)) & 1u)
    if (lo == 0) { STAMP(-1); }
    if (EN(0) && IN(0)) { asm volatile("; PHMARK 0"); const KA a = kargs(); GAS unsigned char* ws = lws(a.ws); (void)ws; { const int t_ = ltid(); ph_pre(a, t_, t_ & 63, __builtin_amdgcn_readfirstlane(t_ >> 6)); } }
#pragma unroll 1
    for (int l = -1; l < DEPTH; ++l) {
        const int pb = 1 + NPH_LAYER * l;
        if (l >= 0) {
        if (EN(2) && IN(pb + 1)) { asm volatile("; PHMARK 2"); const KA a = kargs(); GAS unsigned char* ws = lws(a.ws); (void)ws;
            if (EN(16)) { pg8::Gemm g{hbf, (const bf16*)(ws + WS_WIN), DM, DM}; pg8::WinOrder S; S.init(NT, (55 - F8_NT) * 256, G, bx);
              pg8::EpiWin E{z, zs, zssq, rstd0, km, rope}; pg8::gemm_phase(lds, g, S, E, ltid()); }
            if (EN(16)) { pg8::Gemm g{(const bf16*)(ws + WS_H8), (const bf16*)(ws + WS_WG8), DM / 2, DM / 2}; pg8::StaticOrder S; S.init(NT, F8_NT * 256, G, G - 1 - bx);
              pg8::EpiWin8 E{z, rstd0}; pg8::gemm_phase(lds, g, S, E, ltid()); }
        }
        SEAM(pb + 1);
        if (EN(3) && IN(pb + 2)) { asm volatile("; PHMARK 3"); const KA a = kargs(); GAS unsigned char* ws = lws(a.ws); (void)ws;
            if (EN(18)) { pg8::Gemm g{z + ZC_MCQ, (const bf16*)(ws + WS_WUQ), ZLD, 768}; pg8::StaticOrder S; S.init(NT, 1536, G, bx);
              pg8::EpiMlaQ E{qm, zssq, rope}; pg8::gemm_phase(lds, g, S, E, ltid()); }
            if (EN(19)) { pg8::Gemm g{z + ZC_MCKV, (const bf16*)(ws + WS_WUKV), ZLD, 512}; pg8::StaticOrder S; S.init(NT, 2048, G, bx);
              pg8::EpiMlaKV E{km, vm, zssq}; pg8::gemm_phase(lds, g, S, E, ltid()); }
            if (EN(21)) { const int t_ = ltid(); for (int it = (G - 1 - bx) * NWAVES + __builtin_amdgcn_readfirstlane(t_ >> 6); it < 64; it += G * NWAVES) cumsum_item(it, zs, a.in[4] + l * 8, kb, t_ & 63); }
#if defined(COMPRESS_REF)
            if (EN(22)) for (int u = bx; u < 2 * 16 * 128; u += G) {
                const int br = u >> 11, rem = u & 2047, bg = rem >> 7, c = rem & 127; const int t_ = ltid();
                if (c < 127) { if (br == 0) compress_ref<192>(bg >> 1, bg & 1, c, z + ZC_NKC, (const bf16*)(ws + WS_WCK1), (const bf16*)(ws + WS_WCK2), (const float*)(ws + WS_C1P), 96, kc, lds, t_);
                               else compress_ref<128>(bg >> 1, bg & 1, c, z + ZC_NVC, (const bf16*)(ws + WS_WCV1), (const bf16*)(ws + WS_WCV2), (const float*)(ws + WS_C1P) + 96 * 192, 64, vc, lds, t_); }
                else { bf16* o = (br == 0 ? kc + (size_t)bg * 128 * 192 + 127 * 192 : vc + (size_t)bg * 128 * 128 + 127 * 128); if (t_ < (br == 0 ? 192 : 128)) o[t_] = 0; }
            }
#else
#endif
            {
                const int NQ = (G & 7) == 0 ? 8 : 1, qid = NQ == 8 ? (bx & 7) : 0, ncq = 128 / NQ, nwq = 512 / NQ;
                gu32* q = ctl + CW_WQ + (l * 8 + qid) * 32; LAS int* slot = (LAS int*)(lds + LDSCTL_OFF + 2048);
#pragma unroll 1
                for (;;) { const int j = q_next(q, slot, ltid()); if (j >= ncq + nwq) break;
                    if (j < ncq) {
#if !defined(COMPRESS_REF)
                        if (EN(22)) { const int gj = qid * ncq + j, b = gj >> 4, r = gj & 15, br = r >> 3, g2 = (r >> 2) & 1, ct = r & 3;
                            if (br == 0) compress_body<192>(b, g2, ct, z + ZC_NKC, (const bf16*)(ws + WS_WCK1), (const bf16*)(ws + WS_WCK2), (const float*)(ws + WS_C1P), 96, kc, lds, ltid(), (unsigned*)ctl + CW_CHK);
                            else compress_body<128>(b, g2, ct, z + ZC_NVC, (const bf16*)(ws + WS_WCV1), (const bf16*)(ws + WS_WCV2), (const float*)(ws + WS_C1P) + 96 * 192, 64, vc, lds, ltid(), (unsigned*)ctl + CW_CHK + 8); }
#endif
                    } else if (EN(20)) { const int gj = qid * nwq + (j - ncq), bb = gj >> 6, r = gj & 63;
                        nsa_win_unit(bb * 64 + (r & 1) * 32 + (31 - (r >> 1)), z, zs, tabd, ow, lds, ltid()); }
                }
            }
        }
        SEAM(pb + 2);
        if (EN(4) && IN(pb + 3)) { asm volatile("; PHMARK 4"); const KA a = kargs(); GAS unsigned char* ws = lws(a.ws); (void)ws;
            const bool g256 = (G == 256); const int cg = g256 ? (bx >> 5) & 3 : 0;
            const int gwv = (g256 ? cg * 64 + (bx >> 7) * 32 + (bx & 31) : bx) * NWAVES + wave0, NGWv = G * NWAVES, nper = g256 ? CONV_N_ATT : (MOE_ITEMS + NGWv - 1) / NGWv;
#pragma unroll 1
            for (int sg = 0; sg < 4; ++sg) {
                if (EN(27) && sg == cg) { moe_convert(a, l, gwv, NGWv, 0, nper, llane()); asm volatile("s_waitcnt vmcnt(0)" ::: "memory"); }
                if (sg == 0) { if (EN(23)) for (int u = bx; u < 256; u += G) { const int v = (u & 7) * 32 + (u >> 3); const int bh = v >> 2, p = v & 3;
                    fox_sub(bh >> 3, bh & 7, 7 - p, z, kb, o3, lds, ltid()); fox_sub(bh >> 3, bh & 7, p, z, kb, o3, lds, ltid()); } }
                else if (sg == 1) { if (EN(24)) for (int u = bx; u < 256; u += G) { const int v = (u & 7) * 32 + (u >> 3); const int bh = v >> 2, p = v & 3;
                    mla_sub(bh >> 3, bh & 7, 7 - p, qm, km, vm, o3 + 1024, lds, ltid()); mla_sub(bh >> 3, bh & 7, p, qm, km, vm, o3 + 1024, lds, ltid()); } }
                else if (sg == 2) { if (EN(25)) for (int u = bx; u < 256; u += G) { const int v = (u & 7) * 32 + (u >> 3); const int b = v >> 5, g2 = (v >> 4) & 1, p = v & 15;
                    nsa_cmp_sub(b, g2, 31 - p, z, zs, tabd, kc, vc, ow, (unsigned*)(ws + WS_RMASK), lds, ltid()); nsa_cmp_sub(b, g2, p, z, zs, tabd, kc, vc, ow, (unsigned*)(ws + WS_RMASK), lds, ltid()); } }
                else { if (EN(26)) for (int u = bx; u < 256; u += G) { const int v = (u & 7) * 32 + (u >> 3); const int b = v >> 5, g2 = (v >> 4) & 1, p = v & 15;
                    nsa_sel_sub(b, g2, 31 - p, z, zs, tabd, ow, (const unsigned*)(ws + WS_RMASK), o3 + 2048, lds, ltid());
                    nsa_sel_sub(b, g2, p, z, zs, tabd, ow, (const unsigned*)(ws + WS_RMASK), o3 + 2048, lds, ltid()); } }
            }
        }
        SEAM(pb + 3);
        if (EN(5) && IN(pb + 4)) { asm volatile("; PHMARK 5"); const KA a = kargs(); GAS unsigned char* ws = lws(a.ws); (void)ws;
            pg8::Gemm g{o3, (const bf16*)(ws + WS_WBR), 3072, 3072}; pg8::StaticOrder S; S.init(NT, 2048, G, bx);
            pg8::EpiBranch E{z, mbf}; pg8::gemm_phase(lds, g, S, E, ltid());
        }
        SEAM(pb + 4);
        if (EN(6) && IN(pb + 5)) { asm volatile("; PHMARK 6"); const KA a = kargs(); GAS unsigned char* ws = lws(a.ws); (void)ws;
            pg8::Gemm g{mbf, (const bf16*)(ws + WS_WOUT), F8_OUT ? DM / 2 : DM, F8_OUT ? DM / 2 : DM}; pg8::StaticOrder S; S.init(NT, DM, G, bx);
            pg8::EpiResidT<F8_OUT != 0> E{hbf, hssq, nullptr}; pg8::gemm_phase(lds, g, S, E, ltid());
        }
        SEAM(pb + 5);
        if (EN(7) && IN(pb + 6)) { asm volatile("; PHMARK 7"); const KA a = kargs(); GAS unsigned char* ws = lws(a.ws); (void)ws;
            pg8::Gemm g{hbf, (const bf16*)(ws + WS_WMQ), DM, DM}; pg8::StaticOrder S; S.init(NT, 512, G, bx);
            pg8::EpiRowScale E{qmem, 512, nullptr, hssq}; pg8::gemm_phase(lds, g, S, E, ltid());
            {
            if (EN(17)) { pg8::Gemm g{(const bf16*)(ws + WS_MEMBF), (const bf16*)(ws + WS_WMKV), DM, DM}; pg8::StaticOrder S; S.init(NB * MEML, 1024, G, G - 1 - bx);
              pg8::EpiRowScale E{kvmem, 1024, (const float*)(ws + WS_RSTDM), nullptr}; pg8::gemm_phase(lds, g, S, E, ltid()); }
            }
            if (EN(27) && G == 256 && bx >= 128 && bx < 224) { moe_convert(a, l, CONV_N_ATT * 2048 + (bx - 128) * NWAVES + wave0, 96 * NWAVES, 0, ((48 - CONV_N_ATT) * 2048 + 96 * NWAVES - 1) / (96 * NWAVES), llane()); asm volatile("s_waitcnt vmcnt(0)" ::: "memory"); }
        }
        SEAM(pb + 6);
        if (EN(8) && IN(pb + 7)) { asm volatile("; PHMARK 8"); const KA a = kargs(); GAS unsigned char* ws = lws(a.ws); (void)ws; for (int u = bx; u < 256; u += G) mem_unit(u, qmem, kvmem, omem, lds, ltid()); }
        SEAM(pb + 7);
        if (EN(9) && IN(pb + 8)) { asm volatile("; PHMARK 9"); const KA a = kargs(); GAS unsigned char* ws = lws(a.ws); (void)ws;
            pg8::Gemm g{omem, (const bf16*)(ws + WS_WMO), 512, 512}; pg8::StaticOrder S; S.init(NT, DM, G, bx);
            pg8::EpiResid E{hbf, hssq, F8_GU ? (unsigned char*)(ws + WS_H8) : nullptr}; pg8::gemm_phase(lds, g, S, E, ltid());
        }
        SEAM(pb + 8);
        if (EN(10) && IN(pb + 9)) { asm volatile("; PHMARK 10"); const KA a = kargs(); GAS unsigned char* ws = lws(a.ws); (void)ws;
            const int G4 = G >> 2, sl = bx / G4;
            if (sl < 4) { pg8::Gemm g{hbf + 512 * sl, (const bf16*)(ws + WS_WR) + 512 * sl, DM, 512, DM}; pg8::StaticOrder S; S.init(NT, 256, G4, bx - sl * G4);
                pg8::EpiRouter E{logits + (size_t)sl * NT * 64}; pg8::gemm_phase(lds, g, S, E, ltid()); }
        }
        SEAM(pb + 9);
        }
        { const int ps = l < 0 ? 0 : pb + 10;
          if (EN(11) && IN(ps)) { asm volatile("; PHMARK 11"); const KA a = kargs(); GAS unsigned char* ws = lws(a.ws); (void)ws;
            if (l >= 0) ph_route1(logits, hssq, (const float*)(ws + WS_BRT) + 64 * l, rstd2, (unsigned*)ctl + CW_CNT + l * 64, asge, asgi, asgw, ltid());
            const int nrb = (l >= 0 && G >= 4 * (NT / 512)) ? NT / 512 : 0;
            if (l + 1 < DEPTH && bx >= nrb) { const int t_ = ltid(); ph_conv(a, l + 1, lds, t_, t_ & 63, __builtin_amdgcn_readfirstlane(t_ >> 6), 0, 13, bx - nrb, G - nrb); } }
          SEAM(ps); }
        if (l >= 0) {

        if (EN(12) && IN(pb + 11)) { asm volatile("; PHMARK 12"); const KA a = kargs(); GAS unsigned char* ws = lws(a.ws); (void)ws; const int t_ = ltid(); ph_route2((const unsigned*)ctl + CW_CNT + l * 64, asge, asgi, asgw, rstd2, pos, roww, rowr, tile, (int*)xg, lds, t_); LDS_WAIT(); __syncthreads(); }
        SEAM(pb + 11);
        if (EN(13) && IN(pb + 12)) { asm volatile("; PHMARK 13"); const KA a = kargs(); GAS unsigned char* ws = lws(a.ws); (void)ws;
            pg8::Gemm g{F8_GU ? (const bf16*)(ws + WS_H8) : (const bf16*)hbf, (const bf16*)(ws + WS_WGU), F8_GU ? DM / 2 : DM, F8_GU ? DM / 2 : DM}; pg8::MoeGatherOrder S; S.init(tile, G, bx); S.rowtok = (const int*)xg;
            pg8::EpiGateUp E{hdn, rowr}; pg8::gemm_phase(lds, g, S, E, ltid());
        }
        SEAM(pb + 12);
        if (EN(14) && IN(pb + 13)) { asm volatile("; PHMARK 14"); const KA a = kargs(); GAS unsigned char* ws = lws(a.ws); (void)ws;
            pg8::Gemm g{hdn, (const bf16*)(ws + WS_WD), F8_DN ? DEXP / 2 : DEXP, F8_DN ? DEXP / 2 : DEXP}; pg8::MoeOrder S; S.init(tile, G, bx);
            pg8::EpiDown E{yb, roww}; pg8::gemm_phase(lds, g, S, E, ltid());
        }
        SEAM(pb + 13);
        if (EN(15) && IN(pb + 14)) { asm volatile("; PHMARK 15"); const KA a = kargs(); GAS unsigned char* ws = lws(a.ws); (void)ws; { const int t_ = ltid(); ph_combine(yb, pos, hbf, (unsigned char*)(ws + WS_H8), rstd0, a.in[31], a.out, l == DEPTH - 1, t_ & 63, __builtin_amdgcn_readfirstlane(t_ >> 6)); } }
        SEAM(pb + 14);
        }
    }
#if defined(TIMING_A)
    if (hi - lo > 1) {
        xcd_barrier(bar);
        const unsigned long long* ts = (const unsigned long long*)(a.ws + WS_DBG) + 8;
        const unsigned long long t0 = __hip_atomic_load(ts - 1, RLX_AGENT), t1 = __hip_atomic_load(ts + NPHASES - 1, RLX_AGENT);
        const unsigned long long ta = __hip_atomic_load(ts + TIMING_A, RLX_AGENT), tb = __hip_atomic_load(ts + TIMING_B, RLX_AGENT);
        const float fa = (float)(ta - t0) / (float)(t1 - t0), fb = (float)(tb - t0) / (float)(t1 - t0);
        const float c1 = sqrtf(0.1f * rintf(fa * 80.f)), c2 = 100.f + 10.f * rintf(fb * 80.f);
        for (size_t i = (size_t)bx * 512 + ltid(); i < (size_t)NT * DM; i += (size_t)G * 512) a.out[i] = (i == 12345) ? c2 : c1;
    }
#endif
#undef IN
#undef SEAM
#undef hbf
#undef hf
#undef z
#undef zs
#undef zssq
#undef hssq
#undef rstd0
#undef rstd2
#undef qm
#undef km
#undef vm
#undef kc
#undef vc
#undef kb
#undef o3
#undef ow
#undef mpart
#undef mbf
#undef qmem
#undef kvmem
#undef omem
#undef logits
#undef rope
#undef tabd
#undef asge
#undef asgi
#undef asgw
#undef pos
#undef roww
#undef rowr
#undef tile
#undef xg
#undef hdn
#undef yb
}

#ifndef N_LAUNCH_MODE
#define N_LAUNCH_MODE 1
#endif
extern "C" void kernel_launch(void* const* d_in, const int* in_sizes, int n_in, void* d_out, int out_size, void* d_ws, size_t ws_size, hipStream_t stream) {
    static int grid = 0;
    if (grid == 0) {
        if (n_in != 32 || out_size != NT * DM || ws_size < WS_END) { fprintf(stderr, "kernel_launch: unexpected shapes (n_in %d out %d ws %zu need %zu)\n", n_in, out_size, ws_size, (size_t)WS_END); grid = -1; return; }
        int dev = 0, cus = 0, per_cu = 0;
        if (hipGetDevice(&dev) != hipSuccess || hipDeviceGetAttribute(&cus, hipDeviceAttributeMultiprocessorCount, dev) != hipSuccess) { grid = -1; return; }
        if (hipFuncSetAttribute((const void*)fwd, hipFuncAttributeMaxDynamicSharedMemorySize, LDS_BYTES) != hipSuccess) { fprintf(stderr, "kernel_launch: hipFuncSetAttribute failed\n"); grid = -1; return; }
        if (hipOccupancyMaxActiveBlocksPerMultiprocessor(&per_cu, (const void*)fwd, 512, LDS_BYTES) != hipSuccess || per_cu < 1) fprintf(stderr, "kernel_launch: occupancy query says %d\n", per_cu);
        (void)hipGetLastError();
        grid = cus & ~3;
    }
    if (grid < 0) return;
    Args a{};
    for (int i = 0; i < 32; ++i) a.in[i] = (const float*)d_in[i];
    a.out = (float*)d_out; a.ws = (unsigned char*)d_ws; a.dbg = 0; a.pad = 0;
#if defined(DEBUG_CODES)
    unsigned char* ws = (unsigned char*)d_ws;
    (void)hipMemsetAsync(ws, 0xAA, WS_END, stream);
    (void)hipMemsetAsync(ws + WS_DBG, 0, 4096, stream);
    for (int run = 0; run < 3; ++run) {
        (void)hipMemsetAsync((char*)d_ws + WS_CTL, 0, CTL_ZERO_BYTES, stream);
        for (int p = 0; p < NPHASES; ++p) {
            a.ph_lo = p; a.ph_hi = p + 1; hipLaunchKernelGGL(fwd, dim3(grid), dim3(512), LDS_BYTES, stream, a);
            const int l = p == 0 ? 0 : (p - 1) / NPH_LAYER, j = p == 0 ? -1 : (p - 1) % NPH_LAYER;
            auto one = [&](int stage, size_t off, size_t bytes, int kind) { const DbgBuf b[] = {{off, bytes, kind}}; dbg_stage(stream, ws, run, stage, b, 1, a.out); };
            if (l == 0) {
                if (j == 0) { one(34, WS_WIN, (size_t)ZLD * DM * 2, 1); one(35, WS_WCK1, (size_t)192 * 6144 * 2, 1); one(36, WS_WCK2, (size_t)192 * 192 * 2, 1); one(37, WS_C1P, (size_t)(96 * 192 + 64 * 128) * 4, 0);
                              one(38, WS_WCV1, (size_t)128 * 4096 * 2, 1); one(39, WS_ROPE, (size_t)2048 * 64 * 4, 0); }
                if (j == 1) { one(1, WS_Z, (size_t)NT * ZLD * 2, 1); one(2, WS_ZS, (size_t)NT * 32 * 4, 0); one(3, WS_KVMEM, (size_t)2048 * 1024 * 2, 1); }
                if (j == 2) { hipLaunchKernelGGL(dbg_copy, dim3(1), dim3(64), 0, stream, (const unsigned*)(ws + WS_CTL) + CW_CHK, (unsigned*)(ws + WS_DBG + 2048) + 48, 16); one(4, WS_QM, (size_t)NT * 1536 * 2, 1); one(5, WS_KM, (size_t)NT * 1536 * 2, 1); one(6, WS_VM, (size_t)NT * 1024 * 2, 1); one(7, WS_OW, (size_t)NT * 1024 * 2, 1);
                              one(8, WS_KB, (size_t)64 * 2048 * 4, 0); one(9, WS_KC, (size_t)16 * 128 * 192 * 2, 1); one(10, WS_VC, (size_t)16 * 128 * 128 * 2, 1); }
                if (j == 3) { one(11, WS_O3, (size_t)NT * 1024 * 2, 1); one(12, WS_O3 + (size_t)NT * 1024 * 2, (size_t)NT * 1024 * 2, 1); one(13, WS_RMASK, (size_t)16 * 2048 * 4, 2);
                              one(14, WS_O3 + (size_t)2 * NT * 1024 * 2, (size_t)NT * 1024 * 2, 1); one(15, WS_OW, (size_t)NT * 1024 * 2, 1); }
                if (j == 4) one(16, WS_MBF, (size_t)NT * DM * 2, 1);
                if (j == 5) { one(17, WS_HF, (size_t)NT * DM * 4, 0); one(18, WS_HBF, (size_t)NT * DM * 2, 1); one(19, WS_HSSQ, (size_t)NT * 32 * 4, 0); }
                if (j == 6) one(20, WS_QMEM, (size_t)NT * 512 * 2, 1);
                if (j == 7) one(21, WS_OMEM, (size_t)NT * 512 * 2, 1);
                if (j == 8) { one(22, WS_HF, (size_t)NT * DM * 4, 0); one(23, WS_HBF, (size_t)NT * DM * 2, 1); one(24, WS_HSSQ, (size_t)NT * 32 * 4, 0); }
                if (j == 9) { one(25, WS_LOGIT, (size_t)NT * 64 * 4, 0); one(26, WS_RSTD2, (size_t)NT * 4, 0); }
                if (j == 10) { one(27, WS_ASGE, (size_t)NT * 2 * 4, 2); one(28, WS_ASGW, (size_t)NT * 2 * 4, 0); }
                if (j == 11) one(29, WS_TILE, (size_t)201 * 4, 2);
                if (j == 14) { one(30, WS_HF, (size_t)NT * DM * 4, 0); one(31, WS_HBF, (size_t)NT * DM * 2, 1); one(32, WS_RSTD0, (size_t)NT * 4, 0); }
            } else if (j == 14) one(33, (size_t)-1, (size_t)NT * DM * 4, 0);
        }
    }
    hipLaunchKernelGGL(dbg_final, dim3(1024), dim3(256), 0, stream, (const unsigned long long*)(ws + WS_DBG), (const unsigned*)(ws + WS_DBG + 2048), a.out, (size_t)NT * DM, 39);
#else
    (void)hipMemsetAsync((char*)d_ws + WS_CTL, 0, CTL_ZERO_BYTES, stream);
#if N_LAUNCH_MODE == 0
    a.ph_lo = 0; a.ph_hi = NPHASES;
    hipLaunchKernelGGL(fwd, dim3(grid), dim3(512), LDS_BYTES, stream, a);
#else
    for (int p = 0; p < NPHASES; ++p) { a.ph_lo = p; a.ph_hi = p + 1; hipLaunchKernelGGL(fwd, dim3(grid), dim3(512), LDS_BYTES, stream, a); }
#endif
#endif
}
```
